# Optimizing an MI355X kernel written in HIP

```python
import jax, jax.numpy as jnp
from jax import lax
import numpy as np

D_MODEL = 1024
BATCH = 8
SEQ = 2048
DEPTH = 1
DEC_BATCH = 4
DEC_SEQ = 4096
PAST_LEN = 128

D_MIX = D_MODEL
D_GMLP = D_MIX // 2
D_HGRN = D_MIX - D_GMLP
GMLP_HEADS = 4
GMLP_HEAD_DIM = D_GMLP // GMLP_HEADS
GMLP_CHUNK = 128
HGRN_HEAD_DIM = 128
HGRN_HEADS = D_HGRN // HGRN_HEAD_DIM
HGRN_CHUNK = 16
D_FF = 2816
EPS = 1e-6
D_IN = 2 * D_GMLP + 5 * D_HGRN
IN_SPLIT = (D_GMLP, 2 * D_GMLP, 2 * D_GMLP + D_HGRN, 2 * D_GMLP + 2 * D_HGRN,
            2 * D_GMLP + 3 * D_HGRN, 2 * D_GMLP + 4 * D_HGRN)

kernel_name = "hybrid_gmlp_hgrn2_macaron_encoder"


def rms_norm(x, gain):
    xf = x.astype(jnp.float32)
    y = xf * lax.rsqrt(jnp.mean(xf * xf, axis=-1, keepdims=True) + EPS)
    return (y * gain.astype(jnp.float32)).astype(x.dtype)


def layer_norm(x, gain, bias):
    xf = x.astype(jnp.float32)
    mu = jnp.mean(xf, axis=-1, keepdims=True)
    xc = xf - mu
    y = xc * lax.rsqrt(jnp.mean(xc * xc, axis=-1, keepdims=True) + EPS)
    return (y * gain.astype(jnp.float32) + bias.astype(jnp.float32)).astype(x.dtype)


def swiglu(x, w_gate, w_up, w_down):
    return (jax.nn.silu(x @ w_gate) * (x @ w_up)) @ w_down


def gmlp_mixer(u, v, ln_g, ln_b, w_s, b_s):
    B, L, _ = v.shape
    v = layer_norm(v, ln_g, ln_b)
    vc = v.reshape(B, L // GMLP_CHUNK, GMLP_CHUNK, GMLP_HEADS, GMLP_HEAD_DIM)
    mixed = jnp.einsum('hts,bcshd->bcthd', w_s, vc) + b_s.T[None, None, :, :, None]
    return u * mixed.reshape(B, L, D_GMLP)


def hgrn2_chunkwise(q, k, v, log_f):
    B, L, H, DK = q.shape
    DV = v.shape[-1]
    C = HGRN_CHUNK
    n = L // C
    q, k, v, log_f = (t.reshape(B, n, C, H, t.shape[-1]) for t in (q, k, v, log_f))
    a = jnp.cumsum(log_f, axis=2)
    a_last = a[:, :, -1]
    lower = jnp.tril(jnp.ones((C, C), dtype=bool))[None, None, :, :, None, None]
    diff = a[:, :, :, None] - a[:, :, None, :]
    decay = jnp.exp(jnp.where(lower, diff, -jnp.inf))
    scores = jnp.einsum('bnthk,bnshk,bntshk->bnhts', q, k, decay)
    o_intra = jnp.einsum('bnhts,bnshv->bnthv', scores, v)
    chunk_kv = jnp.einsum('bnshk,bnshv->bnhkv', k * jnp.exp(a_last[:, :, None] - a), v)
    chunk_decay = jnp.exp(a_last)

    def step(S, inp):
        dec, kv = inp
        return dec[..., None] * S + kv, S

    S0 = jnp.zeros((B, H, DK, DV), jnp.float32)
    _, S_start = lax.scan(step, S0, (jnp.moveaxis(chunk_decay, 1, 0), jnp.moveaxis(chunk_kv, 1, 0)))
    S_start = jnp.moveaxis(S_start, 0, 1)
    o_inter = jnp.einsum('bnthk,bnhkv->bnthv', q * jnp.exp(a), S_start)
    return (o_intra + o_inter).reshape(B, L, H, DV)


def hgrn2_mixer(q_raw, i_raw, f_fwd_raw, f_bwd_raw, g_raw, lb_fwd, lb_bwd, out_norm):
    B, L, _ = q_raw.shape
    heads = lambda t: t.astype(jnp.float32).reshape(B, L, HGRN_HEADS, HGRN_HEAD_DIM)
    q = heads(jax.nn.silu(q_raw))
    v = heads(i_raw)

    def direction(f_raw, lb, reverse):
        lbh = lb.reshape(HGRN_HEADS, HGRN_HEAD_DIM)
        f = lbh + (1.0 - lbh) * jax.nn.sigmoid(heads(f_raw))
        k = 1.0 - f
        log_f = jnp.log(f)
        if reverse:
            qd, kd, vd, lfd = (jnp.flip(t, axis=1) for t in (q, k, v, log_f))
            return jnp.flip(hgrn2_chunkwise(qd, kd, vd, lfd), axis=1)
        return hgrn2_chunkwise(q, k, v, log_f)

    o = direction(f_fwd_raw, lb_fwd, False) + direction(f_bwd_raw, lb_bwd, True)
    o = rms_norm(o, out_norm.reshape(HGRN_HEADS, HGRN_HEAD_DIM)).reshape(B, L, D_HGRN)
    return (o * jax.nn.silu(g_raw.astype(jnp.float32))).astype(q_raw.dtype)


def trunk(x, ffn1_norm, ffn1_w_gate, ffn1_w_up, ffn1_w_down, mix_norm, w_in,
          gmlp_ln_g, gmlp_ln_b, gmlp_w_s, gmlp_b_s, gmlp_out_norm,
          hgrn_lb_fwd, hgrn_lb_bwd, hgrn_out_norm, w_out,
          ffn2_norm, ffn2_w_gate, ffn2_w_up, ffn2_w_down, final_norm):
    lb_fwd_all = jnp.cumsum(jax.nn.softmax(hgrn_lb_fwd.astype(jnp.float32), axis=0), axis=0)
    lb_bwd_all = jnp.cumsum(jax.nn.softmax(hgrn_lb_bwd.astype(jnp.float32), axis=0), axis=0)
    for l in range(DEPTH):
        h = rms_norm(x, ffn1_norm[l])
        x = x + 0.5 * swiglu(h, ffn1_w_gate[l], ffn1_w_up[l], ffn1_w_down[l])
        h = rms_norm(x, mix_norm[l])
        proj = h @ w_in[l]
        u, v, q, i, f_f, f_b, g = jnp.split(proj, IN_SPLIT, axis=-1)
        y_g = gmlp_mixer(jax.nn.gelu(u, approximate=False), jax.nn.gelu(v, approximate=False),
                         gmlp_ln_g[l], gmlp_ln_b[l], gmlp_w_s[l], gmlp_b_s[l])
        y_g = rms_norm(y_g, gmlp_out_norm[l])
        y_h = hgrn2_mixer(q, i, f_f, f_b, g, lb_fwd_all[l].astype(x.dtype), lb_bwd_all[l].astype(x.dtype),
                          hgrn_out_norm[l])
        x = x + jnp.concatenate([y_g, y_h], axis=-1) @ w_out[l]
        h = rms_norm(x, ffn2_norm[l])
        x = x + 0.5 * swiglu(h, ffn2_w_gate[l], ffn2_w_up[l], ffn2_w_down[l])
    return rms_norm(x, final_norm)


def setup_inputs(seed: int = 0) -> dict:
    key = jax.random.key(seed)
    ks = jax.random.split(key, 24)
    nrm = lambda k, shape, scale: jax.random.normal(k, shape, jnp.float32) * scale
    gain = lambda k, shape: 1.0 + 0.02 * jax.random.normal(k, shape, jnp.float32)
    return {
        "x_prompt": nrm(ks[0], (BATCH, SEQ, D_MODEL), 1.0),
        "x_sample": nrm(ks[1], (DEC_BATCH, DEC_SEQ, D_MODEL), 1.0),
        "ffn1_norm": gain(ks[2], (DEPTH, D_MODEL)),
        "ffn1_w_gate": nrm(ks[3], (DEPTH, D_MODEL, D_FF), D_MODEL ** -0.5),
        "ffn1_w_up": nrm(ks[4], (DEPTH, D_MODEL, D_FF), D_MODEL ** -0.5),
        "ffn1_w_down": nrm(ks[5], (DEPTH, D_FF, D_MODEL), D_FF ** -0.5),
        "mix_norm": gain(ks[6], (DEPTH, D_MODEL)),
        "w_in": nrm(ks[7], (DEPTH, D_MODEL, D_IN), D_MODEL ** -0.5),
        "gmlp_ln_g": gain(ks[8], (DEPTH, D_GMLP)),
        "gmlp_ln_b": nrm(ks[9], (DEPTH, D_GMLP), 0.02),
        "gmlp_w_s": nrm(ks[10], (DEPTH, GMLP_HEADS, GMLP_CHUNK, GMLP_CHUNK), GMLP_CHUNK ** -0.5),
        "gmlp_b_s": gain(ks[11], (DEPTH, GMLP_HEADS, GMLP_CHUNK)),
        "gmlp_out_norm": gain(ks[12], (DEPTH, D_GMLP)),
        "hgrn_lb_fwd": nrm(ks[13], (DEPTH + 1, D_HGRN), 0.1),
        "hgrn_lb_bwd": nrm(ks[14], (DEPTH + 1, D_HGRN), 0.1),
        "hgrn_out_norm": gain(ks[15], (DEPTH, D_HGRN)),
        "w_out": nrm(ks[16], (DEPTH, D_MIX, D_MODEL), D_MIX ** -0.5),
        "ffn2_norm": gain(ks[17], (DEPTH, D_MODEL)),
        "ffn2_w_gate": nrm(ks[18], (DEPTH, D_MODEL, D_FF), D_MODEL ** -0.5),
        "ffn2_w_up": nrm(ks[19], (DEPTH, D_MODEL, D_FF), D_MODEL ** -0.5),
        "ffn2_w_down": nrm(ks[20], (DEPTH, D_FF, D_MODEL), D_FF ** -0.5),
        "final_norm": gain(ks[21], (D_MODEL,)),
    }


def reference(x_prompt, x_sample, ffn1_norm, ffn1_w_gate, ffn1_w_up, ffn1_w_down, mix_norm, w_in,
              gmlp_ln_g, gmlp_ln_b, gmlp_w_s, gmlp_b_s, gmlp_out_norm,
              hgrn_lb_fwd, hgrn_lb_bwd, hgrn_out_norm, w_out,
              ffn2_norm, ffn2_w_gate, ffn2_w_up, ffn2_w_down, final_norm):
    y_prompt = trunk(x_prompt, ffn1_norm, ffn1_w_gate, ffn1_w_up, ffn1_w_down, mix_norm, w_in,
                     gmlp_ln_g, gmlp_ln_b, gmlp_w_s, gmlp_b_s, gmlp_out_norm,
                     hgrn_lb_fwd, hgrn_lb_bwd, hgrn_out_norm, w_out,
                     ffn2_norm, ffn2_w_gate, ffn2_w_up, ffn2_w_down, final_norm)
    y_sample = trunk(x_sample, ffn1_norm, ffn1_w_gate, ffn1_w_up, ffn1_w_down, mix_norm, w_in,
                     gmlp_ln_g, gmlp_ln_b, gmlp_w_s, gmlp_b_s, gmlp_out_norm,
                     hgrn_lb_fwd, hgrn_lb_bwd, hgrn_out_norm, w_out,
                     ffn2_norm, ffn2_w_gate, ffn2_w_up, ffn2_w_down, final_norm)
    return (y_prompt, y_sample)
```

```cpp
#define DBG_NAIVE_HGRN 1
#include <hip/hip_runtime.h>
#include <cstdio>
#include <cstdint>
namespace pg8 {
#define PG8_LAS __attribute__((address_space(3)))
typedef unsigned short bf16_t;
typedef short bf16x8 __attribute__((ext_vector_type(8)));
typedef float f32x4 __attribute__((ext_vector_type(4)));
typedef unsigned u32x4 __attribute__((ext_vector_type(4)));
constexpr int BM = 256, BK = 64, HALF = 128, HTB = HALF * BK * 2  , STAGE_BYTES = 8 * HTB, NXCD = 8, WGM = 8;

__host__ __device__ __forceinline__ int lds_byte(int r, int c) { const int st = (r >> 4) * 2 + (c >> 5), rr = r & 15, cc = c & 31, ob = rr * 64 + cc * 2; return st * 1024 + (ob ^ (((ob >> 9) & 1) << 5)); }
__host__ __device__ __forceinline__ void stage_rc(int b, int& R, int& C) { const int st = b / 1024, sb = b % 1024, swz = sb ^ (((sb >> 9) & 1) << 5); R = (st >> 1) * 16 + swz / 64; C = (st & 1) * 32 + (swz % 64) / 2; }
__host__ __device__ __forceinline__ int perm32(int rho) { const int n = rho >> 4, i = rho & 15; return 8 * (i >> 2) + 4 * n + (i & 3); }

struct Unit { int pm, pn; };
struct Gemm { const bf16_t* A; const bf16_t* Bt; int M, N, K; };

struct StaticOrder {
    int nM, nN, nwg, G, c;
    __host__ __device__ void init(int M, int N, int G_, int c_) { nM = M / BM; nN = N / BM; nwg = nM * nN; G = G_; c = c_; }
    __host__ __device__ bool next(int i, Unit& u) const {
        const long L = (long)i * G + c; if (L >= nwg) return false;
        int wgid = (int)L; { const int q = nwg / NXCD, r = nwg % NXCD, xcd = wgid % NXCD, off = wgid / NXCD; wgid = (xcd < r ? xcd * (q + 1) : r * (q + 1) + (xcd - r) * q) + off; }
        const int nig = WGM * nN, gid = wgid / nig, fm = gid * WGM, gsz = (nM - fm) < WGM ? (nM - fm) : WGM;
        u.pm = fm + ((wgid % nig) % gsz); u.pn = (wgid % nig) / gsz; return true;
    }
    __device__ __forceinline__ void a_ready(const Unit&) const {}
    __device__ __forceinline__ void done(const Unit&) const {}
};

typedef __bf16 bf16x2_hw __attribute__((ext_vector_type(2)));
typedef float f32x2_hw __attribute__((ext_vector_type(2)));
__device__ __forceinline__ unsigned cvt_pk_bf16(float lo, float hi) { const f32x2_hw v = {lo, hi}; const bf16x2_hw b = __builtin_convertvector(v, bf16x2_hw); return __builtin_bit_cast(unsigned, b); }
typedef float f32x2 __attribute__((ext_vector_type(2)));
__device__ __forceinline__ f32x2 gelu_pk(f32x2 v) {
    const f32x2 av = __builtin_elementwise_abs(v), d = av * 0.2316418882f + 1.0f;
    f32x2 t; t.x = __builtin_amdgcn_rcpf(d.x); t.y = __builtin_amdgcn_rcpf(d.y);
    f32x2 q = t * 0.5307027145f + (-0.7265760135f); q = q * t + 0.7107068705f; q = q * t + (-0.142248368f); q = q * t + 0.127414796f; q = q * t;
    const f32x2 s = (v * v) * (-0.72134752044f);
    f32x2 e; e.x = __builtin_amdgcn_exp2f(s.x); e.y = __builtin_amdgcn_exp2f(s.y);
    const f32x2 m = v * (q * e), r = v - m;
    f32x2 o; o.x = v.x < 0.f ? m.x : r.x; o.y = v.y < 0.f ? m.y : r.y; return o;
}

constexpr float RMS_EPS = 1e-6f;
constexpr int DM = 1024;
__device__ __forceinline__ float row_rstd(const float* p16, int row, int fq) {
    const f32x4 v = *(const f32x4*)(p16 + (size_t)row * 16 + 4 * fq);
    float s = (v[0] + v[1]) + (v[2] + v[3]);
    s += __shfl_xor(s, 16); s += __shfl_xor(s, 32);
    return __builtin_amdgcn_rsqf(s * (1.0f / DM) + RMS_EPS);
}
__device__ __forceinline__ float fast_sigmoid(float z) { return __builtin_amdgcn_rcpf(1.0f + __builtin_amdgcn_exp2f(-1.44269504089f * z)); }

struct EpiSwiGLU {
    static constexpr bool PERM = true, AFTER_DRAIN = false;
    bf16_t* O; int ldo; const float* p16;
    __device__ __forceinline__ void operator()(const f32x4 (&acc)[2][2][4][2], const Unit& u, int wr, int wc, int fr, int fq) const {
        const int row0 = u.pm * BM + wr * 64 + fr, col0 = u.pn * HALF + wc * 32 + 8 * fq;
#pragma unroll
        for (int ai = 0; ai < 2; ++ai)
#pragma unroll
            for (int m = 0; m < 4; ++m) {
                const int row = row0 + ai * HALF + m * 16;
                const float r = row_rstd(p16, row, fq);
                float h[8];
#pragma unroll
                for (int n = 0; n < 2; ++n)
#pragma unroll
                    for (int e = 0; e < 4; ++e) { const float g = acc[ai][0][m][n][e] * r, up = acc[ai][1][m][n][e] * r; h[4 * n + e] = g * up * fast_sigmoid(g); }
                u32x4 w; w.x = cvt_pk_bf16(h[0], h[1]); w.y = cvt_pk_bf16(h[2], h[3]); w.z = cvt_pk_bf16(h[4], h[5]); w.w = cvt_pk_bf16(h[6], h[7]);
                *(u32x4*)(O + (size_t)row * ldo + col0) = w;
            }
    }
};

template <bool WANT_BF16, bool WANT_SS> struct EpiResid {
    static constexpr bool PERM = true, AFTER_DRAIN = false;
    const float* base0; const float* base1;
    float* out; bf16_t* xb; float* p16; float alpha;
    __device__ __forceinline__ void operator()(const f32x4 (&acc)[2][2][4][2], const Unit& u, int wr, int wc, int fr, int fq) const {
        const int row0 = u.pm * BM + wr * 64 + fr, col0 = u.pn * BM + wc * 32 + 8 * fq;
        const float* bp = (u.pm < 64) ? base0 : base1; const int brow = (u.pm < 64) ? 0 : 16384;
#pragma unroll
        for (int ai = 0; ai < 2; ++ai)
#pragma unroll
            for (int m = 0; m < 4; ++m) {
                const int row = row0 + ai * HALF + m * 16; const size_t off = (size_t)row * DM + col0, boff = (size_t)(row - brow) * DM + col0;
                float ss = 0.f;
#pragma unroll
                for (int bj = 0; bj < 2; ++bj) {
                    const f32x4 b0 = *(const f32x4*)(bp + boff + bj * HALF), b1 = *(const f32x4*)(bp + boff + bj * HALF + 4);
                    const f32x4 v0 = b0 + acc[ai][bj][m][0] * alpha, v1 = b1 + acc[ai][bj][m][1] * alpha;
                    *(f32x4*)(out + off + bj * HALF) = v0; *(f32x4*)(out + off + bj * HALF + 4) = v1;
                    if (WANT_BF16) { u32x4 w; w.x = cvt_pk_bf16(v0[0], v0[1]); w.y = cvt_pk_bf16(v0[2], v0[3]); w.z = cvt_pk_bf16(v1[0], v1[1]); w.w = cvt_pk_bf16(v1[2], v1[3]);
                        *(u32x4*)(xb + off + bj * HALF) = w; }
                    if (WANT_SS) ss += ((v0[0] * v0[0] + v0[1] * v0[1]) + (v0[2] * v0[2] + v0[3] * v0[3])) + ((v1[0] * v1[0] + v1[1] * v1[1]) + (v1[2] * v1[2] + v1[3] * v1[3]));
                }
                if (WANT_SS) { ss += __shfl_xor(ss, 16); ss += __shfl_xor(ss, 32); if (fq == 0) p16[(size_t)row * 16 + 4 * u.pn + wc] = ss; }
                asm volatile("" ::: "memory");
            }
    }
};

struct EpiMix {
    static constexpr bool PERM = true, AFTER_DRAIN = false;
    bf16_t* P; int ldp; const float* p16; const float* lbf; const float* lbb;
    template <int ACT> __device__ __forceinline__ void run(const f32x4 (&acc)[2][2][4][2], const Unit& u, int wr, int wc, int fr, int fq) const {
        const int row0 = u.pm * BM + wr * 64 + fr, col0 = u.pn * BM + wc * 32 + 8 * fq;
        float oml[2][8];
        if (ACT == 3) { const float* lb = ((u.pn >> 1) == 4) ? lbf : lbb; const int c0 = (u.pn & 1) * BM + wc * 32 + 8 * fq;
#pragma unroll
            for (int bj = 0; bj < 2; ++bj)
#pragma unroll
                for (int e = 0; e < 8; ++e) { const float a0 = lb[c0 + bj * HALF + e], a1 = lb[512 + c0 + bj * HALF + e]; oml[bj][e] = fast_sigmoid(a1 - a0);
#ifdef DBG_OML
                    oml[bj][e] = 0.5f;
#endif
                } }
#pragma unroll
        for (int ai = 0; ai < 2; ++ai)
#pragma unroll
            for (int m = 0; m < 4; ++m) {
                const int row = row0 + ai * HALF + m * 16;
                const float r = row_rstd(p16, row, fq);
#pragma unroll
                for (int bj = 0; bj < 2; ++bj) {
                    float h[8];
#pragma unroll
                    for (int n = 0; n < 2; ++n) {
                        const f32x4 z = acc[ai][bj][m][n] * r;
                        if (ACT == 0) { const f32x2 a = gelu_pk((f32x2){z[0], z[1]}), b = gelu_pk((f32x2){z[2], z[3]}); h[4 * n] = a.x; h[4 * n + 1] = a.y; h[4 * n + 2] = b.x; h[4 * n + 3] = b.y; }
                        else if (ACT == 1) {
#pragma unroll
                            for (int e = 0; e < 4; ++e) h[4 * n + e] = z[e] * fast_sigmoid(z[e]); }
                        else if (ACT == 2) {
#pragma unroll
                            for (int e = 0; e < 4; ++e) h[4 * n + e] = z[e]; }
                        else {
#pragma unroll
                            for (int e = 0; e < 4; ++e) { const float kk = oml[bj][4 * n + e] * __builtin_amdgcn_rcpf(1.0f + __builtin_amdgcn_exp2f(1.44269504089f * z[e]));
                                h[4 * n + e] = __builtin_amdgcn_logf(1.0f - kk); }
                        }
                    }
                    u32x4 w; w.x = cvt_pk_bf16(h[0], h[1]); w.y = cvt_pk_bf16(h[2], h[3]); w.z = cvt_pk_bf16(h[4], h[5]); w.w = cvt_pk_bf16(h[6], h[7]);
                    *(u32x4*)(P + (size_t)row * ldp + col0 + bj * HALF) = w;
                }
            }
    }
    __device__ __forceinline__ void operator()(const f32x4 (&acc)[2][2][4][2], const Unit& u, int wr, int wc, int fr, int fq) const {
        const int seg = u.pn >> 1;
        if (seg <= 1) run<0>(acc, u, wr, wc, fr, fq);
        else if (seg == 2 || seg == 6) run<1>(acc, u, wr, wc, fr, fq);
        else if (seg == 3) run<2>(acc, u, wr, wc, fr, fq);
        else run<3>(acc, u, wr, wc, fr, fq);
    }
};

template <class Epi, class Sched, bool ALIGN_EPI = false, bool SP2 = false>
__device__ __forceinline__ void gemm_phase(PG8_LAS unsigned char* lds, const Gemm g, const Sched& S, const Epi& E) {
    const int tid = threadIdx.x, wid = __builtin_amdgcn_readfirstlane(tid >> 6), lane = tid & 63, wr = wid >> 2, wc = wid & 3, fr = lane & 15, fq = lane >> 4;
    const int K = g.K, nt = K / BK;
    unsigned voffA[2], voffB[2];
#pragma unroll
    for (int i = 0; i < 2; ++i) { int R, C; stage_rc(tid * 16 + i * 8192, R, C); const int Rb = Epi::PERM ? ((R & ~31) + perm32(R & 31)) : R;
        voffA[i] = (unsigned)(R * K + C) * 2u; voffB[i] = (unsigned)(Rb * K + C) * 2u; }
    const size_t kstep = (size_t)(BK * 2);
    const size_t hstep = (size_t)HALF * K * 2;
    const size_t tstep = 2 * hstep;
    const unsigned ldsw = (unsigned)wid * 1024u;
    const int aoff = lds_byte(wr * 64 + fr, fq * 8), boff = lds_byte(wc * 32 + fr, fq * 8);
#define PG8_SA(b, h) (((b) * 2 + (h)) * HTB)
#define PG8_SB(b, h) ((4 + (b) * 2 + (h)) * HTB)
#define PG8_STAGE(bufoff, gbase, voff) do { _Pragma("unroll") for (int _i = 0; _i < 2; ++_i) \
        __builtin_amdgcn_global_load_lds((const unsigned*)((const char*)(gbase) + (voff)[_i]), (PG8_LAS unsigned*)(lds + (bufoff) + ldsw + _i * 8192), 16, 0, 0); } while (0)
#define PG8_LDA(dst, b, h) do { _Pragma("unroll") for (int m = 0; m < 4; ++m) _Pragma("unroll") for (int k = 0; k < 2; ++k) dst[m][k] = *(const PG8_LAS bf16x8*)(lds + PG8_SA(b, h) + aoff + m * 2048 + k * 1024); } while (0)
#define PG8_LDB(dst, b, h) do { _Pragma("unroll") for (int n = 0; n < 2; ++n) _Pragma("unroll") for (int k = 0; k < 2; ++k) dst[n][k] = *(const PG8_LAS bf16x8*)(lds + PG8_SB(b, h) + boff + n * 2048 + k * 1024); } while (0)
#define PG8_MMA(ai, bj, At, Bt) do { __builtin_amdgcn_s_setprio(1); _Pragma("unroll") for (int m = 0; m < 4; ++m) _Pragma("unroll") for (int n = 0; n < 2; ++n) _Pragma("unroll") for (int k = 0; k < 2; ++k) \
        acc[ai][bj][m][n] = __builtin_amdgcn_mfma_f32_16x16x32_bf16(Bt[n][k], At[m][k], acc[ai][bj][m][n], 0, 0, 0); __builtin_amdgcn_s_setprio(0); } while (0)
#define PG8_WAIT_V(n) asm volatile("s_waitcnt vmcnt(" #n ")" ::: "memory")
#define PG8_WAIT_L(n) asm volatile("s_waitcnt lgkmcnt(" #n ")" ::: "memory")
#define PG8_BAR __builtin_amdgcn_s_barrier()
#define PG8_SCHED __builtin_amdgcn_sched_barrier(0)
    Unit cur, nxt; int ui = 0;
    if (!S.next(0, cur)) return;
    f32x4 acc[2][2][4][2];
#pragma unroll
    for (int a = 0; a < 2; ++a)
#pragma unroll
        for (int b = 0; b < 2; ++b)
#pragma unroll
            for (int m = 0; m < 4; ++m)
#pragma unroll
                for (int n = 0; n < 2; ++n) acc[a][b][m][n] = (f32x4){0.f, 0.f, 0.f, 0.f};
    bf16x8 At[4][2], B0[2][2], B1[2][2];
    const char* cA = (const char*)g.A + (size_t)cur.pm * tstep; const char* cB = (const char*)g.Bt + (size_t)cur.pn * tstep;
    S.a_ready(cur);
    if constexpr (SP2) {
        PG8_STAGE(PG8_SB(0, 0), cB, voffB); PG8_STAGE(PG8_SB(0, 1), cB + hstep, voffB); PG8_STAGE(PG8_SA(0, 0), cA, voffA); PG8_STAGE(PG8_SA(0, 1), cA + hstep, voffA);
        if (wr == 1) PG8_BAR;
        PG8_WAIT_V(2); PG8_BAR;
        PG8_STAGE(PG8_SB(1, 0), cB + kstep, voffB); PG8_STAGE(PG8_SA(1, 0), cA + kstep, voffA); PG8_STAGE(PG8_SB(1, 1), cB + hstep + kstep, voffB);
        PG8_WAIT_V(6); PG8_BAR;
    } else {
        PG8_STAGE(PG8_SB(0, 0), cB, voffB); PG8_STAGE(PG8_SA(0, 0), cA, voffA); PG8_STAGE(PG8_SB(0, 1), cB + hstep, voffB); PG8_STAGE(PG8_SA(0, 1), cA + hstep, voffA);
        if (wr == 1) PG8_BAR;
        PG8_WAIT_V(4); PG8_BAR;
        PG8_STAGE(PG8_SB(1, 0), cB + kstep, voffB); PG8_STAGE(PG8_SA(1, 0), cA + kstep, voffA); PG8_STAGE(PG8_SB(1, 1), cB + hstep + kstep, voffB);
        PG8_WAIT_V(6); PG8_BAR;
    }
    for (;;) {
        const bool has_next = S.next(ui + 1, nxt);
        const char* nA = has_next ? (const char*)g.A + (size_t)nxt.pm * tstep : cA; const char* nB = has_next ? (const char*)g.Bt + (size_t)nxt.pn * tstep : cB;
        for (int t = 0; t < nt; t += 2) {
            const bool last = (t == nt - 2);
            const char* a1 = cA + (size_t)(t + 1) * kstep;
            const char* a2 = last ? nA : cA + (size_t)(t + 2) * kstep; const char* b2 = last ? nB : cB + (size_t)(t + 2) * kstep;
            const char* a3 = a2 + kstep; const char* b3 = b2 + kstep;
            if (last && has_next) S.a_ready(nxt);
            if constexpr (SP2) {
            PG8_LDB(B0, 0, 0); PG8_LDB(B1, 0, 1); PG8_SCHED; PG8_LDA(At, 0, 0); PG8_STAGE(PG8_SA(1, 1), a1 + hstep, voffA);
            PG8_WAIT_V(8); PG8_WAIT_L(0); PG8_BAR; PG8_MMA(0, 0, At, B0); PG8_MMA(0, 1, At, B1); PG8_BAR; PG8_SCHED;
            PG8_LDA(At, 0, 1); PG8_STAGE(PG8_SB(0, 0), b2, voffB); PG8_STAGE(PG8_SB(0, 1), b2 + hstep, voffB); PG8_STAGE(PG8_SA(0, 0), a2, voffA);
            PG8_WAIT_V(8); PG8_WAIT_L(0); PG8_BAR; PG8_MMA(1, 0, At, B0); PG8_MMA(1, 1, At, B1); PG8_BAR; PG8_SCHED;
            PG8_LDB(B0, 1, 0); PG8_LDB(B1, 1, 1); PG8_SCHED; PG8_LDA(At, 1, 0); PG8_STAGE(PG8_SA(0, 1), a2 + hstep, voffA);
            PG8_WAIT_V(8); PG8_WAIT_L(0); PG8_BAR; PG8_MMA(0, 0, At, B0); PG8_MMA(0, 1, At, B1); PG8_BAR; PG8_SCHED;
            PG8_LDA(At, 1, 1); PG8_STAGE(PG8_SB(1, 0), b3, voffB); PG8_STAGE(PG8_SB(1, 1), b3 + hstep, voffB); PG8_STAGE(PG8_SA(1, 0), a3, voffA);
            PG8_WAIT_V(8); PG8_WAIT_L(0); PG8_BAR; PG8_MMA(1, 0, At, B0); PG8_MMA(1, 1, At, B1); PG8_BAR; PG8_SCHED;
            } else {
            PG8_LDB(B0, 0, 0); PG8_SCHED; PG8_LDA(At, 0, 0); PG8_STAGE(PG8_SA(1, 1), a1 + hstep, voffA);
            PG8_WAIT_L(8); PG8_BAR; PG8_WAIT_L(0); PG8_MMA(0, 0, At, B0); PG8_BAR; PG8_SCHED;
            PG8_LDB(B1, 0, 1); PG8_STAGE(PG8_SB(0, 0), b2, voffB);
            PG8_BAR; PG8_WAIT_L(0); PG8_MMA(0, 1, At, B1); PG8_BAR;
            PG8_LDA(At, 0, 1); PG8_STAGE(PG8_SA(0, 0), a2, voffA);
            PG8_BAR; PG8_WAIT_L(0); PG8_MMA(1, 0, At, B0); PG8_BAR; PG8_SCHED;
            PG8_STAGE(PG8_SB(0, 1), b2 + hstep, voffB);
            PG8_WAIT_V(6); PG8_BAR; PG8_MMA(1, 1, At, B1); PG8_BAR;
            PG8_LDB(B0, 1, 0); PG8_SCHED; PG8_LDA(At, 1, 0); PG8_STAGE(PG8_SA(0, 1), a2 + hstep, voffA);
            PG8_WAIT_L(8); PG8_BAR; PG8_WAIT_L(0); PG8_MMA(0, 0, At, B0); PG8_BAR; PG8_SCHED;
            PG8_LDB(B1, 1, 1); PG8_STAGE(PG8_SB(1, 0), b3, voffB);
            PG8_BAR; PG8_WAIT_L(0); PG8_MMA(0, 1, At, B1); PG8_BAR;
            PG8_LDA(At, 1, 1); PG8_STAGE(PG8_SA(1, 0), a3, voffA);
            PG8_BAR; PG8_WAIT_L(0); PG8_MMA(1, 0, At, B0); PG8_BAR; PG8_SCHED;
            PG8_STAGE(PG8_SB(1, 1), b3 + hstep, voffB);
            PG8_WAIT_V(6); PG8_BAR; PG8_MMA(1, 1, At, B1); PG8_BAR;
            }
        }
        if constexpr (ALIGN_EPI) { if (wr == 0) PG8_BAR; }
        if constexpr (!Epi::AFTER_DRAIN) { E(acc, cur, wr, wc, fr, fq); S.done(cur); }
        if (!has_next) break;
#pragma unroll
        for (int a = 0; a < 2; ++a)
#pragma unroll
            for (int b = 0; b < 2; ++b)
#pragma unroll
                for (int m = 0; m < 4; ++m)
#pragma unroll
                    for (int n = 0; n < 2; ++n) acc[a][b][m][n] = (f32x4){0.f, 0.f, 0.f, 0.f};
        cur = nxt; cA = nA; cB = nB; ++ui;
        if constexpr (ALIGN_EPI) { if (wr == 1) PG8_BAR; }
    }
    PG8_WAIT_V(0);
    if constexpr (!ALIGN_EPI) { if (wr == 0) PG8_BAR; }
    PG8_BAR;
    if constexpr (Epi::AFTER_DRAIN) { E.fused(acc, cur, wr, wc, fr, fq, lds, wid, lane); S.done(cur); }
#undef PG8_SA
#undef PG8_SB
#undef PG8_STAGE
#undef PG8_LDA
#undef PG8_LDB
#undef PG8_MMA
#undef PG8_WAIT_V
#undef PG8_WAIT_L
#undef PG8_BAR
#undef PG8_SCHED
}
}

#ifndef PG8_SP2
#define PG8_SP2 true
#endif
#ifndef PG8_ALIGN
#define PG8_ALIGN true
#endif
constexpr int NWAVES = 8;
constexpr int TOK = 32768, NPROMPT = 16384;
constexpr int DMODEL = 1024, DFF = 2816, DIN = 3584;
constexpr int COL_U = 0, COL_V = 512, COL_Q = 1024, COL_I = 1536, COL_FF = 2048, COL_FB = 2560, COL_G = 3072;
constexpr float EPS = 1e-6f;
constexpr size_t MiB = 1u << 20;
constexpr size_t WS_CTL = 0, CTL_ZERO_BYTES = 1 * MiB;
constexpr size_t WS_SSG = 1 * MiB;
constexpr size_t WS_P16 = 2 * MiB;
constexpr size_t WS_WGU1 = 8 * MiB, WS_WD1 = 19 * MiB, WS_WIN = 25 * MiB, WS_WOUT = 32 * MiB, WS_WGU2 = 34 * MiB, WS_WD2 = 45 * MiB;
constexpr size_t WS_BUFA = 52 * MiB;
constexpr size_t WS_BUFB = 116 * MiB;
constexpr size_t WS_BIG = 180 * MiB;
constexpr size_t WS_OB1 = 404 * MiB;
constexpr size_t WS_END = 468 * MiB;
static_assert(WS_WGU1 + (size_t)2 * DFF * DMODEL * 2 <= WS_WD1 && WS_WD1 + (size_t)DMODEL * DFF * 2 <= WS_WIN && WS_WIN + (size_t)DIN * DMODEL * 2 <= WS_WOUT && WS_WOUT + (size_t)DMODEL * DMODEL * 2 <= WS_WGU2
              && WS_WGU2 + (size_t)2 * DFF * DMODEL * 2 <= WS_WD2 && WS_WD2 + (size_t)DMODEL * DFF * 2 <= WS_BUFA && WS_BUFA + (size_t)TOK * DMODEL * 2 <= WS_BUFB && WS_BUFB + (size_t)TOK * DMODEL * 2 <= WS_BIG
              && WS_BIG + (size_t)TOK * DIN * 2 <= WS_OB1 && WS_OB1 + (size_t)TOK * 512 * 4 <= WS_END && WS_P16 + 3 * 2 * MiB <= WS_WGU1, "d_ws map");
constexpr int CW_BAR = 4096;
constexpr int RING_OFF = 0, RING_BYTES = 131072;
constexpr int LDSCTL_OFF = RING_BYTES, MISC_OFF = LDSCTL_OFF + 320;
constexpr int LDS_BYTES = 147456;
static_assert(MISC_OFF + 128 <= LDS_BYTES, "LDS map");

#define GAS __attribute__((address_space(1)))
#define LAS __attribute__((address_space(3)))
typedef unsigned short bf16;
typedef unsigned v4u __attribute__((ext_vector_type(4)));
typedef float f32x4 __attribute__((ext_vector_type(4)));
typedef short bf16x8 __attribute__((ext_vector_type(8)));
typedef GAS unsigned gu32;
typedef GAS unsigned long long gu64;
#define RLX_AGENT __ATOMIC_RELAXED, __HIP_MEMORY_SCOPE_AGENT
#define LDS_WAIT() asm volatile("s_waitcnt lgkmcnt(0)" ::: "memory")
#define VM_WAIT() asm volatile("s_waitcnt vmcnt(0)" ::: "memory")
__device__ __forceinline__ unsigned long long rt() { return __builtin_amdgcn_s_memrealtime(); }
__device__ __forceinline__ unsigned f2bf(float f) { unsigned u = __builtin_bit_cast(unsigned, f); return (u + 0x7fffu + ((u >> 16) & 1u)) >> 16; }
__device__ __forceinline__ unsigned pk2(float lo, float hi) { return f2bf(lo) | (f2bf(hi) << 16); }

#define XB_TMO      128
#define XB_XCNT(j)  (256  + 64 * (j))
#define XB_XSUB(j)  (1280 + 64 * (j))
#define XB_XGEN(j)  (2304 + 64 * (j))
#define XB_TOP      3328
#define XB_TOPGEN   3392
#define XCD_BAR_WORDS 3456
#define XB_SPIN_CAP (1u << 18)

__device__ __forceinline__ unsigned xb_ld(unsigned* p)              { return __hip_atomic_load(p, __ATOMIC_RELAXED, __HIP_MEMORY_SCOPE_AGENT); }
__device__ __forceinline__ unsigned xb_add(unsigned* p, unsigned v) { return __hip_atomic_fetch_add(p, v, __ATOMIC_RELAXED, __HIP_MEMORY_SCOPE_AGENT); }
__device__ __forceinline__ unsigned xb_xcc_id() { return (unsigned)__builtin_amdgcn_s_getreg((3 << 11) | 20) & 0xFu; }
#define XB_SPIN(cond, bar) do { unsigned _sp = 0; while (cond) { __builtin_amdgcn_s_sleep(1); \
    if ((++_sp & 255u) == 0u) { if (xb_ld(&(bar)[XB_TMO])) break; if (_sp > XB_SPIN_CAP) { atomicAdd(&(bar)[XB_TMO], 1u); break; } } } } while (0)

struct XcdBarrier {
    unsigned* bar; unsigned x;
    volatile LAS unsigned* st;
};

__device__ __forceinline__ XcdBarrier xcd_barrier_post(unsigned* bar, volatile LAS unsigned* st) {
    XcdBarrier b; b.bar = bar; b.x = xb_xcc_id(); b.st = st;
    if (threadIdx.x == 0) (void)xb_add(&bar[XB_XCNT(b.x)], 1u);
    return b;
}
__device__ __forceinline__ void xcd_barrier_complete(unsigned* bar, unsigned x, unsigned& nloc, unsigned& nx) {
    const unsigned G = gridDim.x * gridDim.y * gridDim.z;
    unsigned sum, cnt, mine, sp = 0u;
    for (;;) {
        sum = 0u; cnt = 0u; mine = 0u;
#pragma unroll
        for (unsigned j = 0; j < 16; ++j) { const unsigned c = xb_ld(&bar[XB_XCNT(j)]); sum += c; cnt += (c > 0u) ? 1u : 0u; mine = (j == x) ? c : mine; }
        if (sum == G) break;
        __builtin_amdgcn_s_sleep(1);
        if ((++sp & 255u) == 0u) { if (xb_ld(&bar[XB_TMO])) break; if (sp > XB_SPIN_CAP) { atomicAdd(&bar[XB_TMO], 1u); break; } }
    }
    nloc = mine > 0u ? mine : 1u; nx = cnt > 0u ? cnt : 1u;
}

__device__ __forceinline__ void xcd_barrier(const XcdBarrier& b) {
    asm volatile("s_waitcnt vmcnt(0)" ::: "memory");
    __syncthreads();
    if (threadIdx.x == 0) {
        unsigned* bar = b.bar;
        __builtin_amdgcn_s_waitcnt(0);
        unsigned nloc = b.st[0], nx = b.st[1];
        if (nloc == 0u) { xcd_barrier_complete(bar, b.x, nloc, nx); b.st[0] = nloc; b.st[1] = nx; }
        const unsigned old = xb_add(&bar[XB_XSUB(b.x)], 1u);
        const unsigned gen = old / nloc;
        if (old + 1u == (gen + 1u) * nloc) {
            __builtin_amdgcn_fence(__ATOMIC_RELEASE, "agent");
            asm volatile("s_waitcnt vmcnt(0)" ::: "memory");
            const unsigned og = xb_add(&bar[XB_TOP], 1u);
            const unsigned tg = og / nx;
            if (og + 1u == (tg + 1u) * nx) xb_add(&bar[XB_TOPGEN], 1u);
            else XB_SPIN(xb_ld(&bar[XB_TOPGEN]) == tg, bar);
            __builtin_amdgcn_fence(__ATOMIC_ACQUIRE, "agent");
            xb_add(&bar[XB_XGEN(b.x)], 1u);
            asm volatile("s_waitcnt vmcnt(0)" ::: "memory");
        } else {
            XB_SPIN(xb_ld(&bar[XB_XGEN(b.x)]) == gen, bar);
            __builtin_amdgcn_fence(__ATOMIC_ACQUIRE, "agent");
            asm volatile("s_waitcnt vmcnt(0)" ::: "memory");
        }
    }
    __syncthreads();
}
typedef unsigned v2u __attribute__((ext_vector_type(2)));
__device__ __forceinline__ float wave_sum(float v) {
#pragma unroll
    for (int o = 1; o < 64; o <<= 1) v += __shfl_xor(v, o);
    return v;
}
__device__ __forceinline__ float bflo(unsigned w) { return __builtin_bit_cast(float, w << 16); }
__device__ __forceinline__ float bfhi(unsigned w) { return __builtin_bit_cast(float, w & 0xffff0000u); }
__device__ __forceinline__ float bf1(unsigned short h) { return __builtin_bit_cast(float, (unsigned)h << 16); }
__device__ __forceinline__ float ex2(float x) { return __builtin_amdgcn_exp2f(x); }
__device__ __forceinline__ float rsq(float x) { return __builtin_amdgcn_rsqf(x); }

__device__ __forceinline__ void p0_item(const float* W, int Nsrc, int k0, int scol0, const float* gain, bf16* WT, int K, int drow0, LAS float* scr, int lane) {
#pragma unroll 8
    for (int i = 0; i < 32; ++i) { const int kk = 2 * i + (lane >> 5); float v = W[(size_t)(k0 + kk) * Nsrc + scol0 + (lane & 31)]; if (gain) v *= gain[k0 + kk]; scr[kk * 33 + (lane & 31)] = v; }
    LDS_WAIT(); asm volatile("" ::: "memory");
    const int c = lane & 7;
#pragma unroll
    for (int j = 0; j < 4; ++j) { const int n = (lane >> 3) + 8 * j; const LAS float* s = scr + (8 * c) * 33 + n;
        v4u o; o.x = pk2(s[0 * 33], s[1 * 33]); o.y = pk2(s[2 * 33], s[3 * 33]); o.z = pk2(s[4 * 33], s[5 * 33]); o.w = pk2(s[6 * 33], s[7 * 33]);
        *(GAS v4u*)(WT + (size_t)(drow0 + n) * K + k0 + 8 * c) = o; }
    LDS_WAIT(); asm volatile("" ::: "memory");
}
__device__ __forceinline__ void p0_gu(const float* Wg, const float* Wu, const float* gain, bf16* WT, int r, LAS float* scr, int lane) {
    const int nblk = 2 * DFF / 32, kb = r / nblk, nb = r % nblk, n0 = 32 * nb, pn = n0 >> 8, bj = (n0 >> 7) & 1, j0 = n0 & 127;
    p0_item(bj ? Wu : Wg, DFF, 64 * kb, 128 * pn + j0, gain, WT, DMODEL, n0, scr, lane);
}
__device__ __forceinline__ void p0_plain(const float* W, int K, int N, const float* gain, bf16* WT, int r, LAS float* scr, int lane) {
    const int nblk = N / 32, kb = r / nblk, nb = r % nblk;
    p0_item(W, N, 64 * kb, 32 * nb, gain, WT, K, 32 * nb, scr, lane);
}
__device__ __forceinline__ void p0_prologue(LAS unsigned char* lds, const float* const* in, unsigned char* ws, int gw, int NGW, int wave, int lane) {
    LAS float* scr = (LAS float*)(lds + RING_OFF + wave * 16384);
    constexpr int I_GU = (DMODEL / 64) * (2 * DFF / 32), I_D = (DFF / 64) * (DMODEL / 32), I_IN = (DMODEL / 64) * (DIN / 32), I_OUT = (DMODEL / 64) * (DMODEL / 32);
    constexpr int NITEMS = 2 * I_GU + 2 * I_D + I_IN + I_OUT;
    for (int it = gw; it < NITEMS; it += NGW) {
        int r = it;
        if (r < I_GU) { p0_gu(in[3], in[4], in[2], (bf16*)(ws + WS_WGU1), r, scr, lane); continue; } r -= I_GU;
        if (r < I_GU) { p0_gu(in[18], in[19], in[17], (bf16*)(ws + WS_WGU2), r, scr, lane); continue; } r -= I_GU;
        if (r < I_D) { p0_plain(in[5], DFF, DMODEL, nullptr, (bf16*)(ws + WS_WD1), r, scr, lane); continue; } r -= I_D;
        if (r < I_D) { p0_plain(in[20], DFF, DMODEL, nullptr, (bf16*)(ws + WS_WD2), r, scr, lane); continue; } r -= I_D;
        if (r < I_IN) { p0_plain(in[7], DMODEL, DIN, in[6], (bf16*)(ws + WS_WIN), r, scr, lane); continue; } r -= I_IN;
        p0_plain(in[16], DMODEL, DMODEL, nullptr, (bf16*)(ws + WS_WOUT), r, scr, lane);
    }
    bf16* XB = (bf16*)(ws + WS_BUFA); float* p16 = (float*)(ws + WS_P16);
    for (int m = gw; m < TOK; m += NGW) {
        const float* xrow = m < NPROMPT ? in[0] + (size_t)m * DMODEL : in[1] + (size_t)(m - NPROMPT) * DMODEL;
        const GAS f32x4* xr = (const GAS f32x4*)xrow + lane;
        f32x4 v[4]; float s = 0.f;
#pragma unroll
        for (int j = 0; j < 4; ++j) { v[j] = xr[64 * j]; s += (v[j].x * v[j].x + v[j].y * v[j].y) + (v[j].z * v[j].z + v[j].w * v[j].w); }
        s = wave_sum(s);
        GAS v2u* o8 = (GAS v2u*)(XB + (size_t)m * DMODEL) + lane;
#pragma unroll
        for (int j = 0; j < 4; ++j) { v2u w; w.x = pk2(v[j].x, v[j].y); w.y = pk2(v[j].z, v[j].w); o8[64 * j] = w; }
        if (lane < 16) p16[(size_t)m * 16 + lane] = lane == 0 ? s : 0.f;
    }
}

__device__ __forceinline__ void final_norm(float* out, const float* gfin, int gw, int NGW, int lane) {
    for (int m = gw; m < TOK; m += NGW) {
        GAS f32x4* xr = (GAS f32x4*)(out + (size_t)m * DMODEL) + lane;
        f32x4 v[4]; float s = 0.f;
#pragma unroll
        for (int j = 0; j < 4; ++j) { v[j] = xr[64 * j]; s += (v[j].x * v[j].x + v[j].y * v[j].y) + (v[j].z * v[j].z + v[j].w * v[j].w); }
        const float r = rsq(wave_sum(s) * (1.0f / DMODEL) + EPS);
#pragma unroll
        for (int j = 0; j < 4; ++j) { const f32x4 g = *((const GAS f32x4*)gfin + lane + 64 * j); xr[64 * j] = v[j] * r * g; }
    }
}

constexpr int HG_RAWLF = 0, HG_RAWQ = 17408, HG_QN = 34816, HG_KN = 52224, HG_KT = 69632, HG_VT = 88064, HG_SCL = 97280, HG_ST = 106496, HG_SEG = 115200, HG_SA = 119296, HG_SB = 119808, HG_END = 120320;
static_assert(HG_END <= RING_BYTES, "hgrn LDS");
__device__ __forceinline__ void hgrn_item(LAS unsigned char* lds, const bf16* P, float* ob, int row0, int L, int h, int dir, int dq, int tid, int lane, int wave) {
    const int fr = lane & 15, fq = lane >> 4, nch = L >> 6;
    const bf16* gq = P + COL_Q + h * 128;
    const bf16* gl = P + (dir ? COL_FB : COL_FF) + h * 128;
    const bf16* gv = P + COL_I + h * 128 + dq * 32;
    float* go = ob + h * 128 + dq * 32;
    const int lr = tid >> 4, lc = tid & 15, lp = (tid >> 2) & 31, vc = tid & 3, cp = lane, s8 = wave;
#define TOKROW(n, l) (row0 + (dir ? (L - 1 - (64 * (n) + (l))) : (64 * (n) + (l))))
#define HG_LOAD(n) do { _Pragma("unroll") for (int i_ = 0; i_ < 2; ++i_) { const size_t ro_ = (size_t)TOKROW(n, lr + 32 * i_) * DIN + 8 * lc; rl[i_] = *(const GAS v4u*)(gl + ro_); rq[i_] = *(const GAS v4u*)(gq + ro_); \
        rv[i_] = *(const GAS v4u*)(gv + (size_t)TOKROW(n, 2 * lp + i_) * DIN + 8 * vc); } } while (0)
    v4u rl[2], rq[2], rv[2];
    HG_LOAD(0);
    f32x4 S0 = {0.f, 0.f, 0.f, 0.f}, S1 = {0.f, 0.f, 0.f, 0.f};
    for (int n = 0; n < nch; ++n) {
        const int vbuf = HG_VT + (n & 1) * 4608;
#pragma unroll
        for (int i = 0; i < 2; ++i) { *(LAS v4u*)(lds + HG_RAWLF + (lr + 32 * i) * 272 + lc * 16) = rl[i]; *(LAS v4u*)(lds + HG_RAWQ + (lr + 32 * i) * 272 + lc * 16) = rq[i]; }
        if (tid < 128) {
#pragma unroll
            for (int e = 0; e < 4; ++e) { const unsigned w0 = rv[0][e], w1 = rv[1][e];
                *(LAS unsigned*)(lds + vbuf + (8 * vc + 2 * e) * 144 + lp * 4) = (w0 & 0xffffu) | (w1 << 16);
                *(LAS unsigned*)(lds + vbuf + (8 * vc + 2 * e + 1) * 144 + lp * 4) = (w0 >> 16) | (w1 & 0xffff0000u); }
        }
        if (n + 1 < nch) HG_LOAD(n + 1);
        __syncthreads();
        float lfa[8], lfb[8], ava[8], avb[8]; float runa = 0.f, runb = 0.f;
#pragma unroll
        for (int j = 0; j < 8; ++j) { const unsigned w = *(const LAS unsigned*)(lds + HG_RAWLF + (8 * s8 + j) * 272 + cp * 4);
            lfa[j] = bflo(w); lfb[j] = bfhi(w); runa += lfa[j]; runb += lfb[j]; ava[j] = runa; avb[j] = runb; }
        *(LAS v2u*)(lds + HG_SEG + (s8 * 128 + 2 * cp) * 4) = (v2u){__builtin_bit_cast(unsigned, runa), __builtin_bit_cast(unsigned, runb)};
        __syncthreads();
        {
            float sa_[8], sb_[8];
#pragma unroll
            for (int q = 0; q < 8; ++q) { const v2u w = *(const LAS v2u*)(lds + HG_SEG + (q * 128 + 2 * cp) * 4); sa_[q] = __builtin_bit_cast(float, w.x); sb_[q] = __builtin_bit_cast(float, w.y); }
            const float amida = (sa_[0] + sa_[1]) + (sa_[2] + sa_[3]), amidb = (sb_[0] + sb_[1]) + (sb_[2] + sb_[3]);
            const float atota = amida + ((sa_[4] + sa_[5]) + (sa_[6] + sa_[7])), atotb = amidb + ((sb_[4] + sb_[5]) + (sb_[6] + sb_[7]));
            float offa = -amida, offb = -amidb;
#pragma unroll
            for (int q = 0; q < 8; ++q) if (q < s8) { offa += sa_[q]; offb += sb_[q]; }
            unsigned kta[4], ktb[4];
#pragma unroll
            for (int j = 0; j < 8; ++j) {
                const float aa = offa + ava[j], ab = offb + avb[j];
                const unsigned qw = *(const LAS unsigned*)(lds + HG_RAWQ + (8 * s8 + j) * 272 + cp * 4);
                const float qta = bflo(qw) * ex2(aa), qtb = bfhi(qw) * ex2(ab);
                const float k_a = (1.0f - ex2(lfa[j])) * ex2(-aa), k_b = (1.0f - ex2(lfb[j])) * ex2(-ab);
                const unsigned kba = f2bf(k_a), kbb = f2bf(k_b);
                *(LAS unsigned*)(lds + HG_QN + (8 * s8 + j) * 272 + cp * 4) = pk2(qta, qtb);
                *(LAS unsigned*)(lds + HG_KN + (8 * s8 + j) * 272 + cp * 4) = kba | (kbb << 16);
                if (j & 1) { kta[j >> 1] |= kba << 16; ktb[j >> 1] |= kbb << 16; } else { kta[j >> 1] = kba; ktb[j >> 1] = kbb; }
            }
            *(LAS v4u*)(lds + HG_KT + (2 * cp) * 144 + s8 * 16) = (v4u){kta[0], kta[1], kta[2], kta[3]};
            *(LAS v4u*)(lds + HG_KT + (2 * cp + 1) * 144 + s8 * 16) = (v4u){ktb[0], ktb[1], ktb[2], ktb[3]};
            if (s8 == 0) { *(LAS v2u*)(lds + HG_SA + (2 * cp) * 4) = (v2u){__builtin_bit_cast(unsigned, ex2(amida)), __builtin_bit_cast(unsigned, ex2(amidb))};
                           *(LAS v2u*)(lds + HG_SB + (2 * cp) * 4) = (v2u){__builtin_bit_cast(unsigned, ex2(atota - amida)), __builtin_bit_cast(unsigned, ex2(atotb - amidb))}; }
        }
        __syncthreads();
        {
            const f32x4 sa = *(const LAS f32x4*)(lds + HG_SA + (16 * wave + 4 * fq) * 4);
            S0 = S0 * sa; S1 = S1 * sa;
#ifdef DBG_NOSTATE
            S0 = (f32x4){0.f,0.f,0.f,0.f}; S1 = S0;
#endif
            v2u w0, w1; w0.x = pk2(S0[0], S0[1]); w0.y = pk2(S0[2], S0[3]); w1.x = pk2(S1[0], S1[1]); w1.y = pk2(S1[2], S1[3]);
            *(LAS v2u*)(lds + HG_ST + fr * 272 + (16 * wave + 4 * fq) * 2) = w0;
            *(LAS v2u*)(lds + HG_ST + (16 + fr) * 272 + (16 * wave + 4 * fq) * 2) = w1;
        }
        {
            const int ib = wave & 3, jp = wave >> 2;
#pragma unroll
            for (int t = 0; t < 2; ++t) {
                const int jb = 2 * jp + t;
                f32x4 sc = {0.f, 0.f, 0.f, 0.f};
                if (jb <= ib) {
#pragma unroll
                    for (int ks = 0; ks < 4; ++ks) {
                        const bf16x8 x = *(const LAS bf16x8*)(lds + HG_KN + (16 * jb + fr) * 272 + ks * 64 + fq * 16);
                        const bf16x8 y = *(const LAS bf16x8*)(lds + HG_QN + (16 * ib + fr) * 272 + ks * 64 + fq * 16);
                        sc = __builtin_amdgcn_mfma_f32_16x16x32_bf16(x, y, sc, 0, 0, 0);
                    }
                    if (jb == ib) {
#pragma unroll
                        for (int r = 0; r < 4; ++r) if (4 * fq + r > fr) sc[r] = 0.f;
                    }
                }
                v2u w; w.x = pk2(sc[0], sc[1]); w.y = pk2(sc[2], sc[3]);
                *(LAS v2u*)(lds + HG_SCL + (16 * ib + fr) * 144 + (16 * jb + 4 * fq) * 2) = w;
            }
        }
        __syncthreads();
        {
            const int ib2 = wave >> 1, db = wave & 1;
            f32x4 O = {0.f, 0.f, 0.f, 0.f};
#pragma unroll
            for (int ks = 0; ks < 2; ++ks) {
                const bf16x8 x = *(const LAS bf16x8*)(lds + vbuf + (16 * db + fr) * 144 + ks * 64 + fq * 16);
                const bf16x8 y = *(const LAS bf16x8*)(lds + HG_SCL + (16 * ib2 + fr) * 144 + ks * 64 + fq * 16);
                O = __builtin_amdgcn_mfma_f32_16x16x32_bf16(x, y, O, 0, 0, 0);
            }
#pragma unroll
            for (int ks = 0; ks < 4; ++ks) {
                const bf16x8 x = *(const LAS bf16x8*)(lds + HG_ST + (16 * db + fr) * 272 + ks * 64 + fq * 16);
                const bf16x8 y = *(const LAS bf16x8*)(lds + HG_QN + (16 * ib2 + fr) * 272 + ks * 64 + fq * 16);
                O = __builtin_amdgcn_mfma_f32_16x16x32_bf16(x, y, O, 0, 0, 0);
            }
#if defined(DBG_HG) && DBG_HG == 1
            { const v2u w = *(const LAS v2u*)(lds + HG_QN + (16 * ib2 + fr) * 272 + (16 * db + 4 * fq) * 2); O = (f32x4){bflo(w.x), bfhi(w.x), bflo(w.y), bfhi(w.y)}; }
#elif defined(DBG_HG) && DBG_HG == 2
            { const v2u w = *(const LAS v2u*)(lds + HG_SCL + (16 * ib2 + fr) * 144 + (16 * db + 4 * fq) * 2); O = (f32x4){bflo(w.x), bfhi(w.x), bflo(w.y), bfhi(w.y)}; }
#elif defined(DBG_HG) && DBG_HG == 3
            { const v2u w = *(const LAS v2u*)(lds + vbuf + (16 * db + fr) * 144 + (16 * (ib2 & 3) + 4 * fq) * 2); O = (f32x4){bflo(w.x), bfhi(w.x), bflo(w.y), bfhi(w.y)}; }
#elif defined(DBG_HG) && DBG_HG == 5
            { const v2u w = *(const GAS v2u*)(gq + (size_t)TOKROW(n, 16 * ib2 + fr) * DIN + 16 * db + 4 * fq); O = (f32x4){bflo(w.x), bfhi(w.x), bflo(w.y), bfhi(w.y)}; }
#elif defined(DBG_HG) && DBG_HG == 9
            { const v2u w = *(const GAS v2u*)(gl + (size_t)TOKROW(n, 16 * ib2 + fr) * DIN + 16 * db + 4 * fq); O = (f32x4){bflo(w.x), bfhi(w.x), bflo(w.y), bfhi(w.y)}; }
#elif defined(DBG_HG) && DBG_HG == 10
            { const v2u w = *(const LAS v2u*)(lds + HG_RAWLF + (16 * ib2 + fr) * 272 + (16 * db + 4 * fq) * 2); O = (f32x4){bflo(w.x), bfhi(w.x), bflo(w.y), bfhi(w.y)}; }
#elif defined(DBG_HG) && DBG_HG == 7
            { const v2u w = *(const GAS v2u*)(P + COL_U + h * 128 + (size_t)TOKROW(n, 16 * ib2 + fr) * DIN + 16 * db + 4 * fq); O = (f32x4){bflo(w.x), bfhi(w.x), bflo(w.y), bfhi(w.y)}; }
#elif defined(DBG_HG) && DBG_HG == 8
            { O = (f32x4){(float)TOKROW(n, 16 * ib2 + fr), (float)(16 * db + 4 * fq), (float)h, (float)dq}; }
#elif defined(DBG_HG) && DBG_HG == 6
            { const v2u w = *(const LAS v2u*)(lds + HG_RAWQ + (16 * ib2 + fr) * 272 + (16 * db + 4 * fq) * 2); O = (f32x4){bflo(w.x), bfhi(w.x), bflo(w.y), bfhi(w.y)}; }
#elif defined(DBG_HG) && DBG_HG == 4
            { const v2u w = *(const LAS v2u*)(lds + HG_KN + (16 * ib2 + fr) * 272 + (16 * db + 4 * fq) * 2); O = (f32x4){bflo(w.x), bfhi(w.x), bflo(w.y), bfhi(w.y)}; }
#endif
            *(GAS f32x4*)(go + (size_t)TOKROW(n, 16 * ib2 + fr) * 512 + 16 * db + 4 * fq) = O;
        }
        {
#pragma unroll
            for (int ks = 0; ks < 2; ++ks) {
                const bf16x8 x = *(const LAS bf16x8*)(lds + HG_KT + (16 * wave + fr) * 144 + ks * 64 + fq * 16);
                const bf16x8 y0 = *(const LAS bf16x8*)(lds + vbuf + fr * 144 + ks * 64 + fq * 16);
                const bf16x8 y1 = *(const LAS bf16x8*)(lds + vbuf + (16 + fr) * 144 + ks * 64 + fq * 16);
                S0 = __builtin_amdgcn_mfma_f32_16x16x32_bf16(x, y0, S0, 0, 0, 0);
                S1 = __builtin_amdgcn_mfma_f32_16x16x32_bf16(x, y1, S1, 0, 0, 0);
            }
            const f32x4 sb = *(const LAS f32x4*)(lds + HG_SB + (16 * wave + 4 * fq) * 4);
            S0 = S0 * sb; S1 = S1 * sb;
        }
        __syncthreads();
    }
#undef HG_LOAD
#undef TOKROW
}

#ifdef DBG_NAIVE_HGRN
__device__ __forceinline__ void naive_hgrn_item(LAS unsigned char* lds, const bf16* P, float* ob, int row0, int L, int h, int dir, int tid) {
    LAS float* LQ = (LAS float*)lds; LAS float* LF = LQ + 2048; LAS float* LK = LF + 2048;
    const unsigned short* Pu = (const unsigned short*)P;
    float S[128];
#pragma unroll
    for (int k = 0; k < 128; ++k) S[k] = 0.f;
    for (int t0 = 0; t0 < L; t0 += 16) {
        __syncthreads();
#pragma unroll
        for (int i = 0; i < 4; ++i) { const int idx = tid + 512 * i, st = idx >> 7, k = idx & 127; const size_t row = (size_t)(row0 + (dir ? (L - 1 - (t0 + st)) : (t0 + st)));
            const float qv = bf1(Pu[row * DIN + COL_Q + h * 128 + k]), l2 = bf1(Pu[row * DIN + (dir ? COL_FB : COL_FF) + h * 128 + k]), f = exp2f(l2);
            LQ[st * 128 + k] = qv; LF[st * 128 + k] = f; LK[st * 128 + k] = 1.0f - f; }
        __syncthreads();
        if (tid < 128) {
#pragma unroll 1
            for (int st = 0; st < 16; ++st) { const size_t row = (size_t)(row0 + (dir ? (L - 1 - (t0 + st)) : (t0 + st)));
                const float v = bf1(Pu[row * DIN + COL_I + h * 128 + tid]); float o = 0.f;
#pragma unroll
                for (int k4 = 0; k4 < 32; ++k4) { const f32x4 f4 = *(const LAS f32x4*)(LF + st * 128 + 4 * k4), k4v = *(const LAS f32x4*)(LK + st * 128 + 4 * k4), q4 = *(const LAS f32x4*)(LQ + st * 128 + 4 * k4);
#pragma unroll
                    for (int e = 0; e < 4; ++e) { S[4 * k4 + e] = f4[e] * S[4 * k4 + e] + k4v[e] * v; o += q4[e] * S[4 * k4 + e]; } }
                ob[row * 512 + h * 128 + tid] = o; }
        }
    }
    __syncthreads();
}
#endif
__device__ __forceinline__ void hgrn_combine(const float* ob0, const float* ob1, const bf16* P, const float* onorm, const float* ssg, const float* gon, bf16* Y, int gw, int NGW, int lane) {
    const int c = 8 * lane;
    const f32x4 g0 = *(const GAS f32x4*)(onorm + c), g1 = *(const GAS f32x4*)(onorm + c + 4);
    const f32x4 n0 = *(const GAS f32x4*)(gon + c), n1 = *(const GAS f32x4*)(gon + c + 4);
    for (int m = gw; m < TOK; m += NGW) {
        const f32x4 a0 = *(const GAS f32x4*)(ob0 + (size_t)m * 512 + c), a1 = *(const GAS f32x4*)(ob0 + (size_t)m * 512 + c + 4);
        const f32x4 b0 = *(const GAS f32x4*)(ob1 + (size_t)m * 512 + c), b1 = *(const GAS f32x4*)(ob1 + (size_t)m * 512 + c + 4);
        const v4u sgw = *(const GAS v4u*)(P + (size_t)m * DIN + COL_G + c);
#ifdef DBG_PCOPY
        f32x4 o0 = {0.f,0.f,0.f,0.f}, o1 = o0;
        { const int segs[4] = {COL_Q, COL_I, COL_FF, COL_FB};
#pragma unroll
          for (int q_ = 0; q_ < 4; ++q_) { const v4u pw = *(const GAS v4u*)(P + (size_t)m * DIN + segs[q_] + c);
            o0 += (f32x4){bflo(pw.x), bfhi(pw.x), bflo(pw.y), bfhi(pw.y)}; o1 += (f32x4){bflo(pw.z), bfhi(pw.z), bflo(pw.w), bfhi(pw.w)}; } }
#else
        const f32x4 o0 = a0 + b0, o1 = a1 + b1;
#endif
        float s = ((o0[0] * o0[0] + o0[1] * o0[1]) + (o0[2] * o0[2] + o0[3] * o0[3])) + ((o1[0] * o1[0] + o1[1] * o1[1]) + (o1[2] * o1[2] + o1[3] * o1[3]));
        s += __shfl_xor(s, 1); s += __shfl_xor(s, 2); s += __shfl_xor(s, 4); s += __shfl_xor(s, 8);
        const float r = rsq(s * (1.0f / 128.0f) + EPS);
        const f32x4 y0 = o0 * r * g0 * (f32x4){bflo(sgw.x), bfhi(sgw.x), bflo(sgw.y), bfhi(sgw.y)};
        const f32x4 y1 = o1 * r * g1 * (f32x4){bflo(sgw.z), bfhi(sgw.z), bflo(sgw.w), bfhi(sgw.w)};
        v4u w; w.x = pk2(y0[0], y0[1]); w.y = pk2(y0[2], y0[3]); w.z = pk2(y1[0], y1[1]); w.w = pk2(y1[2], y1[3]);
        *(GAS v4u*)(Y + (size_t)m * DMODEL + 512 + c) = w;
#ifndef NO_GMLP
        const f32x4 sv = *(const GAS f32x4*)(ssg + (size_t)m * 4);
        const float rg = rsq(((sv[0] + sv[1]) + (sv[2] + sv[3])) * (1.0f / 512.0f) + EPS);
        const v4u yw = *(const GAS v4u*)(Y + (size_t)m * DMODEL + c);
        const f32x4 z0 = (f32x4){bflo(yw.x), bfhi(yw.x), bflo(yw.y), bfhi(yw.y)} * rg * n0, z1 = (f32x4){bflo(yw.z), bfhi(yw.z), bflo(yw.w), bfhi(yw.w)} * rg * n1;
        v4u zw; zw.x = pk2(z0[0], z0[1]); zw.y = pk2(z0[2], z0[3]); zw.z = pk2(z1[0], z1[1]); zw.w = pk2(z1[2], z1[3]);
        *(GAS v4u*)(Y + (size_t)m * DMODEL + c) = zw;
#endif
    }
}

constexpr int GM_RAWV = 0, GM_VLT = 34816, GM_WL = 69632, GM_MEAN = 104448, GM_RSTD = 104960, GM_END = 105472;
static_assert(GM_END <= RING_BYTES, "gmlp LDS");
__device__ __forceinline__ void gmlp_item(LAS unsigned char* lds, const bf16* P, bf16* Y, float* ssg, const float* ln_g, const float* ln_b, const float* w_s, const float* b_s, int c, int h, int tid, int lane, int wave) {
    const int fr = lane & 15, fq = lane >> 4, R0 = 128 * c;
#pragma unroll 1
    for (int jj = 0; jj < 4; ++jj) {
        float sm[4], sq[4];
#pragma unroll
        for (int j = 0; j < 4; ++j) {
            const int s = 16 * wave + 4 * jj + j;
            const v4u raw = *(const GAS v4u*)(P + (size_t)(R0 + s) * DIN + COL_V + 8 * lane);
            const float x0 = bflo(raw.x), x1 = bfhi(raw.x), x2 = bflo(raw.y), x3 = bfhi(raw.y), x4 = bflo(raw.z), x5 = bfhi(raw.z), x6 = bflo(raw.w), x7 = bfhi(raw.w);
            sm[j] = ((x0 + x1) + (x2 + x3)) + ((x4 + x5) + (x6 + x7));
            sq[j] = ((x0 * x0 + x1 * x1) + (x2 * x2 + x3 * x3)) + ((x4 * x4 + x5 * x5) + (x6 * x6 + x7 * x7));
        }
#pragma unroll
        for (int o = 1; o < 64; o <<= 1) {
#pragma unroll
            for (int j = 0; j < 4; ++j) { sm[j] += __shfl_xor(sm[j], o); sq[j] += __shfl_xor(sq[j], o); }
        }
        if (lane == 0) {
#pragma unroll
            for (int j = 0; j < 4; ++j) { const int s = 16 * wave + 4 * jj + j; const float mean = sm[j] * (1.0f / 512.0f), var = fmaxf(sq[j] * (1.0f / 512.0f) - mean * mean, 0.f);
                *(LAS float*)(lds + GM_MEAN + s * 4) = mean; *(LAS float*)(lds + GM_RSTD + s * 4) = rsq(var + EPS); }
        }
    }
#pragma unroll
    for (int i = 0; i < 4; ++i) { const int idx = tid + 512 * i, row = idx >> 4, c16 = idx & 15;
        *(LAS v4u*)(lds + GM_RAWV + row * 272 + c16 * 16) = *(const GAS v4u*)(P + (size_t)(R0 + row) * DIN + COL_V + 128 * h + 8 * c16); }
#pragma unroll
    for (int i = 0; i < 8; ++i) { const int idx = tid + 512 * i, tt = idx >> 5, s4 = idx & 31;
        const f32x4 w = *(const GAS f32x4*)(w_s + (size_t)h * 16384 + tt * 128 + 4 * s4);
        v2u o; o.x = pk2(w[0], w[1]); o.y = pk2(w[2], w[3]);
        *(LAS v2u*)(lds + GM_WL + tt * 272 + s4 * 8) = o; }
    __syncthreads();
    {
        const int ch = tid & 127, sq4 = tid >> 7;
        const float g = ln_g[128 * h + ch], b = ln_b[128 * h + ch];
#pragma unroll
        for (int i = 0; i < 4; ++i) {
            unsigned wv[4];
#pragma unroll
            for (int e = 0; e < 8; ++e) { const int s = 32 * sq4 + 8 * i + e;
                const float x = bf1(*(const LAS unsigned short*)(lds + GM_RAWV + s * 272 + ch * 2));
                const float y = (x - *(const LAS float*)(lds + GM_MEAN + s * 4)) * *(const LAS float*)(lds + GM_RSTD + s * 4) * g + b;
                const unsigned yb = f2bf(y);
                if (e & 1) wv[e >> 1] |= yb << 16; else wv[e >> 1] = yb; }
            *(LAS v4u*)(lds + GM_VLT + ch * 272 + (32 * sq4 + 8 * i) * 2) = (v4u){wv[0], wv[1], wv[2], wv[3]};
        }
    }
    __syncthreads();
    const int t = 16 * wave + fr;
    bf16x8 yf[4];
#pragma unroll
    for (int ks = 0; ks < 4; ++ks) yf[ks] = *(const LAS bf16x8*)(lds + GM_WL + (16 * wave + fr) * 272 + ks * 64 + fq * 16);
    const float bs = b_s[h * 128 + t];
    float ss = 0.f;
#pragma unroll
    for (int cb = 0; cb < 8; ++cb) {
        f32x4 a = {0.f, 0.f, 0.f, 0.f};
#pragma unroll
        for (int ks = 0; ks < 4; ++ks) {
            const bf16x8 x = *(const LAS bf16x8*)(lds + GM_VLT + (16 * cb + fr) * 272 + ks * 64 + fq * 16);
            a = __builtin_amdgcn_mfma_f32_16x16x32_bf16(x, yf[ks], a, 0, 0, 0);
        }
        const int ch = 128 * h + 16 * cb + 4 * fq;
        const v2u uw = *(const GAS v2u*)(P + (size_t)(R0 + t) * DIN + COL_U + ch);
        const f32x4 uu = {bflo(uw.x), bfhi(uw.x), bflo(uw.y), bfhi(uw.y)};
        a = (a + bs) * uu;
        ss += (a[0] * a[0] + a[1] * a[1]) + (a[2] * a[2] + a[3] * a[3]);
        v2u w; w.x = pk2(a[0], a[1]); w.y = pk2(a[2], a[3]);
        *(GAS v2u*)(Y + (size_t)(R0 + t) * DMODEL + ch) = w;
    }
    ss += __shfl_xor(ss, 16); ss += __shfl_xor(ss, 32);
    if (fq == 0) ssg[(size_t)(R0 + t) * 4 + h] = ss;
    __syncthreads();
}

struct Args { const float* in[22]; float* out; unsigned char* ws; int ph_lo, ph_hi, li, pad; };
constexpr int N_PHASES = 10;
#ifndef PHMASK
#define PHMASK 1023
#endif
#ifndef MK_N_LAUNCHES
#define MK_N_LAUNCHES 1
#endif
__global__ void __launch_bounds__(NWAVES * 64, 2) fwd_kernel(Args args) {
    extern __shared__ __attribute__((aligned(16))) unsigned char lds_raw[];
    LAS unsigned char* lds = (LAS unsigned char*)lds_raw;
    volatile LAS unsigned* MISC = (volatile LAS unsigned*)(lds + MISC_OFF);
    const int tid = threadIdx.x, lane = tid & 63, wave = __builtin_amdgcn_readfirstlane(tid >> 6);
    const int G = gridDim.x, bx = blockIdx.x;
    const int vcu = (G % 8 == 0) ? (bx % 8) * (G / 8) + bx / 8 : bx;
    const int gw = vcu * NWAVES + wave, NGW = G * NWAVES;
    unsigned char* ws = args.ws;
    gu32* ctl = (gu32*)(ws + WS_CTL);
    for (int u = tid; u < (LDS_BYTES - LDSCTL_OFF) / 4; u += NWAVES * 64) ((LAS unsigned*)(lds + LDSCTL_OFF))[u] = 0u;
    __syncthreads();
    XcdBarrier bar = xcd_barrier_post((unsigned*)(ctl + CW_BAR) + args.li * XCD_BAR_WORDS, MISC + 8);
    const int lo = args.ph_lo, hi = args.ph_hi;
#define IN(k) (lo <= (k) && (k) < hi)
#define SEAM(k) do { if (IN(k) && IN((k) + 1)) xcd_barrier(bar); } while (0)
    bf16* XB = (bf16*)(ws + WS_BUFA); bf16* Y = (bf16*)(ws + WS_BUFB); bf16* BIG = (bf16*)(ws + WS_BIG);
    float* OB0 = (float*)(ws + WS_BUFA); float* OB1 = (float*)(ws + WS_OB1);
    float* SSG = (float*)(ws + WS_SSG);
    float* P16_0 = (float*)(ws + WS_P16); float* P16_1 = (float*)(ws + WS_P16 + 2 * MiB); float* P16_2 = (float*)(ws + WS_P16 + 4 * MiB);

    if (((PHMASK >> 0) & 1) && IN(0)) { p0_prologue(lds, args.in, ws, gw, NGW, wave, lane); }
    SEAM(0);
    if (((PHMASK >> 1) & 1) && IN(1)) { pg8::Gemm g{XB, (const bf16*)(ws + WS_WGU1), TOK, 2 * DFF, DMODEL}; pg8::StaticOrder S; S.init(TOK, 2 * DFF, G, bx);
        pg8::EpiSwiGLU E{BIG, DFF, P16_0};
        pg8::gemm_phase<pg8::EpiSwiGLU, pg8::StaticOrder, PG8_ALIGN, PG8_SP2>(lds + RING_OFF, g, S, E); }
    SEAM(1);
    if (((PHMASK >> 2) & 1) && IN(2)) { pg8::Gemm g{BIG, (const bf16*)(ws + WS_WD1), TOK, DMODEL, DFF}; pg8::StaticOrder S; S.init(TOK, DMODEL, G, bx);
        pg8::EpiResid<true, true> E{args.in[0], args.in[1], args.out, XB, P16_1, 0.5f};
        pg8::gemm_phase<pg8::EpiResid<true, true>, pg8::StaticOrder, PG8_ALIGN, PG8_SP2>(lds + RING_OFF, g, S, E); }
    SEAM(2);
    if (((PHMASK >> 3) & 1) && IN(3)) { pg8::Gemm g{XB, (const bf16*)(ws + WS_WIN), TOK, DIN, DMODEL}; pg8::StaticOrder S; S.init(TOK, DIN, G, bx);
        pg8::EpiMix E{BIG, DIN, P16_1, args.in[13], args.in[14]};
        pg8::gemm_phase<pg8::EpiMix, pg8::StaticOrder, PG8_ALIGN, PG8_SP2>(lds + RING_OFF, g, S, E); }
    SEAM(3);
    if (((PHMASK >> 4) & 1) && IN(4)) {
#ifdef DBG_NAIVE_HGRN
        for (int it = bx; it < 96; it += G) { const int sq = it >> 3, h = (it >> 1) & 3, dir = it & 1; const int row0 = sq < 8 ? 2048 * sq : NPROMPT + 4096 * (sq - 8), L = sq < 8 ? 2048 : 4096;
            naive_hgrn_item(lds, BIG, dir ? OB1 : OB0, row0, L, h, dir, tid); }
#elif !defined(NO_HGRN)
        for (int slot = bx; slot < 256; slot += G) {
            const int xcd = slot & 7;
            const int nit = slot < 128 ? 1 : 2;
#pragma unroll 1
            for (int q2 = 0; q2 < nit; ++q2) {
                int row0, L, h, dir, dq;
                if (slot < 128) { const int j = slot >> 3, grp = xcd * 4 + (j >> 2), b = grp >> 3; dq = j & 3; h = (grp >> 1) & 3; dir = grp & 1; row0 = NPROMPT + 4096 * b; L = 4096; }
                else { const int j = (slot - 128) >> 3, grp = xcd * 8 + (j >> 1), b = grp >> 3; dq = 2 * (j & 1) + q2; h = (grp >> 1) & 3; dir = grp & 1; row0 = 2048 * b; L = 2048; }
                hgrn_item(lds, BIG, dir ? OB1 : OB0, row0, L, h, dir, dq, tid, lane, wave);
            }
        }
#endif
#ifndef NO_GMLP
        for (int it = bx; it < 1024; it += G) gmlp_item(lds, BIG, Y, SSG, args.in[8], args.in[9], args.in[10], args.in[11], it >> 2, it & 3, tid, lane, wave);
#endif
    }
    SEAM(4);
    if (((PHMASK >> 5) & 1) && IN(5)) { hgrn_combine(OB0, OB1, BIG, args.in[15], SSG, args.in[12], Y, gw, NGW, lane); }
    SEAM(5);
    if (((PHMASK >> 6) & 1) && IN(6)) { pg8::Gemm g{Y, (const bf16*)(ws + WS_WOUT), TOK, DMODEL, DMODEL}; pg8::StaticOrder S; S.init(TOK, DMODEL, G, bx);
        pg8::EpiResid<true, true> E{args.out, args.out + (size_t)NPROMPT * DMODEL, args.out, XB, P16_2, 1.0f};
        pg8::gemm_phase<pg8::EpiResid<true, true>, pg8::StaticOrder, PG8_ALIGN, PG8_SP2>(lds + RING_OFF, g, S, E); }
    SEAM(6);
    if (((PHMASK >> 7) & 1) && IN(7)) { pg8::Gemm g{XB, (const bf16*)(ws + WS_WGU2), TOK, 2 * DFF, DMODEL}; pg8::StaticOrder S; S.init(TOK, 2 * DFF, G, bx);
        pg8::EpiSwiGLU E{BIG, DFF, P16_2};
        pg8::gemm_phase<pg8::EpiSwiGLU, pg8::StaticOrder, PG8_ALIGN, PG8_SP2>(lds + RING_OFF, g, S, E); }
    SEAM(7);
    if (((PHMASK >> 8) & 1) && IN(8)) { pg8::Gemm g{BIG, (const bf16*)(ws + WS_WD2), TOK, DMODEL, DFF}; pg8::StaticOrder S; S.init(TOK, DMODEL, G, bx);
        pg8::EpiResid<false, false> E{args.out, args.out + (size_t)NPROMPT * DMODEL, args.out, nullptr, nullptr, 0.5f};
        pg8::gemm_phase<pg8::EpiResid<false, false>, pg8::StaticOrder, PG8_ALIGN, PG8_SP2>(lds + RING_OFF, g, S, E); }
    SEAM(8);
#ifdef DBG_OBOUT
    if (IN(9)) { for (int m = gw; m < TOK; m += NGW) { for (int j = 0; j < 4; ++j) { const int c = 4 * lane + 256 * j; const f32x4 a = *(const GAS f32x4*)(OB0 + (size_t)m * 512 + (c & 511)), b = *(const GAS f32x4*)(OB1 + (size_t)m * 512 + (c & 511));
        *(GAS f32x4*)(args.out + (size_t)m * DMODEL + c) = (j < 2) ? a : b; } } }
#else
    if (((PHMASK >> 9) & 1) && IN(9)) { final_norm(args.out, args.in[21], gw, NGW, lane); }
#endif
#undef IN
#undef SEAM
}

extern "C" void kernel_launch(void* const* d_in, const int* in_sizes, int n_in, void* d_out, int out_size, void* d_ws, size_t ws_size, hipStream_t stream) {
    static int grid = 0;
    if (grid == 0) {
        if (n_in != 22 || out_size != TOK * DMODEL || ws_size < WS_END) { fprintf(stderr, "kernel_launch: unexpected problem (n_in %d, out %d, ws %zu); nothing launched\n", n_in, out_size, ws_size); grid = -1; return; }
        int dev = 0, cus = 0, per_cu = 0;
        if (hipGetDevice(&dev) != hipSuccess || hipDeviceGetAttribute(&cus, hipDeviceAttributeMultiprocessorCount, dev) != hipSuccess) { grid = -1; return; }
        if (hipFuncSetAttribute((const void*)fwd_kernel, hipFuncAttributeMaxDynamicSharedMemorySize, LDS_BYTES) != hipSuccess) { fprintf(stderr, "kernel_launch: hipFuncSetAttribute failed\n"); grid = -1; return; }
        if (hipOccupancyMaxActiveBlocksPerMultiprocessor(&per_cu, (const void*)fwd_kernel, NWAVES * 64, LDS_BYTES) != hipSuccess || per_cu < 1) { fprintf(stderr, "kernel_launch: occupancy query says %d blocks per CU; nothing launched\n", per_cu); (void)hipGetLastError(); grid = -1; return; }
        grid = cus;
    }
    if (grid < 0) return;
    if (hipMemsetAsync((char*)d_ws + WS_CTL, 0, CTL_ZERO_BYTES, stream) != hipSuccess) return;
    Args a{};
    for (int i = 0; i < 22; ++i) a.in[i] = (const float*)d_in[i];
    a.out = (float*)d_out; a.ws = (unsigned char*)d_ws;
    constexpr int NL = MK_N_LAUNCHES;
    for (int li = 0; li < NL; ++li) {
        a.ph_lo = (NL == 1) ? 0 : li; a.ph_hi = (NL == 1) ? N_PHASES : li + 1; a.li = (NL == 1) ? 0 : 0;
        hipLaunchKernelGGL(fwd_kernel, dim3(grid), dim3(NWAVES * 64), LDS_BYTES, stream, a);
        if (hipPeekAtLastError() != hipSuccess) { fprintf(stderr, "kernel_launch: launch %d failed\n", li); break; }
    }
}
```

```cpp
#include <hip/hip_runtime.h>
#include <cstdio>
#include <cstdint>
namespace pg8 {
#define PG8_LAS __attribute__((address_space(3)))
typedef unsigned short bf16_t;
typedef short bf16x8 __attribute__((ext_vector_type(8)));
typedef float f32x4 __attribute__((ext_vector_type(4)));
typedef unsigned u32x4 __attribute__((ext_vector_type(4)));
constexpr int BM = 256, BK = 64, HALF = 128, HTB = HALF * BK * 2  , STAGE_BYTES = 8 * HTB, NXCD = 8, WGM = 8;

__host__ __device__ __forceinline__ int lds_byte(int r, int c) { const int st = (r >> 4) * 2 + (c >> 5), rr = r & 15, cc = c & 31, ob = rr * 64 + cc * 2; return st * 1024 + (ob ^ (((ob >> 9) & 1) << 5)); }
__host__ __device__ __forceinline__ void stage_rc(int b, int& R, int& C) { const int st = b / 1024, sb = b % 1024, swz = sb ^ (((sb >> 9) & 1) << 5); R = (st >> 1) * 16 + swz / 64; C = (st & 1) * 32 + (swz % 64) / 2; }
__host__ __device__ __forceinline__ int perm32(int rho) { const int n = rho >> 4, i = rho & 15; return 8 * (i >> 2) + 4 * n + (i & 3); }

struct Unit { int pm, pn; };
struct Gemm { const bf16_t* A; const bf16_t* Bt; int M, N, K; };

struct StaticOrder {
    int nM, nN, nwg, G, c;
    __host__ __device__ void init(int M, int N, int G_, int c_) { nM = M / BM; nN = N / BM; nwg = nM * nN; G = G_; c = c_; }
    __host__ __device__ bool next(int i, Unit& u) const {
        const long L = (long)i * G + c; if (L >= nwg) return false;
        int wgid = (int)L; { const int q = nwg / NXCD, r = nwg % NXCD, xcd = wgid % NXCD, off = wgid / NXCD; wgid = (xcd < r ? xcd * (q + 1) : r * (q + 1) + (xcd - r) * q) + off; }
        const int nig = WGM * nN, gid = wgid / nig, fm = gid * WGM, gsz = (nM - fm) < WGM ? (nM - fm) : WGM;
        u.pm = fm + ((wgid % nig) % gsz); u.pn = (wgid % nig) / gsz; return true;
    }
    __device__ __forceinline__ void a_ready(const Unit&) const {}
    __device__ __forceinline__ void done(const Unit&) const {}
};

typedef __bf16 bf16x2_hw __attribute__((ext_vector_type(2)));
typedef float f32x2_hw __attribute__((ext_vector_type(2)));
__device__ __forceinline__ unsigned cvt_pk_bf16(float lo, float hi) { const f32x2_hw v = {lo, hi}; const bf16x2_hw b = __builtin_convertvector(v, bf16x2_hw); return __builtin_bit_cast(unsigned, b); }
typedef float f32x2 __attribute__((ext_vector_type(2)));
__device__ __forceinline__ f32x2 gelu_pk(f32x2 v) {
    const f32x2 av = __builtin_elementwise_abs(v), d = av * 0.2316418882f + 1.0f;
    f32x2 t; t.x = __builtin_amdgcn_rcpf(d.x); t.y = __builtin_amdgcn_rcpf(d.y);
    f32x2 q = t * 0.5307027145f + (-0.7265760135f); q = q * t + 0.7107068705f; q = q * t + (-0.142248368f); q = q * t + 0.127414796f; q = q * t;
    const f32x2 s = (v * v) * (-0.72134752044f);
    f32x2 e; e.x = __builtin_amdgcn_exp2f(s.x); e.y = __builtin_amdgcn_exp2f(s.y);
    const f32x2 m = v * (q * e), r = v - m;
    f32x2 o; o.x = v.x < 0.f ? m.x : r.x; o.y = v.y < 0.f ? m.y : r.y; return o;
}

constexpr float RMS_EPS = 1e-6f;
constexpr int DM = 1024;
__device__ __forceinline__ float row_rstd(const float* p16, int row, int fq) {
    const f32x4 v = *(const f32x4*)(p16 + (size_t)row * 16 + 4 * fq);
    float s = (v[0] + v[1]) + (v[2] + v[3]);
    s += __shfl_xor(s, 16); s += __shfl_xor(s, 32);
    return __builtin_amdgcn_rsqf(s * (1.0f / DM) + RMS_EPS);
}
__device__ __forceinline__ float fast_sigmoid(float z) { return __builtin_amdgcn_rcpf(1.0f + __builtin_amdgcn_exp2f(-1.44269504089f * z)); }

struct EpiSwiGLU {
    static constexpr bool PERM = true, AFTER_DRAIN = false;
    bf16_t* O; int ldo; const float* p16;
    __device__ __forceinline__ void operator()(const f32x4 (&acc)[2][2][4][2], const Unit& u, int wr, int wc, int fr, int fq) const {
        const int row0 = u.pm * BM + wr * 64 + fr, col0 = u.pn * HALF + wc * 32 + 8 * fq;
#pragma unroll
        for (int ai = 0; ai < 2; ++ai)
#pragma unroll
            for (int m = 0; m < 4; ++m) {
                const int row = row0 + ai * HALF + m * 16;
                const float r = row_rstd(p16, row, fq);
                float h[8];
#pragma unroll
                for (int n = 0; n < 2; ++n)
#pragma unroll
                    for (int e = 0; e < 4; ++e) { const float g = acc[ai][0][m][n][e] * r, up = acc[ai][1][m][n][e] * r; h[4 * n + e] = g * up * fast_sigmoid(g); }
                u32x4 w; w.x = cvt_pk_bf16(h[0], h[1]); w.y = cvt_pk_bf16(h[2], h[3]); w.z = cvt_pk_bf16(h[4], h[5]); w.w = cvt_pk_bf16(h[6], h[7]);
                *(u32x4*)(O + (size_t)row * ldo + col0) = w;
            }
    }
};

template <bool WANT_BF16, bool WANT_SS> struct EpiResid {
    static constexpr bool PERM = true, AFTER_DRAIN = false;
    const float* base0; const float* base1;
    float* out; bf16_t* xb; float* p16; float alpha;
    __device__ __forceinline__ void operator()(const f32x4 (&acc)[2][2][4][2], const Unit& u, int wr, int wc, int fr, int fq) const {
        const int row0 = u.pm * BM + wr * 64 + fr, col0 = u.pn * BM + wc * 32 + 8 * fq;
        const float* bp = (u.pm < 64) ? base0 : base1; const int brow = (u.pm < 64) ? 0 : 16384;
#pragma unroll
        for (int ai = 0; ai < 2; ++ai)
#pragma unroll
            for (int m = 0; m < 4; ++m) {
                const int row = row0 + ai * HALF + m * 16; const size_t off = (size_t)row * DM + col0, boff = (size_t)(row - brow) * DM + col0;
                float ss = 0.f;
#pragma unroll
                for (int bj = 0; bj < 2; ++bj) {
                    const f32x4 b0 = *(const f32x4*)(bp + boff + bj * HALF), b1 = *(const f32x4*)(bp + boff + bj * HALF + 4);
                    const f32x4 v0 = b0 + acc[ai][bj][m][0] * alpha, v1 = b1 + acc[ai][bj][m][1] * alpha;
                    *(f32x4*)(out + off + bj * HALF) = v0; *(f32x4*)(out + off + bj * HALF + 4) = v1;
                    if (WANT_BF16) { u32x4 w; w.x = cvt_pk_bf16(v0[0], v0[1]); w.y = cvt_pk_bf16(v0[2], v0[3]); w.z = cvt_pk_bf16(v1[0], v1[1]); w.w = cvt_pk_bf16(v1[2], v1[3]);
                        *(u32x4*)(xb + off + bj * HALF) = w; }
                    if (WANT_SS) ss += ((v0[0] * v0[0] + v0[1] * v0[1]) + (v0[2] * v0[2] + v0[3] * v0[3])) + ((v1[0] * v1[0] + v1[1] * v1[1]) + (v1[2] * v1[2] + v1[3] * v1[3]));
                }
                if (WANT_SS) { ss += __shfl_xor(ss, 16); ss += __shfl_xor(ss, 32); if (fq == 0) p16[(size_t)row * 16 + 4 * u.pn + wc] = ss; }
                asm volatile("" ::: "memory");
            }
    }
};

struct EpiMix {
    static constexpr bool PERM = true, AFTER_DRAIN = false;
    bf16_t* P; int ldp; const float* p16; const float* lbf; const float* lbb;
    template <int ACT> __device__ __forceinline__ void run(const f32x4 (&acc)[2][2][4][2], const Unit& u, int wr, int wc, int fr, int fq) const {
        const int row0 = u.pm * BM + wr * 64 + fr, col0 = u.pn * BM + wc * 32 + 8 * fq;
        float oml[2][8];
        if (ACT == 3) { const float* lb = ((u.pn >> 1) == 4) ? lbf : lbb; const int c0 = (u.pn & 1) * BM + wc * 32 + 8 * fq;
#pragma unroll
            for (int bj = 0; bj < 2; ++bj)
#pragma unroll
                for (int e = 0; e < 8; ++e) { const float a0 = lb[c0 + bj * HALF + e], a1 = lb[512 + c0 + bj * HALF + e]; oml[bj][e] = fast_sigmoid(a1 - a0);
#ifdef DBG_OML
                    oml[bj][e] = 0.5f;
#endif
                } }
#pragma unroll
        for (int ai = 0; ai < 2; ++ai)
#pragma unroll
            for (int m = 0; m < 4; ++m) {
                const int row = row0 + ai * HALF + m * 16;
                const float r = row_rstd(p16, row, fq);
#pragma unroll
                for (int bj = 0; bj < 2; ++bj) {
                    float h[8];
#pragma unroll
                    for (int n = 0; n < 2; ++n) {
                        const f32x4 z = acc[ai][bj][m][n] * r;
                        if (ACT == 0) { const f32x2 a = gelu_pk((f32x2){z[0], z[1]}), b = gelu_pk((f32x2){z[2], z[3]}); h[4 * n] = a.x; h[4 * n + 1] = a.y; h[4 * n + 2] = b.x; h[4 * n + 3] = b.y; }
                        else if (ACT == 1) {
#pragma unroll
                            for (int e = 0; e < 4; ++e) h[4 * n + e] = z[e] * fast_sigmoid(z[e]); }
                        else if (ACT == 2) {
#pragma unroll
                            for (int e = 0; e < 4; ++e) h[4 * n + e] = z[e]; }
                        else {
#pragma unroll
                            for (int e = 0; e < 4; ++e) { const float kk = oml[bj][4 * n + e] * __builtin_amdgcn_rcpf(1.0f + __builtin_amdgcn_exp2f(1.44269504089f * z[e]));
                                h[4 * n + e] = __builtin_amdgcn_logf(1.0f - kk); }
                        }
                    }
                    u32x4 w; w.x = cvt_pk_bf16(h[0], h[1]); w.y = cvt_pk_bf16(h[2], h[3]); w.z = cvt_pk_bf16(h[4], h[5]); w.w = cvt_pk_bf16(h[6], h[7]);
                    *(u32x4*)(P + (size_t)row * ldp + col0 + bj * HALF) = w;
                }
            }
    }
    __device__ __forceinline__ void operator()(const f32x4 (&acc)[2][2][4][2], const Unit& u, int wr, int wc, int fr, int fq) const {
        const int seg = u.pn >> 1;
        if (seg <= 1) run<0>(acc, u, wr, wc, fr, fq);
        else if (seg == 2 || seg == 6) run<1>(acc, u, wr, wc, fr, fq);
        else if (seg == 3) run<2>(acc, u, wr, wc, fr, fq);
        else run<3>(acc, u, wr, wc, fr, fq);
    }
};

template <class Epi, class Sched, bool ALIGN_EPI = false, bool SP2 = false>
__device__ __forceinline__ void gemm_phase(PG8_LAS unsigned char* lds, const Gemm g, const Sched& S, const Epi& E) {
    const int tid = threadIdx.x, wid = __builtin_amdgcn_readfirstlane(tid >> 6), lane = tid & 63, wr = wid >> 2, wc = wid & 3, fr = lane & 15, fq = lane >> 4;
    const int K = g.K, nt = K / BK;
    unsigned voffA[2], voffB[2];
#pragma unroll
    for (int i = 0; i < 2; ++i) { int R, C; stage_rc(tid * 16 + i * 8192, R, C); const int Rb = Epi::PERM ? ((R & ~31) + perm32(R & 31)) : R;
        voffA[i] = (unsigned)(R * K + C) * 2u; voffB[i] = (unsigned)(Rb * K + C) * 2u; }
    const size_t kstep = (size_t)(BK * 2);
    const size_t hstep = (size_t)HALF * K * 2;
    const size_t tstep = 2 * hstep;
    const unsigned ldsw = (unsigned)wid * 1024u;
    const int aoff = lds_byte(wr * 64 + fr, fq * 8), boff = lds_byte(wc * 32 + fr, fq * 8);
#define PG8_SA(b, h) (((b) * 2 + (h)) * HTB)
#define PG8_SB(b, h) ((4 + (b) * 2 + (h)) * HTB)
#define PG8_STAGE(bufoff, gbase, voff) do { _Pragma("unroll") for (int _i = 0; _i < 2; ++_i) \
        __builtin_amdgcn_global_load_lds((const unsigned*)((const char*)(gbase) + (voff)[_i]), (PG8_LAS unsigned*)(lds + (bufoff) + ldsw + _i * 8192), 16, 0, 0); } while (0)
#define PG8_LDA(dst, b, h) do { _Pragma("unroll") for (int m = 0; m < 4; ++m) _Pragma("unroll") for (int k = 0; k < 2; ++k) dst[m][k] = *(const PG8_LAS bf16x8*)(lds + PG8_SA(b, h) + aoff + m * 2048 + k * 1024); } while (0)
#define PG8_LDB(dst, b, h) do { _Pragma("unroll") for (int n = 0; n < 2; ++n) _Pragma("unroll") for (int k = 0; k < 2; ++k) dst[n][k] = *(const PG8_LAS bf16x8*)(lds + PG8_SB(b, h) + boff + n * 2048 + k * 1024); } while (0)
#define PG8_MMA(ai, bj, At, Bt) do { __builtin_amdgcn_s_setprio(1); _Pragma("unroll") for (int m = 0; m < 4; ++m) _Pragma("unroll") for (int n = 0; n < 2; ++n) _Pragma("unroll") for (int k = 0; k < 2; ++k) \
        acc[ai][bj][m][n] = __builtin_amdgcn_mfma_f32_16x16x32_bf16(Bt[n][k], At[m][k], acc[ai][bj][m][n], 0, 0, 0); __builtin_amdgcn_s_setprio(0); } while (0)
#define PG8_WAIT_V(n) asm volatile("s_waitcnt vmcnt(" #n ")" ::: "memory")
#define PG8_WAIT_L(n) asm volatile("s_waitcnt lgkmcnt(" #n ")" ::: "memory")
#define PG8_BAR __builtin_amdgcn_s_barrier()
#define PG8_SCHED __builtin_amdgcn_sched_barrier(0)
    Unit cur, nxt; int ui = 0;
    if (!S.next(0, cur)) return;
    f32x4 acc[2][2][4][2];
#pragma unroll
    for (int a = 0; a < 2; ++a)
#pragma unroll
        for (int b = 0; b < 2; ++b)
#pragma unroll
            for (int m = 0; m < 4; ++m)
#pragma unroll
                for (int n = 0; n < 2; ++n) acc[a][b][m][n] = (f32x4){0.f, 0.f, 0.f, 0.f};
    bf16x8 At[4][2], B0[2][2], B1[2][2];
    const char* cA = (const char*)g.A + (size_t)cur.pm * tstep; const char* cB = (const char*)g.Bt + (size_t)cur.pn * tstep;
    S.a_ready(cur);
    if constexpr (SP2) {
        PG8_STAGE(PG8_SB(0, 0), cB, voffB); PG8_STAGE(PG8_SB(0, 1), cB + hstep, voffB); PG8_STAGE(PG8_SA(0, 0), cA, voffA); PG8_STAGE(PG8_SA(0, 1), cA + hstep, voffA);
        if (wr == 1) PG8_BAR;
        PG8_WAIT_V(2); PG8_BAR;
        PG8_STAGE(PG8_SB(1, 0), cB + kstep, voffB); PG8_STAGE(PG8_SA(1, 0), cA + kstep, voffA); PG8_STAGE(PG8_SB(1, 1), cB + hstep + kstep, voffB);
        PG8_WAIT_V(6); PG8_BAR;
    } else {
        PG8_STAGE(PG8_SB(0, 0), cB, voffB); PG8_STAGE(PG8_SA(0, 0), cA, voffA); PG8_STAGE(PG8_SB(0, 1), cB + hstep, voffB); PG8_STAGE(PG8_SA(0, 1), cA + hstep, voffA);
        if (wr == 1) PG8_BAR;
        PG8_WAIT_V(4); PG8_BAR;
        PG8_STAGE(PG8_SB(1, 0), cB + kstep, voffB); PG8_STAGE(PG8_SA(1, 0), cA + kstep, voffA); PG8_STAGE(PG8_SB(1, 1), cB + hstep + kstep, voffB);
        PG8_WAIT_V(6); PG8_BAR;
    }
    for (;;) {
        const bool has_next = S.next(ui + 1, nxt);
        const char* nA = has_next ? (const char*)g.A + (size_t)nxt.pm * tstep : cA; const char* nB = has_next ? (const char*)g.Bt + (size_t)nxt.pn * tstep : cB;
        for (int t = 0; t < nt; t += 2) {
            const bool last = (t == nt - 2);
            const char* a1 = cA + (size_t)(t + 1) * kstep;
            const char* a2 = last ? nA : cA + (size_t)(t + 2) * kstep; const char* b2 = last ? nB : cB + (size_t)(t + 2) * kstep;
            const char* a3 = a2 + kstep; const char* b3 = b2 + kstep;
            if (last && has_next) S.a_ready(nxt);
            if constexpr (SP2) {
            PG8_LDB(B0, 0, 0); PG8_LDB(B1, 0, 1); PG8_SCHED; PG8_LDA(At, 0, 0); PG8_STAGE(PG8_SA(1, 1), a1 + hstep, voffA);
            PG8_WAIT_V(8); PG8_WAIT_L(0); PG8_BAR; PG8_MMA(0, 0, At, B0); PG8_MMA(0, 1, At, B1); PG8_BAR; PG8_SCHED;
            PG8_LDA(At, 0, 1); PG8_STAGE(PG8_SB(0, 0), b2, voffB); PG8_STAGE(PG8_SB(0, 1), b2 + hstep, voffB); PG8_STAGE(PG8_SA(0, 0), a2, voffA);
            PG8_WAIT_V(8); PG8_WAIT_L(0); PG8_BAR; PG8_MMA(1, 0, At, B0); PG8_MMA(1, 1, At, B1); PG8_BAR; PG8_SCHED;
            PG8_LDB(B0, 1, 0); PG8_LDB(B1, 1, 1); PG8_SCHED; PG8_LDA(At, 1, 0); PG8_STAGE(PG8_SA(0, 1), a2 + hstep, voffA);
            PG8_WAIT_V(8); PG8_WAIT_L(0); PG8_BAR; PG8_MMA(0, 0, At, B0); PG8_MMA(0, 1, At, B1); PG8_BAR; PG8_SCHED;
            PG8_LDA(At, 1, 1); PG8_STAGE(PG8_SB(1, 0), b3, voffB); PG8_STAGE(PG8_SB(1, 1), b3 + hstep, voffB); PG8_STAGE(PG8_SA(1, 0), a3, voffA);
            PG8_WAIT_V(8); PG8_WAIT_L(0); PG8_BAR; PG8_MMA(1, 0, At, B0); PG8_MMA(1, 1, At, B1); PG8_BAR; PG8_SCHED;
            } else {
            PG8_LDB(B0, 0, 0); PG8_SCHED; PG8_LDA(At, 0, 0); PG8_STAGE(PG8_SA(1, 1), a1 + hstep, voffA);
            PG8_WAIT_L(8); PG8_BAR; PG8_WAIT_L(0); PG8_MMA(0, 0, At, B0); PG8_BAR; PG8_SCHED;
            PG8_LDB(B1, 0, 1); PG8_STAGE(PG8_SB(0, 0), b2, voffB);
            PG8_BAR; PG8_WAIT_L(0); PG8_MMA(0, 1, At, B1); PG8_BAR;
            PG8_LDA(At, 0, 1); PG8_STAGE(PG8_SA(0, 0), a2, voffA);
            PG8_BAR; PG8_WAIT_L(0); PG8_MMA(1, 0, At, B0); PG8_BAR; PG8_SCHED;
            PG8_STAGE(PG8_SB(0, 1), b2 + hstep, voffB);
            PG8_WAIT_V(6); PG8_BAR; PG8_MMA(1, 1, At, B1); PG8_BAR;
            PG8_LDB(B0, 1, 0); PG8_SCHED; PG8_LDA(At, 1, 0); PG8_STAGE(PG8_SA(0, 1), a2 + hstep, voffA);
            PG8_WAIT_L(8); PG8_BAR; PG8_WAIT_L(0); PG8_MMA(0, 0, At, B0); PG8_BAR; PG8_SCHED;
            PG8_LDB(B1, 1, 1); PG8_STAGE(PG8_SB(1, 0), b3, voffB);
            PG8_BAR; PG8_WAIT_L(0); PG8_MMA(0, 1, At, B1); PG8_BAR;
            PG8_LDA(At, 1, 1); PG8_STAGE(PG8_SA(1, 0), a3, voffA);
            PG8_BAR; PG8_WAIT_L(0); PG8_MMA(1, 0, At, B0); PG8_BAR; PG8_SCHED;
            PG8_STAGE(PG8_SB(1, 1), b3 + hstep, voffB);
            PG8_WAIT_V(6); PG8_BAR; PG8_MMA(1, 1, At, B1); PG8_BAR;
            }
        }
        if constexpr (ALIGN_EPI) { if (wr == 0) PG8_BAR; }
        if constexpr (!Epi::AFTER_DRAIN) { E(acc, cur, wr, wc, fr, fq); S.done(cur); }
        if (!has_next) break;
#pragma unroll
        for (int a = 0; a < 2; ++a)
#pragma unroll
            for (int b = 0; b < 2; ++b)
#pragma unroll
                for (int m = 0; m < 4; ++m)
#pragma unroll
                    for (int n = 0; n < 2; ++n) acc[a][b][m][n] = (f32x4){0.f, 0.f, 0.f, 0.f};
        cur = nxt; cA = nA; cB = nB; ++ui;
        if constexpr (ALIGN_EPI) { if (wr == 1) PG8_BAR; }
    }
    PG8_WAIT_V(0);
    if constexpr (!ALIGN_EPI) { if (wr == 0) PG8_BAR; }
    PG8_BAR;
    if constexpr (Epi::AFTER_DRAIN) { E.fused(acc, cur, wr, wc, fr, fq, lds, wid, lane); S.done(cur); }
#undef PG8_SA
#undef PG8_SB
#undef PG8_STAGE
#undef PG8_LDA
#undef PG8_LDB
#undef PG8_MMA
#undef PG8_WAIT_V
#undef PG8_WAIT_L
#undef PG8_BAR
#undef PG8_SCHED
}
}

#ifndef PG8_SP2
#define PG8_SP2 true
#endif
#ifndef PG8_ALIGN
#define PG8_ALIGN true
#endif
constexpr int NWAVES = 8;
constexpr int TOK = 32768, NPROMPT = 16384;
constexpr int DMODEL = 1024, DFF = 2816, DIN = 3584;
constexpr int COL_U = 0, COL_V = 512, COL_Q = 1024, COL_I = 1536, COL_FF = 2048, COL_FB = 2560, COL_G = 3072;
constexpr float EPS = 1e-6f;
constexpr size_t MiB = 1u << 20;
constexpr size_t WS_CTL = 0, CTL_ZERO_BYTES = 1 * MiB;
constexpr size_t WS_SSG = 1 * MiB;
constexpr size_t WS_P16 = 2 * MiB;
constexpr size_t WS_WGU1 = 8 * MiB, WS_WD1 = 19 * MiB, WS_WIN = 25 * MiB, WS_WOUT = 32 * MiB, WS_WGU2 = 34 * MiB, WS_WD2 = 45 * MiB;
constexpr size_t WS_BUFA = 52 * MiB;
constexpr size_t WS_BUFB = 116 * MiB;
constexpr size_t WS_BIG = 180 * MiB;
constexpr size_t WS_OB1 = 404 * MiB;
constexpr size_t WS_END = 468 * MiB;
static_assert(WS_WGU1 + (size_t)2 * DFF * DMODEL * 2 <= WS_WD1 && WS_WD1 + (size_t)DMODEL * DFF * 2 <= WS_WIN && WS_WIN + (size_t)DIN * DMODEL * 2 <= WS_WOUT && WS_WOUT + (size_t)DMODEL * DMODEL * 2 <= WS_WGU2
              && WS_WGU2 + (size_t)2 * DFF * DMODEL * 2 <= WS_WD2 && WS_WD2 + (size_t)DMODEL * DFF * 2 <= WS_BUFA && WS_BUFA + (size_t)TOK * DMODEL * 2 <= WS_BUFB && WS_BUFB + (size_t)TOK * DMODEL * 2 <= WS_BIG
              && WS_BIG + (size_t)TOK * DIN * 2 <= WS_OB1 && WS_OB1 + (size_t)TOK * 512 * 4 <= WS_END && WS_P16 + 3 * 2 * MiB <= WS_WGU1, "d_ws map");
constexpr int CW_BAR = 4096;
constexpr int RING_OFF = 0, RING_BYTES = 131072;
constexpr int LDSCTL_OFF = RING_BYTES, MISC_OFF = LDSCTL_OFF + 320;
constexpr int LDS_BYTES = 147456;
static_assert(MISC_OFF + 128 <= LDS_BYTES, "LDS map");

#define GAS __attribute__((address_space(1)))
#define LAS __attribute__((address_space(3)))
typedef unsigned short bf16;
typedef unsigned v4u __attribute__((ext_vector_type(4)));
typedef float f32x4 __attribute__((ext_vector_type(4)));
typedef short bf16x8 __attribute__((ext_vector_type(8)));
typedef GAS unsigned gu32;
typedef GAS unsigned long long gu64;
#define RLX_AGENT __ATOMIC_RELAXED, __HIP_MEMORY_SCOPE_AGENT
#define LDS_WAIT() asm volatile("s_waitcnt lgkmcnt(0)" ::: "memory")
#define VM_WAIT() asm volatile("s_waitcnt vmcnt(0)" ::: "memory")
__device__ __forceinline__ unsigned long long rt() { return __builtin_amdgcn_s_memrealtime(); }
__device__ __forceinline__ unsigned f2bf(float f) { unsigned u = __builtin_bit_cast(unsigned, f); return (u + 0x7fffu + ((u >> 16) & 1u)) >> 16; }
__device__ __forceinline__ unsigned pk2(float lo, float hi) { return f2bf(lo) | (f2bf(hi) << 16); }

#define XB_TMO      128
#define XB_XCNT(j)  (256  + 64 * (j))
#define XB_XSUB(j)  (1280 + 64 * (j))
#define XB_XGEN(j)  (2304 + 64 * (j))
#define XB_TOP      3328
#define XB_TOPGEN   3392
#define XCD_BAR_WORDS 3456
#define XB_SPIN_CAP (1u << 18)

__device__ __forceinline__ unsigned xb_ld(unsigned* p)              { return __hip_atomic_load(p, __ATOMIC_RELAXED, __HIP_MEMORY_SCOPE_AGENT); }
__device__ __forceinline__ unsigned xb_add(unsigned* p, unsigned v) { return __hip_atomic_fetch_add(p, v, __ATOMIC_RELAXED, __HIP_MEMORY_SCOPE_AGENT); }
__device__ __forceinline__ unsigned xb_xcc_id() { return (unsigned)__builtin_amdgcn_s_getreg((3 << 11) | 20) & 0xFu; }
#define XB_SPIN(cond, bar) do { unsigned _sp = 0; while (cond) { __builtin_amdgcn_s_sleep(1); \
    if ((++_sp & 255u) == 0u) { if (xb_ld(&(bar)[XB_TMO])) break; if (_sp > XB_SPIN_CAP) { atomicAdd(&(bar)[XB_TMO], 1u); break; } } } } while (0)

struct XcdBarrier {
    unsigned* bar; unsigned x;
    volatile LAS unsigned* st;
};

__device__ __forceinline__ XcdBarrier xcd_barrier_post(unsigned* bar, volatile LAS unsigned* st) {
    XcdBarrier b; b.bar = bar; b.x = xb_xcc_id(); b.st = st;
    if (threadIdx.x == 0) (void)xb_add(&bar[XB_XCNT(b.x)], 1u);
    return b;
}
__device__ __forceinline__ void xcd_barrier_complete(unsigned* bar, unsigned x, unsigned& nloc, unsigned& nx) {
    const unsigned G = gridDim.x * gridDim.y * gridDim.z;
    unsigned sum, cnt, mine, sp = 0u;
    for (;;) {
        sum = 0u; cnt = 0u; mine = 0u;
#pragma unroll
        for (unsigned j = 0; j < 16; ++j) { const unsigned c = xb_ld(&bar[XB_XCNT(j)]); sum += c; cnt += (c > 0u) ? 1u : 0u; mine = (j == x) ? c : mine; }
        if (sum == G) break;
        __builtin_amdgcn_s_sleep(1);
        if ((++sp & 255u) == 0u) { if (xb_ld(&bar[XB_TMO])) break; if (sp > XB_SPIN_CAP) { atomicAdd(&bar[XB_TMO], 1u); break; } }
    }
    nloc = mine > 0u ? mine : 1u; nx = cnt > 0u ? cnt : 1u;
}

__device__ __forceinline__ void xcd_barrier(const XcdBarrier& b) {
    asm volatile("s_waitcnt vmcnt(0)" ::: "memory");
    __syncthreads();
    if (threadIdx.x == 0) {
        unsigned* bar = b.bar;
        __builtin_amdgcn_s_waitcnt(0);
        unsigned nloc = b.st[0], nx = b.st[1];
        if (nloc == 0u) { xcd_barrier_complete(bar, b.x, nloc, nx); b.st[0] = nloc; b.st[1] = nx; }
        const unsigned old = xb_add(&bar[XB_XSUB(b.x)], 1u);
        const unsigned gen = old / nloc;
        if (old + 1u == (gen + 1u) * nloc) {
            __builtin_amdgcn_fence(__ATOMIC_RELEASE, "agent");
            asm volatile("s_waitcnt vmcnt(0)" ::: "memory");
            const unsigned og = xb_add(&bar[XB_TOP], 1u);
            const unsigned tg = og / nx;
            if (og + 1u == (tg + 1u) * nx) xb_add(&bar[XB_TOPGEN], 1u);
            else XB_SPIN(xb_ld(&bar[XB_TOPGEN]) == tg, bar);
            __builtin_amdgcn_fence(__ATOMIC_ACQUIRE, "agent");
            xb_add(&bar[XB_XGEN(b.x)], 1u);
            asm volatile("s_waitcnt vmcnt(0)" ::: "memory");
        } else {
            XB_SPIN(xb_ld(&bar[XB_XGEN(b.x)]) == gen, bar);
            __builtin_amdgcn_fence(__ATOMIC_ACQUIRE, "agent");
            asm volatile("s_waitcnt vmcnt(0)" ::: "memory");
        }
    }
    __syncthreads();
}
typedef unsigned v2u __attribute__((ext_vector_type(2)));
__device__ __forceinline__ float wave_sum(float v) {
#pragma unroll
    for (int o = 1; o < 64; o <<= 1) v += __shfl_xor(v, o);
    return v;
}
__device__ __forceinline__ float bflo(unsigned w) { return __builtin_bit_cast(float, w << 16); }
__device__ __forceinline__ float bfhi(unsigned w) { return __builtin_bit_cast(float, w & 0xffff0000u); }
__device__ __forceinline__ float bf1(unsigned short h) { return __builtin_bit_cast(float, (unsigned)h << 16); }
__device__ __forceinline__ float ex2(float x) { return __builtin_amdgcn_exp2f(x); }
__device__ __forceinline__ float rsq(float x) { return __builtin_amdgcn_rsqf(x); }

__device__ __forceinline__ void p0_item(const float* W, int Nsrc, int k0, int scol0, const float* gain, bf16* WT, int K, int drow0, LAS float* scr, int lane) {
#pragma unroll 8
    for (int i = 0; i < 32; ++i) { const int kk = 2 * i + (lane >> 5); float v = W[(size_t)(k0 + kk) * Nsrc + scol0 + (lane & 31)]; if (gain) v *= gain[k0 + kk]; scr[kk * 33 + (lane & 31)] = v; }
    LDS_WAIT(); asm volatile("" ::: "memory");
    const int c = lane & 7;
#pragma unroll
    for (int j = 0; j < 4; ++j) { const int n = (lane >> 3) + 8 * j; const LAS float* s = scr + (8 * c) * 33 + n;
        v4u o; o.x = pk2(s[0 * 33], s[1 * 33]); o.y = pk2(s[2 * 33], s[3 * 33]); o.z = pk2(s[4 * 33], s[5 * 33]); o.w = pk2(s[6 * 33], s[7 * 33]);
        *(GAS v4u*)(WT + (size_t)(drow0 + n) * K + k0 + 8 * c) = o; }
    LDS_WAIT(); asm volatile("" ::: "memory");
}
__device__ __forceinline__ void p0_gu(const float* Wg, const float* Wu, const float* gain, bf16* WT, int r, LAS float* scr, int lane) {
    const int nblk = 2 * DFF / 32, kb = r / nblk, nb = r % nblk, n0 = 32 * nb, pn = n0 >> 8, bj = (n0 >> 7) & 1, j0 = n0 & 127;
    p0_item(bj ? Wu : Wg, DFF, 64 * kb, 128 * pn + j0, gain, WT, DMODEL, n0, scr, lane);
}
__device__ __forceinline__ void p0_plain(const float* W, int K, int N, const float* gain, bf16* WT, int r, LAS float* scr, int lane) {
    const int nblk = N / 32, kb = r / nblk, nb = r % nblk;
    p0_item(W, N, 64 * kb, 32 * nb, gain, WT, K, 32 * nb, scr, lane);
}
__device__ __forceinline__ void p0_prologue(LAS unsigned char* lds, const float* const* in, unsigned char* ws, int gw, int NGW, int wave, int lane) {
    LAS float* scr = (LAS float*)(lds + RING_OFF + wave * 16384);
    constexpr int I_GU = (DMODEL / 64) * (2 * DFF / 32), I_D = (DFF / 64) * (DMODEL / 32), I_IN = (DMODEL / 64) * (DIN / 32), I_OUT = (DMODEL / 64) * (DMODEL / 32);
    constexpr int NITEMS = 2 * I_GU + 2 * I_D + I_IN + I_OUT;
    for (int it = gw; it < NITEMS; it += NGW) {
        int r = it;
        if (r < I_GU) { p0_gu(in[3], in[4], in[2], (bf16*)(ws + WS_WGU1), r, scr, lane); continue; } r -= I_GU;
        if (r < I_GU) { p0_gu(in[18], in[19], in[17], (bf16*)(ws + WS_WGU2), r, scr, lane); continue; } r -= I_GU;
        if (r < I_D) { p0_plain(in[5], DFF, DMODEL, nullptr, (bf16*)(ws + WS_WD1), r, scr, lane); continue; } r -= I_D;
        if (r < I_D) { p0_plain(in[20], DFF, DMODEL, nullptr, (bf16*)(ws + WS_WD2), r, scr, lane); continue; } r -= I_D;
        if (r < I_IN) { p0_plain(in[7], DMODEL, DIN, in[6], (bf16*)(ws + WS_WIN), r, scr, lane); continue; } r -= I_IN;
        p0_plain(in[16], DMODEL, DMODEL, nullptr, (bf16*)(ws + WS_WOUT), r, scr, lane);
    }
    bf16* XB = (bf16*)(ws + WS_BUFA); float* p16 = (float*)(ws + WS_P16);
    for (int m = gw; m < TOK; m += NGW) {
        const float* xrow = m < NPROMPT ? in[0] + (size_t)m * DMODEL : in[1] + (size_t)(m - NPROMPT) * DMODEL;
        const GAS f32x4* xr = (const GAS f32x4*)xrow + lane;
        f32x4 v[4]; float s = 0.f;
#pragma unroll
        for (int j = 0; j < 4; ++j) { v[j] = xr[64 * j]; s += (v[j].x * v[j].x + v[j].y * v[j].y) + (v[j].z * v[j].z + v[j].w * v[j].w); }
        s = wave_sum(s);
        GAS v2u* o8 = (GAS v2u*)(XB + (size_t)m * DMODEL) + lane;
#pragma unroll
        for (int j = 0; j < 4; ++j) { v2u w; w.x = pk2(v[j].x, v[j].y); w.y = pk2(v[j].z, v[j].w); o8[64 * j] = w; }
        if (lane < 16) p16[(size_t)m * 16 + lane] = lane == 0 ? s : 0.f;
    }
}

__device__ __forceinline__ void final_norm(float* out, const float* gfin, int gw, int NGW, int lane) {
    for (int m = gw; m < TOK; m += NGW) {
        GAS f32x4* xr = (GAS f32x4*)(out + (size_t)m * DMODEL) + lane;
        f32x4 v[4]; float s = 0.f;
#pragma unroll
        for (int j = 0; j < 4; ++j) { v[j] = xr[64 * j]; s += (v[j].x * v[j].x + v[j].y * v[j].y) + (v[j].z * v[j].z + v[j].w * v[j].w); }
        const float r = rsq(wave_sum(s) * (1.0f / DMODEL) + EPS);
#pragma unroll
        for (int j = 0; j < 4; ++j) { const f32x4 g = *((const GAS f32x4*)gfin + lane + 64 * j); xr[64 * j] = v[j] * r * g; }
    }
}

constexpr int HG_RAWLF = 0, HG_RAWQ = 17408, HG_QN = 34816, HG_KN = 52224, HG_KT = 69632, HG_VT = 88064, HG_SCL = 97280, HG_ST = 106496, HG_SEG = 115200, HG_SA = 119296, HG_SB = 119808, HG_END = 120320;
static_assert(HG_END <= RING_BYTES, "hgrn LDS");
__device__ __forceinline__ void hgrn_item(LAS unsigned char* lds, const bf16* P, float* ob, int row0, int L, int h, int dir, int dq, int tid, int lane, int wave) {
    const int fr = lane & 15, fq = lane >> 4, nch = L >> 6;
    const bf16* gq = P + COL_Q + h * 128;
    const bf16* gl = P + (dir ? COL_FB : COL_FF) + h * 128;
    const bf16* gv = P + COL_I + h * 128 + dq * 32;
    float* go = ob + h * 128 + dq * 32;
    const int lr = tid >> 4, lc = tid & 15, lp = (tid >> 2) & 31, vc = tid & 3, cp = lane, s8 = wave;
#define TOKROW(n, l) (row0 + (dir ? (L - 1 - (64 * (n) + (l))) : (64 * (n) + (l))))
#define HG_LOAD(n) do { _Pragma("unroll") for (int i_ = 0; i_ < 2; ++i_) { const size_t ro_ = (size_t)TOKROW(n, lr + 32 * i_) * DIN + 8 * lc; rl[i_] = *(const GAS v4u*)(gl + ro_); rq[i_] = *(const GAS v4u*)(gq + ro_); \
        rv[i_] = *(const GAS v4u*)(gv + (size_t)TOKROW(n, 2 * lp + i_) * DIN + 8 * vc); } } while (0)
    v4u rl[2], rq[2], rv[2];
    HG_LOAD(0);
    f32x4 S0 = {0.f, 0.f, 0.f, 0.f}, S1 = {0.f, 0.f, 0.f, 0.f};
    for (int n = 0; n < nch; ++n) {
        const int vbuf = HG_VT + (n & 1) * 4608;
#pragma unroll
        for (int i = 0; i < 2; ++i) { *(LAS v4u*)(lds + HG_RAWLF + (lr + 32 * i) * 272 + lc * 16) = rl[i]; *(LAS v4u*)(lds + HG_RAWQ + (lr + 32 * i) * 272 + lc * 16) = rq[i]; }
        if (tid < 128) {
#pragma unroll
            for (int e = 0; e < 4; ++e) { const unsigned w0 = rv[0][e], w1 = rv[1][e];
                *(LAS unsigned*)(lds + vbuf + (8 * vc + 2 * e) * 144 + lp * 4) = (w0 & 0xffffu) | (w1 << 16);
                *(LAS unsigned*)(lds + vbuf + (8 * vc + 2 * e + 1) * 144 + lp * 4) = (w0 >> 16) | (w1 & 0xffff0000u); }
        }
        if (n + 1 < nch) HG_LOAD(n + 1);
        __syncthreads();
        float lfa[8], lfb[8], ava[8], avb[8]; float runa = 0.f, runb = 0.f;
#pragma unroll
        for (int j = 0; j < 8; ++j) { const unsigned w = *(const LAS unsigned*)(lds + HG_RAWLF + (8 * s8 + j) * 272 + cp * 4);
            lfa[j] = bflo(w); lfb[j] = bfhi(w); runa += lfa[j]; runb += lfb[j]; ava[j] = runa; avb[j] = runb; }
        *(LAS v2u*)(lds + HG_SEG + (s8 * 128 + 2 * cp) * 4) = (v2u){__builtin_bit_cast(unsigned, runa), __builtin_bit_cast(unsigned, runb)};
        __syncthreads();
        {
            typedef float f32x2v __attribute__((ext_vector_type(2)));
            f32x2v sg_[8];
#pragma unroll
            for (int q = 0; q < 8; ++q) sg_[q] = *(const LAS f32x2v*)(lds + HG_SEG + (q * 128 + 2 * cp) * 4);
            const f32x2v amid2 = (sg_[0] + sg_[1]) + (sg_[2] + sg_[3]);
            const f32x2v atot2 = amid2 + ((sg_[4] + sg_[5]) + (sg_[6] + sg_[7]));
            f32x2v off2 = -amid2;
#pragma unroll
            for (int q = 0; q < 7; ++q) { const float mq = (q < s8) ? 1.0f : 0.0f; off2 = off2 + sg_[q] * mq; }
            const float amida = amid2.x, amidb = amid2.y, atota = atot2.x, atotb = atot2.y;
            const float offa = off2.x, offb = off2.y;
            unsigned kta[4], ktb[4];
#pragma unroll
            for (int j = 0; j < 8; ++j) {
                const float aa = offa + ava[j], ab = offb + avb[j];
                const unsigned qw = *(const LAS unsigned*)(lds + HG_RAWQ + (8 * s8 + j) * 272 + cp * 4);
                const float qta = bflo(qw) * ex2(aa), qtb = bfhi(qw) * ex2(ab);
                const float k_a = (1.0f - ex2(lfa[j])) * ex2(-aa), k_b = (1.0f - ex2(lfb[j])) * ex2(-ab);
                const unsigned kba = f2bf(k_a), kbb = f2bf(k_b);
                *(LAS unsigned*)(lds + HG_QN + (8 * s8 + j) * 272 + cp * 4) = pk2(qta, qtb);
                *(LAS unsigned*)(lds + HG_KN + (8 * s8 + j) * 272 + cp * 4) = kba | (kbb << 16);
                if (j & 1) { kta[j >> 1] |= kba << 16; ktb[j >> 1] |= kbb << 16; } else { kta[j >> 1] = kba; ktb[j >> 1] = kbb; }
            }
            *(LAS v4u*)(lds + HG_KT + (2 * cp) * 144 + s8 * 16) = (v4u){kta[0], kta[1], kta[2], kta[3]};
            *(LAS v4u*)(lds + HG_KT + (2 * cp + 1) * 144 + s8 * 16) = (v4u){ktb[0], ktb[1], ktb[2], ktb[3]};
            if (s8 == 0) { *(LAS v2u*)(lds + HG_SA + (2 * cp) * 4) = (v2u){__builtin_bit_cast(unsigned, ex2(amida)), __builtin_bit_cast(unsigned, ex2(amidb))};
                           *(LAS v2u*)(lds + HG_SB + (2 * cp) * 4) = (v2u){__builtin_bit_cast(unsigned, ex2(atota - amida)), __builtin_bit_cast(unsigned, ex2(atotb - amidb))}; }
        }
        __syncthreads();
        {
            const f32x4 sa = *(const LAS f32x4*)(lds + HG_SA + (16 * wave + 4 * fq) * 4);
            S0 = S0 * sa; S1 = S1 * sa;
#ifdef DBG_NOSTATE
            S0 = (f32x4){0.f,0.f,0.f,0.f}; S1 = S0;
#endif
            v2u w0, w1; w0.x = pk2(S0[0], S0[1]); w0.y = pk2(S0[2], S0[3]); w1.x = pk2(S1[0], S1[1]); w1.y = pk2(S1[2], S1[3]);
            *(LAS v2u*)(lds + HG_ST + fr * 272 + (16 * wave + 4 * fq) * 2) = w0;
            *(LAS v2u*)(lds + HG_ST + (16 + fr) * 272 + (16 * wave + 4 * fq) * 2) = w1;
        }
        {
            const int ib = wave & 3, jp = wave >> 2;
#pragma unroll
            for (int t = 0; t < 2; ++t) {
                const int jb = 2 * jp + t;
                f32x4 sc = {0.f, 0.f, 0.f, 0.f};
                if (jb <= ib) {
#pragma unroll
                    for (int ks = 0; ks < 4; ++ks) {
                        const bf16x8 x = *(const LAS bf16x8*)(lds + HG_KN + (16 * jb + fr) * 272 + ks * 64 + fq * 16);
                        const bf16x8 y = *(const LAS bf16x8*)(lds + HG_QN + (16 * ib + fr) * 272 + ks * 64 + fq * 16);
                        sc = __builtin_amdgcn_mfma_f32_16x16x32_bf16(x, y, sc, 0, 0, 0);
                    }
                    if (jb == ib) {
#pragma unroll
                        for (int r = 0; r < 4; ++r) if (4 * fq + r > fr) sc[r] = 0.f;
                    }
                }
                v2u w; w.x = pk2(sc[0], sc[1]); w.y = pk2(sc[2], sc[3]);
                *(LAS v2u*)(lds + HG_SCL + (16 * ib + fr) * 144 + (16 * jb + 4 * fq) * 2) = w;
            }
        }
        __syncthreads();
        {
            const int ib2 = wave >> 1, db = wave & 1;
            f32x4 O = {0.f, 0.f, 0.f, 0.f};
#pragma unroll
            for (int ks = 0; ks < 2; ++ks) {
                const bf16x8 x = *(const LAS bf16x8*)(lds + vbuf + (16 * db + fr) * 144 + ks * 64 + fq * 16);
                const bf16x8 y = *(const LAS bf16x8*)(lds + HG_SCL + (16 * ib2 + fr) * 144 + ks * 64 + fq * 16);
                O = __builtin_amdgcn_mfma_f32_16x16x32_bf16(x, y, O, 0, 0, 0);
            }
#pragma unroll
            for (int ks = 0; ks < 4; ++ks) {
                const bf16x8 x = *(const LAS bf16x8*)(lds + HG_ST + (16 * db + fr) * 272 + ks * 64 + fq * 16);
                const bf16x8 y = *(const LAS bf16x8*)(lds + HG_QN + (16 * ib2 + fr) * 272 + ks * 64 + fq * 16);
                O = __builtin_amdgcn_mfma_f32_16x16x32_bf16(x, y, O, 0, 0, 0);
            }
#if defined(DBG_HG) && DBG_HG == 1
            { const v2u w = *(const LAS v2u*)(lds + HG_QN + (16 * ib2 + fr) * 272 + (16 * db + 4 * fq) * 2); O = (f32x4){bflo(w.x), bfhi(w.x), bflo(w.y), bfhi(w.y)}; }
#elif defined(DBG_HG) && DBG_HG == 2
            { const v2u w = *(const LAS v2u*)(lds + HG_SCL + (16 * ib2 + fr) * 144 + (16 * db + 4 * fq) * 2); O = (f32x4){bflo(w.x), bfhi(w.x), bflo(w.y), bfhi(w.y)}; }
#elif defined(DBG_HG) && DBG_HG == 3
            { const v2u w = *(const LAS v2u*)(lds + vbuf + (16 * db + fr) * 144 + (16 * (ib2 & 3) + 4 * fq) * 2); O = (f32x4){bflo(w.x), bfhi(w.x), bflo(w.y), bfhi(w.y)}; }
#elif defined(DBG_HG) && DBG_HG == 5
            { const v2u w = *(const GAS v2u*)(gq + (size_t)TOKROW(n, 16 * ib2 + fr) * DIN + 16 * db + 4 * fq); O = (f32x4){bflo(w.x), bfhi(w.x), bflo(w.y), bfhi(w.y)}; }
#elif defined(DBG_HG) && DBG_HG == 9
            { const v2u w = *(const GAS v2u*)(gl + (size_t)TOKROW(n, 16 * ib2 + fr) * DIN + 16 * db + 4 * fq); O = (f32x4){bflo(w.x), bfhi(w.x), bflo(w.y), bfhi(w.y)}; }
#elif defined(DBG_HG) && DBG_HG == 10
            { const v2u w = *(const LAS v2u*)(lds + HG_RAWLF + (16 * ib2 + fr) * 272 + (16 * db + 4 * fq) * 2); O = (f32x4){bflo(w.x), bfhi(w.x), bflo(w.y), bfhi(w.y)}; }
#elif defined(DBG_HG) && DBG_HG == 7
            { const v2u w = *(const GAS v2u*)(P + COL_U + h * 128 + (size_t)TOKROW(n, 16 * ib2 + fr) * DIN + 16 * db + 4 * fq); O = (f32x4){bflo(w.x), bfhi(w.x), bflo(w.y), bfhi(w.y)}; }
#elif defined(DBG_HG) && DBG_HG == 8
            { O = (f32x4){(float)TOKROW(n, 16 * ib2 + fr), (float)(16 * db + 4 * fq), (float)h, (float)dq}; }
#elif defined(DBG_HG) && DBG_HG == 6
            { const v2u w = *(const LAS v2u*)(lds + HG_RAWQ + (16 * ib2 + fr) * 272 + (16 * db + 4 * fq) * 2); O = (f32x4){bflo(w.x), bfhi(w.x), bflo(w.y), bfhi(w.y)}; }
#elif defined(DBG_HG) && DBG_HG == 4
            { const v2u w = *(const LAS v2u*)(lds + HG_KN + (16 * ib2 + fr) * 272 + (16 * db + 4 * fq) * 2); O = (f32x4){bflo(w.x), bfhi(w.x), bflo(w.y), bfhi(w.y)}; }
#endif
            *(GAS f32x4*)(go + (size_t)TOKROW(n, 16 * ib2 + fr) * 512 + 16 * db + 4 * fq) = O;
        }
        {
#pragma unroll
            for (int ks = 0; ks < 2; ++ks) {
                const bf16x8 x = *(const LAS bf16x8*)(lds + HG_KT + (16 * wave + fr) * 144 + ks * 64 + fq * 16);
                const bf16x8 y0 = *(const LAS bf16x8*)(lds + vbuf + fr * 144 + ks * 64 + fq * 16);
                const bf16x8 y1 = *(const LAS bf16x8*)(lds + vbuf + (16 + fr) * 144 + ks * 64 + fq * 16);
                S0 = __builtin_amdgcn_mfma_f32_16x16x32_bf16(x, y0, S0, 0, 0, 0);
                S1 = __builtin_amdgcn_mfma_f32_16x16x32_bf16(x, y1, S1, 0, 0, 0);
            }
            const f32x4 sb = *(const LAS f32x4*)(lds + HG_SB + (16 * wave + 4 * fq) * 4);
            S0 = S0 * sb; S1 = S1 * sb;
        }
        __syncthreads();
    }
#undef HG_LOAD
#undef TOKROW
}

#ifdef DBG_NAIVE_HGRN
__device__ __forceinline__ void naive_hgrn_item(LAS unsigned char* lds, const bf16* P, float* ob, int row0, int L, int h, int dir, int tid) {
    LAS float* LQ = (LAS float*)lds; LAS float* LF = LQ + 2048; LAS float* LK = LF + 2048;
    const unsigned short* Pu = (const unsigned short*)P;
    float S[128];
#pragma unroll
    for (int k = 0; k < 128; ++k) S[k] = 0.f;
    for (int t0 = 0; t0 < L; t0 += 16) {
        __syncthreads();
#pragma unroll
        for (int i = 0; i < 4; ++i) { const int idx = tid + 512 * i, st = idx >> 7, k = idx & 127; const size_t row = (size_t)(row0 + (dir ? (L - 1 - (t0 + st)) : (t0 + st)));
            const float qv = bf1(Pu[row * DIN + COL_Q + h * 128 + k]), l2 = bf1(Pu[row * DIN + (dir ? COL_FB : COL_FF) + h * 128 + k]), f = exp2f(l2);
            LQ[st * 128 + k] = qv; LF[st * 128 + k] = f; LK[st * 128 + k] = 1.0f - f; }
        __syncthreads();
        if (tid < 128) {
#pragma unroll 1
            for (int st = 0; st < 16; ++st) { const size_t row = (size_t)(row0 + (dir ? (L - 1 - (t0 + st)) : (t0 + st)));
                const float v = bf1(Pu[row * DIN + COL_I + h * 128 + tid]); float o = 0.f;
#pragma unroll
                for (int k4 = 0; k4 < 32; ++k4) { const f32x4 f4 = *(const LAS f32x4*)(LF + st * 128 + 4 * k4), k4v = *(const LAS f32x4*)(LK + st * 128 + 4 * k4), q4 = *(const LAS f32x4*)(LQ + st * 128 + 4 * k4);
#pragma unroll
                    for (int e = 0; e < 4; ++e) { S[4 * k4 + e] = f4[e] * S[4 * k4 + e] + k4v[e] * v; o += q4[e] * S[4 * k4 + e]; } }
                ob[row * 512 + h * 128 + tid] = o; }
        }
    }
    __syncthreads();
}
#endif
__device__ __forceinline__ void hgrn_combine(const float* ob0, const float* ob1, const bf16* P, const float* onorm, const float* ssg, const float* gon, bf16* Y, int gw, int NGW, int lane) {
    const int c = 8 * lane;
    const f32x4 g0 = *(const GAS f32x4*)(onorm + c), g1 = *(const GAS f32x4*)(onorm + c + 4);
    const f32x4 n0 = *(const GAS f32x4*)(gon + c), n1 = *(const GAS f32x4*)(gon + c + 4);
    for (int m = gw; m < TOK; m += NGW) {
        const f32x4 a0 = *(const GAS f32x4*)(ob0 + (size_t)m * 512 + c), a1 = *(const GAS f32x4*)(ob0 + (size_t)m * 512 + c + 4);
        const f32x4 b0 = *(const GAS f32x4*)(ob1 + (size_t)m * 512 + c), b1 = *(const GAS f32x4*)(ob1 + (size_t)m * 512 + c + 4);
        const v4u sgw = *(const GAS v4u*)(P + (size_t)m * DIN + COL_G + c);
#ifdef DBG_PCOPY
        f32x4 o0 = {0.f,0.f,0.f,0.f}, o1 = o0;
        { const int segs[4] = {COL_Q, COL_I, COL_FF, COL_FB};
#pragma unroll
          for (int q_ = 0; q_ < 4; ++q_) { const v4u pw = *(const GAS v4u*)(P + (size_t)m * DIN + segs[q_] + c);
            o0 += (f32x4){bflo(pw.x), bfhi(pw.x), bflo(pw.y), bfhi(pw.y)}; o1 += (f32x4){bflo(pw.z), bfhi(pw.z), bflo(pw.w), bfhi(pw.w)}; } }
#else
        const f32x4 o0 = a0 + b0, o1 = a1 + b1;
#endif
        float s = ((o0[0] * o0[0] + o0[1] * o0[1]) + (o0[2] * o0[2] + o0[3] * o0[3])) + ((o1[0] * o1[0] + o1[1] * o1[1]) + (o1[2] * o1[2] + o1[3] * o1[3]));
        s += __shfl_xor(s, 1); s += __shfl_xor(s, 2); s += __shfl_xor(s, 4); s += __shfl_xor(s, 8);
        const float r = rsq(s * (1.0f / 128.0f) + EPS);
        const f32x4 y0 = o0 * r * g0 * (f32x4){bflo(sgw.x), bfhi(sgw.x), bflo(sgw.y), bfhi(sgw.y)};
        const f32x4 y1 = o1 * r * g1 * (f32x4){bflo(sgw.z), bfhi(sgw.z), bflo(sgw.w), bfhi(sgw.w)};
        v4u w; w.x = pk2(y0[0], y0[1]); w.y = pk2(y0[2], y0[3]); w.z = pk2(y1[0], y1[1]); w.w = pk2(y1[2], y1[3]);
        *(GAS v4u*)(Y + (size_t)m * DMODEL + 512 + c) = w;
#ifndef NO_GMLP
        const f32x4 sv = *(const GAS f32x4*)(ssg + (size_t)m * 4);
        const float rg = rsq(((sv[0] + sv[1]) + (sv[2] + sv[3])) * (1.0f / 512.0f) + EPS);
        const v4u yw = *(const GAS v4u*)(Y + (size_t)m * DMODEL + c);
        const f32x4 z0 = (f32x4){bflo(yw.x), bfhi(yw.x), bflo(yw.y), bfhi(yw.y)} * rg * n0, z1 = (f32x4){bflo(yw.z), bfhi(yw.z), bflo(yw.w), bfhi(yw.w)} * rg * n1;
        v4u zw; zw.x = pk2(z0[0], z0[1]); zw.y = pk2(z0[2], z0[3]); zw.z = pk2(z1[0], z1[1]); zw.w = pk2(z1[2], z1[3]);
        *(GAS v4u*)(Y + (size_t)m * DMODEL + c) = zw;
#endif
    }
}

constexpr int GM_RAWV = 0, GM_VLT = 34816, GM_WL = 69632, GM_MEAN = 104448, GM_RSTD = 104960, GM_END = 105472;
static_assert(GM_END <= RING_BYTES, "gmlp LDS");
__device__ __forceinline__ void gmlp_item(LAS unsigned char* lds, const bf16* P, bf16* Y, float* ssg, const float* ln_g, const float* ln_b, const float* w_s, const float* b_s, int c, int h, int tid, int lane, int wave) {
    const int fr = lane & 15, fq = lane >> 4, R0 = 128 * c;
#pragma unroll 1
    for (int jj = 0; jj < 4; ++jj) {
        float sm[4], sq[4];
#pragma unroll
        for (int j = 0; j < 4; ++j) {
            const int s = 16 * wave + 4 * jj + j;
            const v4u raw = *(const GAS v4u*)(P + (size_t)(R0 + s) * DIN + COL_V + 8 * lane);
            const float x0 = bflo(raw.x), x1 = bfhi(raw.x), x2 = bflo(raw.y), x3 = bfhi(raw.y), x4 = bflo(raw.z), x5 = bfhi(raw.z), x6 = bflo(raw.w), x7 = bfhi(raw.w);
            sm[j] = ((x0 + x1) + (x2 + x3)) + ((x4 + x5) + (x6 + x7));
            sq[j] = ((x0 * x0 + x1 * x1) + (x2 * x2 + x3 * x3)) + ((x4 * x4 + x5 * x5) + (x6 * x6 + x7 * x7));
        }
#pragma unroll
        for (int o = 1; o < 64; o <<= 1) {
#pragma unroll
            for (int j = 0; j < 4; ++j) { sm[j] += __shfl_xor(sm[j], o); sq[j] += __shfl_xor(sq[j], o); }
        }
        if (lane == 0) {
#pragma unroll
            for (int j = 0; j < 4; ++j) { const int s = 16 * wave + 4 * jj + j; const float mean = sm[j] * (1.0f / 512.0f), var = fmaxf(sq[j] * (1.0f / 512.0f) - mean * mean, 0.f);
                *(LAS float*)(lds + GM_MEAN + s * 4) = mean; *(LAS float*)(lds + GM_RSTD + s * 4) = rsq(var + EPS); }
        }
    }
#pragma unroll
    for (int i = 0; i < 4; ++i) { const int idx = tid + 512 * i, row = idx >> 4, c16 = idx & 15;
        *(LAS v4u*)(lds + GM_RAWV + row * 272 + c16 * 16) = *(const GAS v4u*)(P + (size_t)(R0 + row) * DIN + COL_V + 128 * h + 8 * c16); }
#pragma unroll
    for (int i = 0; i < 8; ++i) { const int idx = tid + 512 * i, tt = idx >> 5, s4 = idx & 31;
        const f32x4 w = *(const GAS f32x4*)(w_s + (size_t)h * 16384 + tt * 128 + 4 * s4);
        v2u o; o.x = pk2(w[0], w[1]); o.y = pk2(w[2], w[3]);
        *(LAS v2u*)(lds + GM_WL + tt * 272 + s4 * 8) = o; }
    __syncthreads();
    {
        const int ch = tid & 127, sq4 = tid >> 7;
        const float g = ln_g[128 * h + ch], b = ln_b[128 * h + ch];
#pragma unroll
        for (int i = 0; i < 4; ++i) {
            unsigned wv[4];
#pragma unroll
            for (int e = 0; e < 8; ++e) { const int s = 32 * sq4 + 8 * i + e;
                const float x = bf1(*(const LAS unsigned short*)(lds + GM_RAWV + s * 272 + ch * 2));
                const float y = (x - *(const LAS float*)(lds + GM_MEAN + s * 4)) * *(const LAS float*)(lds + GM_RSTD + s * 4) * g + b;
                const unsigned yb = f2bf(y);
                if (e & 1) wv[e >> 1] |= yb << 16; else wv[e >> 1] = yb; }
            *(LAS v4u*)(lds + GM_VLT + ch * 272 + (32 * sq4 + 8 * i) * 2) = (v4u){wv[0], wv[1], wv[2], wv[3]};
        }
    }
    __syncthreads();
    const int t = 16 * wave + fr;
    bf16x8 yf[4];
#pragma unroll
    for (int ks = 0; ks < 4; ++ks) yf[ks] = *(const LAS bf16x8*)(lds + GM_WL + (16 * wave + fr) * 272 + ks * 64 + fq * 16);
    const float bs = b_s[h * 128 + t];
    float ss = 0.f;
#pragma unroll
    for (int cb = 0; cb < 8; ++cb) {
        f32x4 a = {0.f, 0.f, 0.f, 0.f};
#pragma unroll
        for (int ks = 0; ks < 4; ++ks) {
            const bf16x8 x = *(const LAS bf16x8*)(lds + GM_VLT + (16 * cb + fr) * 272 + ks * 64 + fq * 16);
            a = __builtin_amdgcn_mfma_f32_16x16x32_bf16(x, yf[ks], a, 0, 0, 0);
        }
        const int ch = 128 * h + 16 * cb + 4 * fq;
        const v2u uw = *(const GAS v2u*)(P + (size_t)(R0 + t) * DIN + COL_U + ch);
        const f32x4 uu = {bflo(uw.x), bfhi(uw.x), bflo(uw.y), bfhi(uw.y)};
        a = (a + bs) * uu;
        ss += (a[0] * a[0] + a[1] * a[1]) + (a[2] * a[2] + a[3] * a[3]);
        v2u w; w.x = pk2(a[0], a[1]); w.y = pk2(a[2], a[3]);
        *(GAS v2u*)(Y + (size_t)(R0 + t) * DMODEL + ch) = w;
    }
    ss += __shfl_xor(ss, 16); ss += __shfl_xor(ss, 32);
    if (fq == 0) ssg[(size_t)(R0 + t) * 4 + h] = ss;
    __syncthreads();
}

struct Args { const float* in[22]; float* out; unsigned char* ws; int ph_lo, ph_hi, li, pad; };
constexpr int N_PHASES = 10;
#ifndef PHMASK
#define PHMASK 1023
#endif
#ifndef MK_N_LAUNCHES
#define MK_N_LAUNCHES 1
#endif
__global__ void __launch_bounds__(NWAVES * 64, 2) fwd_kernel(Args args) {
    extern __shared__ __attribute__((aligned(16))) unsigned char lds_raw[];
    LAS unsigned char* lds = (LAS unsigned char*)lds_raw;
    volatile LAS unsigned* MISC = (volatile LAS unsigned*)(lds + MISC_OFF);
    const int tid = threadIdx.x, lane = tid & 63, wave = __builtin_amdgcn_readfirstlane(tid >> 6);
    const int G = gridDim.x, bx = blockIdx.x;
    const int vcu = (G % 8 == 0) ? (bx % 8) * (G / 8) + bx / 8 : bx;
    const int gw = vcu * NWAVES + wave, NGW = G * NWAVES;
    unsigned char* ws = args.ws;
    gu32* ctl = (gu32*)(ws + WS_CTL);
    for (int u = tid; u < (LDS_BYTES - LDSCTL_OFF) / 4; u += NWAVES * 64) ((LAS unsigned*)(lds + LDSCTL_OFF))[u] = 0u;
    __syncthreads();
    XcdBarrier bar = xcd_barrier_post((unsigned*)(ctl + CW_BAR) + args.li * XCD_BAR_WORDS, MISC + 8);
    const int lo = args.ph_lo, hi = args.ph_hi;
#define IN(k) (lo <= (k) && (k) < hi)
#define SEAM(k) do { if (IN(k) && IN((k) + 1)) xcd_barrier(bar); } while (0)
    bf16* XB = (bf16*)(ws + WS_BUFA); bf16* Y = (bf16*)(ws + WS_BUFB); bf16* BIG = (bf16*)(ws + WS_BIG);
    float* OB0 = (float*)(ws + WS_BUFA); float* OB1 = (float*)(ws + WS_OB1);
    float* SSG = (float*)(ws + WS_SSG);
    float* P16_0 = (float*)(ws + WS_P16); float* P16_1 = (float*)(ws + WS_P16 + 2 * MiB); float* P16_2 = (float*)(ws + WS_P16 + 4 * MiB);

    if (((PHMASK >> 0) & 1) && IN(0)) { p0_prologue(lds, args.in, ws, gw, NGW, wave, lane); }
    SEAM(0);
    if (((PHMASK >> 1) & 1) && IN(1)) { pg8::Gemm g{XB, (const bf16*)(ws + WS_WGU1), TOK, 2 * DFF, DMODEL}; pg8::StaticOrder S; S.init(TOK, 2 * DFF, G, bx);
        pg8::EpiSwiGLU E{BIG, DFF, P16_0};
        pg8::gemm_phase<pg8::EpiSwiGLU, pg8::StaticOrder, PG8_ALIGN, PG8_SP2>(lds + RING_OFF, g, S, E); }
    SEAM(1);
    if (((PHMASK >> 2) & 1) && IN(2)) { pg8::Gemm g{BIG, (const bf16*)(ws + WS_WD1), TOK, DMODEL, DFF}; pg8::StaticOrder S; S.init(TOK, DMODEL, G, bx);
        pg8::EpiResid<true, true> E{args.in[0], args.in[1], args.out, XB, P16_1, 0.5f};
        pg8::gemm_phase<pg8::EpiResid<true, true>, pg8::StaticOrder, PG8_ALIGN, PG8_SP2>(lds + RING_OFF, g, S, E); }
    SEAM(2);
    if (((PHMASK >> 3) & 1) && IN(3)) { pg8::Gemm g{XB, (const bf16*)(ws + WS_WIN), TOK, DIN, DMODEL}; pg8::StaticOrder S; S.init(TOK, DIN, G, bx);
        pg8::EpiMix E{BIG, DIN, P16_1, args.in[13], args.in[14]};
        pg8::gemm_phase<pg8::EpiMix, pg8::StaticOrder, PG8_ALIGN, PG8_SP2>(lds + RING_OFF, g, S, E); }
    SEAM(3);
    if (((PHMASK >> 4) & 1) && IN(4)) {
#ifdef DBG_CMP
        for (int slot = bx; slot < 256; slot += G) {
            const int xcd = slot & 7; const int nit = slot < 128 ? 1 : 2;
#pragma unroll 1
            for (int q2 = 0; q2 < nit; ++q2) {
                int row0, L, h, dir, dq;
                if (slot < 128) { const int j = slot >> 3, grp = xcd * 4 + (j >> 2), b = grp >> 3; dq = j & 3; h = (grp >> 1) & 3; dir = grp & 1; row0 = NPROMPT + 4096 * b; L = 4096; }
                else { const int j = (slot - 128) >> 3, grp = xcd * 8 + (j >> 1), b = grp >> 3; dq = 2 * (j & 1) + q2; h = (grp >> 1) & 3; dir = grp & 1; row0 = 2048 * b; L = 2048; }
                if (dir == DBG_CMP_DIR) hgrn_item(lds, BIG, (float*)Y, row0, L, h, dir, dq, tid, lane, wave);
            }
        }
#endif
#ifdef DBG_NAIVE_HGRN
        for (int it = bx; it < 96; it += G) { const int sq = it >> 3, h = (it >> 1) & 3, dir = it & 1; const int row0 = sq < 8 ? 2048 * sq : NPROMPT + 4096 * (sq - 8), L = sq < 8 ? 2048 : 4096;
            naive_hgrn_item(lds, BIG, dir ? OB1 : OB0, row0, L, h, dir, tid); }
#elif !defined(NO_HGRN)
        for (int slot = bx; slot < 256; slot += G) {
            const int xcd = slot & 7;
            const int nit = slot < 128 ? 1 : 2;
#pragma unroll 1
            for (int q2 = 0; q2 < nit; ++q2) {
                int row0, L, h, dir, dq;
                if (slot < 128) { const int j = slot >> 3, grp = xcd * 4 + (j >> 2), b = grp >> 3; dq = j & 3; h = (grp >> 1) & 3; dir = grp & 1; row0 = NPROMPT + 4096 * b; L = 4096; }
                else { const int j = (slot - 128) >> 3, grp = xcd * 8 + (j >> 1), b = grp >> 3; dq = 2 * (j & 1) + q2; h = (grp >> 1) & 3; dir = grp & 1; row0 = 2048 * b; L = 2048; }
                hgrn_item(lds, BIG, dir ? OB1 : OB0, row0, L, h, dir, dq, tid, lane, wave);
            }
        }
#endif
#if !defined(NO_GMLP) && !defined(DBG_CMP)
        for (int it = bx; it < 1024; it += G) gmlp_item(lds, BIG, Y, SSG, args.in[8], args.in[9], args.in[10], args.in[11], it >> 2, it & 3, tid, lane, wave);
#endif
    }
    SEAM(4);
#ifdef DBG_CMP
    if (IN(10)) {
        const float* F = (const float*)Y; const float* N = DBG_CMP_DIR ? OB1 : OB0;
        float sd = 0.f, sr = 0.f;
        for (int m = gw; m < TOK; m += NGW) {
            const int sq_ = m < NPROMPT ? (m >> 11) : 8 + ((m - NPROMPT) >> 12); const int t_ = m < NPROMPT ? (m & 2047) : ((m - NPROMPT) & 4095); const int L_ = m < NPROMPT ? 2048 : 4096;
            const int p_ = DBG_CMP_DIR ? (L_ - 1 - t_) : t_;
            (void)sq_;
            if (!(DBG_CMP_SEL)) continue;
            for (int j = 0; j < 2; ++j) { const int c = 4 * lane + 256 * j; const f32x4 a = *(const GAS f32x4*)(F + (size_t)m * 512 + c), b = *(const GAS f32x4*)(N + (size_t)m * 512 + c);
                if (!(DBG_CMP_COLSEL)) continue;
                const f32x4 d = a - b; sd += (d[0] * d[0] + d[1] * d[1]) + (d[2] * d[2] + d[3] * d[3]); sr += (b[0] * b[0] + b[1] * b[1]) + (b[2] * b[2] + b[3] * b[3]); }
        }
        sd = wave_sum(sd); sr = wave_sum(sr);
        if (lane == 0) { atomicAdd((float*)(ws + WS_CTL) + 8, sd); atomicAdd((float*)(ws + WS_CTL) + 9, sr); }
    }
    if (IN(11)) { for (int it = bx; it < 1024; it += G) gmlp_item(lds, BIG, Y, SSG, args.in[8], args.in[9], args.in[10], args.in[11], it >> 2, it & 3, tid, lane, wave); }
#endif
    if (((PHMASK >> 5) & 1) && IN(5)) { hgrn_combine(OB0, OB1, BIG, args.in[15], SSG, args.in[12], Y, gw, NGW, lane); }
    SEAM(5);
    if (((PHMASK >> 6) & 1) && IN(6)) { pg8::Gemm g{Y, (const bf16*)(ws + WS_WOUT), TOK, DMODEL, DMODEL}; pg8::StaticOrder S; S.init(TOK, DMODEL, G, bx);
        pg8::EpiResid<true, true> E{args.out, args.out + (size_t)NPROMPT * DMODEL, args.out, XB, P16_2, 1.0f};
        pg8::gemm_phase<pg8::EpiResid<true, true>, pg8::StaticOrder, PG8_ALIGN, PG8_SP2>(lds + RING_OFF, g, S, E); }
    SEAM(6);
    if (((PHMASK >> 7) & 1) && IN(7)) { pg8::Gemm g{XB, (const bf16*)(ws + WS_WGU2), TOK, 2 * DFF, DMODEL}; pg8::StaticOrder S; S.init(TOK, 2 * DFF, G, bx);
        pg8::EpiSwiGLU E{BIG, DFF, P16_2};
        pg8::gemm_phase<pg8::EpiSwiGLU, pg8::StaticOrder, PG8_ALIGN, PG8_SP2>(lds + RING_OFF, g, S, E); }
    SEAM(7);
    if (((PHMASK >> 8) & 1) && IN(8)) { pg8::Gemm g{BIG, (const bf16*)(ws + WS_WD2), TOK, DMODEL, DFF}; pg8::StaticOrder S; S.init(TOK, DMODEL, G, bx);
        pg8::EpiResid<false, false> E{args.out, args.out + (size_t)NPROMPT * DMODEL, args.out, nullptr, nullptr, 0.5f};
        pg8::gemm_phase<pg8::EpiResid<false, false>, pg8::StaticOrder, PG8_ALIGN, PG8_SP2>(lds + RING_OFF, g, S, E); }
    SEAM(8);
#ifdef DBG_OBOUT
    if (IN(9)) { for (int m = gw; m < TOK; m += NGW) { for (int j = 0; j < 4; ++j) { const int c = 4 * lane + 256 * j; const f32x4 a = *(const GAS f32x4*)(OB0 + (size_t)m * 512 + (c & 511)), b = *(const GAS f32x4*)(OB1 + (size_t)m * 512 + (c & 511));
        *(GAS f32x4*)(args.out + (size_t)m * DMODEL + c) = (j < 2) ? a : b; } } }
#else
    if (((PHMASK >> 9) & 1) && IN(9)) { final_norm(args.out, args.in[21], gw, NGW, lane);
#ifdef DBG_CMP
        { const float sd = __hip_atomic_load((float*)(ws + WS_CTL) + 8, __ATOMIC_RELAXED, __HIP_MEMORY_SCOPE_AGENT), sr = __hip_atomic_load((float*)(ws + WS_CTL) + 9, __ATOMIC_RELAXED, __HIP_MEMORY_SCOPE_AGENT);
          const float delta = sqrtf(sd / fmaxf(sr, 1e-30f));
          for (int m = gw; m < TOK; m += NGW) { GAS f32x4* xr = (GAS f32x4*)(args.out + (size_t)m * DMODEL) + lane;
              for (int j = 0; j < 4; ++j) { f32x4 v = xr[64 * j]; v = v + delta; xr[64 * j] = v; } } }
#endif
    }
#endif
#undef IN
#undef SEAM
}

extern "C" void kernel_launch(void* const* d_in, const int* in_sizes, int n_in, void* d_out, int out_size, void* d_ws, size_t ws_size, hipStream_t stream) {
    static int grid = 0;
    if (grid == 0) {
        if (n_in != 22 || out_size != TOK * DMODEL || ws_size < WS_END) { fprintf(stderr, "kernel_launch: unexpected problem (n_in %d, out %d, ws %zu); nothing launched\n", n_in, out_size, ws_size); grid = -1; return; }
        int dev = 0, cus = 0, per_cu = 0;
        if (hipGetDevice(&dev) != hipSuccess || hipDeviceGetAttribute(&cus, hipDeviceAttributeMultiprocessorCount, dev) != hipSuccess) { grid = -1; return; }
        if (hipFuncSetAttribute((const void*)fwd_kernel, hipFuncAttributeMaxDynamicSharedMemorySize, LDS_BYTES) != hipSuccess) { fprintf(stderr, "kernel_launch: hipFuncSetAttribute failed\n"); grid = -1; return; }
        if (hipOccupancyMaxActiveBlocksPerMultiprocessor(&per_cu, (const void*)fwd_kernel, NWAVES * 64, LDS_BYTES) != hipSuccess || per_cu < 1) { fprintf(stderr, "kernel_launch: occupancy query says %d blocks per CU; nothing launched\n", per_cu); (void)hipGetLastError(); grid = -1; return; }
        grid = cus;
    }
    if (grid < 0) return;
    if (hipMemsetAsync((char*)d_ws + WS_CTL, 0, CTL_ZERO_BYTES, stream) != hipSuccess) return;
    Args a{};
    for (int i = 0; i < 22; ++i) a.in[i] = (const float*)d_in[i];
    a.out = (float*)d_out; a.ws = (unsigned char*)d_ws;
#ifdef DBG_CMP
    constexpr int NL = 12; const int plist[12] = {0, 1, 2, 3, 4, 10, 11, 5, 6, 7, 8, 9};
#else
    constexpr int NL = MK_N_LAUNCHES; const int plist[10] = {0, 1, 2, 3, 4, 5, 6, 7, 8, 9};
#endif
    for (int li = 0; li < NL; ++li) {
        a.ph_lo = (NL == 1) ? 0 : plist[li]; a.ph_hi = (NL == 1) ? N_PHASES : plist[li] + 1; a.li = 0;
        hipLaunchKernelGGL(fwd_kernel, dim3(grid), dim3(NWAVES * 64), LDS_BYTES, stream, a);
        if (hipPeekAtLastError() != hipSuccess) { fprintf(stderr, "kernel_launch: launch %d failed\n", li); break; }
    }
}
```

```cpp
#include <hip/hip_runtime.h>
#include <cstdio>
#include <cstdint>
namespace pg8 {
#define PG8_LAS __attribute__((address_space(3)))
typedef unsigned short bf16_t;
typedef short bf16x8 __attribute__((ext_vector_type(8)));
typedef float f32x4 __attribute__((ext_vector_type(4)));
typedef unsigned u32x4 __attribute__((ext_vector_type(4)));
constexpr int BM = 256, BK = 64, HALF = 128, HTB = HALF * BK * 2  , STAGE_BYTES = 8 * HTB, NXCD = 8, WGM = 8;

__host__ __device__ __forceinline__ int lds_byte(int r, int c) { const int st = (r >> 4) * 2 + (c >> 5), rr = r & 15, cc = c & 31, ob = rr * 64 + cc * 2; return st * 1024 + (ob ^ (((ob >> 9) & 1) << 5)); }
__host__ __device__ __forceinline__ void stage_rc(int b, int& R, int& C) { const int st = b / 1024, sb = b % 1024, swz = sb ^ (((sb >> 9) & 1) << 5); R = (st >> 1) * 16 + swz / 64; C = (st & 1) * 32 + (swz % 64) / 2; }
__host__ __device__ __forceinline__ int perm32(int rho) { const int n = rho >> 4, i = rho & 15; return 8 * (i >> 2) + 4 * n + (i & 3); }

struct Unit { int pm, pn; };
struct Gemm { const bf16_t* A; const bf16_t* Bt; int M, N, K; };

struct StaticOrder {
    int nM, nN, nwg, G, c;
    __host__ __device__ void init(int M, int N, int G_, int c_) { nM = M / BM; nN = N / BM; nwg = nM * nN; G = G_; c = c_; }
    __host__ __device__ bool next(int i, Unit& u) const {
        const long L = (long)i * G + c; if (L >= nwg) return false;
        int wgid = (int)L; { const int q = nwg / NXCD, r = nwg % NXCD, xcd = wgid % NXCD, off = wgid / NXCD; wgid = (xcd < r ? xcd * (q + 1) : r * (q + 1) + (xcd - r) * q) + off; }
        const int nig = WGM * nN, gid = wgid / nig, fm = gid * WGM, gsz = (nM - fm) < WGM ? (nM - fm) : WGM;
        u.pm = fm + ((wgid % nig) % gsz); u.pn = (wgid % nig) / gsz; return true;
    }
    __device__ __forceinline__ void a_ready(const Unit&) const {}
    __device__ __forceinline__ void done(const Unit&) const {}
};

typedef __bf16 bf16x2_hw __attribute__((ext_vector_type(2)));
typedef float f32x2_hw __attribute__((ext_vector_type(2)));
__device__ __forceinline__ unsigned cvt_pk_bf16(float lo, float hi) { const f32x2_hw v = {lo, hi}; const bf16x2_hw b = __builtin_convertvector(v, bf16x2_hw); return __builtin_bit_cast(unsigned, b); }
typedef float f32x2 __attribute__((ext_vector_type(2)));
__device__ __forceinline__ f32x2 gelu_pk(f32x2 v) {
    const f32x2 av = __builtin_elementwise_abs(v), d = av * 0.2316418882f + 1.0f;
    f32x2 t; t.x = __builtin_amdgcn_rcpf(d.x); t.y = __builtin_amdgcn_rcpf(d.y);
    f32x2 q = t * 0.5307027145f + (-0.7265760135f); q = q * t + 0.7107068705f; q = q * t + (-0.142248368f); q = q * t + 0.127414796f; q = q * t;
    const f32x2 s = (v * v) * (-0.72134752044f);
    f32x2 e; e.x = __builtin_amdgcn_exp2f(s.x); e.y = __builtin_amdgcn_exp2f(s.y);
    const f32x2 m = v * (q * e), r = v - m;
    f32x2 o; o.x = v.x < 0.f ? m.x : r.x; o.y = v.y < 0.f ? m.y : r.y; return o;
}

constexpr float RMS_EPS = 1e-6f;
constexpr int DM = 1024;
__device__ __forceinline__ float row_rstd(const float* p16, int row, int fq) {
    const f32x4 v = *(const f32x4*)(p16 + (size_t)row * 16 + 4 * fq);
    float s = (v[0] + v[1]) + (v[2] + v[3]);
    s += __shfl_xor(s, 16); s += __shfl_xor(s, 32);
    return __builtin_amdgcn_rsqf(s * (1.0f / DM) + RMS_EPS);
}
__device__ __forceinline__ void row_rstd8(const float* p16, int row0, int fq, float (&rr)[8]) {
    f32x4 pv[8];
#pragma unroll
    for (int i = 0; i < 8; ++i) pv[i] = *(const f32x4*)(p16 + (size_t)(row0 + (i >> 2) * HALF + (i & 3) * 16) * 16 + 4 * fq);
#pragma unroll
    for (int i = 0; i < 8; ++i) { float s = (pv[i][0] + pv[i][1]) + (pv[i][2] + pv[i][3]); s += __shfl_xor(s, 16); s += __shfl_xor(s, 32); rr[i] = __builtin_amdgcn_rsqf(s * (1.0f / DM) + RMS_EPS); }
}
__device__ __forceinline__ float fast_sigmoid(float z) { return __builtin_amdgcn_rcpf(1.0f + __builtin_amdgcn_exp2f(-1.44269504089f * z)); }

struct EpiSwiGLU {
    static constexpr bool PERM = true, AFTER_DRAIN = false;
    bf16_t* O; int ldo; const float* p16;
    __device__ __forceinline__ void operator()(const f32x4 (&acc)[2][2][4][2], const Unit& u, int wr, int wc, int fr, int fq) const {
        const int row0 = u.pm * BM + wr * 64 + fr, col0 = u.pn * HALF + wc * 32 + 8 * fq;
        float rr[8];
        row_rstd8(p16, row0, fq, rr);
#pragma unroll
        for (int ai = 0; ai < 2; ++ai)
#pragma unroll
            for (int m = 0; m < 4; ++m) {
                const int row = row0 + ai * HALF + m * 16;
                const float r = rr[ai * 4 + m];
                float h[8];
#pragma unroll
                for (int n = 0; n < 2; ++n)
#pragma unroll
                    for (int e = 0; e < 4; ++e) { const float g = acc[ai][0][m][n][e] * r, up = acc[ai][1][m][n][e] * r; h[4 * n + e] = g * up * fast_sigmoid(g); }
                u32x4 w; w.x = cvt_pk_bf16(h[0], h[1]); w.y = cvt_pk_bf16(h[2], h[3]); w.z = cvt_pk_bf16(h[4], h[5]); w.w = cvt_pk_bf16(h[6], h[7]);
                *(u32x4*)(O + (size_t)row * ldo + col0) = w;
            }
    }
};

template <bool WANT_BF16, bool WANT_SS> struct EpiResid {
    static constexpr bool PERM = true, AFTER_DRAIN = false;
    const float* base0; const float* base1;
    float* out; bf16_t* xb; float* p16; float alpha;
    __device__ __forceinline__ void operator()(const f32x4 (&acc)[2][2][4][2], const Unit& u, int wr, int wc, int fr, int fq) const {
        const int row0 = u.pm * BM + wr * 64 + fr, col0 = u.pn * BM + wc * 32 + 8 * fq;
        const float* bp = (u.pm < 64) ? base0 : base1; const int brow = (u.pm < 64) ? 0 : 16384;
        f32x4 bcur[4], bnxt[4];
#define RESID_LOAD(dst, it) do { const size_t bo_ = (size_t)(row0 + ((it) >> 2) * HALF + ((it) & 3) * 16 - brow) * DM + col0; \
            dst[0] = *(const f32x4*)(bp + bo_); dst[1] = *(const f32x4*)(bp + bo_ + 4); dst[2] = *(const f32x4*)(bp + bo_ + HALF); dst[3] = *(const f32x4*)(bp + bo_ + HALF + 4); } while (0)
        RESID_LOAD(bcur, 0);
#pragma unroll
        for (int it = 0; it < 8; ++it) {
            const int ai = it >> 2, m = it & 3;
            if (it + 1 < 8) RESID_LOAD(bnxt, it + 1);
            const int row = row0 + ai * HALF + m * 16; const size_t off = (size_t)row * DM + col0;
            float ss = 0.f;
#pragma unroll
            for (int bj = 0; bj < 2; ++bj) {
                const f32x4 v0 = bcur[2 * bj] + acc[ai][bj][m][0] * alpha, v1 = bcur[2 * bj + 1] + acc[ai][bj][m][1] * alpha;
                *(f32x4*)(out + off + bj * HALF) = v0; *(f32x4*)(out + off + bj * HALF + 4) = v1;
                if (WANT_BF16) { u32x4 w; w.x = cvt_pk_bf16(v0[0], v0[1]); w.y = cvt_pk_bf16(v0[2], v0[3]); w.z = cvt_pk_bf16(v1[0], v1[1]); w.w = cvt_pk_bf16(v1[2], v1[3]);
                    *(u32x4*)(xb + off + bj * HALF) = w; }
                if (WANT_SS) ss += ((v0[0] * v0[0] + v0[1] * v0[1]) + (v0[2] * v0[2] + v0[3] * v0[3])) + ((v1[0] * v1[0] + v1[1] * v1[1]) + (v1[2] * v1[2] + v1[3] * v1[3]));
            }
            if (WANT_SS) { ss += __shfl_xor(ss, 16); ss += __shfl_xor(ss, 32); if (fq == 0) p16[(size_t)row * 16 + 4 * u.pn + wc] = ss; }
#pragma unroll
            for (int q = 0; q < 4; ++q) bcur[q] = bnxt[q];
            asm volatile("" ::: "memory");
        }
#undef RESID_LOAD
    }
};

struct EpiMix {
    static constexpr bool PERM = true, AFTER_DRAIN = false;
    bf16_t* P; int ldp; const float* p16; const float* lbf; const float* lbb;
    template <int ACT> __device__ __forceinline__ void run(const f32x4 (&acc)[2][2][4][2], const Unit& u, int wr, int wc, int fr, int fq) const {
        const int row0 = u.pm * BM + wr * 64 + fr, col0 = u.pn * BM + wc * 32 + 8 * fq;
        float oml[2][8];
        if (ACT == 3) { const float* lb = ((u.pn >> 1) == 4) ? lbf : lbb; const int c0 = (u.pn & 1) * BM + wc * 32 + 8 * fq;
#pragma unroll
            for (int bj = 0; bj < 2; ++bj)
#pragma unroll
                for (int e = 0; e < 8; ++e) { const float a0 = lb[c0 + bj * HALF + e], a1 = lb[512 + c0 + bj * HALF + e]; oml[bj][e] = fast_sigmoid(a1 - a0);
#ifdef DBG_OML
                    oml[bj][e] = 0.5f;
#endif
                } }
        float rr[8];
        row_rstd8(p16, row0, fq, rr);
#pragma unroll
        for (int ai = 0; ai < 2; ++ai)
#pragma unroll
            for (int m = 0; m < 4; ++m) {
                const int row = row0 + ai * HALF + m * 16;
                const float r = rr[ai * 4 + m];
#pragma unroll
                for (int bj = 0; bj < 2; ++bj) {
                    float h[8];
#pragma unroll
                    for (int n = 0; n < 2; ++n) {
                        const f32x4 z = acc[ai][bj][m][n] * r;
                        if (ACT == 0) { const f32x2 a = gelu_pk((f32x2){z[0], z[1]}), b = gelu_pk((f32x2){z[2], z[3]}); h[4 * n] = a.x; h[4 * n + 1] = a.y; h[4 * n + 2] = b.x; h[4 * n + 3] = b.y; }
                        else if (ACT == 1) {
#pragma unroll
                            for (int e = 0; e < 4; ++e) h[4 * n + e] = z[e] * fast_sigmoid(z[e]); }
                        else if (ACT == 2) {
#pragma unroll
                            for (int e = 0; e < 4; ++e) h[4 * n + e] = z[e]; }
                        else {
#pragma unroll
                            for (int e = 0; e < 4; ++e) { const float kk = oml[bj][4 * n + e] * __builtin_amdgcn_rcpf(1.0f + __builtin_amdgcn_exp2f(1.44269504089f * z[e]));
                                h[4 * n + e] = __builtin_amdgcn_logf(1.0f - kk); }
                        }
                    }
                    u32x4 w; w.x = cvt_pk_bf16(h[0], h[1]); w.y = cvt_pk_bf16(h[2], h[3]); w.z = cvt_pk_bf16(h[4], h[5]); w.w = cvt_pk_bf16(h[6], h[7]);
                    *(u32x4*)(P + (size_t)row * ldp + col0 + bj * HALF) = w;
                }
            }
    }
    __device__ __forceinline__ void operator()(const f32x4 (&acc)[2][2][4][2], const Unit& u, int wr, int wc, int fr, int fq) const {
        const int seg = u.pn >> 1;
        if (seg <= 1) run<0>(acc, u, wr, wc, fr, fq);
        else if (seg == 2 || seg == 6) run<1>(acc, u, wr, wc, fr, fq);
        else if (seg == 3) run<2>(acc, u, wr, wc, fr, fq);
        else run<3>(acc, u, wr, wc, fr, fq);
    }
};

template <class Epi, class Sched, bool ALIGN_EPI = false, bool SP2 = false>
__device__ __forceinline__ void gemm_phase(PG8_LAS unsigned char* lds, const Gemm g, const Sched& S, const Epi& E) {
    const int tid = threadIdx.x, wid = __builtin_amdgcn_readfirstlane(tid >> 6), lane = tid & 63, wr = wid >> 2, wc = wid & 3, fr = lane & 15, fq = lane >> 4;
    const int K = g.K, nt = K / BK;
    unsigned voffA[2], voffB[2];
#pragma unroll
    for (int i = 0; i < 2; ++i) { int R, C; stage_rc(tid * 16 + i * 8192, R, C); const int Rb = Epi::PERM ? ((R & ~31) + perm32(R & 31)) : R;
        voffA[i] = (unsigned)(R * K + C) * 2u; voffB[i] = (unsigned)(Rb * K + C) * 2u; }
    const size_t kstep = (size_t)(BK * 2);
    const size_t hstep = (size_t)HALF * K * 2;
    const size_t tstep = 2 * hstep;
    const unsigned ldsw = (unsigned)wid * 1024u;
    const int aoff = lds_byte(wr * 64 + fr, fq * 8), boff = lds_byte(wc * 32 + fr, fq * 8);
#define PG8_SA(b, h) (((b) * 2 + (h)) * HTB)
#define PG8_SB(b, h) ((4 + (b) * 2 + (h)) * HTB)
#define PG8_STAGE(bufoff, gbase, voff) do { _Pragma("unroll") for (int _i = 0; _i < 2; ++_i) \
        __builtin_amdgcn_global_load_lds((const unsigned*)((const char*)(gbase) + (voff)[_i]), (PG8_LAS unsigned*)(lds + (bufoff) + ldsw + _i * 8192), 16, 0, 0); } while (0)
#define PG8_LDA(dst, b, h) do { _Pragma("unroll") for (int m = 0; m < 4; ++m) _Pragma("unroll") for (int k = 0; k < 2; ++k) dst[m][k] = *(const PG8_LAS bf16x8*)(lds + PG8_SA(b, h) + aoff + m * 2048 + k * 1024); } while (0)
#define PG8_LDB(dst, b, h) do { _Pragma("unroll") for (int n = 0; n < 2; ++n) _Pragma("unroll") for (int k = 0; k < 2; ++k) dst[n][k] = *(const PG8_LAS bf16x8*)(lds + PG8_SB(b, h) + boff + n * 2048 + k * 1024); } while (0)
#define PG8_MMA(ai, bj, At, Bt) do { __builtin_amdgcn_s_setprio(1); _Pragma("unroll") for (int m = 0; m < 4; ++m) _Pragma("unroll") for (int n = 0; n < 2; ++n) _Pragma("unroll") for (int k = 0; k < 2; ++k) \
        acc[ai][bj][m][n] = __builtin_amdgcn_mfma_f32_16x16x32_bf16(Bt[n][k], At[m][k], acc[ai][bj][m][n], 0, 0, 0); __builtin_amdgcn_s_setprio(0); } while (0)
#define PG8_WAIT_V(n) asm volatile("s_waitcnt vmcnt(" #n ")" ::: "memory")
#define PG8_WAIT_L(n) asm volatile("s_waitcnt lgkmcnt(" #n ")" ::: "memory")
#define PG8_BAR __builtin_amdgcn_s_barrier()
#define PG8_SCHED __builtin_amdgcn_sched_barrier(0)
    Unit cur, nxt; int ui = 0;
    if (!S.next(0, cur)) return;
    f32x4 acc[2][2][4][2];
#pragma unroll
    for (int a = 0; a < 2; ++a)
#pragma unroll
        for (int b = 0; b < 2; ++b)
#pragma unroll
            for (int m = 0; m < 4; ++m)
#pragma unroll
                for (int n = 0; n < 2; ++n) acc[a][b][m][n] = (f32x4){0.f, 0.f, 0.f, 0.f};
    bf16x8 At[4][2], B0[2][2], B1[2][2];
    const char* cA = (const char*)g.A + (size_t)cur.pm * tstep; const char* cB = (const char*)g.Bt + (size_t)cur.pn * tstep;
    S.a_ready(cur);
    if constexpr (SP2) {
        PG8_STAGE(PG8_SB(0, 0), cB, voffB); PG8_STAGE(PG8_SB(0, 1), cB + hstep, voffB); PG8_STAGE(PG8_SA(0, 0), cA, voffA); PG8_STAGE(PG8_SA(0, 1), cA + hstep, voffA);
        if (wr == 1) PG8_BAR;
        PG8_WAIT_V(2); PG8_BAR;
        PG8_STAGE(PG8_SB(1, 0), cB + kstep, voffB); PG8_STAGE(PG8_SA(1, 0), cA + kstep, voffA); PG8_STAGE(PG8_SB(1, 1), cB + hstep + kstep, voffB);
        PG8_WAIT_V(6); PG8_BAR;
    } else {
        PG8_STAGE(PG8_SB(0, 0), cB, voffB); PG8_STAGE(PG8_SA(0, 0), cA, voffA); PG8_STAGE(PG8_SB(0, 1), cB + hstep, voffB); PG8_STAGE(PG8_SA(0, 1), cA + hstep, voffA);
        if (wr == 1) PG8_BAR;
        PG8_WAIT_V(4); PG8_BAR;
        PG8_STAGE(PG8_SB(1, 0), cB + kstep, voffB); PG8_STAGE(PG8_SA(1, 0), cA + kstep, voffA); PG8_STAGE(PG8_SB(1, 1), cB + hstep + kstep, voffB);
        PG8_WAIT_V(6); PG8_BAR;
    }
    for (;;) {
        const bool has_next = S.next(ui + 1, nxt);
        const char* nA = has_next ? (const char*)g.A + (size_t)nxt.pm * tstep : cA; const char* nB = has_next ? (const char*)g.Bt + (size_t)nxt.pn * tstep : cB;
        for (int t = 0; t < nt; t += 2) {
            const bool last = (t == nt - 2);
            const char* a1 = cA + (size_t)(t + 1) * kstep;
            const char* a2 = last ? nA : cA + (size_t)(t + 2) * kstep; const char* b2 = last ? nB : cB + (size_t)(t + 2) * kstep;
            const char* a3 = a2 + kstep; const char* b3 = b2 + kstep;
            if (last && has_next) S.a_ready(nxt);
            if constexpr (SP2) {
            PG8_LDB(B0, 0, 0); PG8_LDB(B1, 0, 1); PG8_SCHED; PG8_LDA(At, 0, 0); PG8_STAGE(PG8_SA(1, 1), a1 + hstep, voffA);
            PG8_WAIT_V(8); PG8_WAIT_L(0); PG8_BAR; PG8_MMA(0, 0, At, B0); PG8_MMA(0, 1, At, B1); PG8_BAR; PG8_SCHED;
            PG8_LDA(At, 0, 1); PG8_STAGE(PG8_SB(0, 0), b2, voffB); PG8_STAGE(PG8_SB(0, 1), b2 + hstep, voffB); PG8_STAGE(PG8_SA(0, 0), a2, voffA);
            PG8_WAIT_V(8); PG8_WAIT_L(0); PG8_BAR; PG8_MMA(1, 0, At, B0); PG8_MMA(1, 1, At, B1); PG8_BAR; PG8_SCHED;
            PG8_LDB(B0, 1, 0); PG8_LDB(B1, 1, 1); PG8_SCHED; PG8_LDA(At, 1, 0); PG8_STAGE(PG8_SA(0, 1), a2 + hstep, voffA);
            PG8_WAIT_V(8); PG8_WAIT_L(0); PG8_BAR; PG8_MMA(0, 0, At, B0); PG8_MMA(0, 1, At, B1); PG8_BAR; PG8_SCHED;
            PG8_LDA(At, 1, 1); PG8_STAGE(PG8_SB(1, 0), b3, voffB); PG8_STAGE(PG8_SB(1, 1), b3 + hstep, voffB); PG8_STAGE(PG8_SA(1, 0), a3, voffA);
            PG8_WAIT_V(8); PG8_WAIT_L(0); PG8_BAR; PG8_MMA(1, 0, At, B0); PG8_MMA(1, 1, At, B1); PG8_BAR; PG8_SCHED;
            } else {
            PG8_LDB(B0, 0, 0); PG8_SCHED; PG8_LDA(At, 0, 0); PG8_STAGE(PG8_SA(1, 1), a1 + hstep, voffA);
            PG8_WAIT_L(8); PG8_BAR; PG8_WAIT_L(0); PG8_MMA(0, 0, At, B0); PG8_BAR; PG8_SCHED;
            PG8_LDB(B1, 0, 1); PG8_STAGE(PG8_SB(0, 0), b2, voffB);
            PG8_BAR; PG8_WAIT_L(0); PG8_MMA(0, 1, At, B1); PG8_BAR;
            PG8_LDA(At, 0, 1); PG8_STAGE(PG8_SA(0, 0), a2, voffA);
            PG8_BAR; PG8_WAIT_L(0); PG8_MMA(1, 0, At, B0); PG8_BAR; PG8_SCHED;
            PG8_STAGE(PG8_SB(0, 1), b2 + hstep, voffB);
            PG8_WAIT_V(6); PG8_BAR; PG8_MMA(1, 1, At, B1); PG8_BAR;
            PG8_LDB(B0, 1, 0); PG8_SCHED; PG8_LDA(At, 1, 0); PG8_STAGE(PG8_SA(0, 1), a2 + hstep, voffA);
            PG8_WAIT_L(8); PG8_BAR; PG8_WAIT_L(0); PG8_MMA(0, 0, At, B0); PG8_BAR; PG8_SCHED;
            PG8_LDB(B1, 1, 1); PG8_STAGE(PG8_SB(1, 0), b3, voffB);
            PG8_BAR; PG8_WAIT_L(0); PG8_MMA(0, 1, At, B1); PG8_BAR;
            PG8_LDA(At, 1, 1); PG8_STAGE(PG8_SA(1, 0), a3, voffA);
            PG8_BAR; PG8_WAIT_L(0); PG8_MMA(1, 0, At, B0); PG8_BAR; PG8_SCHED;
            PG8_STAGE(PG8_SB(1, 1), b3 + hstep, voffB);
            PG8_WAIT_V(6); PG8_BAR; PG8_MMA(1, 1, At, B1); PG8_BAR;
            }
        }
        if constexpr (ALIGN_EPI) { if (wr == 0) PG8_BAR; }
        if constexpr (!Epi::AFTER_DRAIN) { E(acc, cur, wr, wc, fr, fq); S.done(cur); }
        if (!has_next) break;
#pragma unroll
        for (int a = 0; a < 2; ++a)
#pragma unroll
            for (int b = 0; b < 2; ++b)
#pragma unroll
                for (int m = 0; m < 4; ++m)
#pragma unroll
                    for (int n = 0; n < 2; ++n) acc[a][b][m][n] = (f32x4){0.f, 0.f, 0.f, 0.f};
        cur = nxt; cA = nA; cB = nB; ++ui;
        if constexpr (ALIGN_EPI) { if (wr == 1) PG8_BAR; }
    }
    PG8_WAIT_V(0);
    if constexpr (!ALIGN_EPI) { if (wr == 0) PG8_BAR; }
    PG8_BAR;
    if constexpr (Epi::AFTER_DRAIN) { E.fused(acc, cur, wr, wc, fr, fq, lds, wid, lane); S.done(cur); }
#undef PG8_SA
#undef PG8_SB
#undef PG8_STAGE
#undef PG8_LDA
#undef PG8_LDB
#undef PG8_MMA
#undef PG8_WAIT_V
#undef PG8_WAIT_L
#undef PG8_BAR
#undef PG8_SCHED
}
}

#ifndef PG8_SP2
#define PG8_SP2 true
#endif
#ifndef PG8_ALIGN
#define PG8_ALIGN true
#endif
constexpr int NWAVES = 8;
constexpr int TOK = 32768, NPROMPT = 16384;
constexpr int DMODEL = 1024, DFF = 2816, DIN = 3584;
constexpr int COL_U = 0, COL_V = 512, COL_Q = 1024, COL_I = 1536, COL_FF = 2048, COL_FB = 2560, COL_G = 3072;
constexpr float EPS = 1e-6f;
constexpr size_t MiB = 1u << 20;
constexpr size_t WS_CTL = 0, CTL_ZERO_BYTES = 1 * MiB;
constexpr size_t WS_SSG = 1 * MiB;
constexpr size_t WS_P16 = 2 * MiB;
constexpr size_t WS_WGU1 = 8 * MiB, WS_WD1 = 19 * MiB, WS_WIN = 25 * MiB, WS_WOUT = 32 * MiB, WS_WGU2 = 34 * MiB, WS_WD2 = 45 * MiB;
constexpr size_t WS_BUFA = 52 * MiB;
constexpr size_t WS_BUFB = 116 * MiB;
constexpr size_t WS_BIG = 180 * MiB;
constexpr size_t WS_OB1 = 404 * MiB;
constexpr size_t WS_HGE = 468 * MiB;
constexpr size_t WS_HGD = 500 * MiB;
constexpr size_t WS_END = 501 * MiB;
static_assert(WS_WGU1 + (size_t)2 * DFF * DMODEL * 2 <= WS_WD1 && WS_WD1 + (size_t)DMODEL * DFF * 2 <= WS_WIN && WS_WIN + (size_t)DIN * DMODEL * 2 <= WS_WOUT && WS_WOUT + (size_t)DMODEL * DMODEL * 2 <= WS_WGU2
              && WS_WGU2 + (size_t)2 * DFF * DMODEL * 2 <= WS_WD2 && WS_WD2 + (size_t)DMODEL * DFF * 2 <= WS_BUFA && WS_BUFA + (size_t)TOK * DMODEL * 2 <= WS_BUFB && WS_BUFB + (size_t)TOK * DMODEL * 2 <= WS_BIG
              && WS_BIG + (size_t)TOK * DIN * 2 <= WS_OB1 && WS_OB1 + (size_t)TOK * 512 * 4 <= WS_HGE && WS_HGE + (size_t)512 * 65536 <= WS_HGD && WS_P16 + 3 * 2 * MiB <= WS_WGU1, "d_ws map");
constexpr int CW_BAR = 4096;
constexpr int RING_OFF = 0, RING_BYTES = 131072;
constexpr int LDSCTL_OFF = RING_BYTES, MISC_OFF = LDSCTL_OFF + 320;
constexpr int LDS_BYTES = 147456;
static_assert(MISC_OFF + 128 <= LDS_BYTES, "LDS map");

#define GAS __attribute__((address_space(1)))
#define LAS __attribute__((address_space(3)))
typedef unsigned short bf16;
typedef unsigned v4u __attribute__((ext_vector_type(4)));
typedef float f32x4 __attribute__((ext_vector_type(4)));
typedef short bf16x8 __attribute__((ext_vector_type(8)));
typedef GAS unsigned gu32;
typedef GAS unsigned long long gu64;
#define RLX_AGENT __ATOMIC_RELAXED, __HIP_MEMORY_SCOPE_AGENT
#define LDS_WAIT() asm volatile("s_waitcnt lgkmcnt(0)" ::: "memory")
#define VM_WAIT() asm volatile("s_waitcnt vmcnt(0)" ::: "memory")
__device__ __forceinline__ unsigned long long rt() { return __builtin_amdgcn_s_memrealtime(); }
__device__ __forceinline__ unsigned f2bf(float f) { unsigned u = __builtin_bit_cast(unsigned, f); return (u + 0x7fffu + ((u >> 16) & 1u)) >> 16; }
__device__ __forceinline__ unsigned pk2(float lo, float hi) { return f2bf(lo) | (f2bf(hi) << 16); }

#define XB_TMO      128
#define XB_XCNT(j)  (256  + 64 * (j))
#define XB_XSUB(j)  (1280 + 64 * (j))
#define XB_XGEN(j)  (2304 + 64 * (j))
#define XB_TOP      3328
#define XB_TOPGEN   3392
#define XCD_BAR_WORDS 3456
#define XB_SPIN_CAP (1u << 18)

__device__ __forceinline__ unsigned xb_ld(unsigned* p)              { return __hip_atomic_load(p, __ATOMIC_RELAXED, __HIP_MEMORY_SCOPE_AGENT); }
__device__ __forceinline__ unsigned xb_add(unsigned* p, unsigned v) { return __hip_atomic_fetch_add(p, v, __ATOMIC_RELAXED, __HIP_MEMORY_SCOPE_AGENT); }
__device__ __forceinline__ unsigned xb_xcc_id() { return (unsigned)__builtin_amdgcn_s_getreg((3 << 11) | 20) & 0xFu; }
#define XB_SPIN(cond, bar) do { unsigned _sp = 0; while (cond) { __builtin_amdgcn_s_sleep(1); \
    if ((++_sp & 255u) == 0u) { if (xb_ld(&(bar)[XB_TMO])) break; if (_sp > XB_SPIN_CAP) { atomicAdd(&(bar)[XB_TMO], 1u); break; } } } } while (0)

struct XcdBarrier {
    unsigned* bar; unsigned x;
    volatile LAS unsigned* st;
};

__device__ __forceinline__ XcdBarrier xcd_barrier_post(unsigned* bar, volatile LAS unsigned* st) {
    XcdBarrier b; b.bar = bar; b.x = xb_xcc_id(); b.st = st;
    if (threadIdx.x == 0) (void)xb_add(&bar[XB_XCNT(b.x)], 1u);
    return b;
}
__device__ __forceinline__ void xcd_barrier_complete(unsigned* bar, unsigned x, unsigned& nloc, unsigned& nx) {
    const unsigned G = gridDim.x * gridDim.y * gridDim.z;
    unsigned sum, cnt, mine, sp = 0u;
    for (;;) {
        sum = 0u; cnt = 0u; mine = 0u;
#pragma unroll
        for (unsigned j = 0; j < 16; ++j) { const unsigned c = xb_ld(&bar[XB_XCNT(j)]); sum += c; cnt += (c > 0u) ? 1u : 0u; mine = (j == x) ? c : mine; }
        if (sum == G) break;
        __builtin_amdgcn_s_sleep(1);
        if ((++sp & 255u) == 0u) { if (xb_ld(&bar[XB_TMO])) break; if (sp > XB_SPIN_CAP) { atomicAdd(&bar[XB_TMO], 1u); break; } }
    }
    nloc = mine > 0u ? mine : 1u; nx = cnt > 0u ? cnt : 1u;
}

__device__ __forceinline__ void xcd_barrier(const XcdBarrier& b) {
    asm volatile("s_waitcnt vmcnt(0)" ::: "memory");
    __syncthreads();
    if (threadIdx.x == 0) {
        unsigned* bar = b.bar;
        __builtin_amdgcn_s_waitcnt(0);
        unsigned nloc = b.st[0], nx = b.st[1];
        if (nloc == 0u) { xcd_barrier_complete(bar, b.x, nloc, nx); b.st[0] = nloc; b.st[1] = nx; }
        const unsigned old = xb_add(&bar[XB_XSUB(b.x)], 1u);
        const unsigned gen = old / nloc;
        if (old + 1u == (gen + 1u) * nloc) {
            __builtin_amdgcn_fence(__ATOMIC_RELEASE, "agent");
            asm volatile("s_waitcnt vmcnt(0)" ::: "memory");
            const unsigned og = xb_add(&bar[XB_TOP], 1u);
            const unsigned tg = og / nx;
            if (og + 1u == (tg + 1u) * nx) xb_add(&bar[XB_TOPGEN], 1u);
            else XB_SPIN(xb_ld(&bar[XB_TOPGEN]) == tg, bar);
            __builtin_amdgcn_fence(__ATOMIC_ACQUIRE, "agent");
            xb_add(&bar[XB_XGEN(b.x)], 1u);
            asm volatile("s_waitcnt vmcnt(0)" ::: "memory");
        } else {
            XB_SPIN(xb_ld(&bar[XB_XGEN(b.x)]) == gen, bar);
            __builtin_amdgcn_fence(__ATOMIC_ACQUIRE, "agent");
            asm volatile("s_waitcnt vmcnt(0)" ::: "memory");
        }
    }
    __syncthreads();
}
typedef unsigned v2u __attribute__((ext_vector_type(2)));
__device__ __forceinline__ float wave_sum(float v) {
#pragma unroll
    for (int o = 1; o < 64; o <<= 1) v += __shfl_xor(v, o);
    return v;
}
__device__ __forceinline__ float bflo(unsigned w) { return __builtin_bit_cast(float, w << 16); }
__device__ __forceinline__ float bfhi(unsigned w) { return __builtin_bit_cast(float, w & 0xffff0000u); }
__device__ __forceinline__ float bf1(unsigned short h) { return __builtin_bit_cast(float, (unsigned)h << 16); }
__device__ __forceinline__ float ex2(float x) { return __builtin_amdgcn_exp2f(x); }
__device__ __forceinline__ float rsq(float x) { return __builtin_amdgcn_rsqf(x); }

__device__ __forceinline__ void p0_item(const float* W, int Nsrc, int k0, int scol0, const float* gain, bf16* WT, int K, int drow0, LAS float* scr, int lane) {
#pragma unroll 8
    for (int i = 0; i < 32; ++i) { const int kk = 2 * i + (lane >> 5); float v = W[(size_t)(k0 + kk) * Nsrc + scol0 + (lane & 31)]; if (gain) v *= gain[k0 + kk]; scr[kk * 33 + (lane & 31)] = v; }
    LDS_WAIT(); asm volatile("" ::: "memory");
    const int c = lane & 7;
#pragma unroll
    for (int j = 0; j < 4; ++j) { const int n = (lane >> 3) + 8 * j; const LAS float* s = scr + (8 * c) * 33 + n;
        v4u o; o.x = pk2(s[0 * 33], s[1 * 33]); o.y = pk2(s[2 * 33], s[3 * 33]); o.z = pk2(s[4 * 33], s[5 * 33]); o.w = pk2(s[6 * 33], s[7 * 33]);
        *(GAS v4u*)(WT + (size_t)(drow0 + n) * K + k0 + 8 * c) = o; }
    LDS_WAIT(); asm volatile("" ::: "memory");
}
__device__ __forceinline__ void p0_gu(const float* Wg, const float* Wu, const float* gain, bf16* WT, int r, LAS float* scr, int lane) {
    const int nblk = 2 * DFF / 32, kb = r / nblk, nb = r % nblk, n0 = 32 * nb, pn = n0 >> 8, bj = (n0 >> 7) & 1, j0 = n0 & 127;
    p0_item(bj ? Wu : Wg, DFF, 64 * kb, 128 * pn + j0, gain, WT, DMODEL, n0, scr, lane);
}
__device__ __forceinline__ void p0_plain(const float* W, int K, int N, const float* gain, bf16* WT, int r, LAS float* scr, int lane) {
    const int nblk = N / 32, kb = r / nblk, nb = r % nblk;
    p0_item(W, N, 64 * kb, 32 * nb, gain, WT, K, 32 * nb, scr, lane);
}
__device__ __forceinline__ void p0_prologue(LAS unsigned char* lds, const float* const* in, unsigned char* ws, int gw, int NGW, int wave, int lane) {
    LAS float* scr = (LAS float*)(lds + RING_OFF + wave * 16384);
    constexpr int I_GU = (DMODEL / 64) * (2 * DFF / 32), I_D = (DFF / 64) * (DMODEL / 32), I_IN = (DMODEL / 64) * (DIN / 32), I_OUT = (DMODEL / 64) * (DMODEL / 32);
    constexpr int NITEMS = 2 * I_GU + 2 * I_D + I_IN + I_OUT;
    for (int it = gw; it < NITEMS; it += NGW) {
        int r = it;
        if (r < I_GU) { p0_gu(in[3], in[4], in[2], (bf16*)(ws + WS_WGU1), r, scr, lane); continue; } r -= I_GU;
        if (r < I_GU) { p0_gu(in[18], in[19], in[17], (bf16*)(ws + WS_WGU2), r, scr, lane); continue; } r -= I_GU;
        if (r < I_D) { p0_plain(in[5], DFF, DMODEL, nullptr, (bf16*)(ws + WS_WD1), r, scr, lane); continue; } r -= I_D;
        if (r < I_D) { p0_plain(in[20], DFF, DMODEL, nullptr, (bf16*)(ws + WS_WD2), r, scr, lane); continue; } r -= I_D;
        if (r < I_IN) { p0_plain(in[7], DMODEL, DIN, in[6], (bf16*)(ws + WS_WIN), r, scr, lane); continue; } r -= I_IN;
        p0_plain(in[16], DMODEL, DMODEL, nullptr, (bf16*)(ws + WS_WOUT), r, scr, lane);
    }
    bf16* XB = (bf16*)(ws + WS_BUFA); float* p16 = (float*)(ws + WS_P16);
    for (int m = gw; m < TOK; m += NGW) {
        const float* xrow = m < NPROMPT ? in[0] + (size_t)m * DMODEL : in[1] + (size_t)(m - NPROMPT) * DMODEL;
        const GAS f32x4* xr = (const GAS f32x4*)xrow + lane;
        f32x4 v[4]; float s = 0.f;
#pragma unroll
        for (int j = 0; j < 4; ++j) { v[j] = xr[64 * j]; s += (v[j].x * v[j].x + v[j].y * v[j].y) + (v[j].z * v[j].z + v[j].w * v[j].w); }
        s = wave_sum(s);
        GAS v2u* o8 = (GAS v2u*)(XB + (size_t)m * DMODEL) + lane;
#pragma unroll
        for (int j = 0; j < 4; ++j) { v2u w; w.x = pk2(v[j].x, v[j].y); w.y = pk2(v[j].z, v[j].w); o8[64 * j] = w; }
        if (lane < 16) p16[(size_t)m * 16 + lane] = lane == 0 ? s : 0.f;
    }
}

__device__ __forceinline__ void final_norm(float* out, const float* gfin, int gw, int NGW, int lane) {
    for (int m = gw; m < TOK; m += NGW) {
        GAS f32x4* xr = (GAS f32x4*)(out + (size_t)m * DMODEL) + lane;
        f32x4 v[4]; float s = 0.f;
#pragma unroll
        for (int j = 0; j < 4; ++j) { v[j] = xr[64 * j]; s += (v[j].x * v[j].x + v[j].y * v[j].y) + (v[j].z * v[j].z + v[j].w * v[j].w); }
        const float r = rsq(wave_sum(s) * (1.0f / DMODEL) + EPS);
#pragma unroll
        for (int j = 0; j < 4; ++j) { const f32x4 g = *((const GAS f32x4*)gfin + lane + 64 * j); xr[64 * j] = v[j] * r * g; }
    }
}

constexpr int HG_RAWLF = 0, HG_RAWQ = 17408, HG_QN = 34816, HG_KN = 52224, HG_KT = 69632, HG_VT = 88064, HG_SCL = 97280, HG_ST = 106496, HG_SEG = 115200, HG_SA = 119296, HG_SB = 119808, HG_END = 120320;
static_assert(HG_END <= RING_BYTES, "hgrn LDS");
__device__ __forceinline__ void hgrn_item(LAS unsigned char* lds, const bf16* P, float* ob, int row0, int L, int h, int dir, int dq, int tid, int lane, int wave) {
    const int fr = lane & 15, fq = lane >> 4, nch = L >> 6;
    const bf16* gq = P + COL_Q + h * 128;
    const bf16* gl = P + (dir ? COL_FB : COL_FF) + h * 128;
    const bf16* gv = P + COL_I + h * 128 + dq * 32;
    float* go = ob + h * 128 + dq * 32;
    const int lr = tid >> 4, lc = tid & 15, lp = (tid >> 2) & 31, vc = tid & 3, cp = lane, s8 = wave;
#define TOKROW(n, l) (row0 + (dir ? (L - 1 - (64 * (n) + (l))) : (64 * (n) + (l))))
#define HG_LOAD(n) do { _Pragma("unroll") for (int i_ = 0; i_ < 2; ++i_) { const size_t ro_ = (size_t)TOKROW(n, lr + 32 * i_) * DIN + 8 * lc; rl[i_] = *(const GAS v4u*)(gl + ro_); rq[i_] = *(const GAS v4u*)(gq + ro_); \
        rv[i_] = *(const GAS v4u*)(gv + (size_t)TOKROW(n, 2 * lp + i_) * DIN + 8 * vc); } } while (0)
    v4u rl[2], rq[2], rv[2];
    HG_LOAD(0);
    f32x4 S0 = {0.f, 0.f, 0.f, 0.f}, S1 = {0.f, 0.f, 0.f, 0.f};
    for (int n = 0; n < nch; ++n) {
        const int vbuf = HG_VT + (n & 1) * 4608;
#pragma unroll
        for (int i = 0; i < 2; ++i) { *(LAS v4u*)(lds + HG_RAWLF + (lr + 32 * i) * 272 + lc * 16) = rl[i]; *(LAS v4u*)(lds + HG_RAWQ + (lr + 32 * i) * 272 + lc * 16) = rq[i]; }
        if (tid < 128) {
#pragma unroll
            for (int e = 0; e < 4; ++e) { const unsigned w0 = rv[0][e], w1 = rv[1][e];
                *(LAS unsigned*)(lds + vbuf + (8 * vc + 2 * e) * 144 + lp * 4) = (w0 & 0xffffu) | (w1 << 16);
                *(LAS unsigned*)(lds + vbuf + (8 * vc + 2 * e + 1) * 144 + lp * 4) = (w0 >> 16) | (w1 & 0xffff0000u); }
        }
        if (n + 1 < nch) HG_LOAD(n + 1);
        __syncthreads();
        float lfa[8], lfb[8], ava[8], avb[8]; float runa = 0.f, runb = 0.f;
#pragma unroll
        for (int j = 0; j < 8; ++j) { const unsigned w = *(const LAS unsigned*)(lds + HG_RAWLF + (8 * s8 + j) * 272 + cp * 4);
            lfa[j] = bflo(w); lfb[j] = bfhi(w); runa += lfa[j]; runb += lfb[j]; ava[j] = runa; avb[j] = runb; }
        *(LAS v2u*)(lds + HG_SEG + (s8 * 128 + 2 * cp) * 4) = (v2u){__builtin_bit_cast(unsigned, runa), __builtin_bit_cast(unsigned, runb)};
        __syncthreads();
        {
            typedef float f32x2v __attribute__((ext_vector_type(2)));
            f32x2v sg_[8];
#pragma unroll
            for (int q = 0; q < 8; ++q) sg_[q] = *(const LAS f32x2v*)(lds + HG_SEG + (q * 128 + 2 * cp) * 4);
            const f32x2v amid2 = (sg_[0] + sg_[1]) + (sg_[2] + sg_[3]);
            const f32x2v atot2 = amid2 + ((sg_[4] + sg_[5]) + (sg_[6] + sg_[7]));
            f32x2v off2 = -amid2;
#pragma unroll
            for (int q = 0; q < 7; ++q) { const float mq = (q < s8) ? 1.0f : 0.0f; off2 = off2 + sg_[q] * mq; }
            const float amida = amid2.x, amidb = amid2.y, atota = atot2.x, atotb = atot2.y;
            const float offa = off2.x, offb = off2.y;
            unsigned kta[4], ktb[4];
#pragma unroll
            for (int j = 0; j < 8; ++j) {
                const float aa = offa + ava[j], ab = offb + avb[j];
                const unsigned qw = *(const LAS unsigned*)(lds + HG_RAWQ + (8 * s8 + j) * 272 + cp * 4);
                const float qta = bflo(qw) * ex2(aa), qtb = bfhi(qw) * ex2(ab);
                const float k_a = (1.0f - ex2(lfa[j])) * ex2(-aa), k_b = (1.0f - ex2(lfb[j])) * ex2(-ab);
                const unsigned kba = f2bf(k_a), kbb = f2bf(k_b);
                *(LAS unsigned*)(lds + HG_QN + (8 * s8 + j) * 272 + cp * 4) = pk2(qta, qtb);
                *(LAS unsigned*)(lds + HG_KN + (8 * s8 + j) * 272 + cp * 4) = kba | (kbb << 16);
                if (j & 1) { kta[j >> 1] |= kba << 16; ktb[j >> 1] |= kbb << 16; } else { kta[j >> 1] = kba; ktb[j >> 1] = kbb; }
            }
            *(LAS v4u*)(lds + HG_KT + (2 * cp) * 144 + s8 * 16) = (v4u){kta[0], kta[1], kta[2], kta[3]};
            *(LAS v4u*)(lds + HG_KT + (2 * cp + 1) * 144 + s8 * 16) = (v4u){ktb[0], ktb[1], ktb[2], ktb[3]};
            if (s8 == 0) { *(LAS v2u*)(lds + HG_SA + (2 * cp) * 4) = (v2u){__builtin_bit_cast(unsigned, ex2(amida)), __builtin_bit_cast(unsigned, ex2(amidb))};
                           *(LAS v2u*)(lds + HG_SB + (2 * cp) * 4) = (v2u){__builtin_bit_cast(unsigned, ex2(atota - amida)), __builtin_bit_cast(unsigned, ex2(atotb - amidb))}; }
        }
        __syncthreads();
        {
            const f32x4 sa = *(const LAS f32x4*)(lds + HG_SA + (16 * wave + 4 * fq) * 4);
            S0 = S0 * sa; S1 = S1 * sa;
#ifdef DBG_NOSTATE
            S0 = (f32x4){0.f,0.f,0.f,0.f}; S1 = S0;
#endif
            v2u w0, w1; w0.x = pk2(S0[0], S0[1]); w0.y = pk2(S0[2], S0[3]); w1.x = pk2(S1[0], S1[1]); w1.y = pk2(S1[2], S1[3]);
            *(LAS v2u*)(lds + HG_ST + fr * 272 + (16 * wave + 4 * fq) * 2) = w0;
            *(LAS v2u*)(lds + HG_ST + (16 + fr) * 272 + (16 * wave + 4 * fq) * 2) = w1;
        }
        {
            const int ib = wave & 3, jp = wave >> 2;
#pragma unroll
            for (int t = 0; t < 2; ++t) {
                const int jb = 2 * jp + t;
                f32x4 sc = {0.f, 0.f, 0.f, 0.f};
                if (jb <= ib) {
#pragma unroll
                    for (int ks = 0; ks < 4; ++ks) {
                        const bf16x8 x = *(const LAS bf16x8*)(lds + HG_KN + (16 * jb + fr) * 272 + ks * 64 + fq * 16);
                        const bf16x8 y = *(const LAS bf16x8*)(lds + HG_QN + (16 * ib + fr) * 272 + ks * 64 + fq * 16);
                        sc = __builtin_amdgcn_mfma_f32_16x16x32_bf16(x, y, sc, 0, 0, 0);
                    }
                    if (jb == ib) {
#pragma unroll
                        for (int r = 0; r < 4; ++r) if (4 * fq + r > fr) sc[r] = 0.f;
                    }
                }
                v2u w; w.x = pk2(sc[0], sc[1]); w.y = pk2(sc[2], sc[3]);
                *(LAS v2u*)(lds + HG_SCL + (16 * ib + fr) * 144 + (16 * jb + 4 * fq) * 2) = w;
            }
        }
        __syncthreads();
        {
            const int ib2 = wave >> 1, db = wave & 1;
            f32x4 O = {0.f, 0.f, 0.f, 0.f};
#pragma unroll
            for (int ks = 0; ks < 2; ++ks) {
                const bf16x8 x = *(const LAS bf16x8*)(lds + vbuf + (16 * db + fr) * 144 + ks * 64 + fq * 16);
                const bf16x8 y = *(const LAS bf16x8*)(lds + HG_SCL + (16 * ib2 + fr) * 144 + ks * 64 + fq * 16);
                O = __builtin_amdgcn_mfma_f32_16x16x32_bf16(x, y, O, 0, 0, 0);
            }
#pragma unroll
            for (int ks = 0; ks < 4; ++ks) {
                const bf16x8 x = *(const LAS bf16x8*)(lds + HG_ST + (16 * db + fr) * 272 + ks * 64 + fq * 16);
                const bf16x8 y = *(const LAS bf16x8*)(lds + HG_QN + (16 * ib2 + fr) * 272 + ks * 64 + fq * 16);
                O = __builtin_amdgcn_mfma_f32_16x16x32_bf16(x, y, O, 0, 0, 0);
            }
#if defined(DBG_HG) && DBG_HG == 1
            { const v2u w = *(const LAS v2u*)(lds + HG_QN + (16 * ib2 + fr) * 272 + (16 * db + 4 * fq) * 2); O = (f32x4){bflo(w.x), bfhi(w.x), bflo(w.y), bfhi(w.y)}; }
#elif defined(DBG_HG) && DBG_HG == 2
            { const v2u w = *(const LAS v2u*)(lds + HG_SCL + (16 * ib2 + fr) * 144 + (16 * db + 4 * fq) * 2); O = (f32x4){bflo(w.x), bfhi(w.x), bflo(w.y), bfhi(w.y)}; }
#elif defined(DBG_HG) && DBG_HG == 3
            { const v2u w = *(const LAS v2u*)(lds + vbuf + (16 * db + fr) * 144 + (16 * (ib2 & 3) + 4 * fq) * 2); O = (f32x4){bflo(w.x), bfhi(w.x), bflo(w.y), bfhi(w.y)}; }
#elif defined(DBG_HG) && DBG_HG == 5
            { const v2u w = *(const GAS v2u*)(gq + (size_t)TOKROW(n, 16 * ib2 + fr) * DIN + 16 * db + 4 * fq); O = (f32x4){bflo(w.x), bfhi(w.x), bflo(w.y), bfhi(w.y)}; }
#elif defined(DBG_HG) && DBG_HG == 9
            { const v2u w = *(const GAS v2u*)(gl + (size_t)TOKROW(n, 16 * ib2 + fr) * DIN + 16 * db + 4 * fq); O = (f32x4){bflo(w.x), bfhi(w.x), bflo(w.y), bfhi(w.y)}; }
#elif defined(DBG_HG) && DBG_HG == 10
            { const v2u w = *(const LAS v2u*)(lds + HG_RAWLF + (16 * ib2 + fr) * 272 + (16 * db + 4 * fq) * 2); O = (f32x4){bflo(w.x), bfhi(w.x), bflo(w.y), bfhi(w.y)}; }
#elif defined(DBG_HG) && DBG_HG == 7
            { const v2u w = *(const GAS v2u*)(P + COL_U + h * 128 + (size_t)TOKROW(n, 16 * ib2 + fr) * DIN + 16 * db + 4 * fq); O = (f32x4){bflo(w.x), bfhi(w.x), bflo(w.y), bfhi(w.y)}; }
#elif defined(DBG_HG) && DBG_HG == 8
            { O = (f32x4){(float)TOKROW(n, 16 * ib2 + fr), (float)(16 * db + 4 * fq), (float)h, (float)dq}; }
#elif defined(DBG_HG) && DBG_HG == 6
            { const v2u w = *(const LAS v2u*)(lds + HG_RAWQ + (16 * ib2 + fr) * 272 + (16 * db + 4 * fq) * 2); O = (f32x4){bflo(w.x), bfhi(w.x), bflo(w.y), bfhi(w.y)}; }
#elif defined(DBG_HG) && DBG_HG == 4
            { const v2u w = *(const LAS v2u*)(lds + HG_KN + (16 * ib2 + fr) * 272 + (16 * db + 4 * fq) * 2); O = (f32x4){bflo(w.x), bfhi(w.x), bflo(w.y), bfhi(w.y)}; }
#endif
            *(GAS f32x4*)(go + (size_t)TOKROW(n, 16 * ib2 + fr) * 512 + 16 * db + 4 * fq) = O;
        }
        {
#pragma unroll
            for (int ks = 0; ks < 2; ++ks) {
                const bf16x8 x = *(const LAS bf16x8*)(lds + HG_KT + (16 * wave + fr) * 144 + ks * 64 + fq * 16);
                const bf16x8 y0 = *(const LAS bf16x8*)(lds + vbuf + fr * 144 + ks * 64 + fq * 16);
                const bf16x8 y1 = *(const LAS bf16x8*)(lds + vbuf + (16 + fr) * 144 + ks * 64 + fq * 16);
                S0 = __builtin_amdgcn_mfma_f32_16x16x32_bf16(x, y0, S0, 0, 0, 0);
                S1 = __builtin_amdgcn_mfma_f32_16x16x32_bf16(x, y1, S1, 0, 0, 0);
            }
            const f32x4 sb = *(const LAS f32x4*)(lds + HG_SB + (16 * wave + 4 * fq) * 4);
            S0 = S0 * sb; S1 = S1 * sb;
        }
        __syncthreads();
    }
#undef HG_LOAD
#undef TOKROW
}

constexpr int H2_RAWLF = 0, H2_RAWQ = 17408, H2_ST = 0, H2_QN = 34816, H2_KN = 52224, H2_KT = 69632, H2_VT = 88064, H2_SCL = 106496, H2_SEG = 115712, H2_SA = 119808, H2_SB = 120320, H2_END = 120832;
static_assert(H2_END <= RING_BYTES, "hgrn v2 LDS");
struct Hg2Inst { int row0, L, h, dir, sc, seqid; };
__device__ __forceinline__ Hg2Inst hg2_decode(int i) {
    Hg2Inst I; const int hd = i & 7, sp = i >> 3; I.h = hd >> 1; I.dir = hd & 1;
    if (sp < 32) { const int b = sp >> 2; I.sc = sp & 3; I.row0 = 2048 * b; I.L = 2048; I.seqid = b; }
    else { const int b = (sp - 32) >> 3; I.sc = (sp - 32) & 7; I.row0 = NPROMPT + 4096 * b; I.L = 4096; I.seqid = 8 + b; }
    return I;
}
__device__ __forceinline__ int hg2_index(int seqid, int h, int dir, int sc) { const int sp = seqid < 8 ? seqid * 4 + sc : 32 + (seqid - 8) * 8 + sc; return sp * 8 + h * 2 + dir; }
#define H2_TOKROW(p) (row0 + (dir ? (L - 1 - (p)) : (p)))
typedef float f32x2v __attribute__((ext_vector_type(2)));

__device__ __forceinline__ void hg2_state_pass(LAS unsigned char* lds, const bf16* P, float* Ebuf, float* Dbuf, int inst, int tid, int lane, int wave) {
    const Hg2Inst I = hg2_decode(inst); const int row0 = I.row0, L = I.L, h = I.h, dir = I.dir;
    const int fr = lane & 15, fq = lane >> 4, cp = lane, s8 = wave;
    const bf16* gl = P + (dir ? COL_FB : COL_FF) + h * 128;
    const bf16* gv = P + COL_I + h * 128;
    const int lr = tid >> 4, lc = tid & 15, vc = 4 * (wave & 3) + (lane & 3), lp = 16 * (wave >> 2) + (lane >> 2);
    const int p0 = 512 * I.sc;
#define H2_LOAD1(n) do { _Pragma("unroll") for (int i_ = 0; i_ < 2; ++i_) { rl[i_] = *(const GAS v4u*)(gl + (size_t)H2_TOKROW(p0 + 64 * (n) + lr + 32 * i_) * DIN + 8 * lc); \
        rv[i_] = *(const GAS v4u*)(gv + (size_t)H2_TOKROW(p0 + 64 * (n) + 2 * lp + i_) * DIN + 8 * vc); } } while (0)
    v4u rl[2], rv[2];
    H2_LOAD1(0);
    f32x4 S[8];
#pragma unroll
    for (int t = 0; t < 8; ++t) S[t] = (f32x4){0.f, 0.f, 0.f, 0.f};
    f32x2v dlog = {0.f, 0.f};
    for (int n = 0; n < 8; ++n) {
#pragma unroll
        for (int i = 0; i < 2; ++i) *(LAS v4u*)(lds + H2_RAWLF + (lr + 32 * i) * 272 + lc * 16) = rl[i];
#pragma unroll
        for (int e = 0; e < 4; ++e) { const unsigned w0 = rv[0][e], w1 = rv[1][e];
            *(LAS unsigned*)(lds + H2_VT + (8 * vc + 2 * e) * 144 + lp * 4) = (w0 & 0xffffu) | (w1 << 16);
            *(LAS unsigned*)(lds + H2_VT + (8 * vc + 2 * e + 1) * 144 + lp * 4) = (w0 >> 16) | (w1 & 0xffff0000u); }
        if (n + 1 < 8) H2_LOAD1(n + 1);
        __syncthreads();
        float lfa[8], lfb[8]; f32x2v av[8]; f32x2v run = {0.f, 0.f};
#pragma unroll
        for (int j = 0; j < 8; ++j) { const unsigned w = *(const LAS unsigned*)(lds + H2_RAWLF + (8 * s8 + j) * 272 + cp * 4);
            lfa[j] = bflo(w); lfb[j] = bfhi(w); run = run + (f32x2v){lfa[j], lfb[j]}; av[j] = run; }
        *(LAS f32x2v*)(lds + H2_SEG + (s8 * 128 + 2 * cp) * 4) = run;
        __syncthreads();
        {
            f32x2v sg_[8];
#pragma unroll
            for (int q = 0; q < 8; ++q) sg_[q] = *(const LAS f32x2v*)(lds + H2_SEG + (q * 128 + 2 * cp) * 4);
            const f32x2v amid2 = (sg_[0] + sg_[1]) + (sg_[2] + sg_[3]);
            const f32x2v atot2 = amid2 + ((sg_[4] + sg_[5]) + (sg_[6] + sg_[7]));
            f32x2v off2 = -amid2;
#pragma unroll
            for (int q = 0; q < 7; ++q) { const float mq = (q < s8) ? 1.0f : 0.0f; off2 = off2 + sg_[q] * mq; }
            unsigned kta[4], ktb[4];
#pragma unroll
            for (int j = 0; j < 8; ++j) {
                const f32x2v aa = off2 + av[j];
                const unsigned kba = f2bf((1.0f - ex2(lfa[j])) * ex2(-aa.x)), kbb = f2bf((1.0f - ex2(lfb[j])) * ex2(-aa.y));
                if (j & 1) { kta[j >> 1] |= kba << 16; ktb[j >> 1] |= kbb << 16; } else { kta[j >> 1] = kba; ktb[j >> 1] = kbb; }
            }
            *(LAS v4u*)(lds + H2_KT + (2 * cp) * 144 + s8 * 16) = (v4u){kta[0], kta[1], kta[2], kta[3]};
            *(LAS v4u*)(lds + H2_KT + (2 * cp + 1) * 144 + s8 * 16) = (v4u){ktb[0], ktb[1], ktb[2], ktb[3]};
            if (s8 == 0) { *(LAS f32x2v*)(lds + H2_SA + (2 * cp) * 4) = (f32x2v){ex2(amid2.x), ex2(amid2.y)};
                           *(LAS f32x2v*)(lds + H2_SB + (2 * cp) * 4) = (f32x2v){ex2(atot2.x - amid2.x), ex2(atot2.y - amid2.y)}; dlog = dlog + atot2; }
        }
        __syncthreads();
        {
            const f32x4 sa = *(const LAS f32x4*)(lds + H2_SA + (16 * wave + 4 * fq) * 4), sb = *(const LAS f32x4*)(lds + H2_SB + (16 * wave + 4 * fq) * 4);
            bf16x8 x[2];
#pragma unroll
            for (int ks = 0; ks < 2; ++ks) x[ks] = *(const LAS bf16x8*)(lds + H2_KT + (16 * wave + fr) * 144 + ks * 64 + fq * 16);
#pragma unroll
            for (int t = 0; t < 8; ++t) { S[t] = S[t] * sa;
#pragma unroll
                for (int ks = 0; ks < 2; ++ks) { const bf16x8 y = *(const LAS bf16x8*)(lds + H2_VT + (16 * t + fr) * 144 + ks * 64 + fq * 16);
                    S[t] = __builtin_amdgcn_mfma_f32_16x16x32_bf16(x[ks], y, S[t], 0, 0, 0); }
                S[t] = S[t] * sb; }
        }
        __syncthreads();
    }
    float* E = Ebuf + (size_t)inst * 16384;
#pragma unroll
    for (int t = 0; t < 8; ++t) *(GAS f32x4*)(E + ((wave * 8 + t) * 64 + lane) * 4) = S[t];
    if (s8 == 0) *(GAS f32x2v*)(Dbuf + (size_t)inst * 128 + 2 * cp) = dlog;
#undef H2_LOAD1
}

__device__ __forceinline__ void hg2_out_pass(LAS unsigned char* lds, const bf16* P, float* ob, const float* Ebuf, const float* Dbuf, int inst, int tid, int lane, int wave) {
    const Hg2Inst I = hg2_decode(inst); const int row0 = I.row0, L = I.L, h = I.h, dir = I.dir;
    const int fr = lane & 15, fq = lane >> 4, cp = lane, s8 = wave;
    const bf16* gq = P + COL_Q + h * 128;
    const bf16* gl = P + (dir ? COL_FB : COL_FF) + h * 128;
    const bf16* gv = P + COL_I + h * 128;
    float* go = ob + h * 128;
    const int lr = tid >> 4, lc = tid & 15, vc = 4 * (wave & 3) + (lane & 3), lp = 16 * (wave >> 2) + (lane >> 2);
    const int p0 = 512 * I.sc;
#define H2_LOAD2(n) do { _Pragma("unroll") for (int i_ = 0; i_ < 2; ++i_) { const size_t ro_ = (size_t)H2_TOKROW(p0 + 64 * (n) + lr + 32 * i_) * DIN + 8 * lc; rl[i_] = *(const GAS v4u*)(gl + ro_); rq[i_] = *(const GAS v4u*)(gq + ro_); \
        rv[i_] = *(const GAS v4u*)(gv + (size_t)H2_TOKROW(p0 + 64 * (n) + 2 * lp + i_) * DIN + 8 * vc); } } while (0)
    v4u rl[2], rq[2], rv[2];
    H2_LOAD2(0);
    f32x4 S[8];
#pragma unroll
    for (int t = 0; t < 8; ++t) S[t] = (f32x4){0.f, 0.f, 0.f, 0.f};
    for (int j = 0; j < I.sc; ++j) {
        const int ij = hg2_index(I.seqid, h, dir, j);
        const f32x4 dl = *(const GAS f32x4*)(Dbuf + (size_t)ij * 128 + 16 * wave + 4 * fq);
        const f32x4 dec = {ex2(dl[0]), ex2(dl[1]), ex2(dl[2]), ex2(dl[3])};
        const float* E = Ebuf + (size_t)ij * 16384;
#pragma unroll
        for (int t = 0; t < 8; ++t) S[t] = S[t] * dec + *(const GAS f32x4*)(E + ((wave * 8 + t) * 64 + lane) * 4);
    }
    for (int n = 0; n < 8; ++n) {
#pragma unroll
        for (int i = 0; i < 2; ++i) { *(LAS v4u*)(lds + H2_RAWLF + (lr + 32 * i) * 272 + lc * 16) = rl[i]; *(LAS v4u*)(lds + H2_RAWQ + (lr + 32 * i) * 272 + lc * 16) = rq[i]; }
#pragma unroll
        for (int e = 0; e < 4; ++e) { const unsigned w0 = rv[0][e], w1 = rv[1][e];
            *(LAS unsigned*)(lds + H2_VT + (8 * vc + 2 * e) * 144 + lp * 4) = (w0 & 0xffffu) | (w1 << 16);
            *(LAS unsigned*)(lds + H2_VT + (8 * vc + 2 * e + 1) * 144 + lp * 4) = (w0 >> 16) | (w1 & 0xffff0000u); }
        if (n + 1 < 8) H2_LOAD2(n + 1);
        __syncthreads();
        float lfa[8], lfb[8]; f32x2v av[8]; f32x2v run = {0.f, 0.f};
#pragma unroll
        for (int j = 0; j < 8; ++j) { const unsigned w = *(const LAS unsigned*)(lds + H2_RAWLF + (8 * s8 + j) * 272 + cp * 4);
            lfa[j] = bflo(w); lfb[j] = bfhi(w); run = run + (f32x2v){lfa[j], lfb[j]}; av[j] = run; }
        *(LAS f32x2v*)(lds + H2_SEG + (s8 * 128 + 2 * cp) * 4) = run;
        __syncthreads();
        {
            f32x2v sg_[8];
#pragma unroll
            for (int q = 0; q < 8; ++q) sg_[q] = *(const LAS f32x2v*)(lds + H2_SEG + (q * 128 + 2 * cp) * 4);
            const f32x2v amid2 = (sg_[0] + sg_[1]) + (sg_[2] + sg_[3]);
            const f32x2v atot2 = amid2 + ((sg_[4] + sg_[5]) + (sg_[6] + sg_[7]));
            f32x2v off2 = -amid2;
#pragma unroll
            for (int q = 0; q < 7; ++q) { const float mq = (q < s8) ? 1.0f : 0.0f; off2 = off2 + sg_[q] * mq; }
            unsigned kta[4], ktb[4];
#pragma unroll
            for (int j = 0; j < 8; ++j) {
                const f32x2v aa = off2 + av[j];
                const unsigned qw = *(const LAS unsigned*)(lds + H2_RAWQ + (8 * s8 + j) * 272 + cp * 4);
                const float qta = bflo(qw) * ex2(aa.x), qtb = bfhi(qw) * ex2(aa.y);
                const unsigned kba = f2bf((1.0f - ex2(lfa[j])) * ex2(-aa.x)), kbb = f2bf((1.0f - ex2(lfb[j])) * ex2(-aa.y));
                *(LAS unsigned*)(lds + H2_QN + (8 * s8 + j) * 272 + cp * 4) = pk2(qta, qtb);
                *(LAS unsigned*)(lds + H2_KN + (8 * s8 + j) * 272 + cp * 4) = kba | (kbb << 16);
                if (j & 1) { kta[j >> 1] |= kba << 16; ktb[j >> 1] |= kbb << 16; } else { kta[j >> 1] = kba; ktb[j >> 1] = kbb; }
            }
            *(LAS v4u*)(lds + H2_KT + (2 * cp) * 144 + s8 * 16) = (v4u){kta[0], kta[1], kta[2], kta[3]};
            *(LAS v4u*)(lds + H2_KT + (2 * cp + 1) * 144 + s8 * 16) = (v4u){ktb[0], ktb[1], ktb[2], ktb[3]};
            if (s8 == 0) { *(LAS f32x2v*)(lds + H2_SA + (2 * cp) * 4) = (f32x2v){ex2(amid2.x), ex2(amid2.y)};
                           *(LAS f32x2v*)(lds + H2_SB + (2 * cp) * 4) = (f32x2v){ex2(atot2.x - amid2.x), ex2(atot2.y - amid2.y)}; }
        }
        __syncthreads();
        {
            const f32x4 sa = *(const LAS f32x4*)(lds + H2_SA + (16 * wave + 4 * fq) * 4);
#pragma unroll
            for (int t = 0; t < 8; ++t) { S[t] = S[t] * sa; v2u w; w.x = pk2(S[t][0], S[t][1]); w.y = pk2(S[t][2], S[t][3]);
                *(LAS v2u*)(lds + H2_ST + (16 * t + fr) * 272 + (16 * wave + 4 * fq) * 2) = w; }
        }
        {
            const int ib = wave & 3, jp = wave >> 2;
#pragma unroll
            for (int t = 0; t < 2; ++t) {
                const int jb = 2 * jp + t;
                f32x4 sc = {0.f, 0.f, 0.f, 0.f};
                if (jb <= ib) {
#pragma unroll
                    for (int ks = 0; ks < 4; ++ks) {
                        const bf16x8 x = *(const LAS bf16x8*)(lds + H2_KN + (16 * jb + fr) * 272 + ks * 64 + fq * 16);
                        const bf16x8 y = *(const LAS bf16x8*)(lds + H2_QN + (16 * ib + fr) * 272 + ks * 64 + fq * 16);
                        sc = __builtin_amdgcn_mfma_f32_16x16x32_bf16(x, y, sc, 0, 0, 0);
                    }
                    if (jb == ib) {
#pragma unroll
                        for (int r = 0; r < 4; ++r) if (4 * fq + r > fr) sc[r] = 0.f;
                    }
                }
                v2u w; w.x = pk2(sc[0], sc[1]); w.y = pk2(sc[2], sc[3]);
                *(LAS v2u*)(lds + H2_SCL + (16 * ib + fr) * 144 + (16 * jb + 4 * fq) * 2) = w;
            }
        }
        __syncthreads();
        {
            const int ib2 = wave >> 1, dh = wave & 1;
            bf16x8 ys[2], yq[4];
#pragma unroll
            for (int ks = 0; ks < 2; ++ks) ys[ks] = *(const LAS bf16x8*)(lds + H2_SCL + (16 * ib2 + fr) * 144 + ks * 64 + fq * 16);
#pragma unroll
            for (int ks = 0; ks < 4; ++ks) yq[ks] = *(const LAS bf16x8*)(lds + H2_QN + (16 * ib2 + fr) * 272 + ks * 64 + fq * 16);
            const size_t orow = (size_t)H2_TOKROW(p0 + 64 * n + 16 * ib2 + fr) * 512;
#pragma unroll
            for (int t = 0; t < 4; ++t) {
                const int db = 4 * dh + t;
                f32x4 O = {0.f, 0.f, 0.f, 0.f};
#pragma unroll
                for (int ks = 0; ks < 2; ++ks) { const bf16x8 x = *(const LAS bf16x8*)(lds + H2_VT + (16 * db + fr) * 144 + ks * 64 + fq * 16); O = __builtin_amdgcn_mfma_f32_16x16x32_bf16(x, ys[ks], O, 0, 0, 0); }
#pragma unroll
                for (int ks = 0; ks < 4; ++ks) { const bf16x8 x = *(const LAS bf16x8*)(lds + H2_ST + (16 * db + fr) * 272 + ks * 64 + fq * 16); O = __builtin_amdgcn_mfma_f32_16x16x32_bf16(x, yq[ks], O, 0, 0, 0); }
                *(GAS f32x4*)(go + orow + 16 * db + 4 * fq) = O;
            }
        }
        {
            const f32x4 sb = *(const LAS f32x4*)(lds + H2_SB + (16 * wave + 4 * fq) * 4);
            bf16x8 x[2];
#pragma unroll
            for (int ks = 0; ks < 2; ++ks) x[ks] = *(const LAS bf16x8*)(lds + H2_KT + (16 * wave + fr) * 144 + ks * 64 + fq * 16);
#pragma unroll
            for (int t = 0; t < 8; ++t) {
#pragma unroll
                for (int ks = 0; ks < 2; ++ks) { const bf16x8 y = *(const LAS bf16x8*)(lds + H2_VT + (16 * t + fr) * 144 + ks * 64 + fq * 16);
                    S[t] = __builtin_amdgcn_mfma_f32_16x16x32_bf16(x[ks], y, S[t], 0, 0, 0); }
                S[t] = S[t] * sb; }
        }
        __syncthreads();
    }
#undef H2_LOAD2
}

#ifdef DBG_NAIVE_HGRN
__device__ __forceinline__ void naive_hgrn_item(LAS unsigned char* lds, const bf16* P, float* ob, int row0, int L, int h, int dir, int tid) {
    LAS float* LQ = (LAS float*)lds; LAS float* LF = LQ + 2048; LAS float* LK = LF + 2048;
    const unsigned short* Pu = (const unsigned short*)P;
    float S[128];
#pragma unroll
    for (int k = 0; k < 128; ++k) S[k] = 0.f;
    for (int t0 = 0; t0 < L; t0 += 16) {
        __syncthreads();
#pragma unroll
        for (int i = 0; i < 4; ++i) { const int idx = tid + 512 * i, st = idx >> 7, k = idx & 127; const size_t row = (size_t)(row0 + (dir ? (L - 1 - (t0 + st)) : (t0 + st)));
            const float qv = bf1(Pu[row * DIN + COL_Q + h * 128 + k]), l2 = bf1(Pu[row * DIN + (dir ? COL_FB : COL_FF) + h * 128 + k]), f = exp2f(l2);
            LQ[st * 128 + k] = qv; LF[st * 128 + k] = f; LK[st * 128 + k] = 1.0f - f; }
        __syncthreads();
        if (tid < 128) {
#pragma unroll 1
            for (int st = 0; st < 16; ++st) { const size_t row = (size_t)(row0 + (dir ? (L - 1 - (t0 + st)) : (t0 + st)));
                const float v = bf1(Pu[row * DIN + COL_I + h * 128 + tid]); float o = 0.f;
#pragma unroll
                for (int k4 = 0; k4 < 32; ++k4) { const f32x4 f4 = *(const LAS f32x4*)(LF + st * 128 + 4 * k4), k4v = *(const LAS f32x4*)(LK + st * 128 + 4 * k4), q4 = *(const LAS f32x4*)(LQ + st * 128 + 4 * k4);
#pragma unroll
                    for (int e = 0; e < 4; ++e) { S[4 * k4 + e] = f4[e] * S[4 * k4 + e] + k4v[e] * v; o += q4[e] * S[4 * k4 + e]; } }
                ob[row * 512 + h * 128 + tid] = o; }
        }
    }
    __syncthreads();
}
#endif
__device__ __forceinline__ void hgrn_combine(const float* ob0, const float* ob1, const bf16* P, const float* onorm, const float* ssg, const float* gon, bf16* Y, int gw, int NGW, int lane) {
    const int c = 8 * lane;
    const f32x4 g0 = *(const GAS f32x4*)(onorm + c), g1 = *(const GAS f32x4*)(onorm + c + 4);
    const f32x4 n0 = *(const GAS f32x4*)(gon + c), n1 = *(const GAS f32x4*)(gon + c + 4);
    for (int m = gw; m < TOK; m += NGW) {
        const f32x4 a0 = *(const GAS f32x4*)(ob0 + (size_t)m * 512 + c), a1 = *(const GAS f32x4*)(ob0 + (size_t)m * 512 + c + 4);
        const f32x4 b0 = *(const GAS f32x4*)(ob1 + (size_t)m * 512 + c), b1 = *(const GAS f32x4*)(ob1 + (size_t)m * 512 + c + 4);
        const v4u sgw = *(const GAS v4u*)(P + (size_t)m * DIN + COL_G + c);
#ifdef DBG_PCOPY
        f32x4 o0 = {0.f,0.f,0.f,0.f}, o1 = o0;
        { const int segs[4] = {COL_Q, COL_I, COL_FF, COL_FB};
#pragma unroll
          for (int q_ = 0; q_ < 4; ++q_) { const v4u pw = *(const GAS v4u*)(P + (size_t)m * DIN + segs[q_] + c);
            o0 += (f32x4){bflo(pw.x), bfhi(pw.x), bflo(pw.y), bfhi(pw.y)}; o1 += (f32x4){bflo(pw.z), bfhi(pw.z), bflo(pw.w), bfhi(pw.w)}; } }
#else
        const f32x4 o0 = a0 + b0, o1 = a1 + b1;
#endif
        float s = ((o0[0] * o0[0] + o0[1] * o0[1]) + (o0[2] * o0[2] + o0[3] * o0[3])) + ((o1[0] * o1[0] + o1[1] * o1[1]) + (o1[2] * o1[2] + o1[3] * o1[3]));
        s += __shfl_xor(s, 1); s += __shfl_xor(s, 2); s += __shfl_xor(s, 4); s += __shfl_xor(s, 8);
        const float r = rsq(s * (1.0f / 128.0f) + EPS);
        const f32x4 y0 = o0 * r * g0 * (f32x4){bflo(sgw.x), bfhi(sgw.x), bflo(sgw.y), bfhi(sgw.y)};
        const f32x4 y1 = o1 * r * g1 * (f32x4){bflo(sgw.z), bfhi(sgw.z), bflo(sgw.w), bfhi(sgw.w)};
        v4u w; w.x = pk2(y0[0], y0[1]); w.y = pk2(y0[2], y0[3]); w.z = pk2(y1[0], y1[1]); w.w = pk2(y1[2], y1[3]);
        *(GAS v4u*)(Y + (size_t)m * DMODEL + 512 + c) = w;
#ifndef NO_GMLP
        const f32x4 sv = *(const GAS f32x4*)(ssg + (size_t)m * 4);
        const float rg = rsq(((sv[0] + sv[1]) + (sv[2] + sv[3])) * (1.0f / 512.0f) + EPS);
        const v4u yw = *(const GAS v4u*)(Y + (size_t)m * DMODEL + c);
        const f32x4 z0 = (f32x4){bflo(yw.x), bfhi(yw.x), bflo(yw.y), bfhi(yw.y)} * rg * n0, z1 = (f32x4){bflo(yw.z), bfhi(yw.z), bflo(yw.w), bfhi(yw.w)} * rg * n1;
        v4u zw; zw.x = pk2(z0[0], z0[1]); zw.y = pk2(z0[2], z0[3]); zw.z = pk2(z1[0], z1[1]); zw.w = pk2(z1[2], z1[3]);
        *(GAS v4u*)(Y + (size_t)m * DMODEL + c) = zw;
#endif
    }
}

constexpr int GM_RAWV = 0, GM_VLT = 34816, GM_WL = 69632, GM_MEAN = 104448, GM_RSTD = 104960, GM_END = 105472;
static_assert(GM_END <= RING_BYTES, "gmlp LDS");
__device__ __forceinline__ void gmlp_item(LAS unsigned char* lds, const bf16* P, bf16* Y, float* ssg, const float* ln_g, const float* ln_b, const float* w_s, const float* b_s, int c, int h, int tid, int lane, int wave) {
    const int fr = lane & 15, fq = lane >> 4, R0 = 128 * c;
#pragma unroll 1
    for (int jj = 0; jj < 4; ++jj) {
        float sm[4], sq[4];
#pragma unroll
        for (int j = 0; j < 4; ++j) {
            const int s = 16 * wave + 4 * jj + j;
            const v4u raw = *(const GAS v4u*)(P + (size_t)(R0 + s) * DIN + COL_V + 8 * lane);
            const float x0 = bflo(raw.x), x1 = bfhi(raw.x), x2 = bflo(raw.y), x3 = bfhi(raw.y), x4 = bflo(raw.z), x5 = bfhi(raw.z), x6 = bflo(raw.w), x7 = bfhi(raw.w);
            sm[j] = ((x0 + x1) + (x2 + x3)) + ((x4 + x5) + (x6 + x7));
            sq[j] = ((x0 * x0 + x1 * x1) + (x2 * x2 + x3 * x3)) + ((x4 * x4 + x5 * x5) + (x6 * x6 + x7 * x7));
        }
#pragma unroll
        for (int o = 1; o < 64; o <<= 1) {
#pragma unroll
            for (int j = 0; j < 4; ++j) { sm[j] += __shfl_xor(sm[j], o); sq[j] += __shfl_xor(sq[j], o); }
        }
        if (lane == 0) {
#pragma unroll
            for (int j = 0; j < 4; ++j) { const int s = 16 * wave + 4 * jj + j; const float mean = sm[j] * (1.0f / 512.0f), var = fmaxf(sq[j] * (1.0f / 512.0f) - mean * mean, 0.f);
                *(LAS float*)(lds + GM_MEAN + s * 4) = mean; *(LAS float*)(lds + GM_RSTD + s * 4) = rsq(var + EPS); }
        }
    }
#pragma unroll
    for (int i = 0; i < 4; ++i) { const int idx = tid + 512 * i, row = idx >> 4, c16 = idx & 15;
        *(LAS v4u*)(lds + GM_RAWV + row * 272 + c16 * 16) = *(const GAS v4u*)(P + (size_t)(R0 + row) * DIN + COL_V + 128 * h + 8 * c16); }
#pragma unroll
    for (int i = 0; i < 8; ++i) { const int idx = tid + 512 * i, tt = idx >> 5, s4 = idx & 31;
        const f32x4 w = *(const GAS f32x4*)(w_s + (size_t)h * 16384 + tt * 128 + 4 * s4);
        v2u o; o.x = pk2(w[0], w[1]); o.y = pk2(w[2], w[3]);
        *(LAS v2u*)(lds + GM_WL + tt * 272 + s4 * 8) = o; }
    __syncthreads();
    {
        const int ch = tid & 127, sq4 = tid >> 7;
        const float g = ln_g[128 * h + ch], b = ln_b[128 * h + ch];
#pragma unroll
        for (int i = 0; i < 4; ++i) {
            unsigned wv[4];
#pragma unroll
            for (int e = 0; e < 8; ++e) { const int s = 32 * sq4 + 8 * i + e;
                const float x = bf1(*(const LAS unsigned short*)(lds + GM_RAWV + s * 272 + ch * 2));
                const float y = (x - *(const LAS float*)(lds + GM_MEAN + s * 4)) * *(const LAS float*)(lds + GM_RSTD + s * 4) * g + b;
                const unsigned yb = f2bf(y);
                if (e & 1) wv[e >> 1] |= yb << 16; else wv[e >> 1] = yb; }
            *(LAS v4u*)(lds + GM_VLT + ch * 272 + (32 * sq4 + 8 * i) * 2) = (v4u){wv[0], wv[1], wv[2], wv[3]};
        }
    }
    __syncthreads();
    const int t = 16 * wave + fr;
    bf16x8 yf[4];
#pragma unroll
    for (int ks = 0; ks < 4; ++ks) yf[ks] = *(const LAS bf16x8*)(lds + GM_WL + (16 * wave + fr) * 272 + ks * 64 + fq * 16);
    const float bs = b_s[h * 128 + t];
    float ss = 0.f;
#pragma unroll
    for (int cb = 0; cb < 8; ++cb) {
        f32x4 a = {0.f, 0.f, 0.f, 0.f};
#pragma unroll
        for (int ks = 0; ks < 4; ++ks) {
            const bf16x8 x = *(const LAS bf16x8*)(lds + GM_VLT + (16 * cb + fr) * 272 + ks * 64 + fq * 16);
            a = __builtin_amdgcn_mfma_f32_16x16x32_bf16(x, yf[ks], a, 0, 0, 0);
        }
        const int ch = 128 * h + 16 * cb + 4 * fq;
        const v2u uw = *(const GAS v2u*)(P + (size_t)(R0 + t) * DIN + COL_U + ch);
        const f32x4 uu = {bflo(uw.x), bfhi(uw.x), bflo(uw.y), bfhi(uw.y)};
        a = (a + bs) * uu;
        ss += (a[0] * a[0] + a[1] * a[1]) + (a[2] * a[2] + a[3] * a[3]);
        v2u w; w.x = pk2(a[0], a[1]); w.y = pk2(a[2], a[3]);
        *(GAS v2u*)(Y + (size_t)(R0 + t) * DMODEL + ch) = w;
    }
    ss += __shfl_xor(ss, 16); ss += __shfl_xor(ss, 32);
    if (fq == 0) ssg[(size_t)(R0 + t) * 4 + h] = ss;
    __syncthreads();
}

struct Args { const float* in[22]; float* out; unsigned char* ws; int ph_lo, ph_hi, li, pad; };
constexpr int N_PHASES = 11;
#ifndef MK_N_LAUNCHES
#define MK_N_LAUNCHES 1
#endif
#ifndef DUP_PHASE
#define DUP_PHASE (-1)
#endif
__global__ void __launch_bounds__(NWAVES * 64, 2) fwd_kernel(Args args) {
    extern __shared__ __attribute__((aligned(16))) unsigned char lds_raw[];
    LAS unsigned char* lds = (LAS unsigned char*)lds_raw;
    volatile LAS unsigned* MISC = (volatile LAS unsigned*)(lds + MISC_OFF);
    const int tid = threadIdx.x, lane = tid & 63, wave = __builtin_amdgcn_readfirstlane(tid >> 6);
    const int G = gridDim.x, bx = blockIdx.x;
    const int vcu = (G % 8 == 0) ? (bx % 8) * (G / 8) + bx / 8 : bx;
    const int gw = vcu * NWAVES + wave, NGW = G * NWAVES;
    unsigned char* ws = args.ws;
    gu32* ctl = (gu32*)(ws + WS_CTL);
    for (int u = tid; u < (LDS_BYTES - LDSCTL_OFF) / 4; u += NWAVES * 64) ((LAS unsigned*)(lds + LDSCTL_OFF))[u] = 0u;
    __syncthreads();
    XcdBarrier bar = xcd_barrier_post((unsigned*)(ctl + CW_BAR) + args.li * XCD_BAR_WORDS, MISC + 8);
    const int lo = args.ph_lo, hi = args.ph_hi;
#define IN(k) (lo <= (k) && (k) < hi)
#define SEAM(k) do { if (IN(k) && IN((k) + 1)) xcd_barrier(bar); } while (0)
    bf16* XB = (bf16*)(ws + WS_BUFA); bf16* Y = (bf16*)(ws + WS_BUFB); bf16* BIG = (bf16*)(ws + WS_BIG);
    float* OB0 = (float*)(ws + WS_BUFA); float* OB1 = (float*)(ws + WS_OB1);
    float* SSG = (float*)(ws + WS_SSG); float* HGE = (float*)(ws + WS_HGE); float* HGD = (float*)(ws + WS_HGD);
    float* P16_0 = (float*)(ws + WS_P16); float* P16_1 = (float*)(ws + WS_P16 + 2 * MiB); float* P16_2 = (float*)(ws + WS_P16 + 4 * MiB);

    for (int rep_ = 0; rep_ < ((DUP_PHASE == 0) ? 2 : 1); ++rep_) if (IN(0)) { p0_prologue(lds, args.in, ws, gw, NGW, wave, lane); }
    SEAM(0);
#define PHASE1 if (IN(1)) { pg8::Gemm g{XB, (const bf16*)(ws + WS_WGU1), TOK, 2 * DFF, DMODEL}; pg8::StaticOrder S; S.init(TOK, 2 * DFF, G, bx); \
        pg8::EpiSwiGLU E{BIG, DFF, P16_0}; pg8::gemm_phase<pg8::EpiSwiGLU, pg8::StaticOrder, PG8_ALIGN, PG8_SP2>(lds + RING_OFF, g, S, E); }
    PHASE1
#if DUP_PHASE == 1
    PHASE1
#endif
    SEAM(1);
#define PHASE2 if (IN(2)) { pg8::Gemm g{BIG, (const bf16*)(ws + WS_WD1), TOK, DMODEL, DFF}; pg8::StaticOrder S; S.init(TOK, DMODEL, G, bx); \
        pg8::EpiResid<true, true> E{args.in[0], args.in[1], args.out, XB, P16_1, 0.5f}; pg8::gemm_phase<pg8::EpiResid<true, true>, pg8::StaticOrder, PG8_ALIGN, PG8_SP2>(lds + RING_OFF, g, S, E); }
    PHASE2
#if DUP_PHASE == 2
    PHASE2
#endif
    SEAM(2);
#define PHASE3 if (IN(3)) { pg8::Gemm g{XB, (const bf16*)(ws + WS_WIN), TOK, DIN, DMODEL}; pg8::StaticOrder S; S.init(TOK, DIN, G, bx); \
        pg8::EpiMix E{BIG, DIN, P16_1, args.in[13], args.in[14]}; pg8::gemm_phase<pg8::EpiMix, pg8::StaticOrder, PG8_ALIGN, PG8_SP2>(lds + RING_OFF, g, S, E); }
    PHASE3
#if DUP_PHASE == 3
    PHASE3
#endif
    SEAM(3);
    for (int rep_ = 0; rep_ < ((DUP_PHASE == 4 || DUP_PHASE == 40 || DUP_PHASE == 41) ? 2 : 1); ++rep_) if (IN(4)) {
        if (rep_ == 0 || DUP_PHASE != 41) for (int i = bx; i < 512; i += G) hg2_state_pass(lds, BIG, HGE, HGD, i, tid, lane, wave);
        if (rep_ == 0 || DUP_PHASE != 40) for (int it = bx; it < 1024; it += G) gmlp_item(lds, BIG, Y, SSG, args.in[8], args.in[9], args.in[10], args.in[11], it >> 2, it & 3, tid, lane, wave);
    }
    SEAM(4);
    for (int rep_ = 0; rep_ < ((DUP_PHASE == 5) ? 2 : 1); ++rep_) if (IN(5)) {
        for (int i = bx; i < 512; i += G) { const Hg2Inst I = hg2_decode(i); hg2_out_pass(lds, BIG, I.dir ? OB1 : OB0, HGE, HGD, i, tid, lane, wave); }
    }
    SEAM(5);
    if (IN(6)) { hgrn_combine(OB0, OB1, BIG, args.in[15], SSG, args.in[12], Y, gw, NGW, lane); }
    SEAM(6);
    if (IN(7)) { pg8::Gemm g{Y, (const bf16*)(ws + WS_WOUT), TOK, DMODEL, DMODEL}; pg8::StaticOrder S; S.init(TOK, DMODEL, G, bx);
        pg8::EpiResid<true, true> E{args.out, args.out + (size_t)NPROMPT * DMODEL, args.out, XB, P16_2, 1.0f};
        pg8::gemm_phase<pg8::EpiResid<true, true>, pg8::StaticOrder, PG8_ALIGN, PG8_SP2>(lds + RING_OFF, g, S, E); }
    SEAM(7);
    if (IN(8)) { pg8::Gemm g{XB, (const bf16*)(ws + WS_WGU2), TOK, 2 * DFF, DMODEL}; pg8::StaticOrder S; S.init(TOK, 2 * DFF, G, bx);
        pg8::EpiSwiGLU E{BIG, DFF, P16_2};
        pg8::gemm_phase<pg8::EpiSwiGLU, pg8::StaticOrder, PG8_ALIGN, PG8_SP2>(lds + RING_OFF, g, S, E); }
    SEAM(8);
    if (IN(9)) { pg8::Gemm g{BIG, (const bf16*)(ws + WS_WD2), TOK, DMODEL, DFF}; pg8::StaticOrder S; S.init(TOK, DMODEL, G, bx);
        pg8::EpiResid<false, false> E{args.out, args.out + (size_t)NPROMPT * DMODEL, args.out, nullptr, nullptr, 0.5f};
        pg8::gemm_phase<pg8::EpiResid<false, false>, pg8::StaticOrder, PG8_ALIGN, PG8_SP2>(lds + RING_OFF, g, S, E); }
    SEAM(9);
    if (IN(10)) { final_norm(args.out, args.in[21], gw, NGW, lane); }
#undef IN
#undef SEAM
}

extern "C" void kernel_launch(void* const* d_in, const int* in_sizes, int n_in, void* d_out, int out_size, void* d_ws, size_t ws_size, hipStream_t stream) {
    static int grid = 0;
    if (grid == 0) {
        if (n_in != 22 || out_size != TOK * DMODEL || ws_size < WS_END) { fprintf(stderr, "kernel_launch: unexpected problem (n_in %d, out %d, ws %zu); nothing launched\n", n_in, out_size, ws_size); grid = -1; return; }
        int dev = 0, cus = 0, per_cu = 0;
        if (hipGetDevice(&dev) != hipSuccess || hipDeviceGetAttribute(&cus, hipDeviceAttributeMultiprocessorCount, dev) != hipSuccess) { grid = -1; return; }
        if (hipFuncSetAttribute((const void*)fwd_kernel, hipFuncAttributeMaxDynamicSharedMemorySize, LDS_BYTES) != hipSuccess) { fprintf(stderr, "kernel_launch: hipFuncSetAttribute failed\n"); grid = -1; return; }
        if (hipOccupancyMaxActiveBlocksPerMultiprocessor(&per_cu, (const void*)fwd_kernel, NWAVES * 64, LDS_BYTES) != hipSuccess || per_cu < 1) { fprintf(stderr, "kernel_launch: occupancy query says %d blocks per CU; nothing launched\n", per_cu); (void)hipGetLastError(); grid = -1; return; }
        grid = cus;
    }
    if (grid < 0) return;
    if (hipMemsetAsync((char*)d_ws + WS_CTL, 0, CTL_ZERO_BYTES, stream) != hipSuccess) return;
    Args a{};
    for (int i = 0; i < 22; ++i) a.in[i] = (const float*)d_in[i];
    a.out = (float*)d_out; a.ws = (unsigned char*)d_ws;
    constexpr int NL = MK_N_LAUNCHES;
    for (int li = 0; li < NL; ++li) {
        a.ph_lo = (NL == 1) ? 0 : li; a.ph_hi = (NL == 1) ? N_PHASES : li + 1; a.li = 0;
        hipLaunchKernelGGL(fwd_kernel, dim3(grid), dim3(NWAVES * 64), LDS_BYTES, stream, a);
        if (hipPeekAtLastError() != hipSuccess) { fprintf(stderr, "kernel_launch: launch %d failed\n", li); break; }
    }
}
```

```cpp
#include <hip/hip_runtime.h>
#include <cstdio>
#include <cstdint>
namespace pg8 {
#define PG8_LAS __attribute__((address_space(3)))
typedef unsigned short bf16_t;
typedef short bf16x8 __attribute__((ext_vector_type(8)));
typedef float f32x4 __attribute__((ext_vector_type(4)));
typedef unsigned u32x4 __attribute__((ext_vector_type(4)));
constexpr int BM = 256, BK = 64, HALF = 128, HTB = HALF * BK * 2  , STAGE_BYTES = 8 * HTB, NXCD = 8, WGM = 8;

__host__ __device__ __forceinline__ int lds_byte(int r, int c) { const int st = (r >> 4) * 2 + (c >> 5), rr = r & 15, cc = c & 31, ob = rr * 64 + cc * 2; return st * 1024 + (ob ^ (((ob >> 9) & 1) << 5)); }
__host__ __device__ __forceinline__ void stage_rc(int b, int& R, int& C) { const int st = b / 1024, sb = b % 1024, swz = sb ^ (((sb >> 9) & 1) << 5); R = (st >> 1) * 16 + swz / 64; C = (st & 1) * 32 + (swz % 64) / 2; }
__host__ __device__ __forceinline__ int perm32(int rho) { const int n = rho >> 4, i = rho & 15; return 8 * (i >> 2) + 4 * n + (i & 3); }

struct Unit { int pm, pn; };
struct Gemm { const bf16_t* A; const bf16_t* Bt; int M, N, K; };

struct StaticOrder {
    int nM, nN, nwg, G, c;
    __host__ __device__ void init(int M, int N, int G_, int c_) { nM = M / BM; nN = N / BM; nwg = nM * nN; G = G_; c = c_; }
    __host__ __device__ bool next(int i, Unit& u) const {
        const long L = (long)i * G + c; if (L >= nwg) return false;
        int wgid = (int)L; { const int q = nwg / NXCD, r = nwg % NXCD, xcd = wgid % NXCD, off = wgid / NXCD; wgid = (xcd < r ? xcd * (q + 1) : r * (q + 1) + (xcd - r) * q) + off; }
        const int nig = WGM * nN, gid = wgid / nig, fm = gid * WGM, gsz = (nM - fm) < WGM ? (nM - fm) : WGM;
        u.pm = fm + ((wgid % nig) % gsz); u.pn = (wgid % nig) / gsz; return true;
    }
    __device__ __forceinline__ void a_ready(const Unit&) const {}
    __device__ __forceinline__ void done(const Unit&) const {}
};

typedef __bf16 bf16x2_hw __attribute__((ext_vector_type(2)));
typedef float f32x2_hw __attribute__((ext_vector_type(2)));
__device__ __forceinline__ unsigned cvt_pk_bf16(float lo, float hi) { const f32x2_hw v = {lo, hi}; const bf16x2_hw b = __builtin_convertvector(v, bf16x2_hw); return __builtin_bit_cast(unsigned, b); }
typedef float f32x2 __attribute__((ext_vector_type(2)));
__device__ __forceinline__ f32x2 gelu_pk(f32x2 v) {
    const f32x2 av = __builtin_elementwise_abs(v), d = av * 0.2316418882f + 1.0f;
    f32x2 t; t.x = __builtin_amdgcn_rcpf(d.x); t.y = __builtin_amdgcn_rcpf(d.y);
    f32x2 q = t * 0.5307027145f + (-0.7265760135f); q = q * t + 0.7107068705f; q = q * t + (-0.142248368f); q = q * t + 0.127414796f; q = q * t;
    const f32x2 s = (v * v) * (-0.72134752044f);
    f32x2 e; e.x = __builtin_amdgcn_exp2f(s.x); e.y = __builtin_amdgcn_exp2f(s.y);
    const f32x2 m = v * (q * e), r = v - m;
    f32x2 o; o.x = v.x < 0.f ? m.x : r.x; o.y = v.y < 0.f ? m.y : r.y; return o;
}

constexpr float RMS_EPS = 1e-6f;
constexpr int DM = 1024;
__device__ __forceinline__ float row_rstd(const float* p16, int row, int fq) {
    const f32x4 v = *(const f32x4*)(p16 + (size_t)row * 16 + 4 * fq);
    float s = (v[0] + v[1]) + (v[2] + v[3]);
    s += __shfl_xor(s, 16); s += __shfl_xor(s, 32);
    return __builtin_amdgcn_rsqf(s * (1.0f / DM) + RMS_EPS);
}
__device__ __forceinline__ void row_rstd8(const float* p16, int row0, int fq, float (&rr)[8]) {
    f32x4 pv[8];
#pragma unroll
    for (int i = 0; i < 8; ++i) pv[i] = *(const f32x4*)(p16 + (size_t)(row0 + (i >> 2) * HALF + (i & 3) * 16) * 16 + 4 * fq);
#pragma unroll
    for (int i = 0; i < 8; ++i) { float s = (pv[i][0] + pv[i][1]) + (pv[i][2] + pv[i][3]); s += __shfl_xor(s, 16); s += __shfl_xor(s, 32); rr[i] = __builtin_amdgcn_rsqf(s * (1.0f / DM) + RMS_EPS); }
}
__device__ __forceinline__ float fast_sigmoid(float z) { return __builtin_amdgcn_rcpf(1.0f + __builtin_amdgcn_exp2f(-1.44269504089f * z)); }

struct EpiSwiGLU {
    static constexpr bool PERM = true, AFTER_DRAIN = false;
    bf16_t* O; int ldo; const float* p16;
    __device__ __forceinline__ void operator()(const f32x4 (&acc)[2][2][4][2], const Unit& u, int wr, int wc, int fr, int fq) const {
        const int row0 = u.pm * BM + wr * 64 + fr, col0 = u.pn * HALF + wc * 32 + 8 * fq;
        float rr[8];
        row_rstd8(p16, row0, fq, rr);
#pragma unroll
        for (int ai = 0; ai < 2; ++ai)
#pragma unroll
            for (int m = 0; m < 4; ++m) {
                const int row = row0 + ai * HALF + m * 16;
                const float r = rr[ai * 4 + m];
                float h[8];
#pragma unroll
                for (int n = 0; n < 2; ++n)
#pragma unroll
                    for (int e = 0; e < 4; ++e) { const float g = acc[ai][0][m][n][e] * r, up = acc[ai][1][m][n][e] * r; h[4 * n + e] = g * up * fast_sigmoid(g); }
                u32x4 w; w.x = cvt_pk_bf16(h[0], h[1]); w.y = cvt_pk_bf16(h[2], h[3]); w.z = cvt_pk_bf16(h[4], h[5]); w.w = cvt_pk_bf16(h[6], h[7]);
                *(u32x4*)(O + (size_t)row * ldo + col0) = w;
            }
    }
};

template <bool WANT_BF16, bool WANT_SS> struct EpiResid {
    static constexpr bool PERM = true, AFTER_DRAIN = false;
    const float* base0; const float* base1;
    float* out; bf16_t* xb; float* p16; float alpha;
    __device__ __forceinline__ void operator()(const f32x4 (&acc)[2][2][4][2], const Unit& u, int wr, int wc, int fr, int fq) const {
        const int row0 = u.pm * BM + wr * 64 + fr, col0 = u.pn * BM + wc * 32 + 8 * fq;
        const float* bp = (u.pm < 64) ? base0 : base1; const int brow = (u.pm < 64) ? 0 : 16384;
        f32x4 bcur[4], bnxt[4];
#define RESID_LOAD(dst, it) do { const size_t bo_ = (size_t)(row0 + ((it) >> 2) * HALF + ((it) & 3) * 16 - brow) * DM + col0; \
            dst[0] = *(const f32x4*)(bp + bo_); dst[1] = *(const f32x4*)(bp + bo_ + 4); dst[2] = *(const f32x4*)(bp + bo_ + HALF); dst[3] = *(const f32x4*)(bp + bo_ + HALF + 4); } while (0)
        RESID_LOAD(bcur, 0);
#pragma unroll
        for (int it = 0; it < 8; ++it) {
            const int ai = it >> 2, m = it & 3;
            if (it + 1 < 8) RESID_LOAD(bnxt, it + 1);
            const int row = row0 + ai * HALF + m * 16; const size_t off = (size_t)row * DM + col0;
            float ss = 0.f;
#pragma unroll
            for (int bj = 0; bj < 2; ++bj) {
                const f32x4 v0 = bcur[2 * bj] + acc[ai][bj][m][0] * alpha, v1 = bcur[2 * bj + 1] + acc[ai][bj][m][1] * alpha;
                *(f32x4*)(out + off + bj * HALF) = v0; *(f32x4*)(out + off + bj * HALF + 4) = v1;
                if (WANT_BF16) { u32x4 w; w.x = cvt_pk_bf16(v0[0], v0[1]); w.y = cvt_pk_bf16(v0[2], v0[3]); w.z = cvt_pk_bf16(v1[0], v1[1]); w.w = cvt_pk_bf16(v1[2], v1[3]);
                    *(u32x4*)(xb + off + bj * HALF) = w; }
                if (WANT_SS) ss += ((v0[0] * v0[0] + v0[1] * v0[1]) + (v0[2] * v0[2] + v0[3] * v0[3])) + ((v1[0] * v1[0] + v1[1] * v1[1]) + (v1[2] * v1[2] + v1[3] * v1[3]));
            }
            if (WANT_SS) { ss += __shfl_xor(ss, 16); ss += __shfl_xor(ss, 32); if (fq == 0) p16[(size_t)row * 16 + 4 * u.pn + wc] = ss; }
#pragma unroll
            for (int q = 0; q < 4; ++q) bcur[q] = bnxt[q];
            asm volatile("" ::: "memory");
        }
#undef RESID_LOAD
    }
};

template <bool WANT_SS> struct EpiResidBf {
    static constexpr bool PERM = true, AFTER_DRAIN = false;
    bf16_t* xb; float* p16; float alpha;
    __device__ __forceinline__ void operator()(const f32x4 (&acc)[2][2][4][2], const Unit& u, int wr, int wc, int fr, int fq) const {
        const int row0 = u.pm * BM + wr * 64 + fr, col0 = u.pn * BM + wc * 32 + 8 * fq;
        u32x4 bcur[2], bnxt[2];
#define RESB_LOAD(dst, it) do { const size_t bo_ = (size_t)(row0 + ((it) >> 2) * HALF + ((it) & 3) * 16) * DM + col0; dst[0] = *(const u32x4*)(xb + bo_); dst[1] = *(const u32x4*)(xb + bo_ + HALF); } while (0)
        RESB_LOAD(bcur, 0);
#pragma unroll
        for (int it = 0; it < 8; ++it) {
            const int ai = it >> 2, m = it & 3;
            if (it + 1 < 8) RESB_LOAD(bnxt, it + 1);
            const int row = row0 + ai * HALF + m * 16; const size_t off = (size_t)row * DM + col0;
            float ss = 0.f;
#pragma unroll
            for (int bj = 0; bj < 2; ++bj) {
                const u32x4 b = bcur[bj];
                const f32x4 b0 = {__builtin_bit_cast(float, b.x << 16), __builtin_bit_cast(float, b.x & 0xffff0000u), __builtin_bit_cast(float, b.y << 16), __builtin_bit_cast(float, b.y & 0xffff0000u)};
                const f32x4 b1 = {__builtin_bit_cast(float, b.z << 16), __builtin_bit_cast(float, b.z & 0xffff0000u), __builtin_bit_cast(float, b.w << 16), __builtin_bit_cast(float, b.w & 0xffff0000u)};
                const f32x4 v0 = b0 + acc[ai][bj][m][0] * alpha, v1 = b1 + acc[ai][bj][m][1] * alpha;
                u32x4 w; w.x = cvt_pk_bf16(v0[0], v0[1]); w.y = cvt_pk_bf16(v0[2], v0[3]); w.z = cvt_pk_bf16(v1[0], v1[1]); w.w = cvt_pk_bf16(v1[2], v1[3]);
                *(u32x4*)(xb + off + bj * HALF) = w;
                if (WANT_SS) ss += ((v0[0] * v0[0] + v0[1] * v0[1]) + (v0[2] * v0[2] + v0[3] * v0[3])) + ((v1[0] * v1[0] + v1[1] * v1[1]) + (v1[2] * v1[2] + v1[3] * v1[3]));
            }
            if (WANT_SS) { ss += __shfl_xor(ss, 16); ss += __shfl_xor(ss, 32); if (fq == 0) p16[(size_t)row * 16 + 4 * u.pn + wc] = ss; }
            bcur[0] = bnxt[0]; bcur[1] = bnxt[1];
            asm volatile("" ::: "memory");
        }
#undef RESB_LOAD
    }
};
struct EpiNull { static constexpr bool PERM = true, AFTER_DRAIN = false; float* sink;
    __device__ __forceinline__ void operator()(const f32x4 (&acc)[2][2][4][2], const Unit& u, int wr, int wc, int fr, int fq) const {
        float s = 0.f;
#pragma unroll
        for (int ai = 0; ai < 2; ++ai)
#pragma unroll
            for (int bj = 0; bj < 2; ++bj)
#pragma unroll
                for (int m = 0; m < 4; ++m)
#pragma unroll
                    for (int n = 0; n < 2; ++n) s += acc[ai][bj][m][n][0] + acc[ai][bj][m][n][1] + acc[ai][bj][m][n][2] + acc[ai][bj][m][n][3];
        if (s == 12345.678f) sink[0] = s;
    } };
struct EpiMix {
    static constexpr bool PERM = true, AFTER_DRAIN = false;
    bf16_t* P; int ldp; const float* p16; const float* lbf; const float* lbb;
    template <int ACT> __device__ __forceinline__ void run(const f32x4 (&acc)[2][2][4][2], const Unit& u, int wr, int wc, int fr, int fq) const {
        const int row0 = u.pm * BM + wr * 64 + fr, col0 = u.pn * BM + wc * 32 + 8 * fq;
        float oml[2][8];
        if (ACT == 3) { const float* lb = ((u.pn >> 1) == 4) ? lbf : lbb; const int c0 = (u.pn & 1) * BM + wc * 32 + 8 * fq;
#pragma unroll
            for (int bj = 0; bj < 2; ++bj)
#pragma unroll
                for (int e = 0; e < 8; ++e) { const float a0 = lb[c0 + bj * HALF + e], a1 = lb[512 + c0 + bj * HALF + e]; oml[bj][e] = fast_sigmoid(a1 - a0);
#ifdef DBG_OML
                    oml[bj][e] = 0.5f;
#endif
                } }
        float rr[8];
        row_rstd8(p16, row0, fq, rr);
#pragma unroll
        for (int ai = 0; ai < 2; ++ai)
#pragma unroll
            for (int m = 0; m < 4; ++m) {
                const int row = row0 + ai * HALF + m * 16;
                const float r = rr[ai * 4 + m];
#pragma unroll
                for (int bj = 0; bj < 2; ++bj) {
                    float h[8];
#pragma unroll
                    for (int n = 0; n < 2; ++n) {
                        const f32x4 z = acc[ai][bj][m][n] * r;
                        if (ACT == 0) { const f32x2 a = gelu_pk((f32x2){z[0], z[1]}), b = gelu_pk((f32x2){z[2], z[3]}); h[4 * n] = a.x; h[4 * n + 1] = a.y; h[4 * n + 2] = b.x; h[4 * n + 3] = b.y; }
                        else if (ACT == 1) {
#pragma unroll
                            for (int e = 0; e < 4; ++e) h[4 * n + e] = z[e] * fast_sigmoid(z[e]); }
                        else if (ACT == 2) {
#pragma unroll
                            for (int e = 0; e < 4; ++e) h[4 * n + e] = z[e]; }
                        else {
#pragma unroll
                            for (int e = 0; e < 4; ++e) { const float kk = oml[bj][4 * n + e] * __builtin_amdgcn_rcpf(1.0f + __builtin_amdgcn_exp2f(1.44269504089f * z[e]));
                                h[4 * n + e] = __builtin_amdgcn_logf(1.0f - kk); }
                        }
                    }
                    u32x4 w; w.x = cvt_pk_bf16(h[0], h[1]); w.y = cvt_pk_bf16(h[2], h[3]); w.z = cvt_pk_bf16(h[4], h[5]); w.w = cvt_pk_bf16(h[6], h[7]);
                    *(u32x4*)(P + (size_t)row * ldp + col0 + bj * HALF) = w;
                }
            }
    }
    __device__ __forceinline__ void operator()(const f32x4 (&acc)[2][2][4][2], const Unit& u, int wr, int wc, int fr, int fq) const {
        const int seg = u.pn >> 1;
        if (seg <= 1) run<0>(acc, u, wr, wc, fr, fq);
        else if (seg == 2 || seg == 6) run<1>(acc, u, wr, wc, fr, fq);
        else if (seg == 3) run<2>(acc, u, wr, wc, fr, fq);
        else run<3>(acc, u, wr, wc, fr, fq);
    }
};

template <class Epi, class Sched, bool ALIGN_EPI = false, bool SP2 = false>
__device__ __forceinline__ void gemm_phase(PG8_LAS unsigned char* lds, const Gemm g, const Sched& S, const Epi& E) {
    const int tid = threadIdx.x, wid = __builtin_amdgcn_readfirstlane(tid >> 6), lane = tid & 63, wr = wid >> 2, wc = wid & 3, fr = lane & 15, fq = lane >> 4;
    const int K = g.K, nt = K / BK;
    unsigned voffA[2], voffB[2];
#pragma unroll
    for (int i = 0; i < 2; ++i) { int R, C; stage_rc(tid * 16 + i * 8192, R, C); const int Rb = Epi::PERM ? ((R & ~31) + perm32(R & 31)) : R;
        voffA[i] = (unsigned)(R * K + C) * 2u; voffB[i] = (unsigned)(Rb * K + C) * 2u; }
    const size_t kstep = (size_t)(BK * 2);
    const size_t hstep = (size_t)HALF * K * 2;
    const size_t tstep = 2 * hstep;
    const unsigned ldsw = (unsigned)wid * 1024u;
    const int aoff = lds_byte(wr * 64 + fr, fq * 8), boff = lds_byte(wc * 32 + fr, fq * 8);
#define PG8_SA(b, h) (((b) * 2 + (h)) * HTB)
#define PG8_SB(b, h) ((4 + (b) * 2 + (h)) * HTB)
#define PG8_STAGE(bufoff, gbase, voff) do { _Pragma("unroll") for (int _i = 0; _i < 2; ++_i) \
        __builtin_amdgcn_global_load_lds((const unsigned*)((const char*)(gbase) + (voff)[_i]), (PG8_LAS unsigned*)(lds + (bufoff) + ldsw + _i * 8192), 16, 0, 0); } while (0)
#define PG8_LDA(dst, b, h) do { _Pragma("unroll") for (int m = 0; m < 4; ++m) _Pragma("unroll") for (int k = 0; k < 2; ++k) dst[m][k] = *(const PG8_LAS bf16x8*)(lds + PG8_SA(b, h) + aoff + m * 2048 + k * 1024); } while (0)
#define PG8_LDB(dst, b, h) do { _Pragma("unroll") for (int n = 0; n < 2; ++n) _Pragma("unroll") for (int k = 0; k < 2; ++k) dst[n][k] = *(const PG8_LAS bf16x8*)(lds + PG8_SB(b, h) + boff + n * 2048 + k * 1024); } while (0)
#define PG8_MMA(ai, bj, At, Bt) do { __builtin_amdgcn_s_setprio(1); _Pragma("unroll") for (int m = 0; m < 4; ++m) _Pragma("unroll") for (int n = 0; n < 2; ++n) _Pragma("unroll") for (int k = 0; k < 2; ++k) \
        acc[ai][bj][m][n] = __builtin_amdgcn_mfma_f32_16x16x32_bf16(Bt[n][k], At[m][k], acc[ai][bj][m][n], 0, 0, 0); __builtin_amdgcn_s_setprio(0); } while (0)
#define PG8_WAIT_V(n) asm volatile("s_waitcnt vmcnt(" #n ")" ::: "memory")
#define PG8_WAIT_L(n) asm volatile("s_waitcnt lgkmcnt(" #n ")" ::: "memory")
#define PG8_BAR __builtin_amdgcn_s_barrier()
#define PG8_SCHED __builtin_amdgcn_sched_barrier(0)
    Unit cur, nxt; int ui = 0;
    if (!S.next(0, cur)) return;
    f32x4 acc[2][2][4][2];
#pragma unroll
    for (int a = 0; a < 2; ++a)
#pragma unroll
        for (int b = 0; b < 2; ++b)
#pragma unroll
            for (int m = 0; m < 4; ++m)
#pragma unroll
                for (int n = 0; n < 2; ++n) acc[a][b][m][n] = (f32x4){0.f, 0.f, 0.f, 0.f};
    bf16x8 At[4][2], B0[2][2], B1[2][2];
    const char* cA = (const char*)g.A + (size_t)cur.pm * tstep; const char* cB = (const char*)g.Bt + (size_t)cur.pn * tstep;
    S.a_ready(cur);
    if constexpr (SP2) {
        PG8_STAGE(PG8_SB(0, 0), cB, voffB); PG8_STAGE(PG8_SB(0, 1), cB + hstep, voffB); PG8_STAGE(PG8_SA(0, 0), cA, voffA); PG8_STAGE(PG8_SA(0, 1), cA + hstep, voffA);
        if (wr == 1) PG8_BAR;
        PG8_WAIT_V(2); PG8_BAR;
        PG8_STAGE(PG8_SB(1, 0), cB + kstep, voffB); PG8_STAGE(PG8_SA(1, 0), cA + kstep, voffA); PG8_STAGE(PG8_SB(1, 1), cB + hstep + kstep, voffB);
        PG8_WAIT_V(6); PG8_BAR;
    } else {
        PG8_STAGE(PG8_SB(0, 0), cB, voffB); PG8_STAGE(PG8_SA(0, 0), cA, voffA); PG8_STAGE(PG8_SB(0, 1), cB + hstep, voffB); PG8_STAGE(PG8_SA(0, 1), cA + hstep, voffA);
        if (wr == 1) PG8_BAR;
        PG8_WAIT_V(4); PG8_BAR;
        PG8_STAGE(PG8_SB(1, 0), cB + kstep, voffB); PG8_STAGE(PG8_SA(1, 0), cA + kstep, voffA); PG8_STAGE(PG8_SB(1, 1), cB + hstep + kstep, voffB);
        PG8_WAIT_V(6); PG8_BAR;
    }
    for (;;) {
        const bool has_next = S.next(ui + 1, nxt);
        const char* nA = has_next ? (const char*)g.A + (size_t)nxt.pm * tstep : cA; const char* nB = has_next ? (const char*)g.Bt + (size_t)nxt.pn * tstep : cB;
        for (int t = 0; t < nt; t += 2) {
            const bool last = (t == nt - 2);
            const char* a1 = cA + (size_t)(t + 1) * kstep;
            const char* a2 = last ? nA : cA + (size_t)(t + 2) * kstep; const char* b2 = last ? nB : cB + (size_t)(t + 2) * kstep;
            const char* a3 = a2 + kstep; const char* b3 = b2 + kstep;
            if (last && has_next) S.a_ready(nxt);
            if constexpr (SP2) {
            PG8_LDB(B0, 0, 0); PG8_LDB(B1, 0, 1); PG8_SCHED; PG8_LDA(At, 0, 0); PG8_STAGE(PG8_SA(1, 1), a1 + hstep, voffA);
            PG8_WAIT_V(8); PG8_WAIT_L(0); PG8_BAR; PG8_MMA(0, 0, At, B0); PG8_MMA(0, 1, At, B1); PG8_BAR; PG8_SCHED;
            PG8_LDA(At, 0, 1); PG8_STAGE(PG8_SB(0, 0), b2, voffB); PG8_STAGE(PG8_SB(0, 1), b2 + hstep, voffB); PG8_STAGE(PG8_SA(0, 0), a2, voffA);
            PG8_WAIT_V(8); PG8_WAIT_L(0); PG8_BAR; PG8_MMA(1, 0, At, B0); PG8_MMA(1, 1, At, B1); PG8_BAR; PG8_SCHED;
            PG8_LDB(B0, 1, 0); PG8_LDB(B1, 1, 1); PG8_SCHED; PG8_LDA(At, 1, 0); PG8_STAGE(PG8_SA(0, 1), a2 + hstep, voffA);
            PG8_WAIT_V(8); PG8_WAIT_L(0); PG8_BAR; PG8_MMA(0, 0, At, B0); PG8_MMA(0, 1, At, B1); PG8_BAR; PG8_SCHED;
            PG8_LDA(At, 1, 1); PG8_STAGE(PG8_SB(1, 0), b3, voffB); PG8_STAGE(PG8_SB(1, 1), b3 + hstep, voffB); PG8_STAGE(PG8_SA(1, 0), a3, voffA);
            PG8_WAIT_V(8); PG8_WAIT_L(0); PG8_BAR; PG8_MMA(1, 0, At, B0); PG8_MMA(1, 1, At, B1); PG8_BAR; PG8_SCHED;
            } else {
            PG8_LDB(B0, 0, 0); PG8_SCHED; PG8_LDA(At, 0, 0); PG8_STAGE(PG8_SA(1, 1), a1 + hstep, voffA);
            PG8_WAIT_L(8); PG8_BAR; PG8_WAIT_L(0); PG8_MMA(0, 0, At, B0); PG8_BAR; PG8_SCHED;
            PG8_LDB(B1, 0, 1); PG8_STAGE(PG8_SB(0, 0), b2, voffB);
            PG8_BAR; PG8_WAIT_L(0); PG8_MMA(0, 1, At, B1); PG8_BAR;
            PG8_LDA(At, 0, 1); PG8_STAGE(PG8_SA(0, 0), a2, voffA);
            PG8_BAR; PG8_WAIT_L(0); PG8_MMA(1, 0, At, B0); PG8_BAR; PG8_SCHED;
            PG8_STAGE(PG8_SB(0, 1), b2 + hstep, voffB);
            PG8_WAIT_V(6); PG8_BAR; PG8_MMA(1, 1, At, B1); PG8_BAR;
            PG8_LDB(B0, 1, 0); PG8_SCHED; PG8_LDA(At, 1, 0); PG8_STAGE(PG8_SA(0, 1), a2 + hstep, voffA);
            PG8_WAIT_L(8); PG8_BAR; PG8_WAIT_L(0); PG8_MMA(0, 0, At, B0); PG8_BAR; PG8_SCHED;
            PG8_LDB(B1, 1, 1); PG8_STAGE(PG8_SB(1, 0), b3, voffB);
            PG8_BAR; PG8_WAIT_L(0); PG8_MMA(0, 1, At, B1); PG8_BAR;
            PG8_LDA(At, 1, 1); PG8_STAGE(PG8_SA(1, 0), a3, voffA);
            PG8_BAR; PG8_WAIT_L(0); PG8_MMA(1, 0, At, B0); PG8_BAR; PG8_SCHED;
            PG8_STAGE(PG8_SB(1, 1), b3 + hstep, voffB);
            PG8_WAIT_V(6); PG8_BAR; PG8_MMA(1, 1, At, B1); PG8_BAR;
            }
        }
        if constexpr (ALIGN_EPI) { if (wr == 0) PG8_BAR; }
        if constexpr (!Epi::AFTER_DRAIN) { E(acc, cur, wr, wc, fr, fq); S.done(cur); }
        if (!has_next) break;
#pragma unroll
        for (int a = 0; a < 2; ++a)
#pragma unroll
            for (int b = 0; b < 2; ++b)
#pragma unroll
                for (int m = 0; m < 4; ++m)
#pragma unroll
                    for (int n = 0; n < 2; ++n) acc[a][b][m][n] = (f32x4){0.f, 0.f, 0.f, 0.f};
        cur = nxt; cA = nA; cB = nB; ++ui;
        if constexpr (ALIGN_EPI) { if (wr == 1) PG8_BAR; }
    }
    PG8_WAIT_V(0);
    if constexpr (!ALIGN_EPI) { if (wr == 0) PG8_BAR; }
    PG8_BAR;
    if constexpr (Epi::AFTER_DRAIN) { E.fused(acc, cur, wr, wc, fr, fq, lds, wid, lane); S.done(cur); }
#undef PG8_SA
#undef PG8_SB
#undef PG8_STAGE
#undef PG8_LDA
#undef PG8_LDB
#undef PG8_MMA
#undef PG8_WAIT_V
#undef PG8_WAIT_L
#undef PG8_BAR
#undef PG8_SCHED
}
}

#ifndef PG8_SP2
#define PG8_SP2 true
#endif
#ifndef PG8_ALIGN
#define PG8_ALIGN true
#endif
constexpr int NWAVES = 8;
constexpr int TOK = 32768, NPROMPT = 16384;
constexpr int DMODEL = 1024, DFF = 2816, DIN = 3584;
constexpr int COL_U = 0, COL_V = 512, COL_Q = 1024, COL_I = 1536, COL_FF = 2048, COL_FB = 2560, COL_G = 3072;
constexpr float EPS = 1e-6f;
constexpr size_t MiB = 1u << 20;
constexpr size_t WS_CTL = 0, CTL_ZERO_BYTES = 1 * MiB;
constexpr size_t WS_SSG = 1 * MiB;
constexpr size_t WS_P16 = 2 * MiB;
constexpr size_t WS_WGU1 = 8 * MiB, WS_WD1 = 19 * MiB, WS_WIN = 25 * MiB, WS_WOUT = 32 * MiB, WS_WGU2 = 34 * MiB, WS_WD2 = 45 * MiB;
constexpr size_t WS_BUFA = 52 * MiB;
constexpr size_t WS_BUFB = 116 * MiB;
constexpr size_t WS_BIG = 180 * MiB;
constexpr size_t WS_OB1 = 404 * MiB;
constexpr size_t WS_HGE = 468 * MiB;
constexpr size_t WS_HGD = 500 * MiB;
constexpr size_t WS_END = 501 * MiB;
static_assert(WS_WGU1 + (size_t)2 * DFF * DMODEL * 2 <= WS_WD1 && WS_WD1 + (size_t)DMODEL * DFF * 2 <= WS_WIN && WS_WIN + (size_t)DIN * DMODEL * 2 <= WS_WOUT && WS_WOUT + (size_t)DMODEL * DMODEL * 2 <= WS_WGU2
              && WS_WGU2 + (size_t)2 * DFF * DMODEL * 2 <= WS_WD2 && WS_WD2 + (size_t)DMODEL * DFF * 2 <= WS_BUFA && WS_BUFA + (size_t)TOK * DMODEL * 2 <= WS_BUFB && WS_BUFB + (size_t)TOK * DMODEL * 2 <= WS_BIG
              && WS_BIG + (size_t)TOK * DIN * 2 <= WS_OB1 && WS_OB1 + (size_t)TOK * 512 * 4 <= WS_HGE && WS_HGE + (size_t)512 * 65536 <= WS_HGD && WS_P16 + 3 * 2 * MiB <= WS_WGU1, "d_ws map");
constexpr int CW_BAR = 4096;
constexpr int RING_OFF = 0, RING_BYTES = 131072;
constexpr int LDSCTL_OFF = RING_BYTES, MISC_OFF = LDSCTL_OFF + 320;
constexpr int LDS_BYTES = 147456;
static_assert(MISC_OFF + 128 <= LDS_BYTES, "LDS map");

#define GAS __attribute__((address_space(1)))
#define LAS __attribute__((address_space(3)))
typedef unsigned short bf16;
typedef unsigned v4u __attribute__((ext_vector_type(4)));
typedef float f32x4 __attribute__((ext_vector_type(4)));
typedef short bf16x8 __attribute__((ext_vector_type(8)));
typedef GAS unsigned gu32;
typedef GAS unsigned long long gu64;
#define RLX_AGENT __ATOMIC_RELAXED, __HIP_MEMORY_SCOPE_AGENT
#define LDS_WAIT() asm volatile("s_waitcnt lgkmcnt(0)" ::: "memory")
#define VM_WAIT() asm volatile("s_waitcnt vmcnt(0)" ::: "memory")
__device__ __forceinline__ unsigned long long rt() { return __builtin_amdgcn_s_memrealtime(); }
__device__ __forceinline__ unsigned f2bf(float f) { unsigned u = __builtin_bit_cast(unsigned, f); return (u + 0x7fffu + ((u >> 16) & 1u)) >> 16; }
__device__ __forceinline__ unsigned pk2(float lo, float hi) { return f2bf(lo) | (f2bf(hi) << 16); }

#define XB_TMO      128
#define XB_XCNT(j)  (256  + 64 * (j))
#define XB_XSUB(j)  (1280 + 64 * (j))
#define XB_XGEN(j)  (2304 + 64 * (j))
#define XB_TOP      3328
#define XB_TOPGEN   3392
#define XCD_BAR_WORDS 3456
#define XB_SPIN_CAP (1u << 18)

__device__ __forceinline__ unsigned xb_ld(unsigned* p)              { return __hip_atomic_load(p, __ATOMIC_RELAXED, __HIP_MEMORY_SCOPE_AGENT); }
__device__ __forceinline__ unsigned xb_add(unsigned* p, unsigned v) { return __hip_atomic_fetch_add(p, v, __ATOMIC_RELAXED, __HIP_MEMORY_SCOPE_AGENT); }
__device__ __forceinline__ unsigned xb_xcc_id() { return (unsigned)__builtin_amdgcn_s_getreg((3 << 11) | 20) & 0xFu; }
#define XB_SPIN(cond, bar) do { unsigned _sp = 0; while (cond) { __builtin_amdgcn_s_sleep(1); \
    if ((++_sp & 255u) == 0u) { if (xb_ld(&(bar)[XB_TMO])) break; if (_sp > XB_SPIN_CAP) { atomicAdd(&(bar)[XB_TMO], 1u); break; } } } } while (0)

struct XcdBarrier {
    unsigned* bar; unsigned x;
    volatile LAS unsigned* st;
};

__device__ __forceinline__ XcdBarrier xcd_barrier_post(unsigned* bar, volatile LAS unsigned* st) {
    XcdBarrier b; b.bar = bar; b.x = xb_xcc_id(); b.st = st;
    if (threadIdx.x == 0) (void)xb_add(&bar[XB_XCNT(b.x)], 1u);
    return b;
}
__device__ __forceinline__ void xcd_barrier_complete(unsigned* bar, unsigned x, unsigned& nloc, unsigned& nx) {
    const unsigned G = gridDim.x * gridDim.y * gridDim.z;
    unsigned sum, cnt, mine, sp = 0u;
    for (;;) {
        sum = 0u; cnt = 0u; mine = 0u;
#pragma unroll
        for (unsigned j = 0; j < 16; ++j) { const unsigned c = xb_ld(&bar[XB_XCNT(j)]); sum += c; cnt += (c > 0u) ? 1u : 0u; mine = (j == x) ? c : mine; }
        if (sum == G) break;
        __builtin_amdgcn_s_sleep(1);
        if ((++sp & 255u) == 0u) { if (xb_ld(&bar[XB_TMO])) break; if (sp > XB_SPIN_CAP) { atomicAdd(&bar[XB_TMO], 1u); break; } }
    }
    nloc = mine > 0u ? mine : 1u; nx = cnt > 0u ? cnt : 1u;
}

__device__ __forceinline__ void xcd_barrier(const XcdBarrier& b) {
    asm volatile("s_waitcnt vmcnt(0)" ::: "memory");
    __syncthreads();
    if (threadIdx.x == 0) {
        unsigned* bar = b.bar;
        __builtin_amdgcn_s_waitcnt(0);
        unsigned nloc = b.st[0], nx = b.st[1];
        if (nloc == 0u) { xcd_barrier_complete(bar, b.x, nloc, nx); b.st[0] = nloc; b.st[1] = nx; }
        const unsigned old = xb_add(&bar[XB_XSUB(b.x)], 1u);
        const unsigned gen = old / nloc;
        if (old + 1u == (gen + 1u) * nloc) {
            __builtin_amdgcn_fence(__ATOMIC_RELEASE, "agent");
            asm volatile("s_waitcnt vmcnt(0)" ::: "memory");
            const unsigned og = xb_add(&bar[XB_TOP], 1u);
            const unsigned tg = og / nx;
            if (og + 1u == (tg + 1u) * nx) xb_add(&bar[XB_TOPGEN], 1u);
            else XB_SPIN(xb_ld(&bar[XB_TOPGEN]) == tg, bar);
            __builtin_amdgcn_fence(__ATOMIC_ACQUIRE, "agent");
            xb_add(&bar[XB_XGEN(b.x)], 1u);
            asm volatile("s_waitcnt vmcnt(0)" ::: "memory");
        } else {
            XB_SPIN(xb_ld(&bar[XB_XGEN(b.x)]) == gen, bar);
            __builtin_amdgcn_fence(__ATOMIC_ACQUIRE, "agent");
            asm volatile("s_waitcnt vmcnt(0)" ::: "memory");
        }
    }
    __syncthreads();
}
typedef unsigned v2u __attribute__((ext_vector_type(2)));
__device__ __forceinline__ float wave_sum(float v) {
#pragma unroll
    for (int o = 1; o < 64; o <<= 1) v += __shfl_xor(v, o);
    return v;
}
__device__ __forceinline__ float bflo(unsigned w) { return __builtin_bit_cast(float, w << 16); }
__device__ __forceinline__ float bfhi(unsigned w) { return __builtin_bit_cast(float, w & 0xffff0000u); }
__device__ __forceinline__ float bf1(unsigned short h) { return __builtin_bit_cast(float, (unsigned)h << 16); }
__device__ __forceinline__ float ex2(float x) { return __builtin_amdgcn_exp2f(x); }
__device__ __forceinline__ float rsq(float x) { return __builtin_amdgcn_rsqf(x); }

__device__ __forceinline__ void p0_item(const float* W, int Nsrc, int k0, int scol0, const float* gain, bf16* WT, int K, int drow0, LAS float* scr, int lane) {
#pragma unroll 8
    for (int i = 0; i < 32; ++i) { const int kk = 2 * i + (lane >> 5); float v = W[(size_t)(k0 + kk) * Nsrc + scol0 + (lane & 31)]; if (gain) v *= gain[k0 + kk]; scr[kk * 33 + (lane & 31)] = v; }
    LDS_WAIT(); asm volatile("" ::: "memory");
    const int c = lane & 7;
#pragma unroll
    for (int j = 0; j < 4; ++j) { const int n = (lane >> 3) + 8 * j; const LAS float* s = scr + (8 * c) * 33 + n;
        v4u o; o.x = pk2(s[0 * 33], s[1 * 33]); o.y = pk2(s[2 * 33], s[3 * 33]); o.z = pk2(s[4 * 33], s[5 * 33]); o.w = pk2(s[6 * 33], s[7 * 33]);
        *(GAS v4u*)(WT + (size_t)(drow0 + n) * K + k0 + 8 * c) = o; }
    LDS_WAIT(); asm volatile("" ::: "memory");
}
__device__ __forceinline__ void p0_gu(const float* Wg, const float* Wu, const float* gain, bf16* WT, int r, LAS float* scr, int lane) {
    const int nblk = 2 * DFF / 32, kb = r / nblk, nb = r % nblk, n0 = 32 * nb, pn = n0 >> 8, bj = (n0 >> 7) & 1, j0 = n0 & 127;
    p0_item(bj ? Wu : Wg, DFF, 64 * kb, 128 * pn + j0, gain, WT, DMODEL, n0, scr, lane);
}
__device__ __forceinline__ void p0_plain(const float* W, int K, int N, const float* gain, bf16* WT, int r, LAS float* scr, int lane) {
    const int nblk = N / 32, kb = r / nblk, nb = r % nblk;
    p0_item(W, N, 64 * kb, 32 * nb, gain, WT, K, 32 * nb, scr, lane);
}
__device__ __forceinline__ void p0_prologue(LAS unsigned char* lds, const float* const* in, unsigned char* ws, int gw, int NGW, int wave, int lane) {
    LAS float* scr = (LAS float*)(lds + RING_OFF + wave * 16384);
    constexpr int I_GU = (DMODEL / 64) * (2 * DFF / 32), I_D = (DFF / 64) * (DMODEL / 32), I_IN = (DMODEL / 64) * (DIN / 32), I_OUT = (DMODEL / 64) * (DMODEL / 32);
    constexpr int NITEMS = 2 * I_GU + 2 * I_D + I_IN + I_OUT;
    for (int it = gw; it < NITEMS; it += NGW) {
        int r = it;
        if (r < I_GU) { p0_gu(in[3], in[4], in[2], (bf16*)(ws + WS_WGU1), r, scr, lane); continue; } r -= I_GU;
        if (r < I_GU) { p0_gu(in[18], in[19], in[17], (bf16*)(ws + WS_WGU2), r, scr, lane); continue; } r -= I_GU;
        if (r < I_D) { p0_plain(in[5], DFF, DMODEL, nullptr, (bf16*)(ws + WS_WD1), r, scr, lane); continue; } r -= I_D;
        if (r < I_D) { p0_plain(in[20], DFF, DMODEL, nullptr, (bf16*)(ws + WS_WD2), r, scr, lane); continue; } r -= I_D;
        if (r < I_IN) { p0_plain(in[7], DMODEL, DIN, in[6], (bf16*)(ws + WS_WIN), r, scr, lane); continue; } r -= I_IN;
        p0_plain(in[16], DMODEL, DMODEL, nullptr, (bf16*)(ws + WS_WOUT), r, scr, lane);
    }
    bf16* XB = (bf16*)(ws + WS_BUFA); float* p16 = (float*)(ws + WS_P16);
    for (int m = gw; m < TOK; m += NGW) {
        const float* xrow = m < NPROMPT ? in[0] + (size_t)m * DMODEL : in[1] + (size_t)(m - NPROMPT) * DMODEL;
        const GAS f32x4* xr = (const GAS f32x4*)xrow + lane;
        f32x4 v[4]; float s = 0.f;
#pragma unroll
        for (int j = 0; j < 4; ++j) { v[j] = xr[64 * j]; s += (v[j].x * v[j].x + v[j].y * v[j].y) + (v[j].z * v[j].z + v[j].w * v[j].w); }
        s = wave_sum(s);
        GAS v2u* o8 = (GAS v2u*)(XB + (size_t)m * DMODEL) + lane;
#pragma unroll
        for (int j = 0; j < 4; ++j) { v2u w; w.x = pk2(v[j].x, v[j].y); w.y = pk2(v[j].z, v[j].w); o8[64 * j] = w; }
        if (lane < 16) p16[(size_t)m * 16 + lane] = lane == 0 ? s : 0.f;
    }
}

__device__ __forceinline__ void final_norm(const bf16* XBr, float* out, const float* gfin, int gw, int NGW, int lane) {
    for (int m = gw; m < TOK; m += NGW) {
        const v4u w0 = *(const GAS v4u*)(XBr + (size_t)m * DMODEL + 8 * lane), w1 = *(const GAS v4u*)(XBr + (size_t)m * DMODEL + 512 + 8 * lane);
        float x[16] = {bflo(w0.x), bfhi(w0.x), bflo(w0.y), bfhi(w0.y), bflo(w0.z), bfhi(w0.z), bflo(w0.w), bfhi(w0.w), bflo(w1.x), bfhi(w1.x), bflo(w1.y), bfhi(w1.y), bflo(w1.z), bfhi(w1.z), bflo(w1.w), bfhi(w1.w)};
        float s = 0.f;
#pragma unroll
        for (int e = 0; e < 16; ++e) s += x[e] * x[e];
        const float r = rsq(wave_sum(s) * (1.0f / DMODEL) + EPS);
#pragma unroll
        for (int j = 0; j < 2; ++j) { const int c = 512 * j + 8 * lane;
            const f32x4 g0 = *(const GAS f32x4*)(gfin + c), g1 = *(const GAS f32x4*)(gfin + c + 4);
            *(GAS f32x4*)(out + (size_t)m * DMODEL + c) = (f32x4){x[8 * j] * r * g0[0], x[8 * j + 1] * r * g0[1], x[8 * j + 2] * r * g0[2], x[8 * j + 3] * r * g0[3]};
            *(GAS f32x4*)(out + (size_t)m * DMODEL + c + 4) = (f32x4){x[8 * j + 4] * r * g1[0], x[8 * j + 5] * r * g1[1], x[8 * j + 6] * r * g1[2], x[8 * j + 7] * r * g1[3]}; }
    }
}

constexpr int HG_RAWLF = 0, HG_RAWQ = 17408, HG_QN = 34816, HG_KN = 52224, HG_KT = 69632, HG_VT = 88064, HG_SCL = 97280, HG_ST = 106496, HG_SEG = 115200, HG_SA = 119296, HG_SB = 119808, HG_END = 120320;
static_assert(HG_END <= RING_BYTES, "hgrn LDS");
__device__ __forceinline__ void hgrn_item(LAS unsigned char* lds, const bf16* P, float* ob, int row0, int L, int h, int dir, int dq, int tid, int lane, int wave) {
    const int fr = lane & 15, fq = lane >> 4, nch = L >> 6;
    const bf16* gq = P + COL_Q + h * 128;
    const bf16* gl = P + (dir ? COL_FB : COL_FF) + h * 128;
    const bf16* gv = P + COL_I + h * 128 + dq * 32;
    float* go = ob + h * 128 + dq * 32;
    const int lr = tid >> 4, lc = tid & 15, lp = (tid >> 2) & 31, vc = tid & 3, cp = lane, s8 = wave;
#define TOKROW(n, l) (row0 + (dir ? (L - 1 - (64 * (n) + (l))) : (64 * (n) + (l))))
#define HG_LOAD(n) do { _Pragma("unroll") for (int i_ = 0; i_ < 2; ++i_) { const size_t ro_ = (size_t)TOKROW(n, lr + 32 * i_) * DIN + 8 * lc; rl[i_] = *(const GAS v4u*)(gl + ro_); rq[i_] = *(const GAS v4u*)(gq + ro_); \
        rv[i_] = *(const GAS v4u*)(gv + (size_t)TOKROW(n, 2 * lp + i_) * DIN + 8 * vc); } } while (0)
    v4u rl[2], rq[2], rv[2];
    HG_LOAD(0);
    f32x4 S0 = {0.f, 0.f, 0.f, 0.f}, S1 = {0.f, 0.f, 0.f, 0.f};
    for (int n = 0; n < nch; ++n) {
        const int vbuf = HG_VT + (n & 1) * 4608;
#pragma unroll
        for (int i = 0; i < 2; ++i) { *(LAS v4u*)(lds + HG_RAWLF + (lr + 32 * i) * 272 + lc * 16) = rl[i]; *(LAS v4u*)(lds + HG_RAWQ + (lr + 32 * i) * 272 + lc * 16) = rq[i]; }
        if (tid < 128) {
#pragma unroll
            for (int e = 0; e < 4; ++e) { const unsigned w0 = rv[0][e], w1 = rv[1][e];
                *(LAS unsigned*)(lds + vbuf + (8 * vc + 2 * e) * 144 + lp * 4) = (w0 & 0xffffu) | (w1 << 16);
                *(LAS unsigned*)(lds + vbuf + (8 * vc + 2 * e + 1) * 144 + lp * 4) = (w0 >> 16) | (w1 & 0xffff0000u); }
        }
        if (n + 1 < nch) HG_LOAD(n + 1);
        __syncthreads();
        float lfa[8], lfb[8], ava[8], avb[8]; float runa = 0.f, runb = 0.f;
#pragma unroll
        for (int j = 0; j < 8; ++j) { const unsigned w = *(const LAS unsigned*)(lds + HG_RAWLF + (8 * s8 + j) * 272 + cp * 4);
            lfa[j] = bflo(w); lfb[j] = bfhi(w); runa += lfa[j]; runb += lfb[j]; ava[j] = runa; avb[j] = runb; }
        *(LAS v2u*)(lds + HG_SEG + (s8 * 128 + 2 * cp) * 4) = (v2u){__builtin_bit_cast(unsigned, runa), __builtin_bit_cast(unsigned, runb)};
        __syncthreads();
        {
            typedef float f32x2v __attribute__((ext_vector_type(2)));
            f32x2v sg_[8];
#pragma unroll
            for (int q = 0; q < 8; ++q) sg_[q] = *(const LAS f32x2v*)(lds + HG_SEG + (q * 128 + 2 * cp) * 4);
            const f32x2v amid2 = (sg_[0] + sg_[1]) + (sg_[2] + sg_[3]);
            const f32x2v atot2 = amid2 + ((sg_[4] + sg_[5]) + (sg_[6] + sg_[7]));
            f32x2v off2 = -amid2;
#pragma unroll
            for (int q = 0; q < 7; ++q) { const float mq = (q < s8) ? 1.0f : 0.0f; off2 = off2 + sg_[q] * mq; }
            const float amida = amid2.x, amidb = amid2.y, atota = atot2.x, atotb = atot2.y;
            const float offa = off2.x, offb = off2.y;
            unsigned kta[4], ktb[4];
#pragma unroll
            for (int j = 0; j < 8; ++j) {
                const float aa = offa + ava[j], ab = offb + avb[j];
                const unsigned qw = *(const LAS unsigned*)(lds + HG_RAWQ + (8 * s8 + j) * 272 + cp * 4);
                const float qta = bflo(qw) * ex2(aa), qtb = bfhi(qw) * ex2(ab);
                const float k_a = (1.0f - ex2(lfa[j])) * ex2(-aa), k_b = (1.0f - ex2(lfb[j])) * ex2(-ab);
                const unsigned kba = f2bf(k_a), kbb = f2bf(k_b);
                *(LAS unsigned*)(lds + HG_QN + (8 * s8 + j) * 272 + cp * 4) = pk2(qta, qtb);
                *(LAS unsigned*)(lds + HG_KN + (8 * s8 + j) * 272 + cp * 4) = kba | (kbb << 16);
                if (j & 1) { kta[j >> 1] |= kba << 16; ktb[j >> 1] |= kbb << 16; } else { kta[j >> 1] = kba; ktb[j >> 1] = kbb; }
            }
            *(LAS v4u*)(lds + HG_KT + (2 * cp) * 144 + s8 * 16) = (v4u){kta[0], kta[1], kta[2], kta[3]};
            *(LAS v4u*)(lds + HG_KT + (2 * cp + 1) * 144 + s8 * 16) = (v4u){ktb[0], ktb[1], ktb[2], ktb[3]};
            if (s8 == 0) { *(LAS v2u*)(lds + HG_SA + (2 * cp) * 4) = (v2u){__builtin_bit_cast(unsigned, ex2(amida)), __builtin_bit_cast(unsigned, ex2(amidb))};
                           *(LAS v2u*)(lds + HG_SB + (2 * cp) * 4) = (v2u){__builtin_bit_cast(unsigned, ex2(atota - amida)), __builtin_bit_cast(unsigned, ex2(atotb - amidb))}; }
        }
        __syncthreads();
        {
            const f32x4 sa = *(const LAS f32x4*)(lds + HG_SA + (16 * wave + 4 * fq) * 4);
            S0 = S0 * sa; S1 = S1 * sa;
#ifdef DBG_NOSTATE
            S0 = (f32x4){0.f,0.f,0.f,0.f}; S1 = S0;
#endif
            v2u w0, w1; w0.x = pk2(S0[0], S0[1]); w0.y = pk2(S0[2], S0[3]); w1.x = pk2(S1[0], S1[1]); w1.y = pk2(S1[2], S1[3]);
            *(LAS v2u*)(lds + HG_ST + fr * 272 + (16 * wave + 4 * fq) * 2) = w0;
            *(LAS v2u*)(lds + HG_ST + (16 + fr) * 272 + (16 * wave + 4 * fq) * 2) = w1;
        }
        {
            const int ib = wave & 3, jp = wave >> 2;
#pragma unroll
            for (int t = 0; t < 2; ++t) {
                const int jb = 2 * jp + t;
                f32x4 sc = {0.f, 0.f, 0.f, 0.f};
                if (jb <= ib) {
#pragma unroll
                    for (int ks = 0; ks < 4; ++ks) {
                        const bf16x8 x = *(const LAS bf16x8*)(lds + HG_KN + (16 * jb + fr) * 272 + ks * 64 + fq * 16);
                        const bf16x8 y = *(const LAS bf16x8*)(lds + HG_QN + (16 * ib + fr) * 272 + ks * 64 + fq * 16);
                        sc = __builtin_amdgcn_mfma_f32_16x16x32_bf16(x, y, sc, 0, 0, 0);
                    }
                    if (jb == ib) {
#pragma unroll
                        for (int r = 0; r < 4; ++r) if (4 * fq + r > fr) sc[r] = 0.f;
                    }
                }
                v2u w; w.x = pk2(sc[0], sc[1]); w.y = pk2(sc[2], sc[3]);
                *(LAS v2u*)(lds + HG_SCL + (16 * ib + fr) * 144 + (16 * jb + 4 * fq) * 2) = w;
            }
        }
        __syncthreads();
        {
            const int ib2 = wave >> 1, db = wave & 1;
            f32x4 O = {0.f, 0.f, 0.f, 0.f};
#pragma unroll
            for (int ks = 0; ks < 2; ++ks) {
                const bf16x8 x = *(const LAS bf16x8*)(lds + vbuf + (16 * db + fr) * 144 + ks * 64 + fq * 16);
                const bf16x8 y = *(const LAS bf16x8*)(lds + HG_SCL + (16 * ib2 + fr) * 144 + ks * 64 + fq * 16);
                O = __builtin_amdgcn_mfma_f32_16x16x32_bf16(x, y, O, 0, 0, 0);
            }
#pragma unroll
            for (int ks = 0; ks < 4; ++ks) {
                const bf16x8 x = *(const LAS bf16x8*)(lds + HG_ST + (16 * db + fr) * 272 + ks * 64 + fq * 16);
                const bf16x8 y = *(const LAS bf16x8*)(lds + HG_QN + (16 * ib2 + fr) * 272 + ks * 64 + fq * 16);
                O = __builtin_amdgcn_mfma_f32_16x16x32_bf16(x, y, O, 0, 0, 0);
            }
#if defined(DBG_HG) && DBG_HG == 1
            { const v2u w = *(const LAS v2u*)(lds + HG_QN + (16 * ib2 + fr) * 272 + (16 * db + 4 * fq) * 2); O = (f32x4){bflo(w.x), bfhi(w.x), bflo(w.y), bfhi(w.y)}; }
#elif defined(DBG_HG) && DBG_HG == 2
            { const v2u w = *(const LAS v2u*)(lds + HG_SCL + (16 * ib2 + fr) * 144 + (16 * db + 4 * fq) * 2); O = (f32x4){bflo(w.x), bfhi(w.x), bflo(w.y), bfhi(w.y)}; }
#elif defined(DBG_HG) && DBG_HG == 3
            { const v2u w = *(const LAS v2u*)(lds + vbuf + (16 * db + fr) * 144 + (16 * (ib2 & 3) + 4 * fq) * 2); O = (f32x4){bflo(w.x), bfhi(w.x), bflo(w.y), bfhi(w.y)}; }
#elif defined(DBG_HG) && DBG_HG == 5
            { const v2u w = *(const GAS v2u*)(gq + (size_t)TOKROW(n, 16 * ib2 + fr) * DIN + 16 * db + 4 * fq); O = (f32x4){bflo(w.x), bfhi(w.x), bflo(w.y), bfhi(w.y)}; }
#elif defined(DBG_HG) && DBG_HG == 9
            { const v2u w = *(const GAS v2u*)(gl + (size_t)TOKROW(n, 16 * ib2 + fr) * DIN + 16 * db + 4 * fq); O = (f32x4){bflo(w.x), bfhi(w.x), bflo(w.y), bfhi(w.y)}; }
#elif defined(DBG_HG) && DBG_HG == 10
            { const v2u w = *(const LAS v2u*)(lds + HG_RAWLF + (16 * ib2 + fr) * 272 + (16 * db + 4 * fq) * 2); O = (f32x4){bflo(w.x), bfhi(w.x), bflo(w.y), bfhi(w.y)}; }
#elif defined(DBG_HG) && DBG_HG == 7
            { const v2u w = *(const GAS v2u*)(P + COL_U + h * 128 + (size_t)TOKROW(n, 16 * ib2 + fr) * DIN + 16 * db + 4 * fq); O = (f32x4){bflo(w.x), bfhi(w.x), bflo(w.y), bfhi(w.y)}; }
#elif defined(DBG_HG) && DBG_HG == 8
            { O = (f32x4){(float)TOKROW(n, 16 * ib2 + fr), (float)(16 * db + 4 * fq), (float)h, (float)dq}; }
#elif defined(DBG_HG) && DBG_HG == 6
            { const v2u w = *(const LAS v2u*)(lds + HG_RAWQ + (16 * ib2 + fr) * 272 + (16 * db + 4 * fq) * 2); O = (f32x4){bflo(w.x), bfhi(w.x), bflo(w.y), bfhi(w.y)}; }
#elif defined(DBG_HG) && DBG_HG == 4
            { const v2u w = *(const LAS v2u*)(lds + HG_KN + (16 * ib2 + fr) * 272 + (16 * db + 4 * fq) * 2); O = (f32x4){bflo(w.x), bfhi(w.x), bflo(w.y), bfhi(w.y)}; }
#endif
            *(GAS f32x4*)(go + (size_t)TOKROW(n, 16 * ib2 + fr) * 512 + 16 * db + 4 * fq) = O;
        }
        {
#pragma unroll
            for (int ks = 0; ks < 2; ++ks) {
                const bf16x8 x = *(const LAS bf16x8*)(lds + HG_KT + (16 * wave + fr) * 144 + ks * 64 + fq * 16);
                const bf16x8 y0 = *(const LAS bf16x8*)(lds + vbuf + fr * 144 + ks * 64 + fq * 16);
                const bf16x8 y1 = *(const LAS bf16x8*)(lds + vbuf + (16 + fr) * 144 + ks * 64 + fq * 16);
                S0 = __builtin_amdgcn_mfma_f32_16x16x32_bf16(x, y0, S0, 0, 0, 0);
                S1 = __builtin_amdgcn_mfma_f32_16x16x32_bf16(x, y1, S1, 0, 0, 0);
            }
            const f32x4 sb = *(const LAS f32x4*)(lds + HG_SB + (16 * wave + 4 * fq) * 4);
            S0 = S0 * sb; S1 = S1 * sb;
        }
        __syncthreads();
    }
#undef HG_LOAD
#undef TOKROW
}

constexpr int H2_RAWLF = 0, H2_RAWQ = 17408, H2_ST = 0, H2_QN = 34816, H2_KN = 52224, H2_KT = 69632, H2_VT = 88064, H2_SCL = 106496, H2_SEG = 115712, H2_SA = 119808, H2_SB = 120320, H2_END = 120832;
static_assert(H2_END <= RING_BYTES, "hgrn v2 LDS");
struct Hg2Inst { int row0, L, h, dir, sc, seqid; };
__device__ __forceinline__ Hg2Inst hg2_decode(int i) {
    Hg2Inst I; const int hd = i & 7, sp = i >> 3; I.h = hd >> 1; I.dir = hd & 1;
    if (sp < 32) { const int b = sp >> 2; I.sc = sp & 3; I.row0 = 2048 * b; I.L = 2048; I.seqid = b; }
    else { const int b = (sp - 32) >> 3; I.sc = (sp - 32) & 7; I.row0 = NPROMPT + 4096 * b; I.L = 4096; I.seqid = 8 + b; }
    return I;
}
__device__ __forceinline__ int hg2_index(int seqid, int h, int dir, int sc) { const int sp = seqid < 8 ? seqid * 4 + sc : 32 + (seqid - 8) * 8 + sc; return sp * 8 + h * 2 + dir; }
#define H2_TOKROW(p) (row0 + (dir ? (L - 1 - (p)) : (p)))
typedef float f32x2v __attribute__((ext_vector_type(2)));

__device__ __forceinline__ void hg2_state_pass(LAS unsigned char* lds, const bf16* P, float* Ebuf, float* Dbuf, int inst, int tid, int lane, int wave) {
    const Hg2Inst I = hg2_decode(inst); const int row0 = I.row0, L = I.L, h = I.h, dir = I.dir;
    const int fr = lane & 15, fq = lane >> 4, cp = lane, s8 = wave;
    const bf16* gl = P + (dir ? COL_FB : COL_FF) + h * 128;
    const bf16* gv = P + COL_I + h * 128;
    const int lr = tid >> 4, lc = tid & 15, vc = 4 * (wave & 3) + (lane & 3), lp = 16 * (wave >> 2) + (lane >> 2);
    const int p0 = 512 * I.sc;
#define H2_LOAD1(n) do { _Pragma("unroll") for (int i_ = 0; i_ < 2; ++i_) { rl[i_] = *(const GAS v4u*)(gl + (size_t)H2_TOKROW(p0 + 64 * (n) + lr + 32 * i_) * DIN + 8 * lc); \
        rv[i_] = *(const GAS v4u*)(gv + (size_t)H2_TOKROW(p0 + 64 * (n) + 2 * lp + i_) * DIN + 8 * vc); } } while (0)
    v4u rl[2], rv[2];
    H2_LOAD1(0);
    f32x4 S[8];
#pragma unroll
    for (int t = 0; t < 8; ++t) S[t] = (f32x4){0.f, 0.f, 0.f, 0.f};
    f32x2v dlog = {0.f, 0.f};
    for (int n = 0; n < 8; ++n) {
#pragma unroll
        for (int i = 0; i < 2; ++i) *(LAS v4u*)(lds + H2_RAWLF + (lr + 32 * i) * 272 + lc * 16) = rl[i];
#pragma unroll
        for (int e = 0; e < 4; ++e) { const unsigned w0 = rv[0][e], w1 = rv[1][e];
            *(LAS unsigned*)(lds + H2_VT + (8 * vc + 2 * e) * 144 + lp * 4) = (w0 & 0xffffu) | (w1 << 16);
            *(LAS unsigned*)(lds + H2_VT + (8 * vc + 2 * e + 1) * 144 + lp * 4) = (w0 >> 16) | (w1 & 0xffff0000u); }
        if (n + 1 < 8) H2_LOAD1(n + 1);
        __syncthreads();
        float lfa[8], lfb[8]; f32x2v av[8]; f32x2v run = {0.f, 0.f};
#pragma unroll
        for (int j = 0; j < 8; ++j) { const unsigned w = *(const LAS unsigned*)(lds + H2_RAWLF + (8 * s8 + j) * 272 + cp * 4);
            lfa[j] = bflo(w); lfb[j] = bfhi(w); run = run + (f32x2v){lfa[j], lfb[j]}; av[j] = run; }
        *(LAS f32x2v*)(lds + H2_SEG + (s8 * 128 + 2 * cp) * 4) = run;
        __syncthreads();
        {
            f32x2v sg_[8];
#pragma unroll
            for (int q = 0; q < 8; ++q) sg_[q] = *(const LAS f32x2v*)(lds + H2_SEG + (q * 128 + 2 * cp) * 4);
            const f32x2v amid2 = (sg_[0] + sg_[1]) + (sg_[2] + sg_[3]);
            const f32x2v atot2 = amid2 + ((sg_[4] + sg_[5]) + (sg_[6] + sg_[7]));
            f32x2v off2 = -amid2;
#pragma unroll
            for (int q = 0; q < 7; ++q) { const float mq = (q < s8) ? 1.0f : 0.0f; off2 = off2 + sg_[q] * mq; }
            unsigned kta[4], ktb[4];
#pragma unroll
            for (int j = 0; j < 8; ++j) {
                const f32x2v aa = off2 + av[j];
                const unsigned kba = f2bf((1.0f - ex2(lfa[j])) * ex2(-aa.x)), kbb = f2bf((1.0f - ex2(lfb[j])) * ex2(-aa.y));
                if (j & 1) { kta[j >> 1] |= kba << 16; ktb[j >> 1] |= kbb << 16; } else { kta[j >> 1] = kba; ktb[j >> 1] = kbb; }
            }
            *(LAS v4u*)(lds + H2_KT + (2 * cp) * 144 + s8 * 16) = (v4u){kta[0], kta[1], kta[2], kta[3]};
            *(LAS v4u*)(lds + H2_KT + (2 * cp + 1) * 144 + s8 * 16) = (v4u){ktb[0], ktb[1], ktb[2], ktb[3]};
            if (s8 == 0) { *(LAS f32x2v*)(lds + H2_SA + (2 * cp) * 4) = (f32x2v){ex2(amid2.x), ex2(amid2.y)};
                           *(LAS f32x2v*)(lds + H2_SB + (2 * cp) * 4) = (f32x2v){ex2(atot2.x - amid2.x), ex2(atot2.y - amid2.y)}; dlog = dlog + atot2; }
        }
        __syncthreads();
        {
            const f32x4 sa = *(const LAS f32x4*)(lds + H2_SA + (16 * wave + 4 * fq) * 4), sb = *(const LAS f32x4*)(lds + H2_SB + (16 * wave + 4 * fq) * 4);
            bf16x8 x[2];
#pragma unroll
            for (int ks = 0; ks < 2; ++ks) x[ks] = *(const LAS bf16x8*)(lds + H2_KT + (16 * wave + fr) * 144 + ks * 64 + fq * 16);
#pragma unroll
            for (int t = 0; t < 8; ++t) { S[t] = S[t] * sa;
#pragma unroll
                for (int ks = 0; ks < 2; ++ks) { const bf16x8 y = *(const LAS bf16x8*)(lds + H2_VT + (16 * t + fr) * 144 + ks * 64 + fq * 16);
                    S[t] = __builtin_amdgcn_mfma_f32_16x16x32_bf16(x[ks], y, S[t], 0, 0, 0); }
                S[t] = S[t] * sb; }
        }
        __syncthreads();
    }
    float* E = Ebuf + (size_t)inst * 16384;
#pragma unroll
    for (int t = 0; t < 8; ++t) *(GAS f32x4*)(E + ((wave * 8 + t) * 64 + lane) * 4) = S[t];
    if (s8 == 0) *(GAS f32x2v*)(Dbuf + (size_t)inst * 128 + 2 * cp) = dlog;
#undef H2_LOAD1
}

__device__ __forceinline__ void hg2_out_pass(LAS unsigned char* lds, const bf16* P, float* ob, const float* Ebuf, const float* Dbuf, int inst, int tid, int lane, int wave) {
    const Hg2Inst I = hg2_decode(inst); const int row0 = I.row0, L = I.L, h = I.h, dir = I.dir;
    const int fr = lane & 15, fq = lane >> 4, cp = lane, s8 = wave;
    const bf16* gq = P + COL_Q + h * 128;
    const bf16* gl = P + (dir ? COL_FB : COL_FF) + h * 128;
    const bf16* gv = P + COL_I + h * 128;
    float* go = ob + h * 128;
    const int lr = tid >> 4, lc = tid & 15, vc = 4 * (wave & 3) + (lane & 3), lp = 16 * (wave >> 2) + (lane >> 2);
    const int p0 = 512 * I.sc;
#define H2_LOAD2(n) do { _Pragma("unroll") for (int i_ = 0; i_ < 2; ++i_) { const size_t ro_ = (size_t)H2_TOKROW(p0 + 64 * (n) + lr + 32 * i_) * DIN + 8 * lc; rl[i_] = *(const GAS v4u*)(gl + ro_); rq[i_] = *(const GAS v4u*)(gq + ro_); \
        rv[i_] = *(const GAS v4u*)(gv + (size_t)H2_TOKROW(p0 + 64 * (n) + 2 * lp + i_) * DIN + 8 * vc); } } while (0)
    v4u rl[2], rq[2], rv[2];
    H2_LOAD2(0);
    f32x4 S[8];
#pragma unroll
    for (int t = 0; t < 8; ++t) S[t] = (f32x4){0.f, 0.f, 0.f, 0.f};
    for (int j = 0; j < I.sc; ++j) {
        const int ij = hg2_index(I.seqid, h, dir, j);
        const f32x4 dl = *(const GAS f32x4*)(Dbuf + (size_t)ij * 128 + 16 * wave + 4 * fq);
        const f32x4 dec = {ex2(dl[0]), ex2(dl[1]), ex2(dl[2]), ex2(dl[3])};
        const float* E = Ebuf + (size_t)ij * 16384;
#pragma unroll
        for (int t = 0; t < 8; ++t) S[t] = S[t] * dec + *(const GAS f32x4*)(E + ((wave * 8 + t) * 64 + lane) * 4);
    }
    for (int n = 0; n < 8; ++n) {
#pragma unroll
        for (int i = 0; i < 2; ++i) { *(LAS v4u*)(lds + H2_RAWLF + (lr + 32 * i) * 272 + lc * 16) = rl[i]; *(LAS v4u*)(lds + H2_RAWQ + (lr + 32 * i) * 272 + lc * 16) = rq[i]; }
#pragma unroll
        for (int e = 0; e < 4; ++e) { const unsigned w0 = rv[0][e], w1 = rv[1][e];
            *(LAS unsigned*)(lds + H2_VT + (8 * vc + 2 * e) * 144 + lp * 4) = (w0 & 0xffffu) | (w1 << 16);
            *(LAS unsigned*)(lds + H2_VT + (8 * vc + 2 * e + 1) * 144 + lp * 4) = (w0 >> 16) | (w1 & 0xffff0000u); }
        if (n + 1 < 8) H2_LOAD2(n + 1);
        __syncthreads();
        float lfa[8], lfb[8]; f32x2v av[8]; f32x2v run = {0.f, 0.f};
#pragma unroll
        for (int j = 0; j < 8; ++j) { const unsigned w = *(const LAS unsigned*)(lds + H2_RAWLF + (8 * s8 + j) * 272 + cp * 4);
            lfa[j] = bflo(w); lfb[j] = bfhi(w); run = run + (f32x2v){lfa[j], lfb[j]}; av[j] = run; }
        *(LAS f32x2v*)(lds + H2_SEG + (s8 * 128 + 2 * cp) * 4) = run;
        __syncthreads();
        {
            f32x2v sg_[8];
#pragma unroll
            for (int q = 0; q < 8; ++q) sg_[q] = *(const LAS f32x2v*)(lds + H2_SEG + (q * 128 + 2 * cp) * 4);
            const f32x2v amid2 = (sg_[0] + sg_[1]) + (sg_[2] + sg_[3]);
            const f32x2v atot2 = amid2 + ((sg_[4] + sg_[5]) + (sg_[6] + sg_[7]));
            f32x2v off2 = -amid2;
#pragma unroll
            for (int q = 0; q < 7; ++q) { const float mq = (q < s8) ? 1.0f : 0.0f; off2 = off2 + sg_[q] * mq; }
            unsigned kta[4], ktb[4];
#pragma unroll
            for (int j = 0; j < 8; ++j) {
                const f32x2v aa = off2 + av[j];
                const unsigned qw = *(const LAS unsigned*)(lds + H2_RAWQ + (8 * s8 + j) * 272 + cp * 4);
                const float qta = bflo(qw) * ex2(aa.x), qtb = bfhi(qw) * ex2(aa.y);
                const unsigned kba = f2bf((1.0f - ex2(lfa[j])) * ex2(-aa.x)), kbb = f2bf((1.0f - ex2(lfb[j])) * ex2(-aa.y));
                *(LAS unsigned*)(lds + H2_QN + (8 * s8 + j) * 272 + cp * 4) = pk2(qta, qtb);
                *(LAS unsigned*)(lds + H2_KN + (8 * s8 + j) * 272 + cp * 4) = kba | (kbb << 16);
                if (j & 1) { kta[j >> 1] |= kba << 16; ktb[j >> 1] |= kbb << 16; } else { kta[j >> 1] = kba; ktb[j >> 1] = kbb; }
            }
            *(LAS v4u*)(lds + H2_KT + (2 * cp) * 144 + s8 * 16) = (v4u){kta[0], kta[1], kta[2], kta[3]};
            *(LAS v4u*)(lds + H2_KT + (2 * cp + 1) * 144 + s8 * 16) = (v4u){ktb[0], ktb[1], ktb[2], ktb[3]};
            if (s8 == 0) { *(LAS f32x2v*)(lds + H2_SA + (2 * cp) * 4) = (f32x2v){ex2(amid2.x), ex2(amid2.y)};
                           *(LAS f32x2v*)(lds + H2_SB + (2 * cp) * 4) = (f32x2v){ex2(atot2.x - amid2.x), ex2(atot2.y - amid2.y)}; }
        }
        __syncthreads();
        {
            const f32x4 sa = *(const LAS f32x4*)(lds + H2_SA + (16 * wave + 4 * fq) * 4);
#pragma unroll
            for (int t = 0; t < 8; ++t) { S[t] = S[t] * sa; v2u w; w.x = pk2(S[t][0], S[t][1]); w.y = pk2(S[t][2], S[t][3]);
                *(LAS v2u*)(lds + H2_ST + (16 * t + fr) * 272 + (16 * wave + 4 * fq) * 2) = w; }
        }
        {
            const int ib = wave & 3, jp = wave >> 2;
#pragma unroll
            for (int t = 0; t < 2; ++t) {
                const int jb = 2 * jp + t;
                f32x4 sc = {0.f, 0.f, 0.f, 0.f};
                if (jb <= ib) {
#pragma unroll
                    for (int ks = 0; ks < 4; ++ks) {
                        const bf16x8 x = *(const LAS bf16x8*)(lds + H2_KN + (16 * jb + fr) * 272 + ks * 64 + fq * 16);
                        const bf16x8 y = *(const LAS bf16x8*)(lds + H2_QN + (16 * ib + fr) * 272 + ks * 64 + fq * 16);
                        sc = __builtin_amdgcn_mfma_f32_16x16x32_bf16(x, y, sc, 0, 0, 0);
                    }
                    if (jb == ib) {
#pragma unroll
                        for (int r = 0; r < 4; ++r) if (4 * fq + r > fr) sc[r] = 0.f;
                    }
                }
                v2u w; w.x = pk2(sc[0], sc[1]); w.y = pk2(sc[2], sc[3]);
                *(LAS v2u*)(lds + H2_SCL + (16 * ib + fr) * 144 + (16 * jb + 4 * fq) * 2) = w;
            }
        }
        __syncthreads();
        {
            const int ib2 = wave >> 1, dh = wave & 1;
            bf16x8 ys[2], yq[4];
#pragma unroll
            for (int ks = 0; ks < 2; ++ks) ys[ks] = *(const LAS bf16x8*)(lds + H2_SCL + (16 * ib2 + fr) * 144 + ks * 64 + fq * 16);
#pragma unroll
            for (int ks = 0; ks < 4; ++ks) yq[ks] = *(const LAS bf16x8*)(lds + H2_QN + (16 * ib2 + fr) * 272 + ks * 64 + fq * 16);
            const size_t orow = (size_t)H2_TOKROW(p0 + 64 * n + 16 * ib2 + fr) * 512;
#pragma unroll
            for (int t = 0; t < 4; ++t) {
                const int db = 4 * dh + t;
                f32x4 O = {0.f, 0.f, 0.f, 0.f};
#pragma unroll
                for (int ks = 0; ks < 2; ++ks) { const bf16x8 x = *(const LAS bf16x8*)(lds + H2_VT + (16 * db + fr) * 144 + ks * 64 + fq * 16); O = __builtin_amdgcn_mfma_f32_16x16x32_bf16(x, ys[ks], O, 0, 0, 0); }
#pragma unroll
                for (int ks = 0; ks < 4; ++ks) { const bf16x8 x = *(const LAS bf16x8*)(lds + H2_ST + (16 * db + fr) * 272 + ks * 64 + fq * 16); O = __builtin_amdgcn_mfma_f32_16x16x32_bf16(x, yq[ks], O, 0, 0, 0); }
                *(GAS f32x4*)(go + orow + 16 * db + 4 * fq) = O;
            }
        }
        {
            const f32x4 sb = *(const LAS f32x4*)(lds + H2_SB + (16 * wave + 4 * fq) * 4);
            bf16x8 x[2];
#pragma unroll
            for (int ks = 0; ks < 2; ++ks) x[ks] = *(const LAS bf16x8*)(lds + H2_KT + (16 * wave + fr) * 144 + ks * 64 + fq * 16);
#pragma unroll
            for (int t = 0; t < 8; ++t) {
#pragma unroll
                for (int ks = 0; ks < 2; ++ks) { const bf16x8 y = *(const LAS bf16x8*)(lds + H2_VT + (16 * t + fr) * 144 + ks * 64 + fq * 16);
                    S[t] = __builtin_amdgcn_mfma_f32_16x16x32_bf16(x[ks], y, S[t], 0, 0, 0); }
                S[t] = S[t] * sb; }
        }
        __syncthreads();
    }
#undef H2_LOAD2
}

#ifdef DBG_NAIVE_HGRN
__device__ __forceinline__ void naive_hgrn_item(LAS unsigned char* lds, const bf16* P, float* ob, int row0, int L, int h, int dir, int tid) {
    LAS float* LQ = (LAS float*)lds; LAS float* LF = LQ + 2048; LAS float* LK = LF + 2048;
    const unsigned short* Pu = (const unsigned short*)P;
    float S[128];
#pragma unroll
    for (int k = 0; k < 128; ++k) S[k] = 0.f;
    for (int t0 = 0; t0 < L; t0 += 16) {
        __syncthreads();
#pragma unroll
        for (int i = 0; i < 4; ++i) { const int idx = tid + 512 * i, st = idx >> 7, k = idx & 127; const size_t row = (size_t)(row0 + (dir ? (L - 1 - (t0 + st)) : (t0 + st)));
            const float qv = bf1(Pu[row * DIN + COL_Q + h * 128 + k]), l2 = bf1(Pu[row * DIN + (dir ? COL_FB : COL_FF) + h * 128 + k]), f = exp2f(l2);
            LQ[st * 128 + k] = qv; LF[st * 128 + k] = f; LK[st * 128 + k] = 1.0f - f; }
        __syncthreads();
        if (tid < 128) {
#pragma unroll 1
            for (int st = 0; st < 16; ++st) { const size_t row = (size_t)(row0 + (dir ? (L - 1 - (t0 + st)) : (t0 + st)));
                const float v = bf1(Pu[row * DIN + COL_I + h * 128 + tid]); float o = 0.f;
#pragma unroll
                for (int k4 = 0; k4 < 32; ++k4) { const f32x4 f4 = *(const LAS f32x4*)(LF + st * 128 + 4 * k4), k4v = *(const LAS f32x4*)(LK + st * 128 + 4 * k4), q4 = *(const LAS f32x4*)(LQ + st * 128 + 4 * k4);
#pragma unroll
                    for (int e = 0; e < 4; ++e) { S[4 * k4 + e] = f4[e] * S[4 * k4 + e] + k4v[e] * v; o += q4[e] * S[4 * k4 + e]; } }
                ob[row * 512 + h * 128 + tid] = o; }
        }
    }
    __syncthreads();
}
#endif
__device__ __forceinline__ void hgrn_combine(const float* ob0, const float* ob1, const bf16* P, const float* onorm, const float* ssg, const float* gon, bf16* Y, int gw, int NGW, int lane) {
    const int c = 8 * lane;
    const f32x4 g0 = *(const GAS f32x4*)(onorm + c), g1 = *(const GAS f32x4*)(onorm + c + 4);
    const f32x4 n0 = *(const GAS f32x4*)(gon + c), n1 = *(const GAS f32x4*)(gon + c + 4);
    for (int m = gw; m < TOK; m += NGW) {
        const f32x4 a0 = *(const GAS f32x4*)(ob0 + (size_t)m * 512 + c), a1 = *(const GAS f32x4*)(ob0 + (size_t)m * 512 + c + 4);
        const f32x4 b0 = *(const GAS f32x4*)(ob1 + (size_t)m * 512 + c), b1 = *(const GAS f32x4*)(ob1 + (size_t)m * 512 + c + 4);
        const v4u sgw = *(const GAS v4u*)(P + (size_t)m * DIN + COL_G + c);
#ifdef DBG_PCOPY
        f32x4 o0 = {0.f,0.f,0.f,0.f}, o1 = o0;
        { const int segs[4] = {COL_Q, COL_I, COL_FF, COL_FB};
#pragma unroll
          for (int q_ = 0; q_ < 4; ++q_) { const v4u pw = *(const GAS v4u*)(P + (size_t)m * DIN + segs[q_] + c);
            o0 += (f32x4){bflo(pw.x), bfhi(pw.x), bflo(pw.y), bfhi(pw.y)}; o1 += (f32x4){bflo(pw.z), bfhi(pw.z), bflo(pw.w), bfhi(pw.w)}; } }
#else
        const f32x4 o0 = a0 + b0, o1 = a1 + b1;
#endif
        float s = ((o0[0] * o0[0] + o0[1] * o0[1]) + (o0[2] * o0[2] + o0[3] * o0[3])) + ((o1[0] * o1[0] + o1[1] * o1[1]) + (o1[2] * o1[2] + o1[3] * o1[3]));
        s += __shfl_xor(s, 1); s += __shfl_xor(s, 2); s += __shfl_xor(s, 4); s += __shfl_xor(s, 8);
        const float r = rsq(s * (1.0f / 128.0f) + EPS);
        const f32x4 y0 = o0 * r * g0 * (f32x4){bflo(sgw.x), bfhi(sgw.x), bflo(sgw.y), bfhi(sgw.y)};
        const f32x4 y1 = o1 * r * g1 * (f32x4){bflo(sgw.z), bfhi(sgw.z), bflo(sgw.w), bfhi(sgw.w)};
        v4u w; w.x = pk2(y0[0], y0[1]); w.y = pk2(y0[2], y0[3]); w.z = pk2(y1[0], y1[1]); w.w = pk2(y1[2], y1[3]);
        *(GAS v4u*)(Y + (size_t)m * DMODEL + 512 + c) = w;
#ifndef NO_GMLP
        const f32x4 sv = *(const GAS f32x4*)(ssg + (size_t)m * 4);
        const float rg = rsq(((sv[0] + sv[1]) + (sv[2] + sv[3])) * (1.0f / 512.0f) + EPS);
        const v4u yw = *(const GAS v4u*)(Y + (size_t)m * DMODEL + c);
        const f32x4 z0 = (f32x4){bflo(yw.x), bfhi(yw.x), bflo(yw.y), bfhi(yw.y)} * rg * n0, z1 = (f32x4){bflo(yw.z), bfhi(yw.z), bflo(yw.w), bfhi(yw.w)} * rg * n1;
        v4u zw; zw.x = pk2(z0[0], z0[1]); zw.y = pk2(z0[2], z0[3]); zw.z = pk2(z1[0], z1[1]); zw.w = pk2(z1[2], z1[3]);
        *(GAS v4u*)(Y + (size_t)m * DMODEL + c) = zw;
#endif
    }
}

constexpr int GM_RAWV = 0, GM_VLT = 34816, GM_WL = 69632, GM_MEAN = 104448, GM_RSTD = 104960, GM_END = 105472;
static_assert(GM_END <= RING_BYTES, "gmlp LDS");
__device__ __forceinline__ void gmlp_item(LAS unsigned char* lds, const bf16* P, bf16* Y, float* ssg, const float* ln_g, const float* ln_b, const float* w_s, const float* b_s, int c, int h, int tid, int lane, int wave) {
    const int fr = lane & 15, fq = lane >> 4, R0 = 128 * c;
#pragma unroll 1
    for (int jj = 0; jj < 4; ++jj) {
        float sm[4], sq[4];
#pragma unroll
        for (int j = 0; j < 4; ++j) {
            const int s = 16 * wave + 4 * jj + j;
            const v4u raw = *(const GAS v4u*)(P + (size_t)(R0 + s) * DIN + COL_V + 8 * lane);
            const float x0 = bflo(raw.x), x1 = bfhi(raw.x), x2 = bflo(raw.y), x3 = bfhi(raw.y), x4 = bflo(raw.z), x5 = bfhi(raw.z), x6 = bflo(raw.w), x7 = bfhi(raw.w);
            sm[j] = ((x0 + x1) + (x2 + x3)) + ((x4 + x5) + (x6 + x7));
            sq[j] = ((x0 * x0 + x1 * x1) + (x2 * x2 + x3 * x3)) + ((x4 * x4 + x5 * x5) + (x6 * x6 + x7 * x7));
        }
#pragma unroll
        for (int o = 1; o < 64; o <<= 1) {
#pragma unroll
            for (int j = 0; j < 4; ++j) { sm[j] += __shfl_xor(sm[j], o); sq[j] += __shfl_xor(sq[j], o); }
        }
        if (lane == 0) {
#pragma unroll
            for (int j = 0; j < 4; ++j) { const int s = 16 * wave + 4 * jj + j; const float mean = sm[j] * (1.0f / 512.0f), var = fmaxf(sq[j] * (1.0f / 512.0f) - mean * mean, 0.f);
                *(LAS float*)(lds + GM_MEAN + s * 4) = mean; *(LAS float*)(lds + GM_RSTD + s * 4) = rsq(var + EPS); }
        }
    }
#pragma unroll
    for (int i = 0; i < 4; ++i) { const int idx = tid + 512 * i, row = idx >> 4, c16 = idx & 15;
        *(LAS v4u*)(lds + GM_RAWV + row * 272 + c16 * 16) = *(const GAS v4u*)(P + (size_t)(R0 + row) * DIN + COL_V + 128 * h + 8 * c16); }
#pragma unroll
    for (int i = 0; i < 8; ++i) { const int idx = tid + 512 * i, tt = idx >> 5, s4 = idx & 31;
        const f32x4 w = *(const GAS f32x4*)(w_s + (size_t)h * 16384 + tt * 128 + 4 * s4);
        v2u o; o.x = pk2(w[0], w[1]); o.y = pk2(w[2], w[3]);
        *(LAS v2u*)(lds + GM_WL + tt * 272 + s4 * 8) = o; }
    __syncthreads();
    {
        const int ch = tid & 127, sq4 = tid >> 7;
        const float g = ln_g[128 * h + ch], b = ln_b[128 * h + ch];
#pragma unroll
        for (int i = 0; i < 4; ++i) {
            unsigned wv[4];
#pragma unroll
            for (int e = 0; e < 8; ++e) { const int s = 32 * sq4 + 8 * i + e;
                const float x = bf1(*(const LAS unsigned short*)(lds + GM_RAWV + s * 272 + ch * 2));
                const float y = (x - *(const LAS float*)(lds + GM_MEAN + s * 4)) * *(const LAS float*)(lds + GM_RSTD + s * 4) * g + b;
                const unsigned yb = f2bf(y);
                if (e & 1) wv[e >> 1] |= yb << 16; else wv[e >> 1] = yb; }
            *(LAS v4u*)(lds + GM_VLT + ch * 272 + (32 * sq4 + 8 * i) * 2) = (v4u){wv[0], wv[1], wv[2], wv[3]};
        }
    }
    __syncthreads();
    const int t = 16 * wave + fr;
    bf16x8 yf[4];
#pragma unroll
    for (int ks = 0; ks < 4; ++ks) yf[ks] = *(const LAS bf16x8*)(lds + GM_WL + (16 * wave + fr) * 272 + ks * 64 + fq * 16);
    const float bs = b_s[h * 128 + t];
    float ss = 0.f;
#pragma unroll
    for (int cb = 0; cb < 8; ++cb) {
        f32x4 a = {0.f, 0.f, 0.f, 0.f};
#pragma unroll
        for (int ks = 0; ks < 4; ++ks) {
            const bf16x8 x = *(const LAS bf16x8*)(lds + GM_VLT + (16 * cb + fr) * 272 + ks * 64 + fq * 16);
            a = __builtin_amdgcn_mfma_f32_16x16x32_bf16(x, yf[ks], a, 0, 0, 0);
        }
        const int ch = 128 * h + 16 * cb + 4 * fq;
        const v2u uw = *(const GAS v2u*)(P + (size_t)(R0 + t) * DIN + COL_U + ch);
        const f32x4 uu = {bflo(uw.x), bfhi(uw.x), bflo(uw.y), bfhi(uw.y)};
        a = (a + bs) * uu;
        ss += (a[0] * a[0] + a[1] * a[1]) + (a[2] * a[2] + a[3] * a[3]);
        v2u w; w.x = pk2(a[0], a[1]); w.y = pk2(a[2], a[3]);
        *(GAS v2u*)(Y + (size_t)(R0 + t) * DMODEL + ch) = w;
    }
    ss += __shfl_xor(ss, 16); ss += __shfl_xor(ss, 32);
    if (fq == 0) ssg[(size_t)(R0 + t) * 4 + h] = ss;
    __syncthreads();
}

struct Args { const float* in[22]; float* out; unsigned char* ws; int ph_lo, ph_hi, li, pad; };
constexpr int N_PHASES = 11;
#ifndef MK_N_LAUNCHES
#define MK_N_LAUNCHES 1
#endif
#ifndef DUP_PHASE
#define DUP_PHASE (-1)
#endif
__global__ void __launch_bounds__(NWAVES * 64, 2) fwd_kernel(Args args) {
    extern __shared__ __attribute__((aligned(16))) unsigned char lds_raw[];
    LAS unsigned char* lds = (LAS unsigned char*)lds_raw;
    volatile LAS unsigned* MISC = (volatile LAS unsigned*)(lds + MISC_OFF);
    const int tid = threadIdx.x, lane = tid & 63, wave = __builtin_amdgcn_readfirstlane(tid >> 6);
    const int G = gridDim.x, bx = blockIdx.x;
    const int vcu = (G % 8 == 0) ? (bx % 8) * (G / 8) + bx / 8 : bx;
    const int gw = vcu * NWAVES + wave, NGW = G * NWAVES;
    unsigned char* ws = args.ws;
    gu32* ctl = (gu32*)(ws + WS_CTL);
    for (int u = tid; u < (LDS_BYTES - LDSCTL_OFF) / 4; u += NWAVES * 64) ((LAS unsigned*)(lds + LDSCTL_OFF))[u] = 0u;
    __syncthreads();
    XcdBarrier bar = xcd_barrier_post((unsigned*)(ctl + CW_BAR) + args.li * XCD_BAR_WORDS, MISC + 8);
    const int lo = args.ph_lo, hi = args.ph_hi;
#define IN(k) (lo <= (k) && (k) < hi)
#define SEAM(k) do { if (IN(k) && IN((k) + 1)) xcd_barrier(bar); } while (0)
    bf16* XB = (bf16*)(ws + WS_BUFA); bf16* Y = (bf16*)(ws + WS_BUFB); bf16* BIG = (bf16*)(ws + WS_BIG);
    float* OB0 = args.out; float* OB1 = args.out + (size_t)TOK * 512;
    float* SSG = (float*)(ws + WS_SSG); float* HGE = (float*)(ws + WS_HGE); float* HGD = (float*)(ws + WS_HGD);
    float* P16_0 = (float*)(ws + WS_P16); float* P16_1 = (float*)(ws + WS_P16 + 2 * MiB); float* P16_2 = (float*)(ws + WS_P16 + 4 * MiB);

    for (int rep_ = 0; rep_ < ((DUP_PHASE == 0) ? 2 : 1); ++rep_) if (IN(0)) { p0_prologue(lds, args.in, ws, gw, NGW, wave, lane); }
    SEAM(0);
#define PHASE1 if (IN(1)) { pg8::Gemm g{XB, (const bf16*)(ws + WS_WGU1), TOK, 2 * DFF, DMODEL}; pg8::StaticOrder S; S.init(TOK, 2 * DFF, G, bx); \
        pg8::EpiSwiGLU E{BIG, DFF, P16_0}; pg8::gemm_phase<pg8::EpiSwiGLU, pg8::StaticOrder, PG8_ALIGN, PG8_SP2>(lds + RING_OFF, g, S, E); }
    PHASE1
#if DUP_PHASE == 1
    PHASE1
#endif
    SEAM(1);
#define PHASE2 if (IN(2)) { pg8::Gemm g{BIG, (const bf16*)(ws + WS_WD1), TOK, DMODEL, DFF}; pg8::StaticOrder S; S.init(TOK, DMODEL, G, bx); \
        pg8::EpiResidBf<true> E{XB, P16_1, 0.5f}; pg8::gemm_phase<pg8::EpiResidBf<true>, pg8::StaticOrder, PG8_ALIGN, PG8_SP2>(lds + RING_OFF, g, S, E); }
    PHASE2
#if DUP_PHASE == 2
    PHASE2
#endif
#if DUP_PHASE == 20
    if (IN(2)) { pg8::Gemm g{BIG, (const bf16*)(ws + WS_WD1), TOK, DMODEL, DFF}; pg8::StaticOrder S; S.init(TOK, DMODEL, G, bx);
        pg8::EpiNull E{SSG}; pg8::gemm_phase<pg8::EpiNull, pg8::StaticOrder, PG8_ALIGN, PG8_SP2>(lds + RING_OFF, g, S, E); }
#endif
#if DUP_PHASE == 10
    if (IN(2)) { pg8::Gemm g{XB, (const bf16*)(ws + WS_WGU1), TOK, 2 * DFF, DMODEL}; pg8::StaticOrder S; S.init(TOK, 2 * DFF, G, bx);
        pg8::EpiNull E{SSG}; pg8::gemm_phase<pg8::EpiNull, pg8::StaticOrder, PG8_ALIGN, PG8_SP2>(lds + RING_OFF, g, S, E); }
#endif
    SEAM(2);
#define PHASE3 if (IN(3)) { pg8::Gemm g{XB, (const bf16*)(ws + WS_WIN), TOK, DIN, DMODEL}; pg8::StaticOrder S; S.init(TOK, DIN, G, bx); \
        pg8::EpiMix E{BIG, DIN, P16_1, args.in[13], args.in[14]}; pg8::gemm_phase<pg8::EpiMix, pg8::StaticOrder, PG8_ALIGN, PG8_SP2>(lds + RING_OFF, g, S, E); }
    PHASE3
#if DUP_PHASE == 3
    PHASE3
#endif
    SEAM(3);
    for (int rep_ = 0; rep_ < ((DUP_PHASE == 4 || DUP_PHASE == 40 || DUP_PHASE == 41) ? 2 : 1); ++rep_) if (IN(4)) {
        if (rep_ == 0 || DUP_PHASE != 41) for (int i = bx; i < 512; i += G) hg2_state_pass(lds, BIG, HGE, HGD, i, tid, lane, wave);
        if (rep_ == 0 || DUP_PHASE != 40) for (int it = bx; it < 1024; it += G) gmlp_item(lds, BIG, Y, SSG, args.in[8], args.in[9], args.in[10], args.in[11], it >> 2, it & 3, tid, lane, wave);
    }
    SEAM(4);
    for (int rep_ = 0; rep_ < ((DUP_PHASE == 5) ? 2 : 1); ++rep_) if (IN(5)) {
        for (int i = bx; i < 512; i += G) { const Hg2Inst I = hg2_decode(i); hg2_out_pass(lds, BIG, I.dir ? OB1 : OB0, HGE, HGD, i, tid, lane, wave); }
    }
    SEAM(5);
    if (IN(6)) { hgrn_combine(OB0, OB1, BIG, args.in[15], SSG, args.in[12], Y, gw, NGW, lane); }
    SEAM(6);
    if (IN(7)) { pg8::Gemm g{Y, (const bf16*)(ws + WS_WOUT), TOK, DMODEL, DMODEL}; pg8::StaticOrder S; S.init(TOK, DMODEL, G, bx);
        pg8::EpiResidBf<true> E{XB, P16_2, 1.0f};
        pg8::gemm_phase<pg8::EpiResidBf<true>, pg8::StaticOrder, PG8_ALIGN, PG8_SP2>(lds + RING_OFF, g, S, E); }
    SEAM(7);
    if (IN(8)) { pg8::Gemm g{XB, (const bf16*)(ws + WS_WGU2), TOK, 2 * DFF, DMODEL}; pg8::StaticOrder S; S.init(TOK, 2 * DFF, G, bx);
        pg8::EpiSwiGLU E{BIG, DFF, P16_2};
        pg8::gemm_phase<pg8::EpiSwiGLU, pg8::StaticOrder, PG8_ALIGN, PG8_SP2>(lds + RING_OFF, g, S, E); }
    SEAM(8);
    if (IN(9)) { pg8::Gemm g{BIG, (const bf16*)(ws + WS_WD2), TOK, DMODEL, DFF}; pg8::StaticOrder S; S.init(TOK, DMODEL, G, bx);
        pg8::EpiResidBf<false> E{XB, nullptr, 0.5f};
        pg8::gemm_phase<pg8::EpiResidBf<false>, pg8::StaticOrder, PG8_ALIGN, PG8_SP2>(lds + RING_OFF, g, S, E); }
    SEAM(9);
    if (IN(10)) { final_norm(XB, args.out, args.in[21], gw, NGW, lane); }
#undef IN
#undef SEAM
}

extern "C" void kernel_launch(void* const* d_in, const int* in_sizes, int n_in, void* d_out, int out_size, void* d_ws, size_t ws_size, hipStream_t stream) {
    static int grid = 0;
    if (grid == 0) {
        if (n_in != 22 || out_size != TOK * DMODEL || ws_size < WS_END) { fprintf(stderr, "kernel_launch: unexpected problem (n_in %d, out %d, ws %zu); nothing launched\n", n_in, out_size, ws_size); grid = -1; return; }
        int dev = 0, cus = 0, per_cu = 0;
        if (hipGetDevice(&dev) != hipSuccess || hipDeviceGetAttribute(&cus, hipDeviceAttributeMultiprocessorCount, dev) != hipSuccess) { grid = -1; return; }
        if (hipFuncSetAttribute((const void*)fwd_kernel, hipFuncAttributeMaxDynamicSharedMemorySize, LDS_BYTES) != hipSuccess) { fprintf(stderr, "kernel_launch: hipFuncSetAttribute failed\n"); grid = -1; return; }
        if (hipOccupancyMaxActiveBlocksPerMultiprocessor(&per_cu, (const void*)fwd_kernel, NWAVES * 64, LDS_BYTES) != hipSuccess || per_cu < 1) { fprintf(stderr, "kernel_launch: occupancy query says %d blocks per CU; nothing launched\n", per_cu); (void)hipGetLastError(); grid = -1; return; }
        grid = cus;
    }
    if (grid < 0) return;
    if (hipMemsetAsync((char*)d_ws + WS_CTL, 0, CTL_ZERO_BYTES, stream) != hipSuccess) return;
    Args a{};
    for (int i = 0; i < 22; ++i) a.in[i] = (const float*)d_in[i];
    a.out = (float*)d_out; a.ws = (unsigned char*)d_ws;
    constexpr int NL = MK_N_LAUNCHES;
    for (int li = 0; li < NL; ++li) {
        a.ph_lo = (NL == 1) ? 0 : li; a.ph_hi = (NL == 1) ? N_PHASES : li + 1; a.li = 0;
        hipLaunchKernelGGL(fwd_kernel, dim3(grid), dim3(NWAVES * 64), LDS_BYTES, stream, a);
        if (hipPeekAtLastError() != hipSuccess) { fprintf(stderr, "kernel_launch: launch %d failed\n", li); break; }
    }
}
```

```cpp
#include <hip/hip_runtime.h>
#include <cstdio>
#include <cstdint>
namespace pg8 {
#define PG8_LAS __attribute__((address_space(3)))
typedef unsigned short bf16_t;
typedef short bf16x8 __attribute__((ext_vector_type(8)));
typedef float f32x4 __attribute__((ext_vector_type(4)));
typedef unsigned u32x4 __attribute__((ext_vector_type(4)));
constexpr int BM = 256, BK = 64, HALF = 128, HTB = HALF * BK * 2  , STAGE_BYTES = 8 * HTB, NXCD = 8, WGM = 8;

__host__ __device__ __forceinline__ int lds_byte(int r, int c) { const int st = (r >> 4) * 2 + (c >> 5), rr = r & 15, cc = c & 31, ob = rr * 64 + cc * 2; return st * 1024 + (ob ^ (((ob >> 9) & 1) << 5)); }
__host__ __device__ __forceinline__ void stage_rc(int b, int& R, int& C) { const int st = b / 1024, sb = b % 1024, swz = sb ^ (((sb >> 9) & 1) << 5); R = (st >> 1) * 16 + swz / 64; C = (st & 1) * 32 + (swz % 64) / 2; }
__host__ __device__ __forceinline__ int perm32(int rho) { const int n = rho >> 4, i = rho & 15; return 8 * (i >> 2) + 4 * n + (i & 3); }

struct Unit { int pm, pn; };
struct Gemm { const bf16_t* A; const bf16_t* Bt; int M, N, K; };

struct StaticOrder {
    int nM, nN, nwg, G, c;
    __host__ __device__ void init(int M, int N, int G_, int c_) { nM = M / BM; nN = N / BM; nwg = nM * nN; G = G_; c = c_; }
    __host__ __device__ bool next(int i, Unit& u) const {
        const long L = (long)i * G + c; if (L >= nwg) return false;
        int wgid = (int)L; { const int q = nwg / NXCD, r = nwg % NXCD, xcd = wgid % NXCD, off = wgid / NXCD; wgid = (xcd < r ? xcd * (q + 1) : r * (q + 1) + (xcd - r) * q) + off; }
        const int nig = WGM * nN, gid = wgid / nig, fm = gid * WGM, gsz = (nM - fm) < WGM ? (nM - fm) : WGM;
        u.pm = fm + ((wgid % nig) % gsz); u.pn = (wgid % nig) / gsz; return true;
    }
    __device__ __forceinline__ void a_ready(const Unit&) const {}
    __device__ __forceinline__ void done(const Unit&) const {}
};

typedef __bf16 bf16x2_hw __attribute__((ext_vector_type(2)));
typedef float f32x2_hw __attribute__((ext_vector_type(2)));
__device__ __forceinline__ unsigned cvt_pk_bf16(float lo, float hi) { const f32x2_hw v = {lo, hi}; const bf16x2_hw b = __builtin_convertvector(v, bf16x2_hw); return __builtin_bit_cast(unsigned, b); }
typedef float f32x2 __attribute__((ext_vector_type(2)));
__device__ __forceinline__ f32x2 gelu_pk(f32x2 v) {
    const f32x2 av = __builtin_elementwise_abs(v), d = av * 0.2316418882f + 1.0f;
    f32x2 t; t.x = __builtin_amdgcn_rcpf(d.x); t.y = __builtin_amdgcn_rcpf(d.y);
    f32x2 q = t * 0.5307027145f + (-0.7265760135f); q = q * t + 0.7107068705f; q = q * t + (-0.142248368f); q = q * t + 0.127414796f; q = q * t;
    const f32x2 s = (v * v) * (-0.72134752044f);
    f32x2 e; e.x = __builtin_amdgcn_exp2f(s.x); e.y = __builtin_amdgcn_exp2f(s.y);
    const f32x2 m = v * (q * e), r = v - m;
    f32x2 o; o.x = v.x < 0.f ? m.x : r.x; o.y = v.y < 0.f ? m.y : r.y; return o;
}

constexpr float RMS_EPS = 1e-6f;
constexpr int DM = 1024;
__device__ __forceinline__ float row_rstd(const float* p16, int row, int fq) {
    const f32x4 v = *(const f32x4*)(p16 + (size_t)row * 16 + 4 * fq);
    float s = (v[0] + v[1]) + (v[2] + v[3]);
    s += __shfl_xor(s, 16); s += __shfl_xor(s, 32);
    return __builtin_amdgcn_rsqf(s * (1.0f / DM) + RMS_EPS);
}
__device__ __forceinline__ void row_rstd8(const float* p16, int row0, int fq, float (&rr)[8]) {
    f32x4 pv[8];
#pragma unroll
    for (int i = 0; i < 8; ++i) pv[i] = *(const f32x4*)(p16 + (size_t)(row0 + (i >> 2) * HALF + (i & 3) * 16) * 16 + 4 * fq);
#pragma unroll
    for (int i = 0; i < 8; ++i) { float s = (pv[i][0] + pv[i][1]) + (pv[i][2] + pv[i][3]); s += __shfl_xor(s, 16); s += __shfl_xor(s, 32); rr[i] = __builtin_amdgcn_rsqf(s * (1.0f / DM) + RMS_EPS); }
}
__device__ __forceinline__ float fast_sigmoid(float z) { return __builtin_amdgcn_rcpf(1.0f + __builtin_amdgcn_exp2f(-1.44269504089f * z)); }

struct EpiSwiGLU {
    static constexpr bool PERM = true, AFTER_DRAIN = false;
    bf16_t* O; int ldo; const float* p16;
    __device__ __forceinline__ void operator()(const f32x4 (&acc)[2][2][4][2], const Unit& u, int wr, int wc, int fr, int fq) const {
        const int row0 = u.pm * BM + wr * 64 + fr, col0 = u.pn * HALF + wc * 32 + 8 * fq;
        float rr[8];
        row_rstd8(p16, row0, fq, rr);
#pragma unroll
        for (int ai = 0; ai < 2; ++ai)
#pragma unroll
            for (int m = 0; m < 4; ++m) {
                const int row = row0 + ai * HALF + m * 16;
                const float r = rr[ai * 4 + m];
                float h[8];
#pragma unroll
                for (int n = 0; n < 2; ++n)
#pragma unroll
                    for (int e = 0; e < 4; ++e) { const float g = acc[ai][0][m][n][e] * r, up = acc[ai][1][m][n][e] * r; h[4 * n + e] = g * up * fast_sigmoid(g); }
                u32x4 w; w.x = cvt_pk_bf16(h[0], h[1]); w.y = cvt_pk_bf16(h[2], h[3]); w.z = cvt_pk_bf16(h[4], h[5]); w.w = cvt_pk_bf16(h[6], h[7]);
                *(u32x4*)(O + (size_t)row * ldo + col0) = w;
            }
    }
};

template <bool WANT_BF16, bool WANT_SS> struct EpiResid {
    static constexpr bool PERM = true, AFTER_DRAIN = false;
    const float* base0; const float* base1;
    float* out; bf16_t* xb; float* p16; float alpha;
    __device__ __forceinline__ void operator()(const f32x4 (&acc)[2][2][4][2], const Unit& u, int wr, int wc, int fr, int fq) const {
        const int row0 = u.pm * BM + wr * 64 + fr, col0 = u.pn * BM + wc * 32 + 8 * fq;
        const float* bp = (u.pm < 64) ? base0 : base1; const int brow = (u.pm < 64) ? 0 : 16384;
        f32x4 bcur[4], bnxt[4];
#define RESID_LOAD(dst, it) do { const size_t bo_ = (size_t)(row0 + ((it) >> 2) * HALF + ((it) & 3) * 16 - brow) * DM + col0; \
            dst[0] = *(const f32x4*)(bp + bo_); dst[1] = *(const f32x4*)(bp + bo_ + 4); dst[2] = *(const f32x4*)(bp + bo_ + HALF); dst[3] = *(const f32x4*)(bp + bo_ + HALF + 4); } while (0)
        RESID_LOAD(bcur, 0);
#pragma unroll
        for (int it = 0; it < 8; ++it) {
            const int ai = it >> 2, m = it & 3;
            if (it + 1 < 8) RESID_LOAD(bnxt, it + 1);
            const int row = row0 + ai * HALF + m * 16; const size_t off = (size_t)row * DM + col0;
            float ss = 0.f;
#pragma unroll
            for (int bj = 0; bj < 2; ++bj) {
                const f32x4 v0 = bcur[2 * bj] + acc[ai][bj][m][0] * alpha, v1 = bcur[2 * bj + 1] + acc[ai][bj][m][1] * alpha;
                *(f32x4*)(out + off + bj * HALF) = v0; *(f32x4*)(out + off + bj * HALF + 4) = v1;
                if (WANT_BF16) { u32x4 w; w.x = cvt_pk_bf16(v0[0], v0[1]); w.y = cvt_pk_bf16(v0[2], v0[3]); w.z = cvt_pk_bf16(v1[0], v1[1]); w.w = cvt_pk_bf16(v1[2], v1[3]);
                    *(u32x4*)(xb + off + bj * HALF) = w; }
                if (WANT_SS) ss += ((v0[0] * v0[0] + v0[1] * v0[1]) + (v0[2] * v0[2] + v0[3] * v0[3])) + ((v1[0] * v1[0] + v1[1] * v1[1]) + (v1[2] * v1[2] + v1[3] * v1[3]));
            }
            if (WANT_SS) { ss += __shfl_xor(ss, 16); ss += __shfl_xor(ss, 32); if (fq == 0) p16[(size_t)row * 16 + 4 * u.pn + wc] = ss; }
#pragma unroll
            for (int q = 0; q < 4; ++q) bcur[q] = bnxt[q];
            asm volatile("" ::: "memory");
        }
#undef RESID_LOAD
    }
};

template <bool WANT_SS> struct EpiResidBf {
    static constexpr bool PERM = true, AFTER_DRAIN = false;
    bf16_t* xb; float* p16; float alpha;
    __device__ __forceinline__ void operator()(const f32x4 (&acc)[2][2][4][2], const Unit& u, int wr, int wc, int fr, int fq) const {
        const int row0 = u.pm * BM + wr * 64 + fr, col0 = u.pn * BM + wc * 32 + 8 * fq;
        u32x4 bcur[2], bnxt[2];
#define RESB_LOAD(dst, it) do { const size_t bo_ = (size_t)(row0 + ((it) >> 2) * HALF + ((it) & 3) * 16) * DM + col0; dst[0] = *(const u32x4*)(xb + bo_); dst[1] = *(const u32x4*)(xb + bo_ + HALF); } while (0)
        RESB_LOAD(bcur, 0);
#pragma unroll
        for (int it = 0; it < 8; ++it) {
            const int ai = it >> 2, m = it & 3;
            if (it + 1 < 8) RESB_LOAD(bnxt, it + 1);
            const int row = row0 + ai * HALF + m * 16; const size_t off = (size_t)row * DM + col0;
            float ss = 0.f;
#pragma unroll
            for (int bj = 0; bj < 2; ++bj) {
                const u32x4 b = bcur[bj];
                const f32x4 b0 = {__builtin_bit_cast(float, b.x << 16), __builtin_bit_cast(float, b.x & 0xffff0000u), __builtin_bit_cast(float, b.y << 16), __builtin_bit_cast(float, b.y & 0xffff0000u)};
                const f32x4 b1 = {__builtin_bit_cast(float, b.z << 16), __builtin_bit_cast(float, b.z & 0xffff0000u), __builtin_bit_cast(float, b.w << 16), __builtin_bit_cast(float, b.w & 0xffff0000u)};
                const f32x4 v0 = b0 + acc[ai][bj][m][0] * alpha, v1 = b1 + acc[ai][bj][m][1] * alpha;
                u32x4 w; w.x = cvt_pk_bf16(v0[0], v0[1]); w.y = cvt_pk_bf16(v0[2], v0[3]); w.z = cvt_pk_bf16(v1[0], v1[1]); w.w = cvt_pk_bf16(v1[2], v1[3]);
                *(u32x4*)(xb + off + bj * HALF) = w;
                if (WANT_SS) ss += ((v0[0] * v0[0] + v0[1] * v0[1]) + (v0[2] * v0[2] + v0[3] * v0[3])) + ((v1[0] * v1[0] + v1[1] * v1[1]) + (v1[2] * v1[2] + v1[3] * v1[3]));
            }
            if (WANT_SS) { ss += __shfl_xor(ss, 16); ss += __shfl_xor(ss, 32); if (fq == 0) p16[(size_t)row * 16 + 4 * u.pn + wc] = ss; }
            bcur[0] = bnxt[0]; bcur[1] = bnxt[1];
            asm volatile("" ::: "memory");
        }
#undef RESB_LOAD
    }
};
struct EpiNull { static constexpr bool PERM = true, AFTER_DRAIN = false; float* sink;
    __device__ __forceinline__ void operator()(const f32x4 (&acc)[2][2][4][2], const Unit& u, int wr, int wc, int fr, int fq) const {
        float s = 0.f;
#pragma unroll
        for (int ai = 0; ai < 2; ++ai)
#pragma unroll
            for (int bj = 0; bj < 2; ++bj)
#pragma unroll
                for (int m = 0; m < 4; ++m)
#pragma unroll
                    for (int n = 0; n < 2; ++n) s += acc[ai][bj][m][n][0] + acc[ai][bj][m][n][1] + acc[ai][bj][m][n][2] + acc[ai][bj][m][n][3];
        if (s == 12345.678f) sink[0] = s;
    } };
struct EpiMix {
    static constexpr bool PERM = true, AFTER_DRAIN = false;
    bf16_t* P; int ldp; const float* p16; const float* lbf; const float* lbb;
    template <int ACT> __device__ __forceinline__ void run(const f32x4 (&acc)[2][2][4][2], const Unit& u, int wr, int wc, int fr, int fq) const {
        const int row0 = u.pm * BM + wr * 64 + fr, col0 = u.pn * BM + wc * 32 + 8 * fq;
        float oml[2][8];
        if (ACT == 3) { const float* lb = ((u.pn >> 1) == 4) ? lbf : lbb; const int c0 = (u.pn & 1) * BM + wc * 32 + 8 * fq;
#pragma unroll
            for (int bj = 0; bj < 2; ++bj)
#pragma unroll
                for (int e = 0; e < 8; ++e) { const float a0 = lb[c0 + bj * HALF + e], a1 = lb[512 + c0 + bj * HALF + e]; oml[bj][e] = fast_sigmoid(a1 - a0);
#ifdef DBG_OML
                    oml[bj][e] = 0.5f;
#endif
                } }
        float rr[8];
        row_rstd8(p16, row0, fq, rr);
#pragma unroll
        for (int ai = 0; ai < 2; ++ai)
#pragma unroll
            for (int m = 0; m < 4; ++m) {
                const int row = row0 + ai * HALF + m * 16;
                const float r = rr[ai * 4 + m];
#pragma unroll
                for (int bj = 0; bj < 2; ++bj) {
                    float h[8];
#pragma unroll
                    for (int n = 0; n < 2; ++n) {
                        const f32x4 z = acc[ai][bj][m][n] * r;
                        if (ACT == 0) { const f32x2 a = gelu_pk((f32x2){z[0], z[1]}), b = gelu_pk((f32x2){z[2], z[3]}); h[4 * n] = a.x; h[4 * n + 1] = a.y; h[4 * n + 2] = b.x; h[4 * n + 3] = b.y; }
                        else if (ACT == 1) {
#pragma unroll
                            for (int e = 0; e < 4; ++e) h[4 * n + e] = z[e] * fast_sigmoid(z[e]); }
                        else if (ACT == 2) {
#pragma unroll
                            for (int e = 0; e < 4; ++e) h[4 * n + e] = z[e]; }
                        else {
#pragma unroll
                            for (int e = 0; e < 4; ++e) { const float kk = oml[bj][4 * n + e] * __builtin_amdgcn_rcpf(1.0f + __builtin_amdgcn_exp2f(1.44269504089f * z[e]));
                                h[4 * n + e] = __builtin_amdgcn_logf(1.0f - kk); }
                        }
                    }
                    u32x4 w; w.x = cvt_pk_bf16(h[0], h[1]); w.y = cvt_pk_bf16(h[2], h[3]); w.z = cvt_pk_bf16(h[4], h[5]); w.w = cvt_pk_bf16(h[6], h[7]);
                    *(u32x4*)(P + (size_t)row * ldp + col0 + bj * HALF) = w;
                }
            }
    }
    __device__ __forceinline__ void operator()(const f32x4 (&acc)[2][2][4][2], const Unit& u, int wr, int wc, int fr, int fq) const {
        const int seg = u.pn >> 1;
        if (seg <= 1) run<0>(acc, u, wr, wc, fr, fq);
        else if (seg == 2 || seg == 6) run<1>(acc, u, wr, wc, fr, fq);
        else if (seg == 3) run<2>(acc, u, wr, wc, fr, fq);
        else run<3>(acc, u, wr, wc, fr, fq);
    }
};

template <class Epi, class Sched, bool ALIGN_EPI = false, bool SP2 = false>
__device__ __forceinline__ void gemm_phase(PG8_LAS unsigned char* lds, const Gemm g, const Sched& S, const Epi& E) {
    const int tid = threadIdx.x, wid = __builtin_amdgcn_readfirstlane(tid >> 6), lane = tid & 63, wr = wid >> 2, wc = wid & 3, fr = lane & 15, fq = lane >> 4;
    const int K = g.K, nt = K / BK;
    unsigned voffA[2], voffB[2];
#pragma unroll
    for (int i = 0; i < 2; ++i) { int R, C; stage_rc(tid * 16 + i * 8192, R, C); const int Rb = Epi::PERM ? ((R & ~31) + perm32(R & 31)) : R;
        voffA[i] = (unsigned)(R * K + C) * 2u; voffB[i] = (unsigned)(Rb * K + C) * 2u; }
    const size_t kstep = (size_t)(BK * 2);
    const size_t hstep = (size_t)HALF * K * 2;
    const size_t tstep = 2 * hstep;
    const unsigned ldsw = (unsigned)wid * 1024u;
    const int aoff = lds_byte(wr * 64 + fr, fq * 8), boff = lds_byte(wc * 32 + fr, fq * 8);
#define PG8_SA(b, h) (((b) * 2 + (h)) * HTB)
#define PG8_SB(b, h) ((4 + (b) * 2 + (h)) * HTB)
#define PG8_STAGE(bufoff, gbase, voff) do { _Pragma("unroll") for (int _i = 0; _i < 2; ++_i) \
        __builtin_amdgcn_global_load_lds((const unsigned*)((const char*)(gbase) + (voff)[_i]), (PG8_LAS unsigned*)(lds + (bufoff) + ldsw + _i * 8192), 16, 0, 0); } while (0)
#define PG8_LDA(dst, b, h) do { _Pragma("unroll") for (int m = 0; m < 4; ++m) _Pragma("unroll") for (int k = 0; k < 2; ++k) dst[m][k] = *(const PG8_LAS bf16x8*)(lds + PG8_SA(b, h) + aoff + m * 2048 + k * 1024); } while (0)
#define PG8_LDB(dst, b, h) do { _Pragma("unroll") for (int n = 0; n < 2; ++n) _Pragma("unroll") for (int k = 0; k < 2; ++k) dst[n][k] = *(const PG8_LAS bf16x8*)(lds + PG8_SB(b, h) + boff + n * 2048 + k * 1024); } while (0)
#define PG8_MMA(ai, bj, At, Bt) do { __builtin_amdgcn_s_setprio(1); _Pragma("unroll") for (int m = 0; m < 4; ++m) _Pragma("unroll") for (int n = 0; n < 2; ++n) _Pragma("unroll") for (int k = 0; k < 2; ++k) \
        acc[ai][bj][m][n] = __builtin_amdgcn_mfma_f32_16x16x32_bf16(Bt[n][k], At[m][k], acc[ai][bj][m][n], 0, 0, 0); __builtin_amdgcn_s_setprio(0); } while (0)
#define PG8_WAIT_V(n) asm volatile("s_waitcnt vmcnt(" #n ")" ::: "memory")
#define PG8_WAIT_L(n) asm volatile("s_waitcnt lgkmcnt(" #n ")" ::: "memory")
#define PG8_BAR __builtin_amdgcn_s_barrier()
#define PG8_SCHED __builtin_amdgcn_sched_barrier(0)
    Unit cur, nxt; int ui = 0;
    if (!S.next(0, cur)) return;
    f32x4 acc[2][2][4][2];
#pragma unroll
    for (int a = 0; a < 2; ++a)
#pragma unroll
        for (int b = 0; b < 2; ++b)
#pragma unroll
            for (int m = 0; m < 4; ++m)
#pragma unroll
                for (int n = 0; n < 2; ++n) acc[a][b][m][n] = (f32x4){0.f, 0.f, 0.f, 0.f};
    bf16x8 At[4][2], B0[2][2], B1[2][2];
    const char* cA = (const char*)g.A + (size_t)cur.pm * tstep; const char* cB = (const char*)g.Bt + (size_t)cur.pn * tstep;
    S.a_ready(cur);
    if constexpr (SP2) {
        PG8_STAGE(PG8_SB(0, 0), cB, voffB); PG8_STAGE(PG8_SB(0, 1), cB + hstep, voffB); PG8_STAGE(PG8_SA(0, 0), cA, voffA); PG8_STAGE(PG8_SA(0, 1), cA + hstep, voffA);
        if (wr == 1) PG8_BAR;
        PG8_WAIT_V(2); PG8_BAR;
        PG8_STAGE(PG8_SB(1, 0), cB + kstep, voffB); PG8_STAGE(PG8_SA(1, 0), cA + kstep, voffA); PG8_STAGE(PG8_SB(1, 1), cB + hstep + kstep, voffB);
        PG8_WAIT_V(6); PG8_BAR;
    } else {
        PG8_STAGE(PG8_SB(0, 0), cB, voffB); PG8_STAGE(PG8_SA(0, 0), cA, voffA); PG8_STAGE(PG8_SB(0, 1), cB + hstep, voffB); PG8_STAGE(PG8_SA(0, 1), cA + hstep, voffA);
        if (wr == 1) PG8_BAR;
        PG8_WAIT_V(4); PG8_BAR;
        PG8_STAGE(PG8_SB(1, 0), cB + kstep, voffB); PG8_STAGE(PG8_SA(1, 0), cA + kstep, voffA); PG8_STAGE(PG8_SB(1, 1), cB + hstep + kstep, voffB);
        PG8_WAIT_V(6); PG8_BAR;
    }
    for (;;) {
        const bool has_next = S.next(ui + 1, nxt);
        const char* nA = has_next ? (const char*)g.A + (size_t)nxt.pm * tstep : cA; const char* nB = has_next ? (const char*)g.Bt + (size_t)nxt.pn * tstep : cB;
        for (int t = 0; t < nt; t += 2) {
            const bool last = (t == nt - 2);
            const char* a1 = cA + (size_t)(t + 1) * kstep;
            const char* a2 = last ? nA : cA + (size_t)(t + 2) * kstep; const char* b2 = last ? nB : cB + (size_t)(t + 2) * kstep;
            const char* a3 = a2 + kstep; const char* b3 = b2 + kstep;
            if (last && has_next) S.a_ready(nxt);
            if constexpr (SP2) {
            PG8_LDB(B0, 0, 0); PG8_LDB(B1, 0, 1); PG8_SCHED; PG8_LDA(At, 0, 0); PG8_STAGE(PG8_SA(1, 1), a1 + hstep, voffA);
            PG8_WAIT_V(8); PG8_WAIT_L(0); PG8_BAR; PG8_MMA(0, 0, At, B0); PG8_MMA(0, 1, At, B1); PG8_BAR; PG8_SCHED;
            PG8_LDA(At, 0, 1); PG8_STAGE(PG8_SB(0, 0), b2, voffB); PG8_STAGE(PG8_SB(0, 1), b2 + hstep, voffB); PG8_STAGE(PG8_SA(0, 0), a2, voffA);
            PG8_WAIT_V(8); PG8_WAIT_L(0); PG8_BAR; PG8_MMA(1, 0, At, B0); PG8_MMA(1, 1, At, B1); PG8_BAR; PG8_SCHED;
            PG8_LDB(B0, 1, 0); PG8_LDB(B1, 1, 1); PG8_SCHED; PG8_LDA(At, 1, 0); PG8_STAGE(PG8_SA(0, 1), a2 + hstep, voffA);
            PG8_WAIT_V(8); PG8_WAIT_L(0); PG8_BAR; PG8_MMA(0, 0, At, B0); PG8_MMA(0, 1, At, B1); PG8_BAR; PG8_SCHED;
            PG8_LDA(At, 1, 1); PG8_STAGE(PG8_SB(1, 0), b3, voffB); PG8_STAGE(PG8_SB(1, 1), b3 + hstep, voffB); PG8_STAGE(PG8_SA(1, 0), a3, voffA);
            PG8_WAIT_V(8); PG8_WAIT_L(0); PG8_BAR; PG8_MMA(1, 0, At, B0); PG8_MMA(1, 1, At, B1); PG8_BAR; PG8_SCHED;
            } else {
            PG8_LDB(B0, 0, 0); PG8_SCHED; PG8_LDA(At, 0, 0); PG8_STAGE(PG8_SA(1, 1), a1 + hstep, voffA);
            PG8_WAIT_L(8); PG8_BAR; PG8_WAIT_L(0); PG8_MMA(0, 0, At, B0); PG8_BAR; PG8_SCHED;
            PG8_LDB(B1, 0, 1); PG8_STAGE(PG8_SB(0, 0), b2, voffB);
            PG8_BAR; PG8_WAIT_L(0); PG8_MMA(0, 1, At, B1); PG8_BAR;
            PG8_LDA(At, 0, 1); PG8_STAGE(PG8_SA(0, 0), a2, voffA);
            PG8_BAR; PG8_WAIT_L(0); PG8_MMA(1, 0, At, B0); PG8_BAR; PG8_SCHED;
            PG8_STAGE(PG8_SB(0, 1), b2 + hstep, voffB);
            PG8_WAIT_V(6); PG8_BAR; PG8_MMA(1, 1, At, B1); PG8_BAR;
            PG8_LDB(B0, 1, 0); PG8_SCHED; PG8_LDA(At, 1, 0); PG8_STAGE(PG8_SA(0, 1), a2 + hstep, voffA);
            PG8_WAIT_L(8); PG8_BAR; PG8_WAIT_L(0); PG8_MMA(0, 0, At, B0); PG8_BAR; PG8_SCHED;
            PG8_LDB(B1, 1, 1); PG8_STAGE(PG8_SB(1, 0), b3, voffB);
            PG8_BAR; PG8_WAIT_L(0); PG8_MMA(0, 1, At, B1); PG8_BAR;
            PG8_LDA(At, 1, 1); PG8_STAGE(PG8_SA(1, 0), a3, voffA);
            PG8_BAR; PG8_WAIT_L(0); PG8_MMA(1, 0, At, B0); PG8_BAR; PG8_SCHED;
            PG8_STAGE(PG8_SB(1, 1), b3 + hstep, voffB);
            PG8_WAIT_V(6); PG8_BAR; PG8_MMA(1, 1, At, B1); PG8_BAR;
            }
        }
        if constexpr (ALIGN_EPI) { if (wr == 0) PG8_BAR; }
        if constexpr (!Epi::AFTER_DRAIN) { E(acc, cur, wr, wc, fr, fq); S.done(cur); }
        if (!has_next) break;
#pragma unroll
        for (int a = 0; a < 2; ++a)
#pragma unroll
            for (int b = 0; b < 2; ++b)
#pragma unroll
                for (int m = 0; m < 4; ++m)
#pragma unroll
                    for (int n = 0; n < 2; ++n) acc[a][b][m][n] = (f32x4){0.f, 0.f, 0.f, 0.f};
        cur = nxt; cA = nA; cB = nB; ++ui;
        if constexpr (ALIGN_EPI) { if (wr == 1) PG8_BAR; }
    }
    PG8_WAIT_V(0);
    if constexpr (!ALIGN_EPI) { if (wr == 0) PG8_BAR; }
    PG8_BAR;
    if constexpr (Epi::AFTER_DRAIN) { E.fused(acc, cur, wr, wc, fr, fq, lds, wid, lane); S.done(cur); }
#undef PG8_SA
#undef PG8_SB
#undef PG8_STAGE
#undef PG8_LDA
#undef PG8_LDB
#undef PG8_MMA
#undef PG8_WAIT_V
#undef PG8_WAIT_L
#undef PG8_BAR
#undef PG8_SCHED
}
}

#ifndef PG8_SP2
#define PG8_SP2 true
#endif
#ifndef PG8_ALIGN
#define PG8_ALIGN true
#endif
constexpr int NWAVES = 8;
constexpr int TOK = 32768, NPROMPT = 16384;
constexpr int DMODEL = 1024, DFF = 2816, DIN = 3584;
constexpr int COL_U = 0, COL_V = 512, COL_Q = 1024, COL_I = 1536, COL_FF = 2048, COL_FB = 2560, COL_G = 3072;
constexpr float EPS = 1e-6f;
constexpr size_t MiB = 1u << 20;
constexpr size_t WS_CTL = 0, CTL_ZERO_BYTES = 1 * MiB;
constexpr size_t WS_SSG = 1 * MiB;
constexpr size_t WS_P16 = 2 * MiB;
constexpr size_t WS_WGU1 = 8 * MiB, WS_WD1 = 19 * MiB, WS_WIN = 25 * MiB, WS_WOUT = 32 * MiB, WS_WGU2 = 34 * MiB, WS_WD2 = 45 * MiB;
constexpr size_t WS_BUFA = 52 * MiB;
constexpr size_t WS_BUFB = 116 * MiB;
constexpr size_t WS_BIG = 180 * MiB;
constexpr size_t WS_OB1 = 404 * MiB;
constexpr size_t WS_HGE = 468 * MiB;
constexpr size_t WS_HGD = 500 * MiB;
constexpr size_t WS_END = 501 * MiB;
static_assert(WS_WGU1 + (size_t)2 * DFF * DMODEL * 2 <= WS_WD1 && WS_WD1 + (size_t)DMODEL * DFF * 2 <= WS_WIN && WS_WIN + (size_t)DIN * DMODEL * 2 <= WS_WOUT && WS_WOUT + (size_t)DMODEL * DMODEL * 2 <= WS_WGU2
              && WS_WGU2 + (size_t)2 * DFF * DMODEL * 2 <= WS_WD2 && WS_WD2 + (size_t)DMODEL * DFF * 2 <= WS_BUFA && WS_BUFA + (size_t)TOK * DMODEL * 2 <= WS_BUFB && WS_BUFB + (size_t)TOK * DMODEL * 2 <= WS_BIG
              && WS_BIG + (size_t)TOK * DIN * 2 <= WS_OB1 && WS_OB1 + (size_t)TOK * 512 * 4 <= WS_HGE && WS_HGE + (size_t)512 * 65536 <= WS_HGD && WS_P16 + 3 * 2 * MiB <= WS_WGU1, "d_ws map");
constexpr int CW_BAR = 4096;
constexpr int RING_OFF = 0, RING_BYTES = 131072;
constexpr int LDSCTL_OFF = RING_BYTES, MISC_OFF = LDSCTL_OFF + 320;
constexpr int LDS_BYTES = 147456;
static_assert(MISC_OFF + 128 <= LDS_BYTES, "LDS map");

#define GAS __attribute__((address_space(1)))
#define LAS __attribute__((address_space(3)))
typedef unsigned short bf16;
typedef unsigned v4u __attribute__((ext_vector_type(4)));
typedef float f32x4 __attribute__((ext_vector_type(4)));
typedef short bf16x8 __attribute__((ext_vector_type(8)));
typedef GAS unsigned gu32;
typedef GAS unsigned long long gu64;
#define RLX_AGENT __ATOMIC_RELAXED, __HIP_MEMORY_SCOPE_AGENT
#define LDS_WAIT() asm volatile("s_waitcnt lgkmcnt(0)" ::: "memory")
#define VM_WAIT() asm volatile("s_waitcnt vmcnt(0)" ::: "memory")
__device__ __forceinline__ unsigned long long rt() { return __builtin_amdgcn_s_memrealtime(); }
__device__ __forceinline__ unsigned f2bf(float f) { unsigned u = __builtin_bit_cast(unsigned, f); return (u + 0x7fffu + ((u >> 16) & 1u)) >> 16; }
__device__ __forceinline__ unsigned pk2(float lo, float hi) { return f2bf(lo) | (f2bf(hi) << 16); }

#define XB_TMO      128
#define XB_XCNT(j)  (256  + 64 * (j))
#define XB_XSUB(j)  (1280 + 64 * (j))
#define XB_XGEN(j)  (2304 + 64 * (j))
#define XB_TOP      3328
#define XB_TOPGEN   3392
#define XCD_BAR_WORDS 3456
#define XB_SPIN_CAP (1u << 18)

__device__ __forceinline__ unsigned xb_ld(unsigned* p)              { return __hip_atomic_load(p, __ATOMIC_RELAXED, __HIP_MEMORY_SCOPE_AGENT); }
__device__ __forceinline__ unsigned xb_add(unsigned* p, unsigned v) { return __hip_atomic_fetch_add(p, v, __ATOMIC_RELAXED, __HIP_MEMORY_SCOPE_AGENT); }
__device__ __forceinline__ unsigned xb_xcc_id() { return (unsigned)__builtin_amdgcn_s_getreg((3 << 11) | 20) & 0xFu; }
#define XB_SPIN(cond, bar) do { unsigned _sp = 0; while (cond) { __builtin_amdgcn_s_sleep(1); \
    if ((++_sp & 255u) == 0u) { if (xb_ld(&(bar)[XB_TMO])) break; if (_sp > XB_SPIN_CAP) { atomicAdd(&(bar)[XB_TMO], 1u); break; } } } } while (0)

struct XcdBarrier {
    unsigned* bar; unsigned x;
    volatile LAS unsigned* st;
};

__device__ __forceinline__ XcdBarrier xcd_barrier_post(unsigned* bar, volatile LAS unsigned* st) {
    XcdBarrier b; b.bar = bar; b.x = xb_xcc_id(); b.st = st;
    if (threadIdx.x == 0) (void)xb_add(&bar[XB_XCNT(b.x)], 1u);
    return b;
}
__device__ __forceinline__ void xcd_barrier_complete(unsigned* bar, unsigned x, unsigned& nloc, unsigned& nx) {
    const unsigned G = gridDim.x * gridDim.y * gridDim.z;
    unsigned sum, cnt, mine, sp = 0u;
    for (;;) {
        sum = 0u; cnt = 0u; mine = 0u;
#pragma unroll
        for (unsigned j = 0; j < 16; ++j) { const unsigned c = xb_ld(&bar[XB_XCNT(j)]); sum += c; cnt += (c > 0u) ? 1u : 0u; mine = (j == x) ? c : mine; }
        if (sum == G) break;
        __builtin_amdgcn_s_sleep(1);
        if ((++sp & 255u) == 0u) { if (xb_ld(&bar[XB_TMO])) break; if (sp > XB_SPIN_CAP) { atomicAdd(&bar[XB_TMO], 1u); break; } }
    }
    nloc = mine > 0u ? mine : 1u; nx = cnt > 0u ? cnt : 1u;
}

__device__ __forceinline__ void xcd_barrier(const XcdBarrier& b) {
    asm volatile("s_waitcnt vmcnt(0)" ::: "memory");
    __syncthreads();
    if (threadIdx.x == 0) {
        unsigned* bar = b.bar;
        __builtin_amdgcn_s_waitcnt(0);
        unsigned nloc = b.st[0], nx = b.st[1];
        if (nloc == 0u) { xcd_barrier_complete(bar, b.x, nloc, nx); b.st[0] = nloc; b.st[1] = nx; }
        const unsigned old = xb_add(&bar[XB_XSUB(b.x)], 1u);
        const unsigned gen = old / nloc;
        if (old + 1u == (gen + 1u) * nloc) {
            __builtin_amdgcn_fence(__ATOMIC_RELEASE, "agent");
            asm volatile("s_waitcnt vmcnt(0)" ::: "memory");
            const unsigned og = xb_add(&bar[XB_TOP], 1u);
            const unsigned tg = og / nx;
            if (og + 1u == (tg + 1u) * nx) xb_add(&bar[XB_TOPGEN], 1u);
            else XB_SPIN(xb_ld(&bar[XB_TOPGEN]) == tg, bar);
            __builtin_amdgcn_fence(__ATOMIC_ACQUIRE, "agent");
            xb_add(&bar[XB_XGEN(b.x)], 1u);
            asm volatile("s_waitcnt vmcnt(0)" ::: "memory");
        } else {
            XB_SPIN(xb_ld(&bar[XB_XGEN(b.x)]) == gen, bar);
            __builtin_amdgcn_fence(__ATOMIC_ACQUIRE, "agent");
            asm volatile("s_waitcnt vmcnt(0)" ::: "memory");
        }
    }
    __syncthreads();
}
typedef unsigned v2u __attribute__((ext_vector_type(2)));
__device__ __forceinline__ float wave_sum(float v) {
#pragma unroll
    for (int o = 1; o < 64; o <<= 1) v += __shfl_xor(v, o);
    return v;
}
__device__ __forceinline__ float bflo(unsigned w) { return __builtin_bit_cast(float, w << 16); }
__device__ __forceinline__ float bfhi(unsigned w) { return __builtin_bit_cast(float, w & 0xffff0000u); }
__device__ __forceinline__ float bf1(unsigned short h) { return __builtin_bit_cast(float, (unsigned)h << 16); }
__device__ __forceinline__ float ex2(float x) { return __builtin_amdgcn_exp2f(x); }
__device__ __forceinline__ float rsq(float x) { return __builtin_amdgcn_rsqf(x); }

__device__ __forceinline__ void p0_item(const float* W, int Nsrc, int k0, int scol0, const float* gain, bf16* WT, int K, int drow0, LAS float* scr, int lane) {
    const int r8 = lane >> 3, c4 = 4 * (lane & 7);
    f32x4 v[8];
#pragma unroll
    for (int i = 0; i < 8; ++i) v[i] = *(const GAS f32x4*)(W + (size_t)(k0 + 8 * i + r8) * Nsrc + scol0 + c4);
#pragma unroll
    for (int i = 0; i < 8; ++i) { const int kk = 8 * i + r8; f32x4 t = v[i]; if (gain) t = t * gain[k0 + kk];
        scr[kk * 33 + c4] = t[0]; scr[kk * 33 + c4 + 1] = t[1]; scr[kk * 33 + c4 + 2] = t[2]; scr[kk * 33 + c4 + 3] = t[3]; }
    LDS_WAIT(); asm volatile("" ::: "memory");
    const int c = lane & 7;
#pragma unroll
    for (int j = 0; j < 4; ++j) { const int n = (lane >> 3) + 8 * j; const LAS float* s = scr + (8 * c) * 33 + n;
        v4u o; o.x = pk2(s[0 * 33], s[1 * 33]); o.y = pk2(s[2 * 33], s[3 * 33]); o.z = pk2(s[4 * 33], s[5 * 33]); o.w = pk2(s[6 * 33], s[7 * 33]);
        *(GAS v4u*)(WT + (size_t)(drow0 + n) * K + k0 + 8 * c) = o; }
    LDS_WAIT(); asm volatile("" ::: "memory");
}
__device__ __forceinline__ void p0_gu(const float* Wg, const float* Wu, const float* gain, bf16* WT, int r, LAS float* scr, int lane) {
    const int nblk = 2 * DFF / 32, kb = r / nblk, nb = r % nblk, n0 = 32 * nb, pn = n0 >> 8, bj = (n0 >> 7) & 1, j0 = n0 & 127;
    p0_item(bj ? Wu : Wg, DFF, 64 * kb, 128 * pn + j0, gain, WT, DMODEL, n0, scr, lane);
}
__device__ __forceinline__ void p0_plain(const float* W, int K, int N, const float* gain, bf16* WT, int r, LAS float* scr, int lane) {
    const int nblk = N / 32, kb = r / nblk, nb = r % nblk;
    p0_item(W, N, 64 * kb, 32 * nb, gain, WT, K, 32 * nb, scr, lane);
}
__device__ __forceinline__ void p0_prologue(LAS unsigned char* lds, const float* const* in, unsigned char* ws, int gw, int NGW, int wave, int lane) {
    LAS float* scr = (LAS float*)(lds + RING_OFF + wave * 16384);
    constexpr int I_GU = (DMODEL / 64) * (2 * DFF / 32), I_D = (DFF / 64) * (DMODEL / 32), I_IN = (DMODEL / 64) * (DIN / 32), I_OUT = (DMODEL / 64) * (DMODEL / 32);
    constexpr int NITEMS = 2 * I_GU + 2 * I_D + I_IN + I_OUT;
    for (int it = gw; it < NITEMS; it += NGW) {
        int r = it;
        if (r < I_GU) { p0_gu(in[3], in[4], in[2], (bf16*)(ws + WS_WGU1), r, scr, lane); continue; } r -= I_GU;
        if (r < I_GU) { p0_gu(in[18], in[19], in[17], (bf16*)(ws + WS_WGU2), r, scr, lane); continue; } r -= I_GU;
        if (r < I_D) { p0_plain(in[5], DFF, DMODEL, nullptr, (bf16*)(ws + WS_WD1), r, scr, lane); continue; } r -= I_D;
        if (r < I_D) { p0_plain(in[20], DFF, DMODEL, nullptr, (bf16*)(ws + WS_WD2), r, scr, lane); continue; } r -= I_D;
        if (r < I_IN) { p0_plain(in[7], DMODEL, DIN, in[6], (bf16*)(ws + WS_WIN), r, scr, lane); continue; } r -= I_IN;
        p0_plain(in[16], DMODEL, DMODEL, nullptr, (bf16*)(ws + WS_WOUT), r, scr, lane);
    }
    bf16* XB = (bf16*)(ws + WS_BUFA); float* p16 = (float*)(ws + WS_P16);
    for (int m0 = gw; m0 < TOK; m0 += 4 * NGW) {
        f32x4 v[4][4]; float s[4];
#pragma unroll
        for (int q = 0; q < 4; ++q) { const int m = m0 + q * NGW;
            if (m < TOK) { const float* xrow = m < NPROMPT ? in[0] + (size_t)m * DMODEL : in[1] + (size_t)(m - NPROMPT) * DMODEL; const GAS f32x4* xr = (const GAS f32x4*)xrow + lane;
#pragma unroll
                for (int j = 0; j < 4; ++j) v[q][j] = xr[64 * j]; } }
#pragma unroll
        for (int q = 0; q < 4; ++q) { s[q] = 0.f;
#pragma unroll
            for (int j = 0; j < 4; ++j) s[q] += (v[q][j].x * v[q][j].x + v[q][j].y * v[q][j].y) + (v[q][j].z * v[q][j].z + v[q][j].w * v[q][j].w); }
#pragma unroll
        for (int o = 1; o < 64; o <<= 1) {
#pragma unroll
            for (int q = 0; q < 4; ++q) s[q] += __shfl_xor(s[q], o); }
#pragma unroll
        for (int q = 0; q < 4; ++q) { const int m = m0 + q * NGW;
            if (m < TOK) { GAS v2u* o8 = (GAS v2u*)(XB + (size_t)m * DMODEL) + lane;
#pragma unroll
                for (int j = 0; j < 4; ++j) { v2u w; w.x = pk2(v[q][j].x, v[q][j].y); w.y = pk2(v[q][j].z, v[q][j].w); o8[64 * j] = w; }
                if (lane < 16) p16[(size_t)m * 16 + lane] = lane == 0 ? s[q] : 0.f; } }
    }
}

__device__ __forceinline__ void final_norm(const bf16* XBr, float* out, const float* gfin, int gw, int NGW, int lane) {
    for (int m = gw; m < TOK; m += NGW) {
        const v4u w0 = *(const GAS v4u*)(XBr + (size_t)m * DMODEL + 8 * lane), w1 = *(const GAS v4u*)(XBr + (size_t)m * DMODEL + 512 + 8 * lane);
        float x[16] = {bflo(w0.x), bfhi(w0.x), bflo(w0.y), bfhi(w0.y), bflo(w0.z), bfhi(w0.z), bflo(w0.w), bfhi(w0.w), bflo(w1.x), bfhi(w1.x), bflo(w1.y), bfhi(w1.y), bflo(w1.z), bfhi(w1.z), bflo(w1.w), bfhi(w1.w)};
        float s = 0.f;
#pragma unroll
        for (int e = 0; e < 16; ++e) s += x[e] * x[e];
        const float r = rsq(wave_sum(s) * (1.0f / DMODEL) + EPS);
#pragma unroll
        for (int j = 0; j < 2; ++j) { const int c = 512 * j + 8 * lane;
            const f32x4 g0 = *(const GAS f32x4*)(gfin + c), g1 = *(const GAS f32x4*)(gfin + c + 4);
            *(GAS f32x4*)(out + (size_t)m * DMODEL + c) = (f32x4){x[8 * j] * r * g0[0], x[8 * j + 1] * r * g0[1], x[8 * j + 2] * r * g0[2], x[8 * j + 3] * r * g0[3]};
            *(GAS f32x4*)(out + (size_t)m * DMODEL + c + 4) = (f32x4){x[8 * j + 4] * r * g1[0], x[8 * j + 5] * r * g1[1], x[8 * j + 6] * r * g1[2], x[8 * j + 7] * r * g1[3]}; }
    }
}

constexpr int HG_RAWLF = 0, HG_RAWQ = 17408, HG_QN = 34816, HG_KN = 52224, HG_KT = 69632, HG_VT = 88064, HG_SCL = 97280, HG_ST = 106496, HG_SEG = 115200, HG_SA = 119296, HG_SB = 119808, HG_END = 120320;
static_assert(HG_END <= RING_BYTES, "hgrn LDS");
__device__ __forceinline__ void hgrn_item(LAS unsigned char* lds, const bf16* P, float* ob, int row0, int L, int h, int dir, int dq, int tid, int lane, int wave) {
    const int fr = lane & 15, fq = lane >> 4, nch = L >> 6;
    const bf16* gq = P + COL_Q + h * 128;
    const bf16* gl = P + (dir ? COL_FB : COL_FF) + h * 128;
    const bf16* gv = P + COL_I + h * 128 + dq * 32;
    float* go = ob + h * 128 + dq * 32;
    const int lr = tid >> 4, lc = tid & 15, lp = (tid >> 2) & 31, vc = tid & 3, cp = lane, s8 = wave;
#define TOKROW(n, l) (row0 + (dir ? (L - 1 - (64 * (n) + (l))) : (64 * (n) + (l))))
#define HG_LOAD(n) do { _Pragma("unroll") for (int i_ = 0; i_ < 2; ++i_) { const size_t ro_ = (size_t)TOKROW(n, lr + 32 * i_) * DIN + 8 * lc; rl[i_] = *(const GAS v4u*)(gl + ro_); rq[i_] = *(const GAS v4u*)(gq + ro_); \
        rv[i_] = *(const GAS v4u*)(gv + (size_t)TOKROW(n, 2 * lp + i_) * DIN + 8 * vc); } } while (0)
    v4u rl[2], rq[2], rv[2];
    HG_LOAD(0);
    f32x4 S0 = {0.f, 0.f, 0.f, 0.f}, S1 = {0.f, 0.f, 0.f, 0.f};
    for (int n = 0; n < nch; ++n) {
        const int vbuf = HG_VT + (n & 1) * 4608;
#pragma unroll
        for (int i = 0; i < 2; ++i) { *(LAS v4u*)(lds + HG_RAWLF + (lr + 32 * i) * 272 + lc * 16) = rl[i]; *(LAS v4u*)(lds + HG_RAWQ + (lr + 32 * i) * 272 + lc * 16) = rq[i]; }
        if (tid < 128) {
#pragma unroll
            for (int e = 0; e < 4; ++e) { const unsigned w0 = rv[0][e], w1 = rv[1][e];
                *(LAS unsigned*)(lds + vbuf + (8 * vc + 2 * e) * 144 + lp * 4) = (w0 & 0xffffu) | (w1 << 16);
                *(LAS unsigned*)(lds + vbuf + (8 * vc + 2 * e + 1) * 144 + lp * 4) = (w0 >> 16) | (w1 & 0xffff0000u); }
        }
        if (n + 1 < nch) HG_LOAD(n + 1);
        __syncthreads();
        float lfa[8], lfb[8], ava[8], avb[8]; float runa = 0.f, runb = 0.f;
#pragma unroll
        for (int j = 0; j < 8; ++j) { const unsigned w = *(const LAS unsigned*)(lds + HG_RAWLF + (8 * s8 + j) * 272 + cp * 4);
            lfa[j] = bflo(w); lfb[j] = bfhi(w); runa += lfa[j]; runb += lfb[j]; ava[j] = runa; avb[j] = runb; }
        *(LAS v2u*)(lds + HG_SEG + (s8 * 128 + 2 * cp) * 4) = (v2u){__builtin_bit_cast(unsigned, runa), __builtin_bit_cast(unsigned, runb)};
        __syncthreads();
        {
            typedef float f32x2v __attribute__((ext_vector_type(2)));
            f32x2v sg_[8];
#pragma unroll
            for (int q = 0; q < 8; ++q) sg_[q] = *(const LAS f32x2v*)(lds + HG_SEG + (q * 128 + 2 * cp) * 4);
            const f32x2v amid2 = (sg_[0] + sg_[1]) + (sg_[2] + sg_[3]);
            const f32x2v atot2 = amid2 + ((sg_[4] + sg_[5]) + (sg_[6] + sg_[7]));
            f32x2v off2 = -amid2;
#pragma unroll
            for (int q = 0; q < 7; ++q) { const float mq = (q < s8) ? 1.0f : 0.0f; off2 = off2 + sg_[q] * mq; }
            const float amida = amid2.x, amidb = amid2.y, atota = atot2.x, atotb = atot2.y;
            const float offa = off2.x, offb = off2.y;
            unsigned kta[4], ktb[4];
#pragma unroll
            for (int j = 0; j < 8; ++j) {
                const float aa = offa + ava[j], ab = offb + avb[j];
                const unsigned qw = *(const LAS unsigned*)(lds + HG_RAWQ + (8 * s8 + j) * 272 + cp * 4);
                const float qta = bflo(qw) * ex2(aa), qtb = bfhi(qw) * ex2(ab);
                const float k_a = (1.0f - ex2(lfa[j])) * ex2(-aa), k_b = (1.0f - ex2(lfb[j])) * ex2(-ab);
                const unsigned kba = f2bf(k_a), kbb = f2bf(k_b);
                *(LAS unsigned*)(lds + HG_QN + (8 * s8 + j) * 272 + cp * 4) = pk2(qta, qtb);
                *(LAS unsigned*)(lds + HG_KN + (8 * s8 + j) * 272 + cp * 4) = kba | (kbb << 16);
                if (j & 1) { kta[j >> 1] |= kba << 16; ktb[j >> 1] |= kbb << 16; } else { kta[j >> 1] = kba; ktb[j >> 1] = kbb; }
            }
            *(LAS v4u*)(lds + HG_KT + (2 * cp) * 144 + s8 * 16) = (v4u){kta[0], kta[1], kta[2], kta[3]};
            *(LAS v4u*)(lds + HG_KT + (2 * cp + 1) * 144 + s8 * 16) = (v4u){ktb[0], ktb[1], ktb[2], ktb[3]};
            if (s8 == 0) { *(LAS v2u*)(lds + HG_SA + (2 * cp) * 4) = (v2u){__builtin_bit_cast(unsigned, ex2(amida)), __builtin_bit_cast(unsigned, ex2(amidb))};
                           *(LAS v2u*)(lds + HG_SB + (2 * cp) * 4) = (v2u){__builtin_bit_cast(unsigned, ex2(atota - amida)), __builtin_bit_cast(unsigned, ex2(atotb - amidb))}; }
        }
        __syncthreads();
        {
            const f32x4 sa = *(const LAS f32x4*)(lds + HG_SA + (16 * wave + 4 * fq) * 4);
            S0 = S0 * sa; S1 = S1 * sa;
#ifdef DBG_NOSTATE
            S0 = (f32x4){0.f,0.f,0.f,0.f}; S1 = S0;
#endif
            v2u w0, w1; w0.x = pk2(S0[0], S0[1]); w0.y = pk2(S0[2], S0[3]); w1.x = pk2(S1[0], S1[1]); w1.y = pk2(S1[2], S1[3]);
            *(LAS v2u*)(lds + HG_ST + fr * 272 + (16 * wave + 4 * fq) * 2) = w0;
            *(LAS v2u*)(lds + HG_ST + (16 + fr) * 272 + (16 * wave + 4 * fq) * 2) = w1;
        }
        {
            const int ib = wave & 3, jp = wave >> 2;
#pragma unroll
            for (int t = 0; t < 2; ++t) {
                const int jb = 2 * jp + t;
                f32x4 sc = {0.f, 0.f, 0.f, 0.f};
                if (jb <= ib) {
#pragma unroll
                    for (int ks = 0; ks < 4; ++ks) {
                        const bf16x8 x = *(const LAS bf16x8*)(lds + HG_KN + (16 * jb + fr) * 272 + ks * 64 + fq * 16);
                        const bf16x8 y = *(const LAS bf16x8*)(lds + HG_QN + (16 * ib + fr) * 272 + ks * 64 + fq * 16);
                        sc = __builtin_amdgcn_mfma_f32_16x16x32_bf16(x, y, sc, 0, 0, 0);
                    }
                    if (jb == ib) {
#pragma unroll
                        for (int r = 0; r < 4; ++r) if (4 * fq + r > fr) sc[r] = 0.f;
                    }
                }
                v2u w; w.x = pk2(sc[0], sc[1]); w.y = pk2(sc[2], sc[3]);
                *(LAS v2u*)(lds + HG_SCL + (16 * ib + fr) * 144 + (16 * jb + 4 * fq) * 2) = w;
            }
        }
        __syncthreads();
        {
            const int ib2 = wave >> 1, db = wave & 1;
            f32x4 O = {0.f, 0.f, 0.f, 0.f};
#pragma unroll
            for (int ks = 0; ks < 2; ++ks) {
                const bf16x8 x = *(const LAS bf16x8*)(lds + vbuf + (16 * db + fr) * 144 + ks * 64 + fq * 16);
                const bf16x8 y = *(const LAS bf16x8*)(lds + HG_SCL + (16 * ib2 + fr) * 144 + ks * 64 + fq * 16);
                O = __builtin_amdgcn_mfma_f32_16x16x32_bf16(x, y, O, 0, 0, 0);
            }
#pragma unroll
            for (int ks = 0; ks < 4; ++ks) {
                const bf16x8 x = *(const LAS bf16x8*)(lds + HG_ST + (16 * db + fr) * 272 + ks * 64 + fq * 16);
                const bf16x8 y = *(const LAS bf16x8*)(lds + HG_QN + (16 * ib2 + fr) * 272 + ks * 64 + fq * 16);
                O = __builtin_amdgcn_mfma_f32_16x16x32_bf16(x, y, O, 0, 0, 0);
            }
#if defined(DBG_HG) && DBG_HG == 1
            { const v2u w = *(const LAS v2u*)(lds + HG_QN + (16 * ib2 + fr) * 272 + (16 * db + 4 * fq) * 2); O = (f32x4){bflo(w.x), bfhi(w.x), bflo(w.y), bfhi(w.y)}; }
#elif defined(DBG_HG) && DBG_HG == 2
            { const v2u w = *(const LAS v2u*)(lds + HG_SCL + (16 * ib2 + fr) * 144 + (16 * db + 4 * fq) * 2); O = (f32x4){bflo(w.x), bfhi(w.x), bflo(w.y), bfhi(w.y)}; }
#elif defined(DBG_HG) && DBG_HG == 3
            { const v2u w = *(const LAS v2u*)(lds + vbuf + (16 * db + fr) * 144 + (16 * (ib2 & 3) + 4 * fq) * 2); O = (f32x4){bflo(w.x), bfhi(w.x), bflo(w.y), bfhi(w.y)}; }
#elif defined(DBG_HG) && DBG_HG == 5
            { const v2u w = *(const GAS v2u*)(gq + (size_t)TOKROW(n, 16 * ib2 + fr) * DIN + 16 * db + 4 * fq); O = (f32x4){bflo(w.x), bfhi(w.x), bflo(w.y), bfhi(w.y)}; }
#elif defined(DBG_HG) && DBG_HG == 9
            { const v2u w = *(const GAS v2u*)(gl + (size_t)TOKROW(n, 16 * ib2 + fr) * DIN + 16 * db + 4 * fq); O = (f32x4){bflo(w.x), bfhi(w.x), bflo(w.y), bfhi(w.y)}; }
#elif defined(DBG_HG) && DBG_HG == 10
            { const v2u w = *(const LAS v2u*)(lds + HG_RAWLF + (16 * ib2 + fr) * 272 + (16 * db + 4 * fq) * 2); O = (f32x4){bflo(w.x), bfhi(w.x), bflo(w.y), bfhi(w.y)}; }
#elif defined(DBG_HG) && DBG_HG == 7
            { const v2u w = *(const GAS v2u*)(P + COL_U + h * 128 + (size_t)TOKROW(n, 16 * ib2 + fr) * DIN + 16 * db + 4 * fq); O = (f32x4){bflo(w.x), bfhi(w.x), bflo(w.y), bfhi(w.y)}; }
#elif defined(DBG_HG) && DBG_HG == 8
            { O = (f32x4){(float)TOKROW(n, 16 * ib2 + fr), (float)(16 * db + 4 * fq), (float)h, (float)dq}; }
#elif defined(DBG_HG) && DBG_HG == 6
            { const v2u w = *(const LAS v2u*)(lds + HG_RAWQ + (16 * ib2 + fr) * 272 + (16 * db + 4 * fq) * 2); O = (f32x4){bflo(w.x), bfhi(w.x), bflo(w.y), bfhi(w.y)}; }
#elif defined(DBG_HG) && DBG_HG == 4
            { const v2u w = *(const LAS v2u*)(lds + HG_KN + (16 * ib2 + fr) * 272 + (16 * db + 4 * fq) * 2); O = (f32x4){bflo(w.x), bfhi(w.x), bflo(w.y), bfhi(w.y)}; }
#endif
            *(GAS f32x4*)(go + (size_t)TOKROW(n, 16 * ib2 + fr) * 512 + 16 * db + 4 * fq) = O;
        }
        {
#pragma unroll
            for (int ks = 0; ks < 2; ++ks) {
                const bf16x8 x = *(const LAS bf16x8*)(lds + HG_KT + (16 * wave + fr) * 144 + ks * 64 + fq * 16);
                const bf16x8 y0 = *(const LAS bf16x8*)(lds + vbuf + fr * 144 + ks * 64 + fq * 16);
                const bf16x8 y1 = *(const LAS bf16x8*)(lds + vbuf + (16 + fr) * 144 + ks * 64 + fq * 16);
                S0 = __builtin_amdgcn_mfma_f32_16x16x32_bf16(x, y0, S0, 0, 0, 0);
                S1 = __builtin_amdgcn_mfma_f32_16x16x32_bf16(x, y1, S1, 0, 0, 0);
            }
            const f32x4 sb = *(const LAS f32x4*)(lds + HG_SB + (16 * wave + 4 * fq) * 4);
            S0 = S0 * sb; S1 = S1 * sb;
        }
        __syncthreads();
    }
#undef HG_LOAD
#undef TOKROW
}

constexpr int H2_RAWLF = 0, H2_RAWQ = 17408, H2_ST = 0, H2_QN = 34816, H2_KN = 52224, H2_KT = 69632, H2_VT = 88064, H2_SCL = 106496, H2_SEG = 115712, H2_SA = 119808, H2_SB = 120320, H2_END = 120832;
static_assert(H2_END <= RING_BYTES, "hgrn v2 LDS");
struct Hg2Inst { int row0, L, h, dir, sc, seqid; };
__device__ __forceinline__ Hg2Inst hg2_decode(int i) {
    Hg2Inst I; const int hd = i & 7, sp = i >> 3; I.h = hd >> 1; I.dir = hd & 1;
    if (sp < 32) { const int b = sp >> 2; I.sc = sp & 3; I.row0 = 2048 * b; I.L = 2048; I.seqid = b; }
    else { const int b = (sp - 32) >> 3; I.sc = (sp - 32) & 7; I.row0 = NPROMPT + 4096 * b; I.L = 4096; I.seqid = 8 + b; }
    return I;
}
__device__ __forceinline__ int hg2_index(int seqid, int h, int dir, int sc) { const int sp = seqid < 8 ? seqid * 4 + sc : 32 + (seqid - 8) * 8 + sc; return sp * 8 + h * 2 + dir; }
#define H2_TOKROW(p) (row0 + (dir ? (L - 1 - (p)) : (p)))
typedef float f32x2v __attribute__((ext_vector_type(2)));

__device__ __forceinline__ void hg2_state_pass(LAS unsigned char* lds, const bf16* P, float* Ebuf, float* Dbuf, int inst, int tid, int lane, int wave) {
    const Hg2Inst I = hg2_decode(inst); const int row0 = I.row0, L = I.L, h = I.h, dir = I.dir;
    const int fr = lane & 15, fq = lane >> 4, cp = lane, s8 = wave;
    const bf16* gl = P + (dir ? COL_FB : COL_FF) + h * 128;
    const bf16* gv = P + COL_I + h * 128;
    const int lr = tid >> 4, lc = tid & 15, vc = 4 * (wave & 3) + (lane & 3), lp = 16 * (wave >> 2) + (lane >> 2);
    const int p0 = 512 * I.sc;
#define H2_LOAD1(n) do { _Pragma("unroll") for (int i_ = 0; i_ < 2; ++i_) { rl[i_] = *(const GAS v4u*)(gl + (size_t)H2_TOKROW(p0 + 64 * (n) + lr + 32 * i_) * DIN + 8 * lc); \
        rv[i_] = *(const GAS v4u*)(gv + (size_t)H2_TOKROW(p0 + 64 * (n) + 2 * lp + i_) * DIN + 8 * vc); } } while (0)
    v4u rl[2], rv[2];
    H2_LOAD1(0);
    f32x4 S[8];
#pragma unroll
    for (int t = 0; t < 8; ++t) S[t] = (f32x4){0.f, 0.f, 0.f, 0.f};
    f32x2v dlog = {0.f, 0.f};
    for (int n = 0; n < 8; ++n) {
#pragma unroll
        for (int i = 0; i < 2; ++i) *(LAS v4u*)(lds + H2_RAWLF + (lr + 32 * i) * 272 + lc * 16) = rl[i];
#pragma unroll
        for (int e = 0; e < 4; ++e) { const unsigned w0 = rv[0][e], w1 = rv[1][e];
            *(LAS unsigned*)(lds + H2_VT + (8 * vc + 2 * e) * 144 + lp * 4) = (w0 & 0xffffu) | (w1 << 16);
            *(LAS unsigned*)(lds + H2_VT + (8 * vc + 2 * e + 1) * 144 + lp * 4) = (w0 >> 16) | (w1 & 0xffff0000u); }
        if (n + 1 < 8) H2_LOAD1(n + 1);
        __syncthreads();
        float lfa[8], lfb[8]; f32x2v av[8]; f32x2v run = {0.f, 0.f};
#pragma unroll
        for (int j = 0; j < 8; ++j) { const unsigned w = *(const LAS unsigned*)(lds + H2_RAWLF + (8 * s8 + j) * 272 + cp * 4);
            lfa[j] = bflo(w); lfb[j] = bfhi(w); run = run + (f32x2v){lfa[j], lfb[j]}; av[j] = run; }
        *(LAS f32x2v*)(lds + H2_SEG + (s8 * 128 + 2 * cp) * 4) = run;
        __syncthreads();
        {
            f32x2v sg_[8];
#pragma unroll
            for (int q = 0; q < 8; ++q) sg_[q] = *(const LAS f32x2v*)(lds + H2_SEG + (q * 128 + 2 * cp) * 4);
            const f32x2v amid2 = (sg_[0] + sg_[1]) + (sg_[2] + sg_[3]);
            const f32x2v atot2 = amid2 + ((sg_[4] + sg_[5]) + (sg_[6] + sg_[7]));
            f32x2v off2 = -amid2;
#pragma unroll
            for (int q = 0; q < 7; ++q) { const float mq = (q < s8) ? 1.0f : 0.0f; off2 = off2 + sg_[q] * mq; }
            unsigned kta[4], ktb[4];
#pragma unroll
            for (int j = 0; j < 8; ++j) {
                const f32x2v aa = off2 + av[j];
                const unsigned kba = f2bf((1.0f - ex2(lfa[j])) * ex2(-aa.x)), kbb = f2bf((1.0f - ex2(lfb[j])) * ex2(-aa.y));
                if (j & 1) { kta[j >> 1] |= kba << 16; ktb[j >> 1] |= kbb << 16; } else { kta[j >> 1] = kba; ktb[j >> 1] = kbb; }
            }
            *(LAS v4u*)(lds + H2_KT + (2 * cp) * 144 + s8 * 16) = (v4u){kta[0], kta[1], kta[2], kta[3]};
            *(LAS v4u*)(lds + H2_KT + (2 * cp + 1) * 144 + s8 * 16) = (v4u){ktb[0], ktb[1], ktb[2], ktb[3]};
            if (s8 == 0) { *(LAS f32x2v*)(lds + H2_SA + (2 * cp) * 4) = (f32x2v){ex2(amid2.x), ex2(amid2.y)};
                           *(LAS f32x2v*)(lds + H2_SB + (2 * cp) * 4) = (f32x2v){ex2(atot2.x - amid2.x), ex2(atot2.y - amid2.y)}; dlog = dlog + atot2; }
        }
        __syncthreads();
        {
            const f32x4 sa = *(const LAS f32x4*)(lds + H2_SA + (16 * wave + 4 * fq) * 4), sb = *(const LAS f32x4*)(lds + H2_SB + (16 * wave + 4 * fq) * 4);
            bf16x8 x[2];
#pragma unroll
            for (int ks = 0; ks < 2; ++ks) x[ks] = *(const LAS bf16x8*)(lds + H2_KT + (16 * wave + fr) * 144 + ks * 64 + fq * 16);
#pragma unroll
            for (int t = 0; t < 8; ++t) { S[t] = S[t] * sa;
#pragma unroll
                for (int ks = 0; ks < 2; ++ks) { const bf16x8 y = *(const LAS bf16x8*)(lds + H2_VT + (16 * t + fr) * 144 + ks * 64 + fq * 16);
                    S[t] = __builtin_amdgcn_mfma_f32_16x16x32_bf16(x[ks], y, S[t], 0, 0, 0); }
                S[t] = S[t] * sb; }
        }
        __syncthreads();
    }
    float* E = Ebuf + (size_t)inst * 16384;
#pragma unroll
    for (int t = 0; t < 8; ++t) *(GAS f32x4*)(E + ((wave * 8 + t) * 64 + lane) * 4) = S[t];
    if (s8 == 0) *(GAS f32x2v*)(Dbuf + (size_t)inst * 128 + 2 * cp) = dlog;
#undef H2_LOAD1
}

__device__ __forceinline__ void hg2_out_pass(LAS unsigned char* lds, const bf16* P, bf16* ob, const float* Ebuf, const float* Dbuf, int inst, int tid, int lane, int wave) {
    const Hg2Inst I = hg2_decode(inst); const int row0 = I.row0, L = I.L, h = I.h, dir = I.dir;
    const int fr = lane & 15, fq = lane >> 4, cp = lane, s8 = wave;
    const bf16* gq = P + COL_Q + h * 128;
    const bf16* gl = P + (dir ? COL_FB : COL_FF) + h * 128;
    const bf16* gv = P + COL_I + h * 128;
    bf16* go = ob + h * 128;
    const int lr = tid >> 4, lc = tid & 15, vc = 4 * (wave & 3) + (lane & 3), lp = 16 * (wave >> 2) + (lane >> 2);
    const int p0 = 512 * I.sc;
#define H2_LOAD2(n) do { _Pragma("unroll") for (int i_ = 0; i_ < 2; ++i_) { const size_t ro_ = (size_t)H2_TOKROW(p0 + 64 * (n) + lr + 32 * i_) * DIN + 8 * lc; rl[i_] = *(const GAS v4u*)(gl + ro_); rq[i_] = *(const GAS v4u*)(gq + ro_); \
        rv[i_] = *(const GAS v4u*)(gv + (size_t)H2_TOKROW(p0 + 64 * (n) + 2 * lp + i_) * DIN + 8 * vc); } } while (0)
    v4u rl[2], rq[2], rv[2];
    H2_LOAD2(0);
    f32x4 S[8];
#pragma unroll
    for (int t = 0; t < 8; ++t) S[t] = (f32x4){0.f, 0.f, 0.f, 0.f};
    for (int j = 0; j < I.sc; ++j) {
        const int ij = hg2_index(I.seqid, h, dir, j);
        const f32x4 dl = *(const GAS f32x4*)(Dbuf + (size_t)ij * 128 + 16 * wave + 4 * fq);
        const f32x4 dec = {ex2(dl[0]), ex2(dl[1]), ex2(dl[2]), ex2(dl[3])};
        const float* E = Ebuf + (size_t)ij * 16384;
#pragma unroll
        for (int t = 0; t < 8; ++t) S[t] = S[t] * dec + *(const GAS f32x4*)(E + ((wave * 8 + t) * 64 + lane) * 4);
    }
    for (int n = 0; n < 8; ++n) {
#pragma unroll
        for (int i = 0; i < 2; ++i) { *(LAS v4u*)(lds + H2_RAWLF + (lr + 32 * i) * 272 + lc * 16) = rl[i]; *(LAS v4u*)(lds + H2_RAWQ + (lr + 32 * i) * 272 + lc * 16) = rq[i]; }
#pragma unroll
        for (int e = 0; e < 4; ++e) { const unsigned w0 = rv[0][e], w1 = rv[1][e];
            *(LAS unsigned*)(lds + H2_VT + (8 * vc + 2 * e) * 144 + lp * 4) = (w0 & 0xffffu) | (w1 << 16);
            *(LAS unsigned*)(lds + H2_VT + (8 * vc + 2 * e + 1) * 144 + lp * 4) = (w0 >> 16) | (w1 & 0xffff0000u); }
        if (n + 1 < 8) H2_LOAD2(n + 1);
        __syncthreads();
        float lfa[8], lfb[8]; f32x2v av[8]; f32x2v run = {0.f, 0.f};
#pragma unroll
        for (int j = 0; j < 8; ++j) { const unsigned w = *(const LAS unsigned*)(lds + H2_RAWLF + (8 * s8 + j) * 272 + cp * 4);
            lfa[j] = bflo(w); lfb[j] = bfhi(w); run = run + (f32x2v){lfa[j], lfb[j]}; av[j] = run; }
        *(LAS f32x2v*)(lds + H2_SEG + (s8 * 128 + 2 * cp) * 4) = run;
        __syncthreads();
        {
            f32x2v sg_[8];
#pragma unroll
            for (int q = 0; q < 8; ++q) sg_[q] = *(const LAS f32x2v*)(lds + H2_SEG + (q * 128 + 2 * cp) * 4);
            const f32x2v amid2 = (sg_[0] + sg_[1]) + (sg_[2] + sg_[3]);
            const f32x2v atot2 = amid2 + ((sg_[4] + sg_[5]) + (sg_[6] + sg_[7]));
            f32x2v off2 = -amid2;
#pragma unroll
            for (int q = 0; q < 7; ++q) { const float mq = (q < s8) ? 1.0f : 0.0f; off2 = off2 + sg_[q] * mq; }
            unsigned kta[4], ktb[4];
#pragma unroll
            for (int j = 0; j < 8; ++j) {
                const f32x2v aa = off2 + av[j];
                const unsigned qw = *(const LAS unsigned*)(lds + H2_RAWQ + (8 * s8 + j) * 272 + cp * 4);
                const float qta = bflo(qw) * ex2(aa.x), qtb = bfhi(qw) * ex2(aa.y);
                const unsigned kba = f2bf((1.0f - ex2(lfa[j])) * ex2(-aa.x)), kbb = f2bf((1.0f - ex2(lfb[j])) * ex2(-aa.y));
                *(LAS unsigned*)(lds + H2_QN + (8 * s8 + j) * 272 + cp * 4) = pk2(qta, qtb);
                *(LAS unsigned*)(lds + H2_KN + (8 * s8 + j) * 272 + cp * 4) = kba | (kbb << 16);
                if (j & 1) { kta[j >> 1] |= kba << 16; ktb[j >> 1] |= kbb << 16; } else { kta[j >> 1] = kba; ktb[j >> 1] = kbb; }
            }
            *(LAS v4u*)(lds + H2_KT + (2 * cp) * 144 + s8 * 16) = (v4u){kta[0], kta[1], kta[2], kta[3]};
            *(LAS v4u*)(lds + H2_KT + (2 * cp + 1) * 144 + s8 * 16) = (v4u){ktb[0], ktb[1], ktb[2], ktb[3]};
            if (s8 == 0) { *(LAS f32x2v*)(lds + H2_SA + (2 * cp) * 4) = (f32x2v){ex2(amid2.x), ex2(amid2.y)};
                           *(LAS f32x2v*)(lds + H2_SB + (2 * cp) * 4) = (f32x2v){ex2(atot2.x - amid2.x), ex2(atot2.y - amid2.y)}; }
        }
        __syncthreads();
        {
            const f32x4 sa = *(const LAS f32x4*)(lds + H2_SA + (16 * wave + 4 * fq) * 4);
#pragma unroll
            for (int t = 0; t < 8; ++t) { S[t] = S[t] * sa; v2u w; w.x = pk2(S[t][0], S[t][1]); w.y = pk2(S[t][2], S[t][3]);
                *(LAS v2u*)(lds + H2_ST + (16 * t + fr) * 272 + (16 * wave + 4 * fq) * 2) = w; }
        }
        {
            const int ib = wave & 3, jp = wave >> 2;
#pragma unroll
            for (int t = 0; t < 2; ++t) {
                const int jb = 2 * jp + t;
                f32x4 sc = {0.f, 0.f, 0.f, 0.f};
                if (jb <= ib) {
#pragma unroll
                    for (int ks = 0; ks < 4; ++ks) {
                        const bf16x8 x = *(const LAS bf16x8*)(lds + H2_KN + (16 * jb + fr) * 272 + ks * 64 + fq * 16);
                        const bf16x8 y = *(const LAS bf16x8*)(lds + H2_QN + (16 * ib + fr) * 272 + ks * 64 + fq * 16);
                        sc = __builtin_amdgcn_mfma_f32_16x16x32_bf16(x, y, sc, 0, 0, 0);
                    }
                    if (jb == ib) {
#pragma unroll
                        for (int r = 0; r < 4; ++r) if (4 * fq + r > fr) sc[r] = 0.f;
                    }
                }
                v2u w; w.x = pk2(sc[0], sc[1]); w.y = pk2(sc[2], sc[3]);
                *(LAS v2u*)(lds + H2_SCL + (16 * ib + fr) * 144 + (16 * jb + 4 * fq) * 2) = w;
            }
        }
        __syncthreads();
        {
            const int ib2 = wave >> 1, dh = wave & 1;
            bf16x8 ys[2], yq[4];
#pragma unroll
            for (int ks = 0; ks < 2; ++ks) ys[ks] = *(const LAS bf16x8*)(lds + H2_SCL + (16 * ib2 + fr) * 144 + ks * 64 + fq * 16);
#pragma unroll
            for (int ks = 0; ks < 4; ++ks) yq[ks] = *(const LAS bf16x8*)(lds + H2_QN + (16 * ib2 + fr) * 272 + ks * 64 + fq * 16);
            const size_t orow = (size_t)H2_TOKROW(p0 + 64 * n + 16 * ib2 + fr) * 512;
#pragma unroll
            for (int t = 0; t < 4; ++t) {
                const int db = 4 * dh + t;
                f32x4 O = {0.f, 0.f, 0.f, 0.f};
#pragma unroll
                for (int ks = 0; ks < 2; ++ks) { const bf16x8 x = *(const LAS bf16x8*)(lds + H2_VT + (16 * db + fr) * 144 + ks * 64 + fq * 16); O = __builtin_amdgcn_mfma_f32_16x16x32_bf16(x, ys[ks], O, 0, 0, 0); }
#pragma unroll
                for (int ks = 0; ks < 4; ++ks) { const bf16x8 x = *(const LAS bf16x8*)(lds + H2_ST + (16 * db + fr) * 272 + ks * 64 + fq * 16); O = __builtin_amdgcn_mfma_f32_16x16x32_bf16(x, yq[ks], O, 0, 0, 0); }
                { v2u w; w.x = pk2(O[0], O[1]); w.y = pk2(O[2], O[3]); *(GAS v2u*)(go + orow + 16 * db + 4 * fq) = w; }
            }
        }
        {
            const f32x4 sb = *(const LAS f32x4*)(lds + H2_SB + (16 * wave + 4 * fq) * 4);
            bf16x8 x[2];
#pragma unroll
            for (int ks = 0; ks < 2; ++ks) x[ks] = *(const LAS bf16x8*)(lds + H2_KT + (16 * wave + fr) * 144 + ks * 64 + fq * 16);
#pragma unroll
            for (int t = 0; t < 8; ++t) {
#pragma unroll
                for (int ks = 0; ks < 2; ++ks) { const bf16x8 y = *(const LAS bf16x8*)(lds + H2_VT + (16 * t + fr) * 144 + ks * 64 + fq * 16);
                    S[t] = __builtin_amdgcn_mfma_f32_16x16x32_bf16(x[ks], y, S[t], 0, 0, 0); }
                S[t] = S[t] * sb; }
        }
        __syncthreads();
    }
#undef H2_LOAD2
}

#ifdef DBG_NAIVE_HGRN
__device__ __forceinline__ void naive_hgrn_item(LAS unsigned char* lds, const bf16* P, float* ob, int row0, int L, int h, int dir, int tid) {
    LAS float* LQ = (LAS float*)lds; LAS float* LF = LQ + 2048; LAS float* LK = LF + 2048;
    const unsigned short* Pu = (const unsigned short*)P;
    float S[128];
#pragma unroll
    for (int k = 0; k < 128; ++k) S[k] = 0.f;
    for (int t0 = 0; t0 < L; t0 += 16) {
        __syncthreads();
#pragma unroll
        for (int i = 0; i < 4; ++i) { const int idx = tid + 512 * i, st = idx >> 7, k = idx & 127; const size_t row = (size_t)(row0 + (dir ? (L - 1 - (t0 + st)) : (t0 + st)));
            const float qv = bf1(Pu[row * DIN + COL_Q + h * 128 + k]), l2 = bf1(Pu[row * DIN + (dir ? COL_FB : COL_FF) + h * 128 + k]), f = exp2f(l2);
            LQ[st * 128 + k] = qv; LF[st * 128 + k] = f; LK[st * 128 + k] = 1.0f - f; }
        __syncthreads();
        if (tid < 128) {
#pragma unroll 1
            for (int st = 0; st < 16; ++st) { const size_t row = (size_t)(row0 + (dir ? (L - 1 - (t0 + st)) : (t0 + st)));
                const float v = bf1(Pu[row * DIN + COL_I + h * 128 + tid]); float o = 0.f;
#pragma unroll
                for (int k4 = 0; k4 < 32; ++k4) { const f32x4 f4 = *(const LAS f32x4*)(LF + st * 128 + 4 * k4), k4v = *(const LAS f32x4*)(LK + st * 128 + 4 * k4), q4 = *(const LAS f32x4*)(LQ + st * 128 + 4 * k4);
#pragma unroll
                    for (int e = 0; e < 4; ++e) { S[4 * k4 + e] = f4[e] * S[4 * k4 + e] + k4v[e] * v; o += q4[e] * S[4 * k4 + e]; } }
                ob[row * 512 + h * 128 + tid] = o; }
        }
    }
    __syncthreads();
}
#endif
__device__ __forceinline__ void hgrn_combine(const bf16* ob0, const bf16* ob1, const bf16* P, const float* onorm, const float* ssg, const float* gon, bf16* Y, int gw, int NGW, int lane) {
    const int c = 8 * lane;
    const f32x4 g0 = *(const GAS f32x4*)(onorm + c), g1 = *(const GAS f32x4*)(onorm + c + 4);
    const f32x4 n0 = *(const GAS f32x4*)(gon + c), n1 = *(const GAS f32x4*)(gon + c + 4);
    for (int m = gw; m < TOK; m += NGW) {
        const v4u aw = *(const GAS v4u*)(ob0 + (size_t)m * 512 + c), bw = *(const GAS v4u*)(ob1 + (size_t)m * 512 + c);
        const f32x4 a0 = {bflo(aw.x), bfhi(aw.x), bflo(aw.y), bfhi(aw.y)}, a1 = {bflo(aw.z), bfhi(aw.z), bflo(aw.w), bfhi(aw.w)};
        const f32x4 b0 = {bflo(bw.x), bfhi(bw.x), bflo(bw.y), bfhi(bw.y)}, b1 = {bflo(bw.z), bfhi(bw.z), bflo(bw.w), bfhi(bw.w)};
        const v4u sgw = *(const GAS v4u*)(P + (size_t)m * DIN + COL_G + c);
#ifdef DBG_PCOPY
        f32x4 o0 = {0.f,0.f,0.f,0.f}, o1 = o0;
        { const int segs[4] = {COL_Q, COL_I, COL_FF, COL_FB};
#pragma unroll
          for (int q_ = 0; q_ < 4; ++q_) { const v4u pw = *(const GAS v4u*)(P + (size_t)m * DIN + segs[q_] + c);
            o0 += (f32x4){bflo(pw.x), bfhi(pw.x), bflo(pw.y), bfhi(pw.y)}; o1 += (f32x4){bflo(pw.z), bfhi(pw.z), bflo(pw.w), bfhi(pw.w)}; } }
#else
        const f32x4 o0 = a0 + b0, o1 = a1 + b1;
#endif
        float s = ((o0[0] * o0[0] + o0[1] * o0[1]) + (o0[2] * o0[2] + o0[3] * o0[3])) + ((o1[0] * o1[0] + o1[1] * o1[1]) + (o1[2] * o1[2] + o1[3] * o1[3]));
        s += __shfl_xor(s, 1); s += __shfl_xor(s, 2); s += __shfl_xor(s, 4); s += __shfl_xor(s, 8);
        const float r = rsq(s * (1.0f / 128.0f) + EPS);
        const f32x4 y0 = o0 * r * g0 * (f32x4){bflo(sgw.x), bfhi(sgw.x), bflo(sgw.y), bfhi(sgw.y)};
        const f32x4 y1 = o1 * r * g1 * (f32x4){bflo(sgw.z), bfhi(sgw.z), bflo(sgw.w), bfhi(sgw.w)};
        v4u w; w.x = pk2(y0[0], y0[1]); w.y = pk2(y0[2], y0[3]); w.z = pk2(y1[0], y1[1]); w.w = pk2(y1[2], y1[3]);
        *(GAS v4u*)(Y + (size_t)m * DMODEL + 512 + c) = w;
#ifndef NO_GMLP
        const f32x4 sv = *(const GAS f32x4*)(ssg + (size_t)m * 4);
        const float rg = rsq(((sv[0] + sv[1]) + (sv[2] + sv[3])) * (1.0f / 512.0f) + EPS);
        const v4u yw = *(const GAS v4u*)(Y + (size_t)m * DMODEL + c);
        const f32x4 z0 = (f32x4){bflo(yw.x), bfhi(yw.x), bflo(yw.y), bfhi(yw.y)} * rg * n0, z1 = (f32x4){bflo(yw.z), bfhi(yw.z), bflo(yw.w), bfhi(yw.w)} * rg * n1;
        v4u zw; zw.x = pk2(z0[0], z0[1]); zw.y = pk2(z0[2], z0[3]); zw.z = pk2(z1[0], z1[1]); zw.w = pk2(z1[2], z1[3]);
        *(GAS v4u*)(Y + (size_t)m * DMODEL + c) = zw;
#endif
    }
}

constexpr int GM_RAWV = 0, GM_VLT = 34816, GM_WL = 69632, GM_MEAN = 104448, GM_RSTD = 104960, GM_END = 105472;
static_assert(GM_END <= RING_BYTES, "gmlp LDS");
__device__ __forceinline__ void gmlp_item(LAS unsigned char* lds, const bf16* P, bf16* Y, float* ssg, const float* ln_g, const float* ln_b, const float* w_s, const float* b_s, int c, int h, int tid, int lane, int wave) {
    const int fr = lane & 15, fq = lane >> 4, R0 = 128 * c;
#pragma unroll 1
    for (int jj = 0; jj < 4; ++jj) {
        float sm[4], sq[4];
#pragma unroll
        for (int j = 0; j < 4; ++j) {
            const int s = 16 * wave + 4 * jj + j;
            const v4u raw = *(const GAS v4u*)(P + (size_t)(R0 + s) * DIN + COL_V + 8 * lane);
            const float x0 = bflo(raw.x), x1 = bfhi(raw.x), x2 = bflo(raw.y), x3 = bfhi(raw.y), x4 = bflo(raw.z), x5 = bfhi(raw.z), x6 = bflo(raw.w), x7 = bfhi(raw.w);
            sm[j] = ((x0 + x1) + (x2 + x3)) + ((x4 + x5) + (x6 + x7));
            sq[j] = ((x0 * x0 + x1 * x1) + (x2 * x2 + x3 * x3)) + ((x4 * x4 + x5 * x5) + (x6 * x6 + x7 * x7));
        }
#pragma unroll
        for (int o = 1; o < 64; o <<= 1) {
#pragma unroll
            for (int j = 0; j < 4; ++j) { sm[j] += __shfl_xor(sm[j], o); sq[j] += __shfl_xor(sq[j], o); }
        }
        if (lane == 0) {
#pragma unroll
            for (int j = 0; j < 4; ++j) { const int s = 16 * wave + 4 * jj + j; const float mean = sm[j] * (1.0f / 512.0f), var = fmaxf(sq[j] * (1.0f / 512.0f) - mean * mean, 0.f);
                *(LAS float*)(lds + GM_MEAN + s * 4) = mean; *(LAS float*)(lds + GM_RSTD + s * 4) = rsq(var + EPS); }
        }
    }
#pragma unroll
    for (int i = 0; i < 4; ++i) { const int idx = tid + 512 * i, row = idx >> 4, c16 = idx & 15;
        *(LAS v4u*)(lds + GM_RAWV + row * 272 + c16 * 16) = *(const GAS v4u*)(P + (size_t)(R0 + row) * DIN + COL_V + 128 * h + 8 * c16); }
#pragma unroll
    for (int i = 0; i < 8; ++i) { const int idx = tid + 512 * i, tt = idx >> 5, s4 = idx & 31;
        const f32x4 w = *(const GAS f32x4*)(w_s + (size_t)h * 16384 + tt * 128 + 4 * s4);
        v2u o; o.x = pk2(w[0], w[1]); o.y = pk2(w[2], w[3]);
        *(LAS v2u*)(lds + GM_WL + tt * 272 + s4 * 8) = o; }
    __syncthreads();
    {
        const int ch = tid & 127, sq4 = tid >> 7;
        const float g = ln_g[128 * h + ch], b = ln_b[128 * h + ch];
#pragma unroll
        for (int i = 0; i < 4; ++i) {
            unsigned wv[4];
#pragma unroll
            for (int e = 0; e < 8; ++e) { const int s = 32 * sq4 + 8 * i + e;
                const float x = bf1(*(const LAS unsigned short*)(lds + GM_RAWV + s * 272 + ch * 2));
                const float y = (x - *(const LAS float*)(lds + GM_MEAN + s * 4)) * *(const LAS float*)(lds + GM_RSTD + s * 4) * g + b;
                const unsigned yb = f2bf(y);
                if (e & 1) wv[e >> 1] |= yb << 16; else wv[e >> 1] = yb; }
            *(LAS v4u*)(lds + GM_VLT + ch * 272 + (32 * sq4 + 8 * i) * 2) = (v4u){wv[0], wv[1], wv[2], wv[3]};
        }
    }
    __syncthreads();
    const int t = 16 * wave + fr;
    bf16x8 yf[4];
#pragma unroll
    for (int ks = 0; ks < 4; ++ks) yf[ks] = *(const LAS bf16x8*)(lds + GM_WL + (16 * wave + fr) * 272 + ks * 64 + fq * 16);
    const float bs = b_s[h * 128 + t];
    float ss = 0.f;
#pragma unroll
    for (int cb = 0; cb < 8; ++cb) {
        f32x4 a = {0.f, 0.f, 0.f, 0.f};
#pragma unroll
        for (int ks = 0; ks < 4; ++ks) {
            const bf16x8 x = *(const LAS bf16x8*)(lds + GM_VLT + (16 * cb + fr) * 272 + ks * 64 + fq * 16);
            a = __builtin_amdgcn_mfma_f32_16x16x32_bf16(x, yf[ks], a, 0, 0, 0);
        }
        const int ch = 128 * h + 16 * cb + 4 * fq;
        const v2u uw = *(const GAS v2u*)(P + (size_t)(R0 + t) * DIN + COL_U + ch);
        const f32x4 uu = {bflo(uw.x), bfhi(uw.x), bflo(uw.y), bfhi(uw.y)};
        a = (a + bs) * uu;
        ss += (a[0] * a[0] + a[1] * a[1]) + (a[2] * a[2] + a[3] * a[3]);
        v2u w; w.x = pk2(a[0], a[1]); w.y = pk2(a[2], a[3]);
        *(GAS v2u*)(Y + (size_t)(R0 + t) * DMODEL + ch) = w;
    }
    ss += __shfl_xor(ss, 16); ss += __shfl_xor(ss, 32);
    if (fq == 0) ssg[(size_t)(R0 + t) * 4 + h] = ss;
    __syncthreads();
}

struct Args { const float* in[22]; float* out; unsigned char* ws; int ph_lo, ph_hi, li, pad; };
constexpr int N_PHASES = 11;
#ifndef MK_N_LAUNCHES
#define MK_N_LAUNCHES 1
#endif
#ifndef DUP_PHASE
#define DUP_PHASE (-1)
#endif
__global__ void __launch_bounds__(NWAVES * 64, 2) fwd_kernel(Args args) {
    extern __shared__ __attribute__((aligned(16))) unsigned char lds_raw[];
    LAS unsigned char* lds = (LAS unsigned char*)lds_raw;
    volatile LAS unsigned* MISC = (volatile LAS unsigned*)(lds + MISC_OFF);
    const int tid = threadIdx.x, lane = tid & 63, wave = __builtin_amdgcn_readfirstlane(tid >> 6);
    const int G = gridDim.x, bx = blockIdx.x;
    const int vcu = (G % 8 == 0) ? (bx % 8) * (G / 8) + bx / 8 : bx;
    const int gw = vcu * NWAVES + wave, NGW = G * NWAVES;
    unsigned char* ws = args.ws;
    gu32* ctl = (gu32*)(ws + WS_CTL);
    for (int u = tid; u < (LDS_BYTES - LDSCTL_OFF) / 4; u += NWAVES * 64) ((LAS unsigned*)(lds + LDSCTL_OFF))[u] = 0u;
    __syncthreads();
    XcdBarrier bar = xcd_barrier_post((unsigned*)(ctl + CW_BAR) + args.li * XCD_BAR_WORDS, MISC + 8);
    const int lo = args.ph_lo, hi = args.ph_hi;
#define IN(k) (lo <= (k) && (k) < hi)
#define SEAM(k) do { if (IN(k) && IN((k) + 1)) xcd_barrier(bar); } while (0)
    bf16* XB = (bf16*)(ws + WS_BUFA); bf16* Y = (bf16*)(ws + WS_BUFB); bf16* BIG = (bf16*)(ws + WS_BIG);
    bf16* OB0 = (bf16*)args.out; bf16* OB1 = (bf16*)args.out + (size_t)TOK * 512;
    float* SSG = (float*)(ws + WS_SSG); float* HGE = (float*)(ws + WS_HGE); float* HGD = (float*)(ws + WS_HGD);
    float* P16_0 = (float*)(ws + WS_P16); float* P16_1 = (float*)(ws + WS_P16 + 2 * MiB); float* P16_2 = (float*)(ws + WS_P16 + 4 * MiB);

    for (int rep_ = 0; rep_ < ((DUP_PHASE == 0) ? 2 : 1); ++rep_) if (IN(0)) { p0_prologue(lds, args.in, ws, gw, NGW, wave, lane); }
    SEAM(0);
#define PHASE1 if (IN(1)) { pg8::Gemm g{XB, (const bf16*)(ws + WS_WGU1), TOK, 2 * DFF, DMODEL}; pg8::StaticOrder S; S.init(TOK, 2 * DFF, G, bx); \
        pg8::EpiSwiGLU E{BIG, DFF, P16_0}; pg8::gemm_phase<pg8::EpiSwiGLU, pg8::StaticOrder, PG8_ALIGN, PG8_SP2>(lds + RING_OFF, g, S, E); }
    PHASE1
#if DUP_PHASE == 1
    PHASE1
#endif
    SEAM(1);
#define PHASE2 if (IN(2)) { pg8::Gemm g{BIG, (const bf16*)(ws + WS_WD1), TOK, DMODEL, DFF}; pg8::StaticOrder S; S.init(TOK, DMODEL, G, bx); \
        pg8::EpiResidBf<true> E{XB, P16_1, 0.5f}; pg8::gemm_phase<pg8::EpiResidBf<true>, pg8::StaticOrder, PG8_ALIGN, PG8_SP2>(lds + RING_OFF, g, S, E); }
    PHASE2
#if DUP_PHASE == 2
    PHASE2
#endif
#if DUP_PHASE == 20
    if (IN(2)) { pg8::Gemm g{BIG, (const bf16*)(ws + WS_WD1), TOK, DMODEL, DFF}; pg8::StaticOrder S; S.init(TOK, DMODEL, G, bx);
        pg8::EpiNull E{SSG}; pg8::gemm_phase<pg8::EpiNull, pg8::StaticOrder, PG8_ALIGN, PG8_SP2>(lds + RING_OFF, g, S, E); }
#endif
#if DUP_PHASE == 10
    if (IN(2)) { pg8::Gemm g{XB, (const bf16*)(ws + WS_WGU1), TOK, 2 * DFF, DMODEL}; pg8::StaticOrder S; S.init(TOK, 2 * DFF, G, bx);
        pg8::EpiNull E{SSG}; pg8::gemm_phase<pg8::EpiNull, pg8::StaticOrder, PG8_ALIGN, PG8_SP2>(lds + RING_OFF, g, S, E); }
#endif
    SEAM(2);
#define PHASE3 if (IN(3)) { pg8::Gemm g{XB, (const bf16*)(ws + WS_WIN), TOK, DIN, DMODEL}; pg8::StaticOrder S; S.init(TOK, DIN, G, bx); \
        pg8::EpiMix E{BIG, DIN, P16_1, args.in[13], args.in[14]}; pg8::gemm_phase<pg8::EpiMix, pg8::StaticOrder, PG8_ALIGN, PG8_SP2>(lds + RING_OFF, g, S, E); }
    PHASE3
#if DUP_PHASE == 3
    PHASE3
#endif
    SEAM(3);
    for (int rep_ = 0; rep_ < ((DUP_PHASE == 4 || DUP_PHASE == 40 || DUP_PHASE == 41) ? 2 : 1); ++rep_) if (IN(4)) {
        if (rep_ == 0 || DUP_PHASE != 41) for (int i = bx; i < 512; i += G) hg2_state_pass(lds, BIG, HGE, HGD, i, tid, lane, wave);
        if (rep_ == 0 || DUP_PHASE != 40) for (int it = bx; it < 1024; it += G) gmlp_item(lds, BIG, Y, SSG, args.in[8], args.in[9], args.in[10], args.in[11], it >> 2, it & 3, tid, lane, wave);
    }
    SEAM(4);
    for (int rep_ = 0; rep_ < ((DUP_PHASE == 5) ? 2 : 1); ++rep_) if (IN(5)) {
        for (int i = bx; i < 512; i += G) { const Hg2Inst I = hg2_decode(i); hg2_out_pass(lds, BIG, I.dir ? OB1 : OB0, HGE, HGD, i, tid, lane, wave); }
    }
    SEAM(5);
    if (IN(6)) { hgrn_combine(OB0, OB1, BIG, args.in[15], SSG, args.in[12], Y, gw, NGW, lane); }
    SEAM(6);
    if (IN(7)) { pg8::Gemm g{Y, (const bf16*)(ws + WS_WOUT), TOK, DMODEL, DMODEL}; pg8::StaticOrder S; S.init(TOK, DMODEL, G, bx);
        pg8::EpiResidBf<true> E{XB, P16_2, 1.0f};
        pg8::gemm_phase<pg8::EpiResidBf<true>, pg8::StaticOrder, PG8_ALIGN, PG8_SP2>(lds + RING_OFF, g, S, E); }
    SEAM(7);
    if (IN(8)) { pg8::Gemm g{XB, (const bf16*)(ws + WS_WGU2), TOK, 2 * DFF, DMODEL}; pg8::StaticOrder S; S.init(TOK, 2 * DFF, G, bx);
        pg8::EpiSwiGLU E{BIG, DFF, P16_2};
        pg8::gemm_phase<pg8::EpiSwiGLU, pg8::StaticOrder, PG8_ALIGN, PG8_SP2>(lds + RING_OFF, g, S, E); }
    SEAM(8);
    if (IN(9)) { pg8::Gemm g{BIG, (const bf16*)(ws + WS_WD2), TOK, DMODEL, DFF}; pg8::StaticOrder S; S.init(TOK, DMODEL, G, bx);
        pg8::EpiResidBf<false> E{XB, nullptr, 0.5f};
        pg8::gemm_phase<pg8::EpiResidBf<false>, pg8::StaticOrder, PG8_ALIGN, PG8_SP2>(lds + RING_OFF, g, S, E); }
    SEAM(9);
    if (IN(10)) { final_norm(XB, args.out, args.in[21], gw, NGW, lane); }
#undef IN
#undef SEAM
}

extern "C" void kernel_launch(void* const* d_in, const int* in_sizes, int n_in, void* d_out, int out_size, void* d_ws, size_t ws_size, hipStream_t stream) {
    static int grid = 0;
    if (grid == 0) {
        if (n_in != 22 || out_size != TOK * DMODEL || ws_size < WS_END) { fprintf(stderr, "kernel_launch: unexpected problem (n_in %d, out %d, ws %zu); nothing launched\n", n_in, out_size, ws_size); grid = -1; return; }
        int dev = 0, cus = 0, per_cu = 0;
        if (hipGetDevice(&dev) != hipSuccess || hipDeviceGetAttribute(&cus, hipDeviceAttributeMultiprocessorCount, dev) != hipSuccess) { grid = -1; return; }
        if (hipFuncSetAttribute((const void*)fwd_kernel, hipFuncAttributeMaxDynamicSharedMemorySize, LDS_BYTES) != hipSuccess) { fprintf(stderr, "kernel_launch: hipFuncSetAttribute failed\n"); grid = -1; return; }
        if (hipOccupancyMaxActiveBlocksPerMultiprocessor(&per_cu, (const void*)fwd_kernel, NWAVES * 64, LDS_BYTES) != hipSuccess || per_cu < 1) { fprintf(stderr, "kernel_launch: occupancy query says %d blocks per CU; nothing launched\n", per_cu); (void)hipGetLastError(); grid = -1; return; }
        grid = cus;
    }
    if (grid < 0) return;
    if (hipMemsetAsync((char*)d_ws + WS_CTL, 0, CTL_ZERO_BYTES, stream) != hipSuccess) return;
    Args a{};
    for (int i = 0; i < 22; ++i) a.in[i] = (const float*)d_in[i];
    a.out = (float*)d_out; a.ws = (unsigned char*)d_ws;
    constexpr int NL = MK_N_LAUNCHES;
    for (int li = 0; li < NL; ++li) {
        a.ph_lo = (NL == 1) ? 0 : li; a.ph_hi = (NL == 1) ? N_PHASES : li + 1; a.li = 0;
        hipLaunchKernelGGL(fwd_kernel, dim3(grid), dim3(NWAVES * 64), LDS_BYTES, stream, a);
        if (hipPeekAtLastError() != hipSuccess) { fprintf(stderr, "kernel_launch: launch %d failed\n", li); break; }
    }
}
```

```cpp
#include <hip/hip_runtime.h>
#include <cstdio>
#include <cstdint>
namespace pg8 {
#define PG8_LAS __attribute__((address_space(3)))
typedef unsigned short bf16_t;
typedef short bf16x8 __attribute__((ext_vector_type(8)));
typedef float f32x4 __attribute__((ext_vector_type(4)));
typedef unsigned u32x4 __attribute__((ext_vector_type(4)));
constexpr int BM = 256, BK = 64, HALF = 128, HTB = HALF * BK * 2  , STAGE_BYTES = 8 * HTB, NXCD = 8, WGM = 8;

__host__ __device__ __forceinline__ int lds_byte(int r, int c) { const int st = (r >> 4) * 2 + (c >> 5), rr = r & 15, cc = c & 31, ob = rr * 64 + cc * 2; return st * 1024 + (ob ^ (((ob >> 9) & 1) << 5)); }
__host__ __device__ __forceinline__ void stage_rc(int b, int& R, int& C) { const int st = b / 1024, sb = b % 1024, swz = sb ^ (((sb >> 9) & 1) << 5); R = (st >> 1) * 16 + swz / 64; C = (st & 1) * 32 + (swz % 64) / 2; }
__host__ __device__ __forceinline__ int perm32(int rho) { const int n = rho >> 4, i = rho & 15; return 8 * (i >> 2) + 4 * n + (i & 3); }

struct Unit { int pm, pn; };
struct Gemm { const bf16_t* A; const bf16_t* Bt; int M, N, K; };

struct StaticOrder {
    int nM, nN, nwg, G, c;
    __host__ __device__ void init(int M, int N, int G_, int c_) { nM = M / BM; nN = N / BM; nwg = nM * nN; G = G_; c = c_; }
    __host__ __device__ bool next(int i, Unit& u) const {
        const long L = (long)i * G + c; if (L >= nwg) return false;
        int wgid = (int)L; { const int q = nwg / NXCD, r = nwg % NXCD, xcd = wgid % NXCD, off = wgid / NXCD; wgid = (xcd < r ? xcd * (q + 1) : r * (q + 1) + (xcd - r) * q) + off; }
        const int nig = WGM * nN, gid = wgid / nig, fm = gid * WGM, gsz = (nM - fm) < WGM ? (nM - fm) : WGM;
        u.pm = fm + ((wgid % nig) % gsz); u.pn = (wgid % nig) / gsz; return true;
    }
    __device__ __forceinline__ void a_ready(const Unit&) const {}
    __device__ __forceinline__ void done(const Unit&) const {}
};

typedef __bf16 bf16x2_hw __attribute__((ext_vector_type(2)));
typedef float f32x2_hw __attribute__((ext_vector_type(2)));
__device__ __forceinline__ unsigned cvt_pk_bf16(float lo, float hi) { const f32x2_hw v = {lo, hi}; const bf16x2_hw b = __builtin_convertvector(v, bf16x2_hw); return __builtin_bit_cast(unsigned, b); }
typedef float f32x2 __attribute__((ext_vector_type(2)));
__device__ __forceinline__ f32x2 gelu_pk(f32x2 v) {
    const f32x2 av = __builtin_elementwise_abs(v), d = av * 0.2316418882f + 1.0f;
    f32x2 t; t.x = __builtin_amdgcn_rcpf(d.x); t.y = __builtin_amdgcn_rcpf(d.y);
    f32x2 q = t * 0.5307027145f + (-0.7265760135f); q = q * t + 0.7107068705f; q = q * t + (-0.142248368f); q = q * t + 0.127414796f; q = q * t;
    const f32x2 s = (v * v) * (-0.72134752044f);
    f32x2 e; e.x = __builtin_amdgcn_exp2f(s.x); e.y = __builtin_amdgcn_exp2f(s.y);
    const f32x2 m = v * (q * e), r = v - m;
    f32x2 o; o.x = v.x < 0.f ? m.x : r.x; o.y = v.y < 0.f ? m.y : r.y; return o;
}

constexpr float RMS_EPS = 1e-6f;
constexpr int DM = 1024;
__device__ __forceinline__ float row_rstd(const float* p16, int row, int fq) {
    const f32x4 v = *(const f32x4*)(p16 + (size_t)row * 16 + 4 * fq);
    float s = (v[0] + v[1]) + (v[2] + v[3]);
    s += __shfl_xor(s, 16); s += __shfl_xor(s, 32);
    return __builtin_amdgcn_rsqf(s * (1.0f / DM) + RMS_EPS);
}
__device__ __forceinline__ void row_rstd8(const float* p16, int row0, int fq, float (&rr)[8]) {
    f32x4 pv[8];
#pragma unroll
    for (int i = 0; i < 8; ++i) pv[i] = *(const f32x4*)(p16 + (size_t)(row0 + (i >> 2) * HALF + (i & 3) * 16) * 16 + 4 * fq);
#pragma unroll
    for (int i = 0; i < 8; ++i) { float s = (pv[i][0] + pv[i][1]) + (pv[i][2] + pv[i][3]); s += __shfl_xor(s, 16); s += __shfl_xor(s, 32); rr[i] = __builtin_amdgcn_rsqf(s * (1.0f / DM) + RMS_EPS); }
}
__device__ __forceinline__ float fast_sigmoid(float z) { return __builtin_amdgcn_rcpf(1.0f + __builtin_amdgcn_exp2f(-1.44269504089f * z)); }

struct EpiSwiGLU {
    static constexpr bool PERM = true, AFTER_DRAIN = false;
    bf16_t* O; int ldo; const float* p16;
    __device__ __forceinline__ void operator()(const f32x4 (&acc)[2][2][4][2], const Unit& u, int wr, int wc, int fr, int fq) const {
        const int row0 = u.pm * BM + wr * 64 + fr, col0 = u.pn * HALF + wc * 32 + 8 * fq;
        float rr[8];
        row_rstd8(p16, row0, fq, rr);
#pragma unroll
        for (int ai = 0; ai < 2; ++ai)
#pragma unroll
            for (int m = 0; m < 4; ++m) {
                const int row = row0 + ai * HALF + m * 16;
                const float r = rr[ai * 4 + m];
                float h[8];
#pragma unroll
                for (int n = 0; n < 2; ++n)
#pragma unroll
                    for (int e = 0; e < 4; ++e) { const float g = acc[ai][0][m][n][e] * r, up = acc[ai][1][m][n][e] * r; h[4 * n + e] = g * up * fast_sigmoid(g); }
                u32x4 w; w.x = cvt_pk_bf16(h[0], h[1]); w.y = cvt_pk_bf16(h[2], h[3]); w.z = cvt_pk_bf16(h[4], h[5]); w.w = cvt_pk_bf16(h[6], h[7]);
                *(u32x4*)(O + (size_t)row * ldo + col0) = w;
            }
    }
};

template <bool WANT_BF16, bool WANT_SS> struct EpiResid {
    static constexpr bool PERM = true, AFTER_DRAIN = false;
    const float* base0; const float* base1;
    float* out; bf16_t* xb; float* p16; float alpha;
    __device__ __forceinline__ void operator()(const f32x4 (&acc)[2][2][4][2], const Unit& u, int wr, int wc, int fr, int fq) const {
        const int row0 = u.pm * BM + wr * 64 + fr, col0 = u.pn * BM + wc * 32 + 8 * fq;
        const float* bp = (u.pm < 64) ? base0 : base1; const int brow = (u.pm < 64) ? 0 : 16384;
        f32x4 bcur[4], bnxt[4];
#define RESID_LOAD(dst, it) do { const size_t bo_ = (size_t)(row0 + ((it) >> 2) * HALF + ((it) & 3) * 16 - brow) * DM + col0; \
            dst[0] = *(const f32x4*)(bp + bo_); dst[1] = *(const f32x4*)(bp + bo_ + 4); dst[2] = *(const f32x4*)(bp + bo_ + HALF); dst[3] = *(const f32x4*)(bp + bo_ + HALF + 4); } while (0)
        RESID_LOAD(bcur, 0);
#pragma unroll
        for (int it = 0; it < 8; ++it) {
            const int ai = it >> 2, m = it & 3;
            if (it + 1 < 8) RESID_LOAD(bnxt, it + 1);
            const int row = row0 + ai * HALF + m * 16; const size_t off = (size_t)row * DM + col0;
            float ss = 0.f;
#pragma unroll
            for (int bj = 0; bj < 2; ++bj) {
                const f32x4 v0 = bcur[2 * bj] + acc[ai][bj][m][0] * alpha, v1 = bcur[2 * bj + 1] + acc[ai][bj][m][1] * alpha;
                *(f32x4*)(out + off + bj * HALF) = v0; *(f32x4*)(out + off + bj * HALF + 4) = v1;
                if (WANT_BF16) { u32x4 w; w.x = cvt_pk_bf16(v0[0], v0[1]); w.y = cvt_pk_bf16(v0[2], v0[3]); w.z = cvt_pk_bf16(v1[0], v1[1]); w.w = cvt_pk_bf16(v1[2], v1[3]);
                    *(u32x4*)(xb + off + bj * HALF) = w; }
                if (WANT_SS) ss += ((v0[0] * v0[0] + v0[1] * v0[1]) + (v0[2] * v0[2] + v0[3] * v0[3])) + ((v1[0] * v1[0] + v1[1] * v1[1]) + (v1[2] * v1[2] + v1[3] * v1[3]));
            }
            if (WANT_SS) { ss += __shfl_xor(ss, 16); ss += __shfl_xor(ss, 32); if (fq == 0) p16[(size_t)row * 16 + 4 * u.pn + wc] = ss; }
#pragma unroll
            for (int q = 0; q < 4; ++q) bcur[q] = bnxt[q];
            asm volatile("" ::: "memory");
        }
#undef RESID_LOAD
    }
};

template <bool WANT_SS> struct EpiResidBf {
    static constexpr bool PERM = true, AFTER_DRAIN = false;
    bf16_t* xb; float* p16; float alpha;
    __device__ __forceinline__ void operator()(const f32x4 (&acc)[2][2][4][2], const Unit& u, int wr, int wc, int fr, int fq) const {
        const int row0 = u.pm * BM + wr * 64 + fr, col0 = u.pn * BM + wc * 32 + 8 * fq;
        u32x4 bcur[2], bnxt[2];
#define RESB_LOAD(dst, it) do { const size_t bo_ = (size_t)(row0 + ((it) >> 2) * HALF + ((it) & 3) * 16) * DM + col0; dst[0] = *(const u32x4*)(xb + bo_); dst[1] = *(const u32x4*)(xb + bo_ + HALF); } while (0)
        RESB_LOAD(bcur, 0);
#pragma unroll
        for (int it = 0; it < 8; ++it) {
            const int ai = it >> 2, m = it & 3;
            if (it + 1 < 8) RESB_LOAD(bnxt, it + 1);
            const int row = row0 + ai * HALF + m * 16; const size_t off = (size_t)row * DM + col0;
            float ss = 0.f;
#pragma unroll
            for (int bj = 0; bj < 2; ++bj) {
                const u32x4 b = bcur[bj];
                const f32x4 b0 = {__builtin_bit_cast(float, b.x << 16), __builtin_bit_cast(float, b.x & 0xffff0000u), __builtin_bit_cast(float, b.y << 16), __builtin_bit_cast(float, b.y & 0xffff0000u)};
                const f32x4 b1 = {__builtin_bit_cast(float, b.z << 16), __builtin_bit_cast(float, b.z & 0xffff0000u), __builtin_bit_cast(float, b.w << 16), __builtin_bit_cast(float, b.w & 0xffff0000u)};
                const f32x4 v0 = b0 + acc[ai][bj][m][0] * alpha, v1 = b1 + acc[ai][bj][m][1] * alpha;
                u32x4 w; w.x = cvt_pk_bf16(v0[0], v0[1]); w.y = cvt_pk_bf16(v0[2], v0[3]); w.z = cvt_pk_bf16(v1[0], v1[1]); w.w = cvt_pk_bf16(v1[2], v1[3]);
                *(u32x4*)(xb + off + bj * HALF) = w;
                if (WANT_SS) ss += ((v0[0] * v0[0] + v0[1] * v0[1]) + (v0[2] * v0[2] + v0[3] * v0[3])) + ((v1[0] * v1[0] + v1[1] * v1[1]) + (v1[2] * v1[2] + v1[3] * v1[3]));
            }
            if (WANT_SS) { ss += __shfl_xor(ss, 16); ss += __shfl_xor(ss, 32); if (fq == 0) p16[(size_t)row * 16 + 4 * u.pn + wc] = ss; }
            bcur[0] = bnxt[0]; bcur[1] = bnxt[1];
            asm volatile("" ::: "memory");
        }
#undef RESB_LOAD
    }
};
struct EpiNull { static constexpr bool PERM = true, AFTER_DRAIN = false; float* sink;
    __device__ __forceinline__ void operator()(const f32x4 (&acc)[2][2][4][2], const Unit& u, int wr, int wc, int fr, int fq) const {
        float s = 0.f;
#pragma unroll
        for (int ai = 0; ai < 2; ++ai)
#pragma unroll
            for (int bj = 0; bj < 2; ++bj)
#pragma unroll
                for (int m = 0; m < 4; ++m)
#pragma unroll
                    for (int n = 0; n < 2; ++n) s += acc[ai][bj][m][n][0] + acc[ai][bj][m][n][1] + acc[ai][bj][m][n][2] + acc[ai][bj][m][n][3];
        if (s == 12345.678f) sink[0] = s;
    } };
struct EpiMix {
    static constexpr bool PERM = true, AFTER_DRAIN = false;
    bf16_t* P; int ldp; const float* p16; const float* lbf; const float* lbb;
    template <int ACT> __device__ __forceinline__ void run(const f32x4 (&acc)[2][2][4][2], const Unit& u, int wr, int wc, int fr, int fq) const {
        const int row0 = u.pm * BM + wr * 64 + fr, col0 = u.pn * BM + wc * 32 + 8 * fq;
        float oml[2][8];
        if (ACT == 3) { const float* lb = ((u.pn >> 1) == 4) ? lbf : lbb; const int c0 = (u.pn & 1) * BM + wc * 32 + 8 * fq;
#pragma unroll
            for (int bj = 0; bj < 2; ++bj)
#pragma unroll
                for (int e = 0; e < 8; ++e) { const float a0 = lb[c0 + bj * HALF + e], a1 = lb[512 + c0 + bj * HALF + e]; oml[bj][e] = fast_sigmoid(a1 - a0);
#ifdef DBG_OML
                    oml[bj][e] = 0.5f;
#endif
                } }
        float rr[8];
        row_rstd8(p16, row0, fq, rr);
#pragma unroll
        for (int ai = 0; ai < 2; ++ai)
#pragma unroll
            for (int m = 0; m < 4; ++m) {
                const int row = row0 + ai * HALF + m * 16;
                const float r = rr[ai * 4 + m];
#pragma unroll
                for (int bj = 0; bj < 2; ++bj) {
                    float h[8];
#pragma unroll
                    for (int n = 0; n < 2; ++n) {
                        const f32x4 z = acc[ai][bj][m][n] * r;
                        if (ACT == 0) { const f32x2 a = gelu_pk((f32x2){z[0], z[1]}), b = gelu_pk((f32x2){z[2], z[3]}); h[4 * n] = a.x; h[4 * n + 1] = a.y; h[4 * n + 2] = b.x; h[4 * n + 3] = b.y; }
                        else if (ACT == 1) {
#pragma unroll
                            for (int e = 0; e < 4; ++e) h[4 * n + e] = z[e] * fast_sigmoid(z[e]); }
                        else if (ACT == 2) {
#pragma unroll
                            for (int e = 0; e < 4; ++e) h[4 * n + e] = z[e]; }
                        else {
#pragma unroll
                            for (int e = 0; e < 4; ++e) { const float kk = oml[bj][4 * n + e] * __builtin_amdgcn_rcpf(1.0f + __builtin_amdgcn_exp2f(1.44269504089f * z[e]));
                                h[4 * n + e] = __builtin_amdgcn_logf(1.0f - kk); }
                        }
                    }
                    u32x4 w; w.x = cvt_pk_bf16(h[0], h[1]); w.y = cvt_pk_bf16(h[2], h[3]); w.z = cvt_pk_bf16(h[4], h[5]); w.w = cvt_pk_bf16(h[6], h[7]);
                    *(u32x4*)(P + (size_t)row * ldp + col0 + bj * HALF) = w;
                }
            }
    }
    __device__ __forceinline__ void operator()(const f32x4 (&acc)[2][2][4][2], const Unit& u, int wr, int wc, int fr, int fq) const {
        const int seg = u.pn >> 1;
        if (seg <= 1) run<0>(acc, u, wr, wc, fr, fq);
        else if (seg == 2 || seg == 6) run<1>(acc, u, wr, wc, fr, fq);
        else if (seg == 3) run<2>(acc, u, wr, wc, fr, fq);
        else run<3>(acc, u, wr, wc, fr, fq);
    }
};

template <class Epi, class Sched, bool ALIGN_EPI = false, bool SP2 = false>
__device__ __forceinline__ void gemm_phase(PG8_LAS unsigned char* lds, const Gemm g, const Sched& S, const Epi& E) {
    const int tid = threadIdx.x, wid = __builtin_amdgcn_readfirstlane(tid >> 6), lane = tid & 63, wr = wid >> 2, wc = wid & 3, fr = lane & 15, fq = lane >> 4;
    const int K = g.K, nt = K / BK;
    unsigned voffA[2], voffB[2];
#pragma unroll
    for (int i = 0; i < 2; ++i) { int R, C; stage_rc(tid * 16 + i * 8192, R, C); const int Rb = Epi::PERM ? ((R & ~31) + perm32(R & 31)) : R;
        voffA[i] = (unsigned)(R * K + C) * 2u; voffB[i] = (unsigned)(Rb * K + C) * 2u; }
    const size_t kstep = (size_t)(BK * 2);
    const size_t hstep = (size_t)HALF * K * 2;
    const size_t tstep = 2 * hstep;
    const unsigned ldsw = (unsigned)wid * 1024u;
    const int aoff = lds_byte(wr * 64 + fr, fq * 8), boff = lds_byte(wc * 32 + fr, fq * 8);
#define PG8_SA(b, h) (((b) * 2 + (h)) * HTB)
#define PG8_SB(b, h) ((4 + (b) * 2 + (h)) * HTB)
#define PG8_STAGE(bufoff, gbase, voff) do { _Pragma("unroll") for (int _i = 0; _i < 2; ++_i) \
        __builtin_amdgcn_global_load_lds((const unsigned*)((const char*)(gbase) + (voff)[_i]), (PG8_LAS unsigned*)(lds + (bufoff) + ldsw + _i * 8192), 16, 0, 0); } while (0)
#define PG8_LDA(dst, b, h) do { _Pragma("unroll") for (int m = 0; m < 4; ++m) _Pragma("unroll") for (int k = 0; k < 2; ++k) dst[m][k] = *(const PG8_LAS bf16x8*)(lds + PG8_SA(b, h) + aoff + m * 2048 + k * 1024); } while (0)
#define PG8_LDB(dst, b, h) do { _Pragma("unroll") for (int n = 0; n < 2; ++n) _Pragma("unroll") for (int k = 0; k < 2; ++k) dst[n][k] = *(const PG8_LAS bf16x8*)(lds + PG8_SB(b, h) + boff + n * 2048 + k * 1024); } while (0)
#define PG8_MMA(ai, bj, At, Bt) do { __builtin_amdgcn_s_setprio(1); _Pragma("unroll") for (int m = 0; m < 4; ++m) _Pragma("unroll") for (int n = 0; n < 2; ++n) _Pragma("unroll") for (int k = 0; k < 2; ++k) \
        acc[ai][bj][m][n] = __builtin_amdgcn_mfma_f32_16x16x32_bf16(Bt[n][k], At[m][k], acc[ai][bj][m][n], 0, 0, 0); __builtin_amdgcn_s_setprio(0); } while (0)
#define PG8_WAIT_V(n) asm volatile("s_waitcnt vmcnt(" #n ")" ::: "memory")
#define PG8_WAIT_L(n) asm volatile("s_waitcnt lgkmcnt(" #n ")" ::: "memory")
#define PG8_BAR __builtin_amdgcn_s_barrier()
#define PG8_SCHED __builtin_amdgcn_sched_barrier(0)
    Unit cur, nxt; int ui = 0;
    if (!S.next(0, cur)) return;
    f32x4 acc[2][2][4][2];
#pragma unroll
    for (int a = 0; a < 2; ++a)
#pragma unroll
        for (int b = 0; b < 2; ++b)
#pragma unroll
            for (int m = 0; m < 4; ++m)
#pragma unroll
                for (int n = 0; n < 2; ++n) acc[a][b][m][n] = (f32x4){0.f, 0.f, 0.f, 0.f};
    bf16x8 At[4][2], B0[2][2], B1[2][2];
    const char* cA = (const char*)g.A + (size_t)cur.pm * tstep; const char* cB = (const char*)g.Bt + (size_t)cur.pn * tstep;
    S.a_ready(cur);
    if constexpr (SP2) {
        PG8_STAGE(PG8_SB(0, 0), cB, voffB); PG8_STAGE(PG8_SB(0, 1), cB + hstep, voffB); PG8_STAGE(PG8_SA(0, 0), cA, voffA); PG8_STAGE(PG8_SA(0, 1), cA + hstep, voffA);
        if (wr == 1) PG8_BAR;
        PG8_WAIT_V(2); PG8_BAR;
        PG8_STAGE(PG8_SB(1, 0), cB + kstep, voffB); PG8_STAGE(PG8_SA(1, 0), cA + kstep, voffA); PG8_STAGE(PG8_SB(1, 1), cB + hstep + kstep, voffB);
        PG8_WAIT_V(6); PG8_BAR;
    } else {
        PG8_STAGE(PG8_SB(0, 0), cB, voffB); PG8_STAGE(PG8_SA(0, 0), cA, voffA); PG8_STAGE(PG8_SB(0, 1), cB + hstep, voffB); PG8_STAGE(PG8_SA(0, 1), cA + hstep, voffA);
        if (wr == 1) PG8_BAR;
        PG8_WAIT_V(4); PG8_BAR;
        PG8_STAGE(PG8_SB(1, 0), cB + kstep, voffB); PG8_STAGE(PG8_SA(1, 0), cA + kstep, voffA); PG8_STAGE(PG8_SB(1, 1), cB + hstep + kstep, voffB);
        PG8_WAIT_V(6); PG8_BAR;
    }
    for (;;) {
        const bool has_next = S.next(ui + 1, nxt);
        const char* nA = has_next ? (const char*)g.A + (size_t)nxt.pm * tstep : cA; const char* nB = has_next ? (const char*)g.Bt + (size_t)nxt.pn * tstep : cB;
        for (int t = 0; t < nt; t += 2) {
            const bool last = (t == nt - 2);
            const char* a1 = cA + (size_t)(t + 1) * kstep;
            const char* a2 = last ? nA : cA + (size_t)(t + 2) * kstep; const char* b2 = last ? nB : cB + (size_t)(t + 2) * kstep;
            const char* a3 = a2 + kstep; const char* b3 = b2 + kstep;
            if (last && has_next) S.a_ready(nxt);
            if constexpr (SP2) {
            PG8_LDB(B0, 0, 0); PG8_LDB(B1, 0, 1); PG8_SCHED; PG8_LDA(At, 0, 0); PG8_STAGE(PG8_SA(1, 1), a1 + hstep, voffA);
            PG8_WAIT_V(8); PG8_WAIT_L(0); PG8_BAR; PG8_MMA(0, 0, At, B0); PG8_MMA(0, 1, At, B1); PG8_BAR; PG8_SCHED;
            PG8_LDA(At, 0, 1); PG8_STAGE(PG8_SB(0, 0), b2, voffB); PG8_STAGE(PG8_SB(0, 1), b2 + hstep, voffB); PG8_STAGE(PG8_SA(0, 0), a2, voffA);
            PG8_WAIT_V(8); PG8_WAIT_L(0); PG8_BAR; PG8_MMA(1, 0, At, B0); PG8_MMA(1, 1, At, B1); PG8_BAR; PG8_SCHED;
            PG8_LDB(B0, 1, 0); PG8_LDB(B1, 1, 1); PG8_SCHED; PG8_LDA(At, 1, 0); PG8_STAGE(PG8_SA(0, 1), a2 + hstep, voffA);
            PG8_WAIT_V(8); PG8_WAIT_L(0); PG8_BAR; PG8_MMA(0, 0, At, B0); PG8_MMA(0, 1, At, B1); PG8_BAR; PG8_SCHED;
            PG8_LDA(At, 1, 1); PG8_STAGE(PG8_SB(1, 0), b3, voffB); PG8_STAGE(PG8_SB(1, 1), b3 + hstep, voffB); PG8_STAGE(PG8_SA(1, 0), a3, voffA);
            PG8_WAIT_V(8); PG8_WAIT_L(0); PG8_BAR; PG8_MMA(1, 0, At, B0); PG8_MMA(1, 1, At, B1); PG8_BAR; PG8_SCHED;
            } else {
            PG8_LDB(B0, 0, 0); PG8_SCHED; PG8_LDA(At, 0, 0); PG8_STAGE(PG8_SA(1, 1), a1 + hstep, voffA);
            PG8_WAIT_L(8); PG8_BAR; PG8_WAIT_L(0); PG8_MMA(0, 0, At, B0); PG8_BAR; PG8_SCHED;
            PG8_LDB(B1, 0, 1); PG8_STAGE(PG8_SB(0, 0), b2, voffB);
            PG8_BAR; PG8_WAIT_L(0); PG8_MMA(0, 1, At, B1); PG8_BAR;
            PG8_LDA(At, 0, 1); PG8_STAGE(PG8_SA(0, 0), a2, voffA);
            PG8_BAR; PG8_WAIT_L(0); PG8_MMA(1, 0, At, B0); PG8_BAR; PG8_SCHED;
            PG8_STAGE(PG8_SB(0, 1), b2 + hstep, voffB);
            PG8_WAIT_V(6); PG8_BAR; PG8_MMA(1, 1, At, B1); PG8_BAR;
            PG8_LDB(B0, 1, 0); PG8_SCHED; PG8_LDA(At, 1, 0); PG8_STAGE(PG8_SA(0, 1), a2 + hstep, voffA);
            PG8_WAIT_L(8); PG8_BAR; PG8_WAIT_L(0); PG8_MMA(0, 0, At, B0); PG8_BAR; PG8_SCHED;
            PG8_LDB(B1, 1, 1); PG8_STAGE(PG8_SB(1, 0), b3, voffB);
            PG8_BAR; PG8_WAIT_L(0); PG8_MMA(0, 1, At, B1); PG8_BAR;
            PG8_LDA(At, 1, 1); PG8_STAGE(PG8_SA(1, 0), a3, voffA);
            PG8_BAR; PG8_WAIT_L(0); PG8_MMA(1, 0, At, B0); PG8_BAR; PG8_SCHED;
            PG8_STAGE(PG8_SB(1, 1), b3 + hstep, voffB);
            PG8_WAIT_V(6); PG8_BAR; PG8_MMA(1, 1, At, B1); PG8_BAR;
            }
        }
        if constexpr (ALIGN_EPI) { if (wr == 0) PG8_BAR; }
        if constexpr (!Epi::AFTER_DRAIN) { E(acc, cur, wr, wc, fr, fq); S.done(cur); }
        if (!has_next) break;
#pragma unroll
        for (int a = 0; a < 2; ++a)
#pragma unroll
            for (int b = 0; b < 2; ++b)
#pragma unroll
                for (int m = 0; m < 4; ++m)
#pragma unroll
                    for (int n = 0; n < 2; ++n) acc[a][b][m][n] = (f32x4){0.f, 0.f, 0.f, 0.f};
        cur = nxt; cA = nA; cB = nB; ++ui;
        if constexpr (ALIGN_EPI) { if (wr == 1) PG8_BAR; }
    }
    PG8_WAIT_V(0);
    if constexpr (!ALIGN_EPI) { if (wr == 0) PG8_BAR; }
    PG8_BAR;
    if constexpr (Epi::AFTER_DRAIN) { E.fused(acc, cur, wr, wc, fr, fq, lds, wid, lane); S.done(cur); }
#undef PG8_SA
#undef PG8_SB
#undef PG8_STAGE
#undef PG8_LDA
#undef PG8_LDB
#undef PG8_MMA
#undef PG8_WAIT_V
#undef PG8_WAIT_L
#undef PG8_BAR
#undef PG8_SCHED
}
}

#ifndef PG8_SP2
#define PG8_SP2 true
#endif
#ifndef PG8_ALIGN
#define PG8_ALIGN true
#endif
constexpr int NWAVES = 8;
constexpr int TOK = 32768, NPROMPT = 16384;
constexpr int DMODEL = 1024, DFF = 2816, DIN = 3584;
constexpr int COL_U = 0, COL_V = 512, COL_Q = 1024, COL_I = 1536, COL_FF = 2048, COL_FB = 2560, COL_G = 3072;
constexpr float EPS = 1e-6f;
constexpr size_t MiB = 1u << 20;
constexpr size_t WS_CTL = 0, CTL_ZERO_BYTES = 1 * MiB;
constexpr size_t WS_SSG = 1 * MiB;
constexpr size_t WS_P16 = 2 * MiB;
constexpr size_t WS_WGU1 = 8 * MiB, WS_WD1 = 19 * MiB, WS_WIN = 25 * MiB, WS_WOUT = 32 * MiB, WS_WGU2 = 34 * MiB, WS_WD2 = 45 * MiB;
constexpr size_t WS_BUFA = 52 * MiB;
constexpr size_t WS_BUFB = 116 * MiB;
constexpr size_t WS_BIG = 180 * MiB;
constexpr size_t WS_OB1 = 404 * MiB;
constexpr size_t WS_HGE = 468 * MiB;
constexpr size_t WS_HGD = 500 * MiB;
constexpr size_t WS_END = 501 * MiB;
static_assert(WS_WGU1 + (size_t)2 * DFF * DMODEL * 2 <= WS_WD1 && WS_WD1 + (size_t)DMODEL * DFF * 2 <= WS_WIN && WS_WIN + (size_t)DIN * DMODEL * 2 <= WS_WOUT && WS_WOUT + (size_t)DMODEL * DMODEL * 2 <= WS_WGU2
              && WS_WGU2 + (size_t)2 * DFF * DMODEL * 2 <= WS_WD2 && WS_WD2 + (size_t)DMODEL * DFF * 2 <= WS_BUFA && WS_BUFA + (size_t)TOK * DMODEL * 2 <= WS_BUFB && WS_BUFB + (size_t)TOK * DMODEL * 2 <= WS_BIG
              && WS_BIG + (size_t)TOK * DIN * 2 <= WS_OB1 && WS_OB1 + (size_t)TOK * 512 * 4 <= WS_HGE && WS_HGE + (size_t)512 * 65536 <= WS_HGD && WS_P16 + 3 * 2 * MiB <= WS_WGU1, "d_ws map");
constexpr int CW_BAR = 4096;
constexpr int RING_OFF = 0, RING_BYTES = 131072;
constexpr int LDSCTL_OFF = RING_BYTES, MISC_OFF = LDSCTL_OFF + 320;
constexpr int LDS_BYTES = 147456;
static_assert(MISC_OFF + 128 <= LDS_BYTES, "LDS map");

#define GAS __attribute__((address_space(1)))
#define LAS __attribute__((address_space(3)))
typedef unsigned short bf16;
typedef unsigned v4u __attribute__((ext_vector_type(4)));
typedef float f32x4 __attribute__((ext_vector_type(4)));
typedef short bf16x8 __attribute__((ext_vector_type(8)));
typedef GAS unsigned gu32;
typedef GAS unsigned long long gu64;
#define RLX_AGENT __ATOMIC_RELAXED, __HIP_MEMORY_SCOPE_AGENT
#define LDS_WAIT() asm volatile("s_waitcnt lgkmcnt(0)" ::: "memory")
#define VM_WAIT() asm volatile("s_waitcnt vmcnt(0)" ::: "memory")
__device__ __forceinline__ unsigned long long rt() { return __builtin_amdgcn_s_memrealtime(); }
__device__ __forceinline__ unsigned f2bf(float f) { unsigned u = __builtin_bit_cast(unsigned, f); return (u + 0x7fffu + ((u >> 16) & 1u)) >> 16; }
__device__ __forceinline__ unsigned pk2(float lo, float hi) { return f2bf(lo) | (f2bf(hi) << 16); }

#define XB_TMO      128
#define XB_XCNT(j)  (256  + 64 * (j))
#define XB_XSUB(j)  (1280 + 64 * (j))
#define XB_XGEN(j)  (2304 + 64 * (j))
#define XB_TOP      3328
#define XB_TOPGEN   3392
#define XCD_BAR_WORDS 3456
#define XB_SPIN_CAP (1u << 18)

__device__ __forceinline__ unsigned xb_ld(unsigned* p)              { return __hip_atomic_load(p, __ATOMIC_RELAXED, __HIP_MEMORY_SCOPE_AGENT); }
__device__ __forceinline__ unsigned xb_add(unsigned* p, unsigned v) { return __hip_atomic_fetch_add(p, v, __ATOMIC_RELAXED, __HIP_MEMORY_SCOPE_AGENT); }
__device__ __forceinline__ unsigned xb_xcc_id() { return (unsigned)__builtin_amdgcn_s_getreg((3 << 11) | 20) & 0xFu; }
#define XB_SPIN(cond, bar) do { unsigned _sp = 0; while (cond) { __builtin_amdgcn_s_sleep(1); \
    if ((++_sp & 255u) == 0u) { if (xb_ld(&(bar)[XB_TMO])) break; if (_sp > XB_SPIN_CAP) { atomicAdd(&(bar)[XB_TMO], 1u); break; } } } } while (0)

struct XcdBarrier {
    unsigned* bar; unsigned x;
    volatile LAS unsigned* st;
};

__device__ __forceinline__ XcdBarrier xcd_barrier_post(unsigned* bar, volatile LAS unsigned* st) {
    XcdBarrier b; b.bar = bar; b.x = xb_xcc_id(); b.st = st;
    if (threadIdx.x == 0) st[3] = xb_add(&bar[XB_XCNT(b.x)], 1u);
    return b;
}
__device__ __forceinline__ void xcd_barrier_complete(unsigned* bar, unsigned x, unsigned& nloc, unsigned& nx) {
    const unsigned G = gridDim.x * gridDim.y * gridDim.z;
    unsigned sum, cnt, mine, sp = 0u;
    for (;;) {
        sum = 0u; cnt = 0u; mine = 0u;
#pragma unroll
        for (unsigned j = 0; j < 16; ++j) { const unsigned c = xb_ld(&bar[XB_XCNT(j)]); sum += c; cnt += (c > 0u) ? 1u : 0u; mine = (j == x) ? c : mine; }
        if (sum == G) break;
        __builtin_amdgcn_s_sleep(1);
        if ((++sp & 255u) == 0u) { if (xb_ld(&bar[XB_TMO])) break; if (sp > XB_SPIN_CAP) { atomicAdd(&bar[XB_TMO], 1u); break; } }
    }
    nloc = mine > 0u ? mine : 1u; nx = cnt > 0u ? cnt : 1u;
}
__device__ __forceinline__ unsigned xcd_census_uniform(unsigned* bar) {
    const unsigned G = gridDim.x * gridDim.y * gridDim.z; unsigned ok = (G % 8u == 0u) ? 1u : 0u;
#pragma unroll
    for (unsigned j = 0; j < 16; ++j) { const unsigned c = xb_ld(&bar[XB_XCNT(j)]); if (j < 8u ? (c != G / 8u) : (c != 0u)) ok = 0u; }
    return (xb_ld(&bar[XB_TMO]) == 0u) ? ok : 0u;
}

__device__ __forceinline__ void xcd_barrier(const XcdBarrier& b) {
    asm volatile("s_waitcnt vmcnt(0)" ::: "memory");
    __syncthreads();
    if (threadIdx.x == 0) {
        unsigned* bar = b.bar;
        __builtin_amdgcn_s_waitcnt(0);
        unsigned nloc = b.st[0], nx = b.st[1];
        if (nloc == 0u) { xcd_barrier_complete(bar, b.x, nloc, nx); b.st[0] = nloc; b.st[1] = nx; b.st[2] = xcd_census_uniform(bar); }
        const unsigned old = xb_add(&bar[XB_XSUB(b.x)], 1u);
        const unsigned gen = old / nloc;
        if (old + 1u == (gen + 1u) * nloc) {
            __builtin_amdgcn_fence(__ATOMIC_RELEASE, "agent");
            asm volatile("s_waitcnt vmcnt(0)" ::: "memory");
            const unsigned og = xb_add(&bar[XB_TOP], 1u);
            const unsigned tg = og / nx;
            if (og + 1u == (tg + 1u) * nx) xb_add(&bar[XB_TOPGEN], 1u);
            else XB_SPIN(xb_ld(&bar[XB_TOPGEN]) == tg, bar);
            __builtin_amdgcn_fence(__ATOMIC_ACQUIRE, "agent");
            xb_add(&bar[XB_XGEN(b.x)], 1u);
            asm volatile("s_waitcnt vmcnt(0)" ::: "memory");
        } else {
            XB_SPIN(xb_ld(&bar[XB_XGEN(b.x)]) == gen, bar);
            __builtin_amdgcn_fence(__ATOMIC_ACQUIRE, "agent");
            asm volatile("s_waitcnt vmcnt(0)" ::: "memory");
        }
    }
    __syncthreads();
}
#define XB_LSUB(j)  (3456 + 64 * (j))
#define XB_LGEN(j)  (4480 + 64 * (j))
__device__ __forceinline__ void xcd_local_barrier(const XcdBarrier& b) {
    asm volatile("s_waitcnt vmcnt(0)" ::: "memory");
    __syncthreads();
    if (threadIdx.x == 0) {
        unsigned* bar = b.bar;
        __builtin_amdgcn_s_waitcnt(0);
        const unsigned nloc = b.st[0];
        const unsigned old = xb_add(&bar[XB_LSUB(b.x)], 1u);
        const unsigned gen = old / nloc;
        if (old + 1u == (gen + 1u) * nloc) xb_add(&bar[XB_LGEN(b.x)], 1u);
        else XB_SPIN(xb_ld(&bar[XB_LGEN(b.x)]) == gen, bar);
        __builtin_amdgcn_fence(__ATOMIC_ACQUIRE, "agent");
        asm volatile("s_waitcnt vmcnt(0)" ::: "memory");
    }
    __syncthreads();
}

typedef unsigned v2u __attribute__((ext_vector_type(2)));
__device__ __forceinline__ float wave_sum(float v) {
#pragma unroll
    for (int o = 1; o < 64; o <<= 1) v += __shfl_xor(v, o);
    return v;
}
__device__ __forceinline__ float bflo(unsigned w) { return __builtin_bit_cast(float, w << 16); }
__device__ __forceinline__ float bfhi(unsigned w) { return __builtin_bit_cast(float, w & 0xffff0000u); }
__device__ __forceinline__ float bf1(unsigned short h) { return __builtin_bit_cast(float, (unsigned)h << 16); }
__device__ __forceinline__ float ex2(float x) { return __builtin_amdgcn_exp2f(x); }
__device__ __forceinline__ float rsq(float x) { return __builtin_amdgcn_rsqf(x); }

__device__ __forceinline__ void p0_item(const float* W, int Nsrc, int k0, int scol0, const float* gain, bf16* WT, int K, int drow0, LAS float* scr, int lane) {
    const int r8 = lane >> 3, c4 = 4 * (lane & 7);
    f32x4 v[8];
#pragma unroll
    for (int i = 0; i < 8; ++i) v[i] = *(const GAS f32x4*)(W + (size_t)(k0 + 8 * i + r8) * Nsrc + scol0 + c4);
#pragma unroll
    for (int i = 0; i < 8; ++i) { const int kk = 8 * i + r8; f32x4 t = v[i]; if (gain) t = t * gain[k0 + kk];
        scr[kk * 33 + c4] = t[0]; scr[kk * 33 + c4 + 1] = t[1]; scr[kk * 33 + c4 + 2] = t[2]; scr[kk * 33 + c4 + 3] = t[3]; }
    LDS_WAIT(); asm volatile("" ::: "memory");
    const int c = lane & 7;
#pragma unroll
    for (int j = 0; j < 4; ++j) { const int n = (lane >> 3) + 8 * j; const LAS float* s = scr + (8 * c) * 33 + n;
        v4u o; o.x = pk2(s[0 * 33], s[1 * 33]); o.y = pk2(s[2 * 33], s[3 * 33]); o.z = pk2(s[4 * 33], s[5 * 33]); o.w = pk2(s[6 * 33], s[7 * 33]);
        *(GAS v4u*)(WT + (size_t)(drow0 + n) * K + k0 + 8 * c) = o; }
    LDS_WAIT(); asm volatile("" ::: "memory");
}
__device__ __forceinline__ void p0_gu(const float* Wg, const float* Wu, const float* gain, bf16* WT, int r, LAS float* scr, int lane) {
    const int nblk = 2 * DFF / 32, kb = r / nblk, nb = r % nblk, n0 = 32 * nb, pn = n0 >> 8, bj = (n0 >> 7) & 1, j0 = n0 & 127;
    p0_item(bj ? Wu : Wg, DFF, 64 * kb, 128 * pn + j0, gain, WT, DMODEL, n0, scr, lane);
}
__device__ __forceinline__ void p0_plain(const float* W, int K, int N, const float* gain, bf16* WT, int r, LAS float* scr, int lane) {
    const int nblk = N / 32, kb = r / nblk, nb = r % nblk;
    p0_item(W, N, 64 * kb, 32 * nb, gain, WT, K, 32 * nb, scr, lane);
}
__device__ __forceinline__ void p0_prologue(LAS unsigned char* lds, const float* const* in, unsigned char* ws, int gw, int NGW, int wave, int lane) {
    LAS float* scr = (LAS float*)(lds + RING_OFF + wave * 16384);
    constexpr int I_GU = (DMODEL / 64) * (2 * DFF / 32), I_D = (DFF / 64) * (DMODEL / 32), I_IN = (DMODEL / 64) * (DIN / 32), I_OUT = (DMODEL / 64) * (DMODEL / 32);
    constexpr int NITEMS = 2 * I_GU + 2 * I_D + I_IN + I_OUT;
    for (int it = gw; it < NITEMS; it += NGW) {
        int r = it;
        if (r < I_GU) { p0_gu(in[3], in[4], in[2], (bf16*)(ws + WS_WGU1), r, scr, lane); continue; } r -= I_GU;
        if (r < I_GU) { p0_gu(in[18], in[19], in[17], (bf16*)(ws + WS_WGU2), r, scr, lane); continue; } r -= I_GU;
        if (r < I_D) { p0_plain(in[5], DFF, DMODEL, nullptr, (bf16*)(ws + WS_WD1), r, scr, lane); continue; } r -= I_D;
        if (r < I_D) { p0_plain(in[20], DFF, DMODEL, nullptr, (bf16*)(ws + WS_WD2), r, scr, lane); continue; } r -= I_D;
        if (r < I_IN) { p0_plain(in[7], DMODEL, DIN, in[6], (bf16*)(ws + WS_WIN), r, scr, lane); continue; } r -= I_IN;
        p0_plain(in[16], DMODEL, DMODEL, nullptr, (bf16*)(ws + WS_WOUT), r, scr, lane);
    }
    bf16* XB = (bf16*)(ws + WS_BUFA); float* p16 = (float*)(ws + WS_P16);
    for (int m0 = gw; m0 < TOK; m0 += 4 * NGW) {
        f32x4 v[4][4]; float s[4];
#pragma unroll
        for (int q = 0; q < 4; ++q) { const int m = m0 + q * NGW;
            if (m < TOK) { const float* xrow = m < NPROMPT ? in[0] + (size_t)m * DMODEL : in[1] + (size_t)(m - NPROMPT) * DMODEL; const GAS f32x4* xr = (const GAS f32x4*)xrow + lane;
#pragma unroll
                for (int j = 0; j < 4; ++j) v[q][j] = xr[64 * j]; } }
#pragma unroll
        for (int q = 0; q < 4; ++q) { s[q] = 0.f;
#pragma unroll
            for (int j = 0; j < 4; ++j) s[q] += (v[q][j].x * v[q][j].x + v[q][j].y * v[q][j].y) + (v[q][j].z * v[q][j].z + v[q][j].w * v[q][j].w); }
#pragma unroll
        for (int o = 1; o < 64; o <<= 1) {
#pragma unroll
            for (int q = 0; q < 4; ++q) s[q] += __shfl_xor(s[q], o); }
#pragma unroll
        for (int q = 0; q < 4; ++q) { const int m = m0 + q * NGW;
            if (m < TOK) { GAS v2u* o8 = (GAS v2u*)(XB + (size_t)m * DMODEL) + lane;
#pragma unroll
                for (int j = 0; j < 4; ++j) { v2u w; w.x = pk2(v[q][j].x, v[q][j].y); w.y = pk2(v[q][j].z, v[q][j].w); o8[64 * j] = w; }
                if (lane < 16) p16[(size_t)m * 16 + lane] = lane == 0 ? s[q] : 0.f; } }
    }
}

__device__ __forceinline__ void final_norm(const bf16* XBr, float* out, const float* gfin, int rbeg, int rend, int gw, int NGW, int lane) {
    for (int m = rbeg + gw; m < rend; m += NGW) {
        const v4u w0 = *(const GAS v4u*)(XBr + (size_t)m * DMODEL + 8 * lane), w1 = *(const GAS v4u*)(XBr + (size_t)m * DMODEL + 512 + 8 * lane);
        float x[16] = {bflo(w0.x), bfhi(w0.x), bflo(w0.y), bfhi(w0.y), bflo(w0.z), bfhi(w0.z), bflo(w0.w), bfhi(w0.w), bflo(w1.x), bfhi(w1.x), bflo(w1.y), bfhi(w1.y), bflo(w1.z), bfhi(w1.z), bflo(w1.w), bfhi(w1.w)};
        float s = 0.f;
#pragma unroll
        for (int e = 0; e < 16; ++e) s += x[e] * x[e];
        const float r = rsq(wave_sum(s) * (1.0f / DMODEL) + EPS);
#pragma unroll
        for (int j = 0; j < 2; ++j) { const int c = 512 * j + 8 * lane;
            const f32x4 g0 = *(const GAS f32x4*)(gfin + c), g1 = *(const GAS f32x4*)(gfin + c + 4);
            *(GAS f32x4*)(out + (size_t)m * DMODEL + c) = (f32x4){x[8 * j] * r * g0[0], x[8 * j + 1] * r * g0[1], x[8 * j + 2] * r * g0[2], x[8 * j + 3] * r * g0[3]};
            *(GAS f32x4*)(out + (size_t)m * DMODEL + c + 4) = (f32x4){x[8 * j + 4] * r * g1[0], x[8 * j + 5] * r * g1[1], x[8 * j + 6] * r * g1[2], x[8 * j + 7] * r * g1[3]}; }
    }
}

constexpr int HG_RAWLF = 0, HG_RAWQ = 17408, HG_QN = 34816, HG_KN = 52224, HG_KT = 69632, HG_VT = 88064, HG_SCL = 97280, HG_ST = 106496, HG_SEG = 115200, HG_SA = 119296, HG_SB = 119808, HG_END = 120320;
static_assert(HG_END <= RING_BYTES, "hgrn LDS");
__device__ __forceinline__ void hgrn_item(LAS unsigned char* lds, const bf16* P, float* ob, int row0, int L, int h, int dir, int dq, int tid, int lane, int wave) {
    const int fr = lane & 15, fq = lane >> 4, nch = L >> 6;
    const bf16* gq = P + COL_Q + h * 128;
    const bf16* gl = P + (dir ? COL_FB : COL_FF) + h * 128;
    const bf16* gv = P + COL_I + h * 128 + dq * 32;
    float* go = ob + h * 128 + dq * 32;
    const int lr = tid >> 4, lc = tid & 15, lp = (tid >> 2) & 31, vc = tid & 3, cp = lane, s8 = wave;
#define TOKROW(n, l) (row0 + (dir ? (L - 1 - (64 * (n) + (l))) : (64 * (n) + (l))))
#define HG_LOAD(n) do { _Pragma("unroll") for (int i_ = 0; i_ < 2; ++i_) { const size_t ro_ = (size_t)TOKROW(n, lr + 32 * i_) * DIN + 8 * lc; rl[i_] = *(const GAS v4u*)(gl + ro_); rq[i_] = *(const GAS v4u*)(gq + ro_); \
        rv[i_] = *(const GAS v4u*)(gv + (size_t)TOKROW(n, 2 * lp + i_) * DIN + 8 * vc); } } while (0)
    v4u rl[2], rq[2], rv[2];
    HG_LOAD(0);
    f32x4 S0 = {0.f, 0.f, 0.f, 0.f}, S1 = {0.f, 0.f, 0.f, 0.f};
    for (int n = 0; n < nch; ++n) {
        const int vbuf = HG_VT + (n & 1) * 4608;
#pragma unroll
        for (int i = 0; i < 2; ++i) { *(LAS v4u*)(lds + HG_RAWLF + (lr + 32 * i) * 272 + lc * 16) = rl[i]; *(LAS v4u*)(lds + HG_RAWQ + (lr + 32 * i) * 272 + lc * 16) = rq[i]; }
        if (tid < 128) {
#pragma unroll
            for (int e = 0; e < 4; ++e) { const unsigned w0 = rv[0][e], w1 = rv[1][e];
                *(LAS unsigned*)(lds + vbuf + (8 * vc + 2 * e) * 144 + lp * 4) = (w0 & 0xffffu) | (w1 << 16);
                *(LAS unsigned*)(lds + vbuf + (8 * vc + 2 * e + 1) * 144 + lp * 4) = (w0 >> 16) | (w1 & 0xffff0000u); }
        }
        if (n + 1 < nch) HG_LOAD(n + 1);
        __syncthreads();
        float lfa[8], lfb[8], ava[8], avb[8]; float runa = 0.f, runb = 0.f;
#pragma unroll
        for (int j = 0; j < 8; ++j) { const unsigned w = *(const LAS unsigned*)(lds + HG_RAWLF + (8 * s8 + j) * 272 + cp * 4);
            lfa[j] = bflo(w); lfb[j] = bfhi(w); runa += lfa[j]; runb += lfb[j]; ava[j] = runa; avb[j] = runb; }
        *(LAS v2u*)(lds + HG_SEG + (s8 * 128 + 2 * cp) * 4) = (v2u){__builtin_bit_cast(unsigned, runa), __builtin_bit_cast(unsigned, runb)};
        __syncthreads();
        {
            typedef float f32x2v __attribute__((ext_vector_type(2)));
            f32x2v sg_[8];
#pragma unroll
            for (int q = 0; q < 8; ++q) sg_[q] = *(const LAS f32x2v*)(lds + HG_SEG + (q * 128 + 2 * cp) * 4);
            const f32x2v amid2 = (sg_[0] + sg_[1]) + (sg_[2] + sg_[3]);
            const f32x2v atot2 = amid2 + ((sg_[4] + sg_[5]) + (sg_[6] + sg_[7]));
            f32x2v off2 = -amid2;
#pragma unroll
            for (int q = 0; q < 7; ++q) { const float mq = (q < s8) ? 1.0f : 0.0f; off2 = off2 + sg_[q] * mq; }
            const float amida = amid2.x, amidb = amid2.y, atota = atot2.x, atotb = atot2.y;
            const float offa = off2.x, offb = off2.y;
            unsigned kta[4], ktb[4];
#pragma unroll
            for (int j = 0; j < 8; ++j) {
                const float aa = offa + ava[j], ab = offb + avb[j];
                const unsigned qw = *(const LAS unsigned*)(lds + HG_RAWQ + (8 * s8 + j) * 272 + cp * 4);
                const float qta = bflo(qw) * ex2(aa), qtb = bfhi(qw) * ex2(ab);
                const float k_a = (1.0f - ex2(lfa[j])) * ex2(-aa), k_b = (1.0f - ex2(lfb[j])) * ex2(-ab);
                const unsigned kba = f2bf(k_a), kbb = f2bf(k_b);
                *(LAS unsigned*)(lds + HG_QN + (8 * s8 + j) * 272 + cp * 4) = pk2(qta, qtb);
                *(LAS unsigned*)(lds + HG_KN + (8 * s8 + j) * 272 + cp * 4) = kba | (kbb << 16);
                if (j & 1) { kta[j >> 1] |= kba << 16; ktb[j >> 1] |= kbb << 16; } else { kta[j >> 1] = kba; ktb[j >> 1] = kbb; }
            }
            *(LAS v4u*)(lds + HG_KT + (2 * cp) * 144 + s8 * 16) = (v4u){kta[0], kta[1], kta[2], kta[3]};
            *(LAS v4u*)(lds + HG_KT + (2 * cp + 1) * 144 + s8 * 16) = (v4u){ktb[0], ktb[1], ktb[2], ktb[3]};
            if (s8 == 0) { *(LAS v2u*)(lds + HG_SA + (2 * cp) * 4) = (v2u){__builtin_bit_cast(unsigned, ex2(amida)), __builtin_bit_cast(unsigned, ex2(amidb))};
                           *(LAS v2u*)(lds + HG_SB + (2 * cp) * 4) = (v2u){__builtin_bit_cast(unsigned, ex2(atota - amida)), __builtin_bit_cast(unsigned, ex2(atotb - amidb))}; }
        }
        __syncthreads();
        {
            const f32x4 sa = *(const LAS f32x4*)(lds + HG_SA + (16 * wave + 4 * fq) * 4);
            S0 = S0 * sa; S1 = S1 * sa;
#ifdef DBG_NOSTATE
            S0 = (f32x4){0.f,0.f,0.f,0.f}; S1 = S0;
#endif
            v2u w0, w1; w0.x = pk2(S0[0], S0[1]); w0.y = pk2(S0[2], S0[3]); w1.x = pk2(S1[0], S1[1]); w1.y = pk2(S1[2], S1[3]);
            *(LAS v2u*)(lds + HG_ST + fr * 272 + (16 * wave + 4 * fq) * 2) = w0;
            *(LAS v2u*)(lds + HG_ST + (16 + fr) * 272 + (16 * wave + 4 * fq) * 2) = w1;
        }
        {
            const int ib = wave & 3, jp = wave >> 2;
#pragma unroll
            for (int t = 0; t < 2; ++t) {
                const int jb = 2 * jp + t;
                f32x4 sc = {0.f, 0.f, 0.f, 0.f};
                if (jb <= ib) {
#pragma unroll
                    for (int ks = 0; ks < 4; ++ks) {
                        const bf16x8 x = *(const LAS bf16x8*)(lds + HG_KN + (16 * jb + fr) * 272 + ks * 64 + fq * 16);
                        const bf16x8 y = *(const LAS bf16x8*)(lds + HG_QN + (16 * ib + fr) * 272 + ks * 64 + fq * 16);
                        sc = __builtin_amdgcn_mfma_f32_16x16x32_bf16(x, y, sc, 0, 0, 0);
                    }
                    if (jb == ib) {
#pragma unroll
                        for (int r = 0; r < 4; ++r) if (4 * fq + r > fr) sc[r] = 0.f;
                    }
                }
                v2u w; w.x = pk2(sc[0], sc[1]); w.y = pk2(sc[2], sc[3]);
                *(LAS v2u*)(lds + HG_SCL + (16 * ib + fr) * 144 + (16 * jb + 4 * fq) * 2) = w;
            }
        }
        __syncthreads();
        {
            const int ib2 = wave >> 1, db = wave & 1;
            f32x4 O = {0.f, 0.f, 0.f, 0.f};
#pragma unroll
            for (int ks = 0; ks < 2; ++ks) {
                const bf16x8 x = *(const LAS bf16x8*)(lds + vbuf + (16 * db + fr) * 144 + ks * 64 + fq * 16);
                const bf16x8 y = *(const LAS bf16x8*)(lds + HG_SCL + (16 * ib2 + fr) * 144 + ks * 64 + fq * 16);
                O = __builtin_amdgcn_mfma_f32_16x16x32_bf16(x, y, O, 0, 0, 0);
            }
#pragma unroll
            for (int ks = 0; ks < 4; ++ks) {
                const bf16x8 x = *(const LAS bf16x8*)(lds + HG_ST + (16 * db + fr) * 272 + ks * 64 + fq * 16);
                const bf16x8 y = *(const LAS bf16x8*)(lds + HG_QN + (16 * ib2 + fr) * 272 + ks * 64 + fq * 16);
                O = __builtin_amdgcn_mfma_f32_16x16x32_bf16(x, y, O, 0, 0, 0);
            }
#if defined(DBG_HG) && DBG_HG == 1
            { const v2u w = *(const LAS v2u*)(lds + HG_QN + (16 * ib2 + fr) * 272 + (16 * db + 4 * fq) * 2); O = (f32x4){bflo(w.x), bfhi(w.x), bflo(w.y), bfhi(w.y)}; }
#elif defined(DBG_HG) && DBG_HG == 2
            { const v2u w = *(const LAS v2u*)(lds + HG_SCL + (16 * ib2 + fr) * 144 + (16 * db + 4 * fq) * 2); O = (f32x4){bflo(w.x), bfhi(w.x), bflo(w.y), bfhi(w.y)}; }
#elif defined(DBG_HG) && DBG_HG == 3
            { const v2u w = *(const LAS v2u*)(lds + vbuf + (16 * db + fr) * 144 + (16 * (ib2 & 3) + 4 * fq) * 2); O = (f32x4){bflo(w.x), bfhi(w.x), bflo(w.y), bfhi(w.y)}; }
#elif defined(DBG_HG) && DBG_HG == 5
            { const v2u w = *(const GAS v2u*)(gq + (size_t)TOKROW(n, 16 * ib2 + fr) * DIN + 16 * db + 4 * fq); O = (f32x4){bflo(w.x), bfhi(w.x), bflo(w.y), bfhi(w.y)}; }
#elif defined(DBG_HG) && DBG_HG == 9
            { const v2u w = *(const GAS v2u*)(gl + (size_t)TOKROW(n, 16 * ib2 + fr) * DIN + 16 * db + 4 * fq); O = (f32x4){bflo(w.x), bfhi(w.x), bflo(w.y), bfhi(w.y)}; }
#elif defined(DBG_HG) && DBG_HG == 10
            { const v2u w = *(const LAS v2u*)(lds + HG_RAWLF + (16 * ib2 + fr) * 272 + (16 * db + 4 * fq) * 2); O = (f32x4){bflo(w.x), bfhi(w.x), bflo(w.y), bfhi(w.y)}; }
#elif defined(DBG_HG) && DBG_HG == 7
            { const v2u w = *(const GAS v2u*)(P + COL_U + h * 128 + (size_t)TOKROW(n, 16 * ib2 + fr) * DIN + 16 * db + 4 * fq); O = (f32x4){bflo(w.x), bfhi(w.x), bflo(w.y), bfhi(w.y)}; }
#elif defined(DBG_HG) && DBG_HG == 8
            { O = (f32x4){(float)TOKROW(n, 16 * ib2 + fr), (float)(16 * db + 4 * fq), (float)h, (float)dq}; }
#elif defined(DBG_HG) && DBG_HG == 6
            { const v2u w = *(const LAS v2u*)(lds + HG_RAWQ + (16 * ib2 + fr) * 272 + (16 * db + 4 * fq) * 2); O = (f32x4){bflo(w.x), bfhi(w.x), bflo(w.y), bfhi(w.y)}; }
#elif defined(DBG_HG) && DBG_HG == 4
            { const v2u w = *(const LAS v2u*)(lds + HG_KN + (16 * ib2 + fr) * 272 + (16 * db + 4 * fq) * 2); O = (f32x4){bflo(w.x), bfhi(w.x), bflo(w.y), bfhi(w.y)}; }
#endif
            *(GAS f32x4*)(go + (size_t)TOKROW(n, 16 * ib2 + fr) * 512 + 16 * db + 4 * fq) = O;
        }
        {
#pragma unroll
            for (int ks = 0; ks < 2; ++ks) {
                const bf16x8 x = *(const LAS bf16x8*)(lds + HG_KT + (16 * wave + fr) * 144 + ks * 64 + fq * 16);
                const bf16x8 y0 = *(const LAS bf16x8*)(lds + vbuf + fr * 144 + ks * 64 + fq * 16);
                const bf16x8 y1 = *(const LAS bf16x8*)(lds + vbuf + (16 + fr) * 144 + ks * 64 + fq * 16);
                S0 = __builtin_amdgcn_mfma_f32_16x16x32_bf16(x, y0, S0, 0, 0, 0);
                S1 = __builtin_amdgcn_mfma_f32_16x16x32_bf16(x, y1, S1, 0, 0, 0);
            }
            const f32x4 sb = *(const LAS f32x4*)(lds + HG_SB + (16 * wave + 4 * fq) * 4);
            S0 = S0 * sb; S1 = S1 * sb;
        }
        __syncthreads();
    }
#undef HG_LOAD
#undef TOKROW
}

constexpr int H2_RAWLF = 0, H2_RAWQ = 17408, H2_ST = 0, H2_QN = 34816, H2_KN = 52224, H2_KT = 69632, H2_VT = 88064, H2_SCL = 106496, H2_SEG = 115712, H2_SA = 119808, H2_SB = 120320, H2_END = 120832;
static_assert(H2_END <= RING_BYTES, "hgrn v2 LDS");
struct Hg2Inst { int row0, L, h, dir, sc, seqid; };
__device__ __forceinline__ Hg2Inst hg2_decode(int i) {
    Hg2Inst I; const int hd = i & 7, sp = i >> 3; I.h = hd >> 1; I.dir = hd & 1;
    if (sp < 32) { const int b = sp >> 2; I.sc = sp & 3; I.row0 = 2048 * b; I.L = 2048; I.seqid = b; }
    else { const int b = (sp - 32) >> 3; I.sc = (sp - 32) & 7; I.row0 = NPROMPT + 4096 * b; I.L = 4096; I.seqid = 8 + b; }
    return I;
}
__device__ __forceinline__ int hg2_index(int seqid, int h, int dir, int sc) { const int sp = seqid < 8 ? seqid * 4 + sc : 32 + (seqid - 8) * 8 + sc; return sp * 8 + h * 2 + dir; }
__device__ __forceinline__ int hg2_xcc_inst(int x, int k) { const int hd = k & 7, sq = k >> 3; const int seqid = x < 4 ? 2 * x + (sq >> 2) : 8 + (x - 4), sc = x < 4 ? (sq & 3) : sq; return hg2_index(seqid, hd >> 1, hd & 1, sc); }
#define H2_TOKROW(p) (row0 + (dir ? (L - 1 - (p)) : (p)))
typedef float f32x2v __attribute__((ext_vector_type(2)));

__device__ __forceinline__ void hg2_state_pass(LAS unsigned char* lds, const bf16* P, float* Ebuf, float* Dbuf, int inst, int tid, int lane, int wave) {
    const Hg2Inst I = hg2_decode(inst); const int row0 = I.row0, L = I.L, h = I.h, dir = I.dir;
    const int fr = lane & 15, fq = lane >> 4, cp = lane, s8 = wave;
    const bf16* gl = P + (dir ? COL_FB : COL_FF) + h * 128;
    const bf16* gv = P + COL_I + h * 128;
    const int lr = tid >> 4, lc = tid & 15, vc = 4 * (wave & 3) + (lane & 3), lp = 16 * (wave >> 2) + (lane >> 2);
    const int p0 = 512 * I.sc;
#define H2_LOAD1(n) do { _Pragma("unroll") for (int i_ = 0; i_ < 2; ++i_) { rl[i_] = *(const GAS v4u*)(gl + (size_t)H2_TOKROW(p0 + 64 * (n) + lr + 32 * i_) * DIN + 8 * lc); \
        rv[i_] = *(const GAS v4u*)(gv + (size_t)H2_TOKROW(p0 + 64 * (n) + 2 * lp + i_) * DIN + 8 * vc); } } while (0)
    v4u rl[2], rv[2];
    H2_LOAD1(0);
    f32x4 S[8];
#pragma unroll
    for (int t = 0; t < 8; ++t) S[t] = (f32x4){0.f, 0.f, 0.f, 0.f};
    f32x2v dlog = {0.f, 0.f};
    for (int n = 0; n < 8; ++n) {
#pragma unroll
        for (int i = 0; i < 2; ++i) *(LAS v4u*)(lds + H2_RAWLF + (lr + 32 * i) * 272 + lc * 16) = rl[i];
#pragma unroll
        for (int e = 0; e < 4; ++e) { const unsigned w0 = rv[0][e], w1 = rv[1][e];
            *(LAS unsigned*)(lds + H2_VT + (8 * vc + 2 * e) * 144 + lp * 4) = (w0 & 0xffffu) | (w1 << 16);
            *(LAS unsigned*)(lds + H2_VT + (8 * vc + 2 * e + 1) * 144 + lp * 4) = (w0 >> 16) | (w1 & 0xffff0000u); }
        if (n + 1 < 8) H2_LOAD1(n + 1);
        __syncthreads();
        float lfa[8], lfb[8]; f32x2v av[8]; f32x2v run = {0.f, 0.f};
#pragma unroll
        for (int j = 0; j < 8; ++j) { const unsigned w = *(const LAS unsigned*)(lds + H2_RAWLF + (8 * s8 + j) * 272 + cp * 4);
            lfa[j] = bflo(w); lfb[j] = bfhi(w); run = run + (f32x2v){lfa[j], lfb[j]}; av[j] = run; }
        *(LAS f32x2v*)(lds + H2_SEG + (s8 * 128 + 2 * cp) * 4) = run;
        __syncthreads();
        {
            f32x2v sg_[8];
#pragma unroll
            for (int q = 0; q < 8; ++q) sg_[q] = *(const LAS f32x2v*)(lds + H2_SEG + (q * 128 + 2 * cp) * 4);
            const f32x2v amid2 = (sg_[0] + sg_[1]) + (sg_[2] + sg_[3]);
            const f32x2v atot2 = amid2 + ((sg_[4] + sg_[5]) + (sg_[6] + sg_[7]));
            f32x2v off2 = -amid2;
#pragma unroll
            for (int q = 0; q < 7; ++q) { const float mq = (q < s8) ? 1.0f : 0.0f; off2 = off2 + sg_[q] * mq; }
            unsigned kta[4], ktb[4];
#pragma unroll
            for (int j = 0; j < 8; ++j) {
                const f32x2v aa = off2 + av[j];
                const unsigned kba = f2bf((1.0f - ex2(lfa[j])) * ex2(-aa.x)), kbb = f2bf((1.0f - ex2(lfb[j])) * ex2(-aa.y));
                if (j & 1) { kta[j >> 1] |= kba << 16; ktb[j >> 1] |= kbb << 16; } else { kta[j >> 1] = kba; ktb[j >> 1] = kbb; }
            }
            *(LAS v4u*)(lds + H2_KT + (2 * cp) * 144 + s8 * 16) = (v4u){kta[0], kta[1], kta[2], kta[3]};
            *(LAS v4u*)(lds + H2_KT + (2 * cp + 1) * 144 + s8 * 16) = (v4u){ktb[0], ktb[1], ktb[2], ktb[3]};
            if (s8 == 0) { *(LAS f32x2v*)(lds + H2_SA + (2 * cp) * 4) = (f32x2v){ex2(amid2.x), ex2(amid2.y)};
                           *(LAS f32x2v*)(lds + H2_SB + (2 * cp) * 4) = (f32x2v){ex2(atot2.x - amid2.x), ex2(atot2.y - amid2.y)}; dlog = dlog + atot2; }
        }
        __syncthreads();
        {
            const f32x4 sa = *(const LAS f32x4*)(lds + H2_SA + (16 * wave + 4 * fq) * 4), sb = *(const LAS f32x4*)(lds + H2_SB + (16 * wave + 4 * fq) * 4);
            bf16x8 x[2];
#pragma unroll
            for (int ks = 0; ks < 2; ++ks) x[ks] = *(const LAS bf16x8*)(lds + H2_KT + (16 * wave + fr) * 144 + ks * 64 + fq * 16);
#pragma unroll
            for (int t = 0; t < 8; ++t) S[t] = S[t] * sa;
#pragma unroll
            for (int ks = 0; ks < 2; ++ks) { bf16x8 y[8];
#pragma unroll
                for (int t = 0; t < 8; ++t) y[t] = *(const LAS bf16x8*)(lds + H2_VT + (16 * t + fr) * 144 + ks * 64 + fq * 16);
#pragma unroll
                for (int t = 0; t < 8; ++t) S[t] = __builtin_amdgcn_mfma_f32_16x16x32_bf16(x[ks], y[t], S[t], 0, 0, 0); }
#pragma unroll
            for (int t = 0; t < 8; ++t) S[t] = S[t] * sb;
        }
        __syncthreads();
    }
    float* E = Ebuf + (size_t)inst * 16384;
#pragma unroll
    for (int t = 0; t < 8; ++t) *(GAS f32x4*)(E + ((wave * 8 + t) * 64 + lane) * 4) = S[t];
    if (s8 == 0) *(GAS f32x2v*)(Dbuf + (size_t)inst * 128 + 2 * cp) = dlog;
#undef H2_LOAD1
}

__device__ __forceinline__ void hg2_out_pass(LAS unsigned char* lds, const bf16* P, bf16* ob, const float* Ebuf, const float* Dbuf, int inst, int tid, int lane, int wave) {
    const Hg2Inst I = hg2_decode(inst); const int row0 = I.row0, L = I.L, h = I.h, dir = I.dir;
    const int fr = lane & 15, fq = lane >> 4, cp = lane, s8 = wave;
    const bf16* gq = P + COL_Q + h * 128;
    const bf16* gl = P + (dir ? COL_FB : COL_FF) + h * 128;
    const bf16* gv = P + COL_I + h * 128;
    bf16* go = ob + h * 128;
    const int lr = tid >> 4, lc = tid & 15, vc = 4 * (wave & 3) + (lane & 3), lp = 16 * (wave >> 2) + (lane >> 2);
    const int p0 = 512 * I.sc;
#define H2_LOAD2(n) do { _Pragma("unroll") for (int i_ = 0; i_ < 2; ++i_) { const size_t ro_ = (size_t)H2_TOKROW(p0 + 64 * (n) + lr + 32 * i_) * DIN + 8 * lc; rl[i_] = *(const GAS v4u*)(gl + ro_); rq[i_] = *(const GAS v4u*)(gq + ro_); \
        rv[i_] = *(const GAS v4u*)(gv + (size_t)H2_TOKROW(p0 + 64 * (n) + 2 * lp + i_) * DIN + 8 * vc); } } while (0)
    v4u rl[2], rq[2], rv[2];
    H2_LOAD2(0);
    f32x4 S[8];
#pragma unroll
    for (int t = 0; t < 8; ++t) S[t] = (f32x4){0.f, 0.f, 0.f, 0.f};
    for (int j = 0; j < I.sc; ++j) {
        const int ij = hg2_index(I.seqid, h, dir, j);
        const f32x4 dl = *(const GAS f32x4*)(Dbuf + (size_t)ij * 128 + 16 * wave + 4 * fq);
        const f32x4 dec = {ex2(dl[0]), ex2(dl[1]), ex2(dl[2]), ex2(dl[3])};
        const float* E = Ebuf + (size_t)ij * 16384;
#pragma unroll
        for (int t = 0; t < 8; ++t) S[t] = S[t] * dec + *(const GAS f32x4*)(E + ((wave * 8 + t) * 64 + lane) * 4);
    }
    for (int n = 0; n < 8; ++n) {
#pragma unroll
        for (int i = 0; i < 2; ++i) { *(LAS v4u*)(lds + H2_RAWLF + (lr + 32 * i) * 272 + lc * 16) = rl[i]; *(LAS v4u*)(lds + H2_RAWQ + (lr + 32 * i) * 272 + lc * 16) = rq[i]; }
#pragma unroll
        for (int e = 0; e < 4; ++e) { const unsigned w0 = rv[0][e], w1 = rv[1][e];
            *(LAS unsigned*)(lds + H2_VT + (8 * vc + 2 * e) * 144 + lp * 4) = (w0 & 0xffffu) | (w1 << 16);
            *(LAS unsigned*)(lds + H2_VT + (8 * vc + 2 * e + 1) * 144 + lp * 4) = (w0 >> 16) | (w1 & 0xffff0000u); }
        if (n + 1 < 8) H2_LOAD2(n + 1);
        __syncthreads();
        float lfa[8], lfb[8]; f32x2v av[8]; f32x2v run = {0.f, 0.f};
#pragma unroll
        for (int j = 0; j < 8; ++j) { const unsigned w = *(const LAS unsigned*)(lds + H2_RAWLF + (8 * s8 + j) * 272 + cp * 4);
            lfa[j] = bflo(w); lfb[j] = bfhi(w); run = run + (f32x2v){lfa[j], lfb[j]}; av[j] = run; }
        *(LAS f32x2v*)(lds + H2_SEG + (s8 * 128 + 2 * cp) * 4) = run;
        __syncthreads();
        {
            f32x2v sg_[8];
#pragma unroll
            for (int q = 0; q < 8; ++q) sg_[q] = *(const LAS f32x2v*)(lds + H2_SEG + (q * 128 + 2 * cp) * 4);
            const f32x2v amid2 = (sg_[0] + sg_[1]) + (sg_[2] + sg_[3]);
            const f32x2v atot2 = amid2 + ((sg_[4] + sg_[5]) + (sg_[6] + sg_[7]));
            f32x2v off2 = -amid2;
#pragma unroll
            for (int q = 0; q < 7; ++q) { const float mq = (q < s8) ? 1.0f : 0.0f; off2 = off2 + sg_[q] * mq; }
            unsigned kta[4], ktb[4];
#pragma unroll
            for (int j = 0; j < 8; ++j) {
                const f32x2v aa = off2 + av[j];
                const unsigned qw = *(const LAS unsigned*)(lds + H2_RAWQ + (8 * s8 + j) * 272 + cp * 4);
                const float qta = bflo(qw) * ex2(aa.x), qtb = bfhi(qw) * ex2(aa.y);
                const unsigned kba = f2bf((1.0f - ex2(lfa[j])) * ex2(-aa.x)), kbb = f2bf((1.0f - ex2(lfb[j])) * ex2(-aa.y));
                *(LAS unsigned*)(lds + H2_QN + (8 * s8 + j) * 272 + cp * 4) = pk2(qta, qtb);
                *(LAS unsigned*)(lds + H2_KN + (8 * s8 + j) * 272 + cp * 4) = kba | (kbb << 16);
                if (j & 1) { kta[j >> 1] |= kba << 16; ktb[j >> 1] |= kbb << 16; } else { kta[j >> 1] = kba; ktb[j >> 1] = kbb; }
            }
            *(LAS v4u*)(lds + H2_KT + (2 * cp) * 144 + s8 * 16) = (v4u){kta[0], kta[1], kta[2], kta[3]};
            *(LAS v4u*)(lds + H2_KT + (2 * cp + 1) * 144 + s8 * 16) = (v4u){ktb[0], ktb[1], ktb[2], ktb[3]};
            if (s8 == 0) { *(LAS f32x2v*)(lds + H2_SA + (2 * cp) * 4) = (f32x2v){ex2(amid2.x), ex2(amid2.y)};
                           *(LAS f32x2v*)(lds + H2_SB + (2 * cp) * 4) = (f32x2v){ex2(atot2.x - amid2.x), ex2(atot2.y - amid2.y)}; }
        }
        __syncthreads();
        {
            const f32x4 sa = *(const LAS f32x4*)(lds + H2_SA + (16 * wave + 4 * fq) * 4);
#pragma unroll
            for (int t = 0; t < 8; ++t) { S[t] = S[t] * sa; v2u w; w.x = pk2(S[t][0], S[t][1]); w.y = pk2(S[t][2], S[t][3]);
                *(LAS v2u*)(lds + H2_ST + (16 * t + fr) * 272 + (16 * wave + 4 * fq) * 2) = w; }
        }
        {
            const int ib = wave & 3, jp = wave >> 2;
#pragma unroll
            for (int t = 0; t < 2; ++t) {
                const int jb = 2 * jp + t;
                f32x4 sc = {0.f, 0.f, 0.f, 0.f};
                if (jb <= ib) {
#pragma unroll
                    for (int ks = 0; ks < 4; ++ks) {
                        const bf16x8 x = *(const LAS bf16x8*)(lds + H2_KN + (16 * jb + fr) * 272 + ks * 64 + fq * 16);
                        const bf16x8 y = *(const LAS bf16x8*)(lds + H2_QN + (16 * ib + fr) * 272 + ks * 64 + fq * 16);
                        sc = __builtin_amdgcn_mfma_f32_16x16x32_bf16(x, y, sc, 0, 0, 0);
                    }
                    if (jb == ib) {
#pragma unroll
                        for (int r = 0; r < 4; ++r) if (4 * fq + r > fr) sc[r] = 0.f;
                    }
                }
                v2u w; w.x = pk2(sc[0], sc[1]); w.y = pk2(sc[2], sc[3]);
                *(LAS v2u*)(lds + H2_SCL + (16 * ib + fr) * 144 + (16 * jb + 4 * fq) * 2) = w;
            }
        }
        __syncthreads();
        {
            const int ib2 = wave >> 1, dh = wave & 1;
            bf16x8 ys[2], yq[4];
#pragma unroll
            for (int ks = 0; ks < 2; ++ks) ys[ks] = *(const LAS bf16x8*)(lds + H2_SCL + (16 * ib2 + fr) * 144 + ks * 64 + fq * 16);
#pragma unroll
            for (int ks = 0; ks < 4; ++ks) yq[ks] = *(const LAS bf16x8*)(lds + H2_QN + (16 * ib2 + fr) * 272 + ks * 64 + fq * 16);
            const size_t orow = (size_t)H2_TOKROW(p0 + 64 * n + 16 * ib2 + fr) * 512;
            f32x4 O[4];
#pragma unroll
            for (int t = 0; t < 4; ++t) O[t] = (f32x4){0.f, 0.f, 0.f, 0.f};
#pragma unroll
            for (int ks = 0; ks < 2; ++ks) { bf16x8 x[4];
#pragma unroll
                for (int t = 0; t < 4; ++t) x[t] = *(const LAS bf16x8*)(lds + H2_VT + (16 * (4 * dh + t) + fr) * 144 + ks * 64 + fq * 16);
#pragma unroll
                for (int t = 0; t < 4; ++t) O[t] = __builtin_amdgcn_mfma_f32_16x16x32_bf16(x[t], ys[ks], O[t], 0, 0, 0); }
#pragma unroll
            for (int ks = 0; ks < 4; ++ks) { bf16x8 x[4];
#pragma unroll
                for (int t = 0; t < 4; ++t) x[t] = *(const LAS bf16x8*)(lds + H2_ST + (16 * (4 * dh + t) + fr) * 272 + ks * 64 + fq * 16);
#pragma unroll
                for (int t = 0; t < 4; ++t) O[t] = __builtin_amdgcn_mfma_f32_16x16x32_bf16(x[t], yq[ks], O[t], 0, 0, 0); }
#pragma unroll
            for (int t = 0; t < 4; ++t) { v2u w; w.x = pk2(O[t][0], O[t][1]); w.y = pk2(O[t][2], O[t][3]); *(GAS v2u*)(go + orow + 16 * (4 * dh + t) + 4 * fq) = w; }
        }
        {
            const f32x4 sb = *(const LAS f32x4*)(lds + H2_SB + (16 * wave + 4 * fq) * 4);
            bf16x8 x[2];
#pragma unroll
            for (int ks = 0; ks < 2; ++ks) x[ks] = *(const LAS bf16x8*)(lds + H2_KT + (16 * wave + fr) * 144 + ks * 64 + fq * 16);
#pragma unroll
            for (int ks = 0; ks < 2; ++ks) { bf16x8 y[8];
#pragma unroll
                for (int t = 0; t < 8; ++t) y[t] = *(const LAS bf16x8*)(lds + H2_VT + (16 * t + fr) * 144 + ks * 64 + fq * 16);
#pragma unroll
                for (int t = 0; t < 8; ++t) S[t] = __builtin_amdgcn_mfma_f32_16x16x32_bf16(x[ks], y[t], S[t], 0, 0, 0); }
#pragma unroll
            for (int t = 0; t < 8; ++t) S[t] = S[t] * sb;
        }
        __syncthreads();
    }
#undef H2_LOAD2
}

#ifdef DBG_NAIVE_HGRN
__device__ __forceinline__ void naive_hgrn_item(LAS unsigned char* lds, const bf16* P, float* ob, int row0, int L, int h, int dir, int tid) {
    LAS float* LQ = (LAS float*)lds; LAS float* LF = LQ + 2048; LAS float* LK = LF + 2048;
    const unsigned short* Pu = (const unsigned short*)P;
    float S[128];
#pragma unroll
    for (int k = 0; k < 128; ++k) S[k] = 0.f;
    for (int t0 = 0; t0 < L; t0 += 16) {
        __syncthreads();
#pragma unroll
        for (int i = 0; i < 4; ++i) { const int idx = tid + 512 * i, st = idx >> 7, k = idx & 127; const size_t row = (size_t)(row0 + (dir ? (L - 1 - (t0 + st)) : (t0 + st)));
            const float qv = bf1(Pu[row * DIN + COL_Q + h * 128 + k]), l2 = bf1(Pu[row * DIN + (dir ? COL_FB : COL_FF) + h * 128 + k]), f = exp2f(l2);
            LQ[st * 128 + k] = qv; LF[st * 128 + k] = f; LK[st * 128 + k] = 1.0f - f; }
        __syncthreads();
        if (tid < 128) {
#pragma unroll 1
            for (int st = 0; st < 16; ++st) { const size_t row = (size_t)(row0 + (dir ? (L - 1 - (t0 + st)) : (t0 + st)));
                const float v = bf1(Pu[row * DIN + COL_I + h * 128 + tid]); float o = 0.f;
#pragma unroll
                for (int k4 = 0; k4 < 32; ++k4) { const f32x4 f4 = *(const LAS f32x4*)(LF + st * 128 + 4 * k4), k4v = *(const LAS f32x4*)(LK + st * 128 + 4 * k4), q4 = *(const LAS f32x4*)(LQ + st * 128 + 4 * k4);
#pragma unroll
                    for (int e = 0; e < 4; ++e) { S[4 * k4 + e] = f4[e] * S[4 * k4 + e] + k4v[e] * v; o += q4[e] * S[4 * k4 + e]; } }
                ob[row * 512 + h * 128 + tid] = o; }
        }
    }
    __syncthreads();
}
#endif
__device__ __forceinline__ void hgrn_combine(const bf16* ob0, const bf16* ob1, const bf16* P, const float* onorm, const float* ssg, const float* gon, bf16* Y, int rbeg, int rend, int gw, int NGW, int lane) {
    const int c = 8 * lane;
    const f32x4 g0 = *(const GAS f32x4*)(onorm + c), g1 = *(const GAS f32x4*)(onorm + c + 4);
    const f32x4 n0 = *(const GAS f32x4*)(gon + c), n1 = *(const GAS f32x4*)(gon + c + 4);
    for (int m = rbeg + gw; m < rend; m += NGW) {
        const v4u aw = *(const GAS v4u*)(ob0 + (size_t)m * 512 + c), bw = *(const GAS v4u*)(ob1 + (size_t)m * 512 + c);
        const f32x4 a0 = {bflo(aw.x), bfhi(aw.x), bflo(aw.y), bfhi(aw.y)}, a1 = {bflo(aw.z), bfhi(aw.z), bflo(aw.w), bfhi(aw.w)};
        const f32x4 b0 = {bflo(bw.x), bfhi(bw.x), bflo(bw.y), bfhi(bw.y)}, b1 = {bflo(bw.z), bfhi(bw.z), bflo(bw.w), bfhi(bw.w)};
        const v4u sgw = *(const GAS v4u*)(P + (size_t)m * DIN + COL_G + c);
#ifdef DBG_PCOPY
        f32x4 o0 = {0.f,0.f,0.f,0.f}, o1 = o0;
        { const int segs[4] = {COL_Q, COL_I, COL_FF, COL_FB};
#pragma unroll
          for (int q_ = 0; q_ < 4; ++q_) { const v4u pw = *(const GAS v4u*)(P + (size_t)m * DIN + segs[q_] + c);
            o0 += (f32x4){bflo(pw.x), bfhi(pw.x), bflo(pw.y), bfhi(pw.y)}; o1 += (f32x4){bflo(pw.z), bfhi(pw.z), bflo(pw.w), bfhi(pw.w)}; } }
#else
        const f32x4 o0 = a0 + b0, o1 = a1 + b1;
#endif
        float s = ((o0[0] * o0[0] + o0[1] * o0[1]) + (o0[2] * o0[2] + o0[3] * o0[3])) + ((o1[0] * o1[0] + o1[1] * o1[1]) + (o1[2] * o1[2] + o1[3] * o1[3]));
        s += __shfl_xor(s, 1); s += __shfl_xor(s, 2); s += __shfl_xor(s, 4); s += __shfl_xor(s, 8);
        const float r = rsq(s * (1.0f / 128.0f) + EPS);
        const f32x4 y0 = o0 * r * g0 * (f32x4){bflo(sgw.x), bfhi(sgw.x), bflo(sgw.y), bfhi(sgw.y)};
        const f32x4 y1 = o1 * r * g1 * (f32x4){bflo(sgw.z), bfhi(sgw.z), bflo(sgw.w), bfhi(sgw.w)};
        v4u w; w.x = pk2(y0[0], y0[1]); w.y = pk2(y0[2], y0[3]); w.z = pk2(y1[0], y1[1]); w.w = pk2(y1[2], y1[3]);
        *(GAS v4u*)(Y + (size_t)m * DMODEL + 512 + c) = w;
#ifndef NO_GMLP
        const f32x4 sv = *(const GAS f32x4*)(ssg + (size_t)m * 4);
        const float rg = rsq(((sv[0] + sv[1]) + (sv[2] + sv[3])) * (1.0f / 512.0f) + EPS);
        const v4u yw = *(const GAS v4u*)(Y + (size_t)m * DMODEL + c);
        const f32x4 z0 = (f32x4){bflo(yw.x), bfhi(yw.x), bflo(yw.y), bfhi(yw.y)} * rg * n0, z1 = (f32x4){bflo(yw.z), bfhi(yw.z), bflo(yw.w), bfhi(yw.w)} * rg * n1;
        v4u zw; zw.x = pk2(z0[0], z0[1]); zw.y = pk2(z0[2], z0[3]); zw.z = pk2(z1[0], z1[1]); zw.w = pk2(z1[2], z1[3]);
        *(GAS v4u*)(Y + (size_t)m * DMODEL + c) = zw;
#endif
    }
}

constexpr int GM_RAWV = 0, GM_VLT = 34816, GM_WL = 69632, GM_MEAN = 104448, GM_RSTD = 104960, GM_END = 105472;
static_assert(GM_END <= RING_BYTES, "gmlp LDS");
__device__ __forceinline__ void gmlp_item(LAS unsigned char* lds, const bf16* P, bf16* Y, float* ssg, const float* ln_g, const float* ln_b, const float* w_s, const float* b_s, int c, int h, int tid, int lane, int wave) {
    const int fr = lane & 15, fq = lane >> 4, R0 = 128 * c;
#pragma unroll 1
    for (int jj = 0; jj < 4; ++jj) {
        float sm[4], sq[4];
#pragma unroll
        for (int j = 0; j < 4; ++j) {
            const int s = 16 * wave + 4 * jj + j;
            const v4u raw = *(const GAS v4u*)(P + (size_t)(R0 + s) * DIN + COL_V + 8 * lane);
            const float x0 = bflo(raw.x), x1 = bfhi(raw.x), x2 = bflo(raw.y), x3 = bfhi(raw.y), x4 = bflo(raw.z), x5 = bfhi(raw.z), x6 = bflo(raw.w), x7 = bfhi(raw.w);
            sm[j] = ((x0 + x1) + (x2 + x3)) + ((x4 + x5) + (x6 + x7));
            sq[j] = ((x0 * x0 + x1 * x1) + (x2 * x2 + x3 * x3)) + ((x4 * x4 + x5 * x5) + (x6 * x6 + x7 * x7));
        }
#pragma unroll
        for (int o = 1; o < 64; o <<= 1) {
#pragma unroll
            for (int j = 0; j < 4; ++j) { sm[j] += __shfl_xor(sm[j], o); sq[j] += __shfl_xor(sq[j], o); }
        }
        if (lane == 0) {
#pragma unroll
            for (int j = 0; j < 4; ++j) { const int s = 16 * wave + 4 * jj + j; const float mean = sm[j] * (1.0f / 512.0f), var = fmaxf(sq[j] * (1.0f / 512.0f) - mean * mean, 0.f);
                *(LAS float*)(lds + GM_MEAN + s * 4) = mean; *(LAS float*)(lds + GM_RSTD + s * 4) = rsq(var + EPS); }
        }
    }
#pragma unroll
    for (int i = 0; i < 4; ++i) { const int idx = tid + 512 * i, row = idx >> 4, c16 = idx & 15;
        *(LAS v4u*)(lds + GM_RAWV + row * 272 + c16 * 16) = *(const GAS v4u*)(P + (size_t)(R0 + row) * DIN + COL_V + 128 * h + 8 * c16); }
#pragma unroll
    for (int i = 0; i < 8; ++i) { const int idx = tid + 512 * i, tt = idx >> 5, s4 = idx & 31;
        const f32x4 w = *(const GAS f32x4*)(w_s + (size_t)h * 16384 + tt * 128 + 4 * s4);
        v2u o; o.x = pk2(w[0], w[1]); o.y = pk2(w[2], w[3]);
        *(LAS v2u*)(lds + GM_WL + tt * 272 + s4 * 8) = o; }
    __syncthreads();
    {
        const int ch = tid & 127, sq4 = tid >> 7;
        const float g = ln_g[128 * h + ch], b = ln_b[128 * h + ch];
#pragma unroll
        for (int i = 0; i < 4; ++i) {
            unsigned wv[4];
#pragma unroll
            for (int e = 0; e < 8; ++e) { const int s = 32 * sq4 + 8 * i + e;
                const float x = bf1(*(const LAS unsigned short*)(lds + GM_RAWV + s * 272 + ch * 2));
                const float y = (x - *(const LAS float*)(lds + GM_MEAN + s * 4)) * *(const LAS float*)(lds + GM_RSTD + s * 4) * g + b;
                const unsigned yb = f2bf(y);
                if (e & 1) wv[e >> 1] |= yb << 16; else wv[e >> 1] = yb; }
            *(LAS v4u*)(lds + GM_VLT + ch * 272 + (32 * sq4 + 8 * i) * 2) = (v4u){wv[0], wv[1], wv[2], wv[3]};
        }
    }
    __syncthreads();
    const int t = 16 * wave + fr;
    bf16x8 yf[4];
#pragma unroll
    for (int ks = 0; ks < 4; ++ks) yf[ks] = *(const LAS bf16x8*)(lds + GM_WL + (16 * wave + fr) * 272 + ks * 64 + fq * 16);
    const float bs = b_s[h * 128 + t];
    float ss = 0.f;
#pragma unroll
    for (int cb = 0; cb < 8; ++cb) {
        f32x4 a = {0.f, 0.f, 0.f, 0.f};
#pragma unroll
        for (int ks = 0; ks < 4; ++ks) {
            const bf16x8 x = *(const LAS bf16x8*)(lds + GM_VLT + (16 * cb + fr) * 272 + ks * 64 + fq * 16);
            a = __builtin_amdgcn_mfma_f32_16x16x32_bf16(x, yf[ks], a, 0, 0, 0);
        }
        const int ch = 128 * h + 16 * cb + 4 * fq;
        const v2u uw = *(const GAS v2u*)(P + (size_t)(R0 + t) * DIN + COL_U + ch);
        const f32x4 uu = {bflo(uw.x), bfhi(uw.x), bflo(uw.y), bfhi(uw.y)};
        a = (a + bs) * uu;
        ss += (a[0] * a[0] + a[1] * a[1]) + (a[2] * a[2] + a[3] * a[3]);
        v2u w; w.x = pk2(a[0], a[1]); w.y = pk2(a[2], a[3]);
        *(GAS v2u*)(Y + (size_t)(R0 + t) * DMODEL + ch) = w;
    }
    ss += __shfl_xor(ss, 16); ss += __shfl_xor(ss, 32);
    if (fq == 0) ssg[(size_t)(R0 + t) * 4 + h] = ss;
    __syncthreads();
}

struct Args { const float* in[22]; float* out; unsigned char* ws; int ph_lo, ph_hi, li, pad; };
constexpr int N_PHASES = 11;
#ifndef MK_N_LAUNCHES
#define MK_N_LAUNCHES 1
#endif
#ifndef DUP_PHASE
#define DUP_PHASE (-1)
#endif
__global__ void __launch_bounds__(NWAVES * 64, 2) fwd_kernel(Args args) {
    extern __shared__ __attribute__((aligned(16))) unsigned char lds_raw[];
    LAS unsigned char* lds = (LAS unsigned char*)lds_raw;
    volatile LAS unsigned* MISC = (volatile LAS unsigned*)(lds + MISC_OFF);
    const int tid = threadIdx.x, lane = tid & 63, wave = __builtin_amdgcn_readfirstlane(tid >> 6);
    const int G = gridDim.x, bx = blockIdx.x;
    const int vcu = (G % 8 == 0) ? (bx % 8) * (G / 8) + bx / 8 : bx;
    const int gw = vcu * NWAVES + wave, NGW = G * NWAVES;
    unsigned char* ws = args.ws;
    gu32* ctl = (gu32*)(ws + WS_CTL);
    for (int u = tid; u < (LDS_BYTES - LDSCTL_OFF) / 4; u += NWAVES * 64) ((LAS unsigned*)(lds + LDSCTL_OFF))[u] = 0u;
    __syncthreads();
    XcdBarrier bar = xcd_barrier_post((unsigned*)(ctl + CW_BAR) + args.li * XCD_BAR_WORDS, MISC + 8);
    const int lo = args.ph_lo, hi = args.ph_hi;
#define IN(k) (lo <= (k) && (k) < hi)
    int uni = 0, cid = bx, xr = 0, xx = 0;
#define SEAM(k) do { if (IN(k) && IN((k) + 1)) { if (uni) xcd_local_barrier(bar); else xcd_barrier(bar); } } while (0)
    bf16* XB = (bf16*)(ws + WS_BUFA); bf16* Y = (bf16*)(ws + WS_BUFB); bf16* BIG = (bf16*)(ws + WS_BIG);
    bf16* OB0 = (bf16*)args.out; bf16* OB1 = (bf16*)args.out + (size_t)TOK * 512;
    float* SSG = (float*)(ws + WS_SSG); float* HGE = (float*)(ws + WS_HGE); float* HGD = (float*)(ws + WS_HGD);
    float* P16_0 = (float*)(ws + WS_P16); float* P16_1 = (float*)(ws + WS_P16 + 2 * MiB); float* P16_2 = (float*)(ws + WS_P16 + 4 * MiB);

    for (int rep_ = 0; rep_ < ((DUP_PHASE == 0) ? 2 : 1); ++rep_) if (IN(0)) { p0_prologue(lds, args.in, ws, gw, NGW, wave, lane); }
    if (IN(0) && IN(1)) { xcd_barrier(bar);
        if (MISC[10] != 0u && G == 256) { uni = 1; xr = (int)MISC[11]; xx = (int)bar.x; cid = 8 * xr + xx; } }
#define PHASE1 if (IN(1)) { pg8::Gemm g{XB, (const bf16*)(ws + WS_WGU1), TOK, 2 * DFF, DMODEL}; pg8::StaticOrder S; S.init(TOK, 2 * DFF, G, cid); \
        pg8::EpiSwiGLU E{BIG, DFF, P16_0}; pg8::gemm_phase<pg8::EpiSwiGLU, pg8::StaticOrder, PG8_ALIGN, PG8_SP2>(lds + RING_OFF, g, S, E); }
    PHASE1
#if DUP_PHASE == 1
    PHASE1
#endif
    SEAM(1);
#if DUP_PHASE == 90
    for (int r_ = 0; r_ < 10; ++r_) { if (uni) xcd_local_barrier(bar); else xcd_barrier(bar); }
#endif
#define PHASE2 if (IN(2)) { pg8::Gemm g{BIG, (const bf16*)(ws + WS_WD1), TOK, DMODEL, DFF}; pg8::StaticOrder S; S.init(TOK, DMODEL, G, cid); \
        pg8::EpiResidBf<true> E{XB, P16_1, 0.5f}; pg8::gemm_phase<pg8::EpiResidBf<true>, pg8::StaticOrder, PG8_ALIGN, PG8_SP2>(lds + RING_OFF, g, S, E); }
    PHASE2
#if DUP_PHASE == 2
    PHASE2
#endif
#if DUP_PHASE == 20
    if (IN(2)) { pg8::Gemm g{BIG, (const bf16*)(ws + WS_WD1), TOK, DMODEL, DFF}; pg8::StaticOrder S; S.init(TOK, DMODEL, G, cid);
        pg8::EpiNull E{SSG}; pg8::gemm_phase<pg8::EpiNull, pg8::StaticOrder, PG8_ALIGN, PG8_SP2>(lds + RING_OFF, g, S, E); }
#endif
#if DUP_PHASE == 10
    if (IN(2)) { pg8::Gemm g{XB, (const bf16*)(ws + WS_WGU1), TOK, 2 * DFF, DMODEL}; pg8::StaticOrder S; S.init(TOK, 2 * DFF, G, cid);
        pg8::EpiNull E{SSG}; pg8::gemm_phase<pg8::EpiNull, pg8::StaticOrder, PG8_ALIGN, PG8_SP2>(lds + RING_OFF, g, S, E); }
#endif
    SEAM(2);
#define PHASE3 if (IN(3)) { pg8::Gemm g{XB, (const bf16*)(ws + WS_WIN), TOK, DIN, DMODEL}; pg8::StaticOrder S; S.init(TOK, DIN, G, cid); \
        pg8::EpiMix E{BIG, DIN, P16_1, args.in[13], args.in[14]}; pg8::gemm_phase<pg8::EpiMix, pg8::StaticOrder, PG8_ALIGN, PG8_SP2>(lds + RING_OFF, g, S, E); }
    PHASE3
#if DUP_PHASE == 3
    PHASE3
#endif
    SEAM(3);
    for (int rep_ = 0; rep_ < ((DUP_PHASE == 4 || DUP_PHASE == 40 || DUP_PHASE == 41) ? 2 : 1); ++rep_) if (IN(4)) {
        if (uni) {
            for (int k = xr; k < 64; k += 32) hg2_state_pass(lds, BIG, HGE, HGD, hg2_xcc_inst(xx, k), tid, lane, wave);
            for (int k = xr; k < 128; k += 32) gmlp_item(lds, BIG, Y, SSG, args.in[8], args.in[9], args.in[10], args.in[11], 32 * xx + (k >> 2), k & 3, tid, lane, wave);
        } else {
        if (rep_ == 0 || DUP_PHASE != 41) for (int i = bx; i < 512; i += G) hg2_state_pass(lds, BIG, HGE, HGD, i, tid, lane, wave);
        if (rep_ == 0 || DUP_PHASE != 40) for (int it = bx; it < 1024; it += G) gmlp_item(lds, BIG, Y, SSG, args.in[8], args.in[9], args.in[10], args.in[11], it >> 2, it & 3, tid, lane, wave);
        }
    }
    SEAM(4);
    for (int rep_ = 0; rep_ < ((DUP_PHASE == 5) ? 2 : 1); ++rep_) if (IN(5)) {
        if (uni) { for (int k = xr; k < 64; k += 32) { const int i = hg2_xcc_inst(xx, k); const Hg2Inst I = hg2_decode(i); hg2_out_pass(lds, BIG, I.dir ? OB1 : OB0, HGE, HGD, i, tid, lane, wave); } }
        else { for (int i = bx; i < 512; i += G) { const Hg2Inst I = hg2_decode(i); hg2_out_pass(lds, BIG, I.dir ? OB1 : OB0, HGE, HGD, i, tid, lane, wave); } }
    }
    SEAM(5);
    if (IN(6)) { if (uni) hgrn_combine(OB0, OB1, BIG, args.in[15], SSG, args.in[12], Y, 4096 * xx, 4096 * xx + 4096, 8 * xr + wave, 256, lane);
                 else hgrn_combine(OB0, OB1, BIG, args.in[15], SSG, args.in[12], Y, 0, TOK, gw, NGW, lane); }
    SEAM(6);
    if (IN(7)) { pg8::Gemm g{Y, (const bf16*)(ws + WS_WOUT), TOK, DMODEL, DMODEL}; pg8::StaticOrder S; S.init(TOK, DMODEL, G, cid);
        pg8::EpiResidBf<true> E{XB, P16_2, 1.0f};
        pg8::gemm_phase<pg8::EpiResidBf<true>, pg8::StaticOrder, PG8_ALIGN, PG8_SP2>(lds + RING_OFF, g, S, E); }
    SEAM(7);
    if (IN(8)) { pg8::Gemm g{XB, (const bf16*)(ws + WS_WGU2), TOK, 2 * DFF, DMODEL}; pg8::StaticOrder S; S.init(TOK, 2 * DFF, G, cid);
        pg8::EpiSwiGLU E{BIG, DFF, P16_2};
        pg8::gemm_phase<pg8::EpiSwiGLU, pg8::StaticOrder, PG8_ALIGN, PG8_SP2>(lds + RING_OFF, g, S, E); }
    SEAM(8);
    if (IN(9)) { pg8::Gemm g{BIG, (const bf16*)(ws + WS_WD2), TOK, DMODEL, DFF}; pg8::StaticOrder S; S.init(TOK, DMODEL, G, cid);
        pg8::EpiResidBf<false> E{XB, nullptr, 0.5f};
        pg8::gemm_phase<pg8::EpiResidBf<false>, pg8::StaticOrder, PG8_ALIGN, PG8_SP2>(lds + RING_OFF, g, S, E); }
    SEAM(9);
    if (IN(10)) { if (uni) final_norm(XB, args.out, args.in[21], 4096 * xx, 4096 * xx + 4096, 8 * xr + wave, 256, lane); else final_norm(XB, args.out, args.in[21], 0, TOK, gw, NGW, lane); }
#undef IN
#undef SEAM
}

extern "C" void kernel_launch(void* const* d_in, const int* in_sizes, int n_in, void* d_out, int out_size, void* d_ws, size_t ws_size, hipStream_t stream) {
    static int grid = 0;
    if (grid == 0) {
        if (n_in != 22 || out_size != TOK * DMODEL || ws_size < WS_END) { fprintf(stderr, "kernel_launch: unexpected problem (n_in %d, out %d, ws %zu); nothing launched\n", n_in, out_size, ws_size); grid = -1; return; }
        int dev = 0, cus = 0, per_cu = 0;
        if (hipGetDevice(&dev) != hipSuccess || hipDeviceGetAttribute(&cus, hipDeviceAttributeMultiprocessorCount, dev) != hipSuccess) { grid = -1; return; }
        if (hipFuncSetAttribute((const void*)fwd_kernel, hipFuncAttributeMaxDynamicSharedMemorySize, LDS_BYTES) != hipSuccess) { fprintf(stderr, "kernel_launch: hipFuncSetAttribute failed\n"); grid = -1; return; }
        if (hipOccupancyMaxActiveBlocksPerMultiprocessor(&per_cu, (const void*)fwd_kernel, NWAVES * 64, LDS_BYTES) != hipSuccess || per_cu < 1) { fprintf(stderr, "kernel_launch: occupancy query says %d blocks per CU; nothing launched\n", per_cu); (void)hipGetLastError(); grid = -1; return; }
        grid = cus;
    }
    if (grid < 0) return;
    if (hipMemsetAsync((char*)d_ws + WS_CTL, 0, CTL_ZERO_BYTES, stream) != hipSuccess) return;
    Args a{};
    for (int i = 0; i < 22; ++i) a.in[i] = (const float*)d_in[i];
    a.out = (float*)d_out; a.ws = (unsigned char*)d_ws;
    constexpr int NL = MK_N_LAUNCHES;
    for (int li = 0; li < NL; ++li) {
        a.ph_lo = (NL == 1) ? 0 : li; a.ph_hi = (NL == 1) ? N_PHASES : li + 1; a.li = 0;
        hipLaunchKernelGGL(fwd_kernel, dim3(grid), dim3(NWAVES * 64), LDS_BYTES, stream, a);
        if (hipPeekAtLastError() != hipSuccess) { fprintf(stderr, "kernel_launch: launch %d failed\n", li); break; }
    }
}
```

```cpp
#include <hip/hip_runtime.h>
#include <cstdio>
#include <cstdint>
namespace pg8 {
#define PG8_LAS __attribute__((address_space(3)))
typedef unsigned short bf16_t;
typedef short bf16x8 __attribute__((ext_vector_type(8)));
typedef float f32x4 __attribute__((ext_vector_type(4)));
typedef unsigned u32x4 __attribute__((ext_vector_type(4)));
constexpr int BM = 256, BK = 64, HALF = 128, HTB = HALF * BK * 2  , STAGE_BYTES = 8 * HTB, NXCD = 8, WGM = 8;

__host__ __device__ __forceinline__ int lds_byte(int r, int c) { const int st = (r >> 4) * 2 + (c >> 5), rr = r & 15, cc = c & 31, ob = rr * 64 + cc * 2; return st * 1024 + (ob ^ (((ob >> 9) & 1) << 5)); }
__host__ __device__ __forceinline__ void stage_rc(int b, int& R, int& C) { const int st = b / 1024, sb = b % 1024, swz = sb ^ (((sb >> 9) & 1) << 5); R = (st >> 1) * 16 + swz / 64; C = (st & 1) * 32 + (swz % 64) / 2; }
__host__ __device__ __forceinline__ int perm32(int rho) { const int n = rho >> 4, i = rho & 15; return 8 * (i >> 2) + 4 * n + (i & 3); }

struct Unit { int pm, pn; };
struct Gemm { const bf16_t* A; const bf16_t* Bt; int M, N, K; };

struct StaticOrder {
    int nM, nN, nwg, G, c;
    __host__ __device__ void init(int M, int N, int G_, int c_) { nM = M / BM; nN = N / BM; nwg = nM * nN; G = G_; c = c_; }
    __host__ __device__ bool next(int i, Unit& u) const {
        const long L = (long)i * G + c; if (L >= nwg) return false;
        int wgid = (int)L; { const int q = nwg / NXCD, r = nwg % NXCD, xcd = wgid % NXCD, off = wgid / NXCD; wgid = (xcd < r ? xcd * (q + 1) : r * (q + 1) + (xcd - r) * q) + off; }
        const int nig = WGM * nN, gid = wgid / nig, fm = gid * WGM, gsz = (nM - fm) < WGM ? (nM - fm) : WGM;
        u.pm = fm + ((wgid % nig) % gsz); u.pn = (wgid % nig) / gsz; return true;
    }
    __device__ __forceinline__ void a_ready(const Unit&) const {}
    __device__ __forceinline__ void done(const Unit&) const {}
};

typedef __bf16 bf16x2_hw __attribute__((ext_vector_type(2)));
typedef float f32x2_hw __attribute__((ext_vector_type(2)));
__device__ __forceinline__ unsigned cvt_pk_bf16(float lo, float hi) { const f32x2_hw v = {lo, hi}; const bf16x2_hw b = __builtin_convertvector(v, bf16x2_hw); return __builtin_bit_cast(unsigned, b); }
typedef float f32x2 __attribute__((ext_vector_type(2)));
__device__ __forceinline__ f32x2 gelu_pk(f32x2 v) {
    const f32x2 av = __builtin_elementwise_abs(v), d = av * 0.2316418882f + 1.0f;
    f32x2 t; t.x = __builtin_amdgcn_rcpf(d.x); t.y = __builtin_amdgcn_rcpf(d.y);
    f32x2 q = t * 0.5307027145f + (-0.7265760135f); q = q * t + 0.7107068705f; q = q * t + (-0.142248368f); q = q * t + 0.127414796f; q = q * t;
    const f32x2 s = (v * v) * (-0.72134752044f);
    f32x2 e; e.x = __builtin_amdgcn_exp2f(s.x); e.y = __builtin_amdgcn_exp2f(s.y);
    const f32x2 m = v * (q * e), r = v - m;
    f32x2 o; o.x = v.x < 0.f ? m.x : r.x; o.y = v.y < 0.f ? m.y : r.y; return o;
}

constexpr float RMS_EPS = 1e-6f;
constexpr int DM = 1024;
__device__ __forceinline__ float row_rstd(const float* p16, int row, int fq) {
    const f32x4 v = *(const f32x4*)(p16 + (size_t)row * 16 + 4 * fq);
    float s = (v[0] + v[1]) + (v[2] + v[3]);
    s += __shfl_xor(s, 16); s += __shfl_xor(s, 32);
    return __builtin_amdgcn_rsqf(s * (1.0f / DM) + RMS_EPS);
}
__device__ __forceinline__ void row_rstd8(const float* p16, int row0, int fq, float (&rr)[8]) {
    f32x4 pv[8];
#pragma unroll
    for (int i = 0; i < 8; ++i) pv[i] = *(const f32x4*)(p16 + (size_t)(row0 + (i >> 2) * HALF + (i & 3) * 16) * 16 + 4 * fq);
#pragma unroll
    for (int i = 0; i < 8; ++i) { float s = (pv[i][0] + pv[i][1]) + (pv[i][2] + pv[i][3]); s += __shfl_xor(s, 16); s += __shfl_xor(s, 32); rr[i] = __builtin_amdgcn_rsqf(s * (1.0f / DM) + RMS_EPS); }
}
__device__ __forceinline__ float fast_sigmoid(float z) { return __builtin_amdgcn_rcpf(1.0f + __builtin_amdgcn_exp2f(-1.44269504089f * z)); }

struct EpiSwiGLU {
    static constexpr bool PERM = true, AFTER_DRAIN = false;
    bf16_t* O; int ldo; const float* p16;
    __device__ __forceinline__ void operator()(const f32x4 (&acc)[2][2][4][2], const Unit& u, int wr, int wc, int fr, int fq) const {
        const int row0 = u.pm * BM + wr * 64 + fr, col0 = u.pn * HALF + wc * 32 + 8 * fq;
        float rr[8];
        row_rstd8(p16, row0, fq, rr);
#pragma unroll
        for (int ai = 0; ai < 2; ++ai)
#pragma unroll
            for (int m = 0; m < 4; ++m) {
                const int row = row0 + ai * HALF + m * 16;
                const float r = rr[ai * 4 + m];
                float h[8];
#pragma unroll
                for (int n = 0; n < 2; ++n)
#pragma unroll
                    for (int e = 0; e < 4; ++e) { const float g = acc[ai][0][m][n][e] * r, up = acc[ai][1][m][n][e] * r; h[4 * n + e] = g * up * fast_sigmoid(g); }
                u32x4 w; w.x = cvt_pk_bf16(h[0], h[1]); w.y = cvt_pk_bf16(h[2], h[3]); w.z = cvt_pk_bf16(h[4], h[5]); w.w = cvt_pk_bf16(h[6], h[7]);
                *(u32x4*)(O + (size_t)row * ldo + col0) = w;
            }
    }
};

template <bool WANT_BF16, bool WANT_SS> struct EpiResid {
    static constexpr bool PERM = true, AFTER_DRAIN = false;
    const float* base0; const float* base1;
    float* out; bf16_t* xb; float* p16; float alpha;
    __device__ __forceinline__ void operator()(const f32x4 (&acc)[2][2][4][2], const Unit& u, int wr, int wc, int fr, int fq) const {
        const int row0 = u.pm * BM + wr * 64 + fr, col0 = u.pn * BM + wc * 32 + 8 * fq;
        const float* bp = (u.pm < 64) ? base0 : base1; const int brow = (u.pm < 64) ? 0 : 16384;
        f32x4 bcur[4], bnxt[4];
#define RESID_LOAD(dst, it) do { const size_t bo_ = (size_t)(row0 + ((it) >> 2) * HALF + ((it) & 3) * 16 - brow) * DM + col0; \
            dst[0] = *(const f32x4*)(bp + bo_); dst[1] = *(const f32x4*)(bp + bo_ + 4); dst[2] = *(const f32x4*)(bp + bo_ + HALF); dst[3] = *(const f32x4*)(bp + bo_ + HALF + 4); } while (0)
        RESID_LOAD(bcur, 0);
#pragma unroll
        for (int it = 0; it < 8; ++it) {
            const int ai = it >> 2, m = it & 3;
            if (it + 1 < 8) RESID_LOAD(bnxt, it + 1);
            const int row = row0 + ai * HALF + m * 16; const size_t off = (size_t)row * DM + col0;
            float ss = 0.f;
#pragma unroll
            for (int bj = 0; bj < 2; ++bj) {
                const f32x4 v0 = bcur[2 * bj] + acc[ai][bj][m][0] * alpha, v1 = bcur[2 * bj + 1] + acc[ai][bj][m][1] * alpha;
                *(f32x4*)(out + off + bj * HALF) = v0; *(f32x4*)(out + off + bj * HALF + 4) = v1;
                if (WANT_BF16) { u32x4 w; w.x = cvt_pk_bf16(v0[0], v0[1]); w.y = cvt_pk_bf16(v0[2], v0[3]); w.z = cvt_pk_bf16(v1[0], v1[1]); w.w = cvt_pk_bf16(v1[2], v1[3]);
                    *(u32x4*)(xb + off + bj * HALF) = w; }
                if (WANT_SS) ss += ((v0[0] * v0[0] + v0[1] * v0[1]) + (v0[2] * v0[2] + v0[3] * v0[3])) + ((v1[0] * v1[0] + v1[1] * v1[1]) + (v1[2] * v1[2] + v1[3] * v1[3]));
            }
            if (WANT_SS) { ss += __shfl_xor(ss, 16); ss += __shfl_xor(ss, 32); if (fq == 0) p16[(size_t)row * 16 + 4 * u.pn + wc] = ss; }
#pragma unroll
            for (int q = 0; q < 4; ++q) bcur[q] = bnxt[q];
            asm volatile("" ::: "memory");
        }
#undef RESID_LOAD
    }
};

template <bool WANT_SS> struct EpiResidBf {
    static constexpr bool PERM = true, AFTER_DRAIN = false;
    bf16_t* xb; float* p16; float alpha;
    __device__ __forceinline__ void operator()(const f32x4 (&acc)[2][2][4][2], const Unit& u, int wr, int wc, int fr, int fq) const {
        const int row0 = u.pm * BM + wr * 64 + fr, col0 = u.pn * BM + wc * 32 + 8 * fq;
        u32x4 bcur[2], bnxt[2];
#define RESB_LOAD(dst, it) do { const size_t bo_ = (size_t)(row0 + ((it) >> 2) * HALF + ((it) & 3) * 16) * DM + col0; dst[0] = *(const u32x4*)(xb + bo_); dst[1] = *(const u32x4*)(xb + bo_ + HALF); } while (0)
        RESB_LOAD(bcur, 0);
#pragma unroll
        for (int it = 0; it < 8; ++it) {
            const int ai = it >> 2, m = it & 3;
            if (it + 1 < 8) RESB_LOAD(bnxt, it + 1);
            const int row = row0 + ai * HALF + m * 16; const size_t off = (size_t)row * DM + col0;
            float ss = 0.f;
#pragma unroll
            for (int bj = 0; bj < 2; ++bj) {
                const u32x4 b = bcur[bj];
                const f32x4 b0 = {__builtin_bit_cast(float, b.x << 16), __builtin_bit_cast(float, b.x & 0xffff0000u), __builtin_bit_cast(float, b.y << 16), __builtin_bit_cast(float, b.y & 0xffff0000u)};
                const f32x4 b1 = {__builtin_bit_cast(float, b.z << 16), __builtin_bit_cast(float, b.z & 0xffff0000u), __builtin_bit_cast(float, b.w << 16), __builtin_bit_cast(float, b.w & 0xffff0000u)};
                const f32x4 v0 = b0 + acc[ai][bj][m][0] * alpha, v1 = b1 + acc[ai][bj][m][1] * alpha;
                u32x4 w; w.x = cvt_pk_bf16(v0[0], v0[1]); w.y = cvt_pk_bf16(v0[2], v0[3]); w.z = cvt_pk_bf16(v1[0], v1[1]); w.w = cvt_pk_bf16(v1[2], v1[3]);
                *(u32x4*)(xb + off + bj * HALF) = w;
                if (WANT_SS) ss += ((v0[0] * v0[0] + v0[1] * v0[1]) + (v0[2] * v0[2] + v0[3] * v0[3])) + ((v1[0] * v1[0] + v1[1] * v1[1]) + (v1[2] * v1[2] + v1[3] * v1[3]));
            }
            if (WANT_SS) { ss += __shfl_xor(ss, 16); ss += __shfl_xor(ss, 32); if (fq == 0) p16[(size_t)row * 16 + 4 * u.pn + wc] = ss; }
            bcur[0] = bnxt[0]; bcur[1] = bnxt[1];
            asm volatile("" ::: "memory");
        }
#undef RESB_LOAD
    }
};
struct EpiNull { static constexpr bool PERM = true, AFTER_DRAIN = false; float* sink;
    __device__ __forceinline__ void operator()(const f32x4 (&acc)[2][2][4][2], const Unit& u, int wr, int wc, int fr, int fq) const {
        float s = 0.f;
#pragma unroll
        for (int ai = 0; ai < 2; ++ai)
#pragma unroll
            for (int bj = 0; bj < 2; ++bj)
#pragma unroll
                for (int m = 0; m < 4; ++m)
#pragma unroll
                    for (int n = 0; n < 2; ++n) s += acc[ai][bj][m][n][0] + acc[ai][bj][m][n][1] + acc[ai][bj][m][n][2] + acc[ai][bj][m][n][3];
        if (s == 12345.678f) sink[0] = s;
    } };
struct EpiMix {
    static constexpr bool PERM = true, AFTER_DRAIN = false;
    bf16_t* P; int ldp; const float* p16; const float* lbf; const float* lbb;
    template <int ACT> __device__ __forceinline__ void run(const f32x4 (&acc)[2][2][4][2], const Unit& u, int wr, int wc, int fr, int fq) const {
        const int row0 = u.pm * BM + wr * 64 + fr, col0 = u.pn * BM + wc * 32 + 8 * fq;
        float oml[2][8];
        if (ACT == 3) { const float* lb = ((u.pn >> 1) == 4) ? lbf : lbb; const int c0 = (u.pn & 1) * BM + wc * 32 + 8 * fq;
#pragma unroll
            for (int bj = 0; bj < 2; ++bj)
#pragma unroll
                for (int e = 0; e < 8; ++e) { const float a0 = lb[c0 + bj * HALF + e], a1 = lb[512 + c0 + bj * HALF + e]; oml[bj][e] = fast_sigmoid(a1 - a0);
#ifdef DBG_OML
                    oml[bj][e] = 0.5f;
#endif
                } }
        float rr[8];
        row_rstd8(p16, row0, fq, rr);
#pragma unroll
        for (int ai = 0; ai < 2; ++ai)
#pragma unroll
            for (int m = 0; m < 4; ++m) {
                const int row = row0 + ai * HALF + m * 16;
                const float r = rr[ai * 4 + m];
#pragma unroll
                for (int bj = 0; bj < 2; ++bj) {
                    float h[8];
#pragma unroll
                    for (int n = 0; n < 2; ++n) {
                        const f32x4 z = acc[ai][bj][m][n] * r;
                        if (ACT == 0) { const f32x2 a = gelu_pk((f32x2){z[0], z[1]}), b = gelu_pk((f32x2){z[2], z[3]}); h[4 * n] = a.x; h[4 * n + 1] = a.y; h[4 * n + 2] = b.x; h[4 * n + 3] = b.y; }
                        else if (ACT == 1) {
#pragma unroll
                            for (int e = 0; e < 4; ++e) h[4 * n + e] = z[e] * fast_sigmoid(z[e]); }
                        else if (ACT == 2) {
#pragma unroll
                            for (int e = 0; e < 4; ++e) h[4 * n + e] = z[e]; }
                        else {
#pragma unroll
                            for (int e = 0; e < 4; ++e) { const float kk = oml[bj][4 * n + e] * __builtin_amdgcn_rcpf(1.0f + __builtin_amdgcn_exp2f(1.44269504089f * z[e]));
                                h[4 * n + e] = __builtin_amdgcn_logf(1.0f - kk); }
                        }
                    }
                    u32x4 w; w.x = cvt_pk_bf16(h[0], h[1]); w.y = cvt_pk_bf16(h[2], h[3]); w.z = cvt_pk_bf16(h[4], h[5]); w.w = cvt_pk_bf16(h[6], h[7]);
                    *(u32x4*)(P + (size_t)row * ldp + col0 + bj * HALF) = w;
                }
            }
    }
    __device__ __forceinline__ void operator()(const f32x4 (&acc)[2][2][4][2], const Unit& u, int wr, int wc, int fr, int fq) const {
        const int seg = u.pn >> 1;
        if (seg <= 1) run<0>(acc, u, wr, wc, fr, fq);
        else if (seg == 2 || seg == 6) run<1>(acc, u, wr, wc, fr, fq);
        else if (seg == 3) run<2>(acc, u, wr, wc, fr, fq);
        else run<3>(acc, u, wr, wc, fr, fq);
    }
};

template <class Epi, class Sched, bool ALIGN_EPI = false, bool SP2 = false>
__device__ __forceinline__ void gemm_phase(PG8_LAS unsigned char* lds, const Gemm g, const Sched& S, const Epi& E) {
    const int tid = threadIdx.x, wid = __builtin_amdgcn_readfirstlane(tid >> 6), lane = tid & 63, wr = wid >> 2, wc = wid & 3, fr = lane & 15, fq = lane >> 4;
    const int K = g.K, nt = K / BK;
    unsigned voffA[2], voffB[2];
#pragma unroll
    for (int i = 0; i < 2; ++i) { int R, C; stage_rc(tid * 16 + i * 8192, R, C); const int Rb = Epi::PERM ? ((R & ~31) + perm32(R & 31)) : R;
        voffA[i] = (unsigned)(R * K + C) * 2u; voffB[i] = (unsigned)(Rb * K + C) * 2u; }
    const size_t kstep = (size_t)(BK * 2);
    const size_t hstep = (size_t)HALF * K * 2;
    const size_t tstep = 2 * hstep;
    const unsigned ldsw = (unsigned)wid * 1024u;
    const int aoff = lds_byte(wr * 64 + fr, fq * 8), boff = lds_byte(wc * 32 + fr, fq * 8);
#define PG8_SA(b, h) (((b) * 2 + (h)) * HTB)
#define PG8_SB(b, h) ((4 + (b) * 2 + (h)) * HTB)
#define PG8_STAGE(bufoff, gbase, voff) do { _Pragma("unroll") for (int _i = 0; _i < 2; ++_i) \
        __builtin_amdgcn_global_load_lds((const unsigned*)((const char*)(gbase) + (voff)[_i]), (PG8_LAS unsigned*)(lds + (bufoff) + ldsw + _i * 8192), 16, 0, 0); } while (0)
#define PG8_LDA(dst, b, h) do { _Pragma("unroll") for (int m = 0; m < 4; ++m) _Pragma("unroll") for (int k = 0; k < 2; ++k) dst[m][k] = *(const PG8_LAS bf16x8*)(lds + PG8_SA(b, h) + aoff + m * 2048 + k * 1024); } while (0)
#define PG8_LDB(dst, b, h) do { _Pragma("unroll") for (int n = 0; n < 2; ++n) _Pragma("unroll") for (int k = 0; k < 2; ++k) dst[n][k] = *(const PG8_LAS bf16x8*)(lds + PG8_SB(b, h) + boff + n * 2048 + k * 1024); } while (0)
#define PG8_MMA(ai, bj, At, Bt) do { __builtin_amdgcn_s_setprio(1); _Pragma("unroll") for (int m = 0; m < 4; ++m) _Pragma("unroll") for (int n = 0; n < 2; ++n) _Pragma("unroll") for (int k = 0; k < 2; ++k) \
        acc[ai][bj][m][n] = __builtin_amdgcn_mfma_f32_16x16x32_bf16(Bt[n][k], At[m][k], acc[ai][bj][m][n], 0, 0, 0); __builtin_amdgcn_s_setprio(0); } while (0)
#define PG8_WAIT_V(n) asm volatile("s_waitcnt vmcnt(" #n ")" ::: "memory")
#define PG8_WAIT_L(n) asm volatile("s_waitcnt lgkmcnt(" #n ")" ::: "memory")
#define PG8_BAR __builtin_amdgcn_s_barrier()
#define PG8_SCHED __builtin_amdgcn_sched_barrier(0)
    Unit cur, nxt; int ui = 0;
    if (!S.next(0, cur)) return;
    f32x4 acc[2][2][4][2];
#pragma unroll
    for (int a = 0; a < 2; ++a)
#pragma unroll
        for (int b = 0; b < 2; ++b)
#pragma unroll
            for (int m = 0; m < 4; ++m)
#pragma unroll
                for (int n = 0; n < 2; ++n) acc[a][b][m][n] = (f32x4){0.f, 0.f, 0.f, 0.f};
    bf16x8 At[4][2], B0[2][2], B1[2][2];
    const char* cA = (const char*)g.A + (size_t)cur.pm * tstep; const char* cB = (const char*)g.Bt + (size_t)cur.pn * tstep;
    S.a_ready(cur);
    if constexpr (SP2) {
        PG8_STAGE(PG8_SB(0, 0), cB, voffB); PG8_STAGE(PG8_SB(0, 1), cB + hstep, voffB); PG8_STAGE(PG8_SA(0, 0), cA, voffA); PG8_STAGE(PG8_SA(0, 1), cA + hstep, voffA);
        if (wr == 1) PG8_BAR;
        PG8_WAIT_V(2); PG8_BAR;
        PG8_STAGE(PG8_SB(1, 0), cB + kstep, voffB); PG8_STAGE(PG8_SA(1, 0), cA + kstep, voffA); PG8_STAGE(PG8_SB(1, 1), cB + hstep + kstep, voffB);
        PG8_WAIT_V(6); PG8_BAR;
    } else {
        PG8_STAGE(PG8_SB(0, 0), cB, voffB); PG8_STAGE(PG8_SA(0, 0), cA, voffA); PG8_STAGE(PG8_SB(0, 1), cB + hstep, voffB); PG8_STAGE(PG8_SA(0, 1), cA + hstep, voffA);
        if (wr == 1) PG8_BAR;
        PG8_WAIT_V(4); PG8_BAR;
        PG8_STAGE(PG8_SB(1, 0), cB + kstep, voffB); PG8_STAGE(PG8_SA(1, 0), cA + kstep, voffA); PG8_STAGE(PG8_SB(1, 1), cB + hstep + kstep, voffB);
        PG8_WAIT_V(6); PG8_BAR;
    }
    for (;;) {
        const bool has_next = S.next(ui + 1, nxt);
        const char* nA = has_next ? (const char*)g.A + (size_t)nxt.pm * tstep : cA; const char* nB = has_next ? (const char*)g.Bt + (size_t)nxt.pn * tstep : cB;
        for (int t = 0; t < nt; t += 2) {
            const bool last = (t == nt - 2);
            const char* a1 = cA + (size_t)(t + 1) * kstep;
            const char* a2 = last ? nA : cA + (size_t)(t + 2) * kstep; const char* b2 = last ? nB : cB + (size_t)(t + 2) * kstep;
            const char* a3 = a2 + kstep; const char* b3 = b2 + kstep;
            if (last && has_next) S.a_ready(nxt);
            if constexpr (SP2) {
            PG8_LDB(B0, 0, 0); PG8_LDB(B1, 0, 1); PG8_SCHED; PG8_LDA(At, 0, 0); PG8_STAGE(PG8_SA(1, 1), a1 + hstep, voffA);
            PG8_WAIT_V(8); PG8_WAIT_L(0); PG8_BAR; PG8_MMA(0, 0, At, B0); PG8_MMA(0, 1, At, B1); PG8_BAR; PG8_SCHED;
            PG8_LDA(At, 0, 1); PG8_STAGE(PG8_SB(0, 0), b2, voffB); PG8_STAGE(PG8_SB(0, 1), b2 + hstep, voffB); PG8_STAGE(PG8_SA(0, 0), a2, voffA);
            PG8_WAIT_V(8); PG8_WAIT_L(0); PG8_BAR; PG8_MMA(1, 0, At, B0); PG8_MMA(1, 1, At, B1); PG8_BAR; PG8_SCHED;
            PG8_LDB(B0, 1, 0); PG8_LDB(B1, 1, 1); PG8_SCHED; PG8_LDA(At, 1, 0); PG8_STAGE(PG8_SA(0, 1), a2 + hstep, voffA);
            PG8_WAIT_V(8); PG8_WAIT_L(0); PG8_BAR; PG8_MMA(0, 0, At, B0); PG8_MMA(0, 1, At, B1); PG8_BAR; PG8_SCHED;
            PG8_LDA(At, 1, 1); PG8_STAGE(PG8_SB(1, 0), b3, voffB); PG8_STAGE(PG8_SB(1, 1), b3 + hstep, voffB); PG8_STAGE(PG8_SA(1, 0), a3, voffA);
            PG8_WAIT_V(8); PG8_WAIT_L(0); PG8_BAR; PG8_MMA(1, 0, At, B0); PG8_MMA(1, 1, At, B1); PG8_BAR; PG8_SCHED;
            } else {
            PG8_LDB(B0, 0, 0); PG8_SCHED; PG8_LDA(At, 0, 0); PG8_STAGE(PG8_SA(1, 1), a1 + hstep, voffA);
            PG8_WAIT_L(8); PG8_BAR; PG8_WAIT_L(0); PG8_MMA(0, 0, At, B0); PG8_BAR; PG8_SCHED;
            PG8_LDB(B1, 0, 1); PG8_STAGE(PG8_SB(0, 0), b2, voffB);
            PG8_BAR; PG8_WAIT_L(0); PG8_MMA(0, 1, At, B1); PG8_BAR;
            PG8_LDA(At, 0, 1); PG8_STAGE(PG8_SA(0, 0), a2, voffA);
            PG8_BAR; PG8_WAIT_L(0); PG8_MMA(1, 0, At, B0); PG8_BAR; PG8_SCHED;
            PG8_STAGE(PG8_SB(0, 1), b2 + hstep, voffB);
            PG8_WAIT_V(6); PG8_BAR; PG8_MMA(1, 1, At, B1); PG8_BAR;
            PG8_LDB(B0, 1, 0); PG8_SCHED; PG8_LDA(At, 1, 0); PG8_STAGE(PG8_SA(0, 1), a2 + hstep, voffA);
            PG8_WAIT_L(8); PG8_BAR; PG8_WAIT_L(0); PG8_MMA(0, 0, At, B0); PG8_BAR; PG8_SCHED;
            PG8_LDB(B1, 1, 1); PG8_STAGE(PG8_SB(1, 0), b3, voffB);
            PG8_BAR; PG8_WAIT_L(0); PG8_MMA(0, 1, At, B1); PG8_BAR;
            PG8_LDA(At, 1, 1); PG8_STAGE(PG8_SA(1, 0), a3, voffA);
            PG8_BAR; PG8_WAIT_L(0); PG8_MMA(1, 0, At, B0); PG8_BAR; PG8_SCHED;
            PG8_STAGE(PG8_SB(1, 1), b3 + hstep, voffB);
            PG8_WAIT_V(6); PG8_BAR; PG8_MMA(1, 1, At, B1); PG8_BAR;
            }
        }
        if constexpr (ALIGN_EPI) { if (wr == 0) PG8_BAR; }
        if constexpr (!Epi::AFTER_DRAIN) { E(acc, cur, wr, wc, fr, fq); S.done(cur); }
        if (!has_next) break;
#pragma unroll
        for (int a = 0; a < 2; ++a)
#pragma unroll
            for (int b = 0; b < 2; ++b)
#pragma unroll
                for (int m = 0; m < 4; ++m)
#pragma unroll
                    for (int n = 0; n < 2; ++n) acc[a][b][m][n] = (f32x4){0.f, 0.f, 0.f, 0.f};
        cur = nxt; cA = nA; cB = nB; ++ui;
        if constexpr (ALIGN_EPI) { if (wr == 1) PG8_BAR; }
    }
    PG8_WAIT_V(0);
    if constexpr (!ALIGN_EPI) { if (wr == 0) PG8_BAR; }
    PG8_BAR;
    if constexpr (Epi::AFTER_DRAIN) { E.fused(acc, cur, wr, wc, fr, fq, lds, wid, lane); S.done(cur); }
#undef PG8_SA
#undef PG8_SB
#undef PG8_STAGE
#undef PG8_LDA
#undef PG8_LDB
#undef PG8_MMA
#undef PG8_WAIT_V
#undef PG8_WAIT_L
#undef PG8_BAR
#undef PG8_SCHED
}
}

#ifndef PG8_SP2
#define PG8_SP2 true
#endif
#ifndef PG8_ALIGN
#define PG8_ALIGN true
#endif
constexpr int NWAVES = 8;
constexpr int TOK = 32768, NPROMPT = 16384;
constexpr int DMODEL = 1024, DFF = 2816, DIN = 3584;
constexpr int COL_U = 0, COL_V = 512, COL_Q = 1024, COL_I = 1536, COL_FF = 2048, COL_FB = 2560, COL_G = 3072;
constexpr float EPS = 1e-6f;
constexpr size_t MiB = 1u << 20;
constexpr size_t WS_CTL = 0, CTL_ZERO_BYTES = 1 * MiB;
constexpr size_t WS_SSG = 1 * MiB;
constexpr size_t WS_P16 = 2 * MiB;
constexpr size_t WS_WGU1 = 8 * MiB, WS_WD1 = 19 * MiB, WS_WIN = 25 * MiB, WS_WOUT = 32 * MiB, WS_WGU2 = 34 * MiB, WS_WD2 = 45 * MiB;
constexpr size_t WS_BUFA = 52 * MiB;
constexpr size_t WS_BUFB = 116 * MiB;
constexpr size_t WS_BIG = 180 * MiB;
constexpr size_t WS_OB1 = 404 * MiB;
constexpr size_t WS_HGE = 468 * MiB;
constexpr size_t WS_HGD = 500 * MiB;
constexpr size_t WS_END = 501 * MiB;
static_assert(WS_WGU1 + (size_t)2 * DFF * DMODEL * 2 <= WS_WD1 && WS_WD1 + (size_t)DMODEL * DFF * 2 <= WS_WIN && WS_WIN + (size_t)DIN * DMODEL * 2 <= WS_WOUT && WS_WOUT + (size_t)DMODEL * DMODEL * 2 <= WS_WGU2
              && WS_WGU2 + (size_t)2 * DFF * DMODEL * 2 <= WS_WD2 && WS_WD2 + (size_t)DMODEL * DFF * 2 <= WS_BUFA && WS_BUFA + (size_t)TOK * DMODEL * 2 <= WS_BUFB && WS_BUFB + (size_t)TOK * DMODEL * 2 <= WS_BIG
              && WS_BIG + (size_t)TOK * DIN * 2 <= WS_OB1 && WS_OB1 + (size_t)TOK * 512 * 4 <= WS_HGE && WS_HGE + (size_t)512 * 65536 <= WS_HGD && WS_P16 + 3 * 2 * MiB <= WS_WGU1, "d_ws map");
constexpr int CW_BAR = 4096;
constexpr int RING_OFF = 0, RING_BYTES = 131072;
constexpr int LDSCTL_OFF = RING_BYTES, MISC_OFF = LDSCTL_OFF + 320;
constexpr int LDS_BYTES = 147456;
static_assert(MISC_OFF + 128 <= LDS_BYTES, "LDS map");

#define GAS __attribute__((address_space(1)))
#define LAS __attribute__((address_space(3)))
typedef unsigned short bf16;
typedef unsigned v4u __attribute__((ext_vector_type(4)));
typedef float f32x4 __attribute__((ext_vector_type(4)));
typedef short bf16x8 __attribute__((ext_vector_type(8)));
typedef GAS unsigned gu32;
typedef GAS unsigned long long gu64;
#define RLX_AGENT __ATOMIC_RELAXED, __HIP_MEMORY_SCOPE_AGENT
#define LDS_WAIT() asm volatile("s_waitcnt lgkmcnt(0)" ::: "memory")
#define VM_WAIT() asm volatile("s_waitcnt vmcnt(0)" ::: "memory")
__device__ __forceinline__ unsigned long long rt() { return __builtin_amdgcn_s_memrealtime(); }
__device__ __forceinline__ unsigned f2bf(float f) { unsigned u = __builtin_bit_cast(unsigned, f); return (u + 0x7fffu + ((u >> 16) & 1u)) >> 16; }
__device__ __forceinline__ unsigned pk2(float lo, float hi) { return f2bf(lo) | (f2bf(hi) << 16); }

#define XB_TMO      128
#define XB_XCNT(j)  (256  + 64 * (j))
#define XB_XSUB(j)  (1280 + 64 * (j))
#define XB_XGEN(j)  (2304 + 64 * (j))
#define XB_TOP      3328
#define XB_TOPGEN   3392
#define XCD_BAR_WORDS 3456
#define XB_SPIN_CAP (1u << 18)

__device__ __forceinline__ unsigned xb_ld(unsigned* p)              { return __hip_atomic_load(p, __ATOMIC_RELAXED, __HIP_MEMORY_SCOPE_AGENT); }
__device__ __forceinline__ unsigned xb_add(unsigned* p, unsigned v) { return __hip_atomic_fetch_add(p, v, __ATOMIC_RELAXED, __HIP_MEMORY_SCOPE_AGENT); }
__device__ __forceinline__ unsigned xb_xcc_id() { return (unsigned)__builtin_amdgcn_s_getreg((3 << 11) | 20) & 0xFu; }
#define XB_SPIN(cond, bar) do { unsigned _sp = 0; while (cond) { __builtin_amdgcn_s_sleep(1); \
    if ((++_sp & 255u) == 0u) { if (xb_ld(&(bar)[XB_TMO])) break; if (_sp > XB_SPIN_CAP) { atomicAdd(&(bar)[XB_TMO], 1u); break; } } } } while (0)

struct XcdBarrier {
    unsigned* bar; unsigned x;
    volatile LAS unsigned* st;
};

__device__ __forceinline__ XcdBarrier xcd_barrier_post(unsigned* bar, volatile LAS unsigned* st) {
    XcdBarrier b; b.bar = bar; b.x = xb_xcc_id(); b.st = st;
    if (threadIdx.x == 0) st[3] = xb_add(&bar[XB_XCNT(b.x)], 1u);
    return b;
}
__device__ __forceinline__ void xcd_barrier_complete(unsigned* bar, unsigned x, unsigned& nloc, unsigned& nx) {
    const unsigned G = gridDim.x * gridDim.y * gridDim.z;
    unsigned sum, cnt, mine, sp = 0u;
    for (;;) {
        sum = 0u; cnt = 0u; mine = 0u;
#pragma unroll
        for (unsigned j = 0; j < 16; ++j) { const unsigned c = xb_ld(&bar[XB_XCNT(j)]); sum += c; cnt += (c > 0u) ? 1u : 0u; mine = (j == x) ? c : mine; }
        if (sum == G) break;
        __builtin_amdgcn_s_sleep(1);
        if ((++sp & 255u) == 0u) { if (xb_ld(&bar[XB_TMO])) break; if (sp > XB_SPIN_CAP) { atomicAdd(&bar[XB_TMO], 1u); break; } }
    }
    nloc = mine > 0u ? mine : 1u; nx = cnt > 0u ? cnt : 1u;
}
__device__ __forceinline__ unsigned xcd_census_uniform(unsigned* bar) {
    const unsigned G = gridDim.x * gridDim.y * gridDim.z; unsigned ok = (G % 8u == 0u) ? 1u : 0u;
#pragma unroll
    for (unsigned j = 0; j < 16; ++j) { const unsigned c = xb_ld(&bar[XB_XCNT(j)]); if (j < 8u ? (c != G / 8u) : (c != 0u)) ok = 0u; }
    return (xb_ld(&bar[XB_TMO]) == 0u) ? ok : 0u;
}

__device__ __forceinline__ void xcd_barrier(const XcdBarrier& b) {
    asm volatile("s_waitcnt vmcnt(0)" ::: "memory");
    __syncthreads();
    if (threadIdx.x == 0) {
        unsigned* bar = b.bar;
        __builtin_amdgcn_s_waitcnt(0);
        unsigned nloc = b.st[0], nx = b.st[1];
        if (nloc == 0u) { xcd_barrier_complete(bar, b.x, nloc, nx); b.st[0] = nloc; b.st[1] = nx; b.st[2] = xcd_census_uniform(bar); }
        const unsigned old = xb_add(&bar[XB_XSUB(b.x)], 1u);
        const unsigned gen = old / nloc;
        if (old + 1u == (gen + 1u) * nloc) {
            __builtin_amdgcn_fence(__ATOMIC_RELEASE, "agent");
            asm volatile("s_waitcnt vmcnt(0)" ::: "memory");
            const unsigned og = xb_add(&bar[XB_TOP], 1u);
            const unsigned tg = og / nx;
            if (og + 1u == (tg + 1u) * nx) xb_add(&bar[XB_TOPGEN], 1u);
            else XB_SPIN(xb_ld(&bar[XB_TOPGEN]) == tg, bar);
            __builtin_amdgcn_fence(__ATOMIC_ACQUIRE, "agent");
            xb_add(&bar[XB_XGEN(b.x)], 1u);
            asm volatile("s_waitcnt vmcnt(0)" ::: "memory");
        } else {
            XB_SPIN(xb_ld(&bar[XB_XGEN(b.x)]) == gen, bar);
            __builtin_amdgcn_fence(__ATOMIC_ACQUIRE, "agent");
            asm volatile("s_waitcnt vmcnt(0)" ::: "memory");
        }
    }
    __syncthreads();
}
#define XB_LSUB(j)  (3456 + 64 * (j))
#define XB_LGEN(j)  (4480 + 64 * (j))
__device__ __forceinline__ void xcd_local_barrier(const XcdBarrier& b, unsigned seq) {
    asm volatile("s_waitcnt vmcnt(0)" ::: "memory");
    __syncthreads();
    if (threadIdx.x == 0) {
        unsigned* bar = b.bar;
        const unsigned target = seq * b.st[0];
        __hip_atomic_fetch_add(&bar[XB_LSUB(b.x)], 1u, __ATOMIC_RELAXED, __HIP_MEMORY_SCOPE_AGENT);
        asm volatile("buffer_inv sc1" ::: "memory");
        XB_SPIN(xb_ld(&bar[XB_LSUB(b.x)]) < target, bar);
        asm volatile("s_waitcnt vmcnt(0)" ::: "memory");
    }
    __syncthreads();
}

typedef unsigned v2u __attribute__((ext_vector_type(2)));
__device__ __forceinline__ float wave_sum(float v) {
#pragma unroll
    for (int o = 1; o < 64; o <<= 1) v += __shfl_xor(v, o);
    return v;
}
__device__ __forceinline__ float bflo(unsigned w) { return __builtin_bit_cast(float, w << 16); }
__device__ __forceinline__ float bfhi(unsigned w) { return __builtin_bit_cast(float, w & 0xffff0000u); }
__device__ __forceinline__ float bf1(unsigned short h) { return __builtin_bit_cast(float, (unsigned)h << 16); }
__device__ __forceinline__ float ex2(float x) { return __builtin_amdgcn_exp2f(x); }
__device__ __forceinline__ float rsq(float x) { return __builtin_amdgcn_rsqf(x); }

__device__ __forceinline__ void p0_item(const float* W, int Nsrc, int k0, int scol0, const float* gain, bf16* WT, int K, int drow0, LAS float* scr, int lane) {
    const int r8 = lane >> 3, c4 = 4 * (lane & 7);
    f32x4 v[8];
#pragma unroll
    for (int i = 0; i < 8; ++i) v[i] = *(const GAS f32x4*)(W + (size_t)(k0 + 8 * i + r8) * Nsrc + scol0 + c4);
#pragma unroll
    for (int i = 0; i < 8; ++i) { const int kk = 8 * i + r8; f32x4 t = v[i]; if (gain) t = t * gain[k0 + kk];
        scr[kk * 33 + c4] = t[0]; scr[kk * 33 + c4 + 1] = t[1]; scr[kk * 33 + c4 + 2] = t[2]; scr[kk * 33 + c4 + 3] = t[3]; }
    LDS_WAIT(); asm volatile("" ::: "memory");
    const int c = lane & 7;
#pragma unroll
    for (int j = 0; j < 4; ++j) { const int n = (lane >> 3) + 8 * j; const LAS float* s = scr + (8 * c) * 33 + n;
        v4u o; o.x = pk2(s[0 * 33], s[1 * 33]); o.y = pk2(s[2 * 33], s[3 * 33]); o.z = pk2(s[4 * 33], s[5 * 33]); o.w = pk2(s[6 * 33], s[7 * 33]);
        *(GAS v4u*)(WT + (size_t)(drow0 + n) * K + k0 + 8 * c) = o; }
    LDS_WAIT(); asm volatile("" ::: "memory");
}
__device__ __forceinline__ void p0_gu(const float* Wg, const float* Wu, const float* gain, bf16* WT, int r, LAS float* scr, int lane) {
    const int nblk = 2 * DFF / 32, kb = r / nblk, nb = r % nblk, n0 = 32 * nb, pn = n0 >> 8, bj = (n0 >> 7) & 1, j0 = n0 & 127;
    p0_item(bj ? Wu : Wg, DFF, 64 * kb, 128 * pn + j0, gain, WT, DMODEL, n0, scr, lane);
}
__device__ __forceinline__ void p0_plain(const float* W, int K, int N, const float* gain, bf16* WT, int r, LAS float* scr, int lane) {
    const int nblk = N / 32, kb = r / nblk, nb = r % nblk;
    p0_item(W, N, 64 * kb, 32 * nb, gain, WT, K, 32 * nb, scr, lane);
}
__device__ __forceinline__ void p0_prologue(LAS unsigned char* lds, const float* const* in, unsigned char* ws, int gw, int NGW, int wave, int lane) {
    LAS float* scr = (LAS float*)(lds + RING_OFF + wave * 16384);
    constexpr int I_GU = (DMODEL / 64) * (2 * DFF / 32), I_D = (DFF / 64) * (DMODEL / 32), I_IN = (DMODEL / 64) * (DIN / 32), I_OUT = (DMODEL / 64) * (DMODEL / 32);
    constexpr int NITEMS = 2 * I_GU + 2 * I_D + I_IN + I_OUT;
    for (int it = gw; it < NITEMS; it += NGW) {
        int r = it;
        if (r < I_GU) { p0_gu(in[3], in[4], in[2], (bf16*)(ws + WS_WGU1), r, scr, lane); continue; } r -= I_GU;
        if (r < I_GU) { p0_gu(in[18], in[19], in[17], (bf16*)(ws + WS_WGU2), r, scr, lane); continue; } r -= I_GU;
        if (r < I_D) { p0_plain(in[5], DFF, DMODEL, nullptr, (bf16*)(ws + WS_WD1), r, scr, lane); continue; } r -= I_D;
        if (r < I_D) { p0_plain(in[20], DFF, DMODEL, nullptr, (bf16*)(ws + WS_WD2), r, scr, lane); continue; } r -= I_D;
        if (r < I_IN) { p0_plain(in[7], DMODEL, DIN, in[6], (bf16*)(ws + WS_WIN), r, scr, lane); continue; } r -= I_IN;
        p0_plain(in[16], DMODEL, DMODEL, nullptr, (bf16*)(ws + WS_WOUT), r, scr, lane);
    }
    bf16* XB = (bf16*)(ws + WS_BUFA); float* p16 = (float*)(ws + WS_P16);
    for (int m0 = gw; m0 < TOK; m0 += 4 * NGW) {
        f32x4 v[4][4]; float s[4];
#pragma unroll
        for (int q = 0; q < 4; ++q) { const int m = m0 + q * NGW;
            if (m < TOK) { const float* xrow = m < NPROMPT ? in[0] + (size_t)m * DMODEL : in[1] + (size_t)(m - NPROMPT) * DMODEL; const GAS f32x4* xr = (const GAS f32x4*)xrow + lane;
#pragma unroll
                for (int j = 0; j < 4; ++j) v[q][j] = xr[64 * j]; } }
#pragma unroll
        for (int q = 0; q < 4; ++q) { s[q] = 0.f;
#pragma unroll
            for (int j = 0; j < 4; ++j) s[q] += (v[q][j].x * v[q][j].x + v[q][j].y * v[q][j].y) + (v[q][j].z * v[q][j].z + v[q][j].w * v[q][j].w); }
#pragma unroll
        for (int o = 1; o < 64; o <<= 1) {
#pragma unroll
            for (int q = 0; q < 4; ++q) s[q] += __shfl_xor(s[q], o); }
#pragma unroll
        for (int q = 0; q < 4; ++q) { const int m = m0 + q * NGW;
            if (m < TOK) { GAS v2u* o8 = (GAS v2u*)(XB + (size_t)m * DMODEL) + lane;
#pragma unroll
                for (int j = 0; j < 4; ++j) { v2u w; w.x = pk2(v[q][j].x, v[q][j].y); w.y = pk2(v[q][j].z, v[q][j].w); o8[64 * j] = w; }
                if (lane < 16) p16[(size_t)m * 16 + lane] = lane == 0 ? s[q] : 0.f; } }
    }
}

__device__ __forceinline__ void final_norm(const bf16* XBr, float* out, const float* gfin, int rbeg, int rend, int gw, int NGW, int lane) {
    for (int m = rbeg + gw; m < rend; m += NGW) {
        const v4u w0 = *(const GAS v4u*)(XBr + (size_t)m * DMODEL + 8 * lane), w1 = *(const GAS v4u*)(XBr + (size_t)m * DMODEL + 512 + 8 * lane);
        float x[16] = {bflo(w0.x), bfhi(w0.x), bflo(w0.y), bfhi(w0.y), bflo(w0.z), bfhi(w0.z), bflo(w0.w), bfhi(w0.w), bflo(w1.x), bfhi(w1.x), bflo(w1.y), bfhi(w1.y), bflo(w1.z), bfhi(w1.z), bflo(w1.w), bfhi(w1.w)};
        float s = 0.f;
#pragma unroll
        for (int e = 0; e < 16; ++e) s += x[e] * x[e];
        const float r = rsq(wave_sum(s) * (1.0f / DMODEL) + EPS);
#pragma unroll
        for (int j = 0; j < 2; ++j) { const int c = 512 * j + 8 * lane;
            const f32x4 g0 = *(const GAS f32x4*)(gfin + c), g1 = *(const GAS f32x4*)(gfin + c + 4);
            *(GAS f32x4*)(out + (size_t)m * DMODEL + c) = (f32x4){x[8 * j] * r * g0[0], x[8 * j + 1] * r * g0[1], x[8 * j + 2] * r * g0[2], x[8 * j + 3] * r * g0[3]};
            *(GAS f32x4*)(out + (size_t)m * DMODEL + c + 4) = (f32x4){x[8 * j + 4] * r * g1[0], x[8 * j + 5] * r * g1[1], x[8 * j + 6] * r * g1[2], x[8 * j + 7] * r * g1[3]}; }
    }
}

constexpr int HG_RAWLF = 0, HG_RAWQ = 17408, HG_QN = 34816, HG_KN = 52224, HG_KT = 69632, HG_VT = 88064, HG_SCL = 97280, HG_ST = 106496, HG_SEG = 115200, HG_SA = 119296, HG_SB = 119808, HG_END = 120320;
static_assert(HG_END <= RING_BYTES, "hgrn LDS");
__device__ __forceinline__ void hgrn_item(LAS unsigned char* lds, const bf16* P, float* ob, int row0, int L, int h, int dir, int dq, int tid, int lane, int wave) {
    const int fr = lane & 15, fq = lane >> 4, nch = L >> 6;
    const bf16* gq = P + COL_Q + h * 128;
    const bf16* gl = P + (dir ? COL_FB : COL_FF) + h * 128;
    const bf16* gv = P + COL_I + h * 128 + dq * 32;
    float* go = ob + h * 128 + dq * 32;
    const int lr = tid >> 4, lc = tid & 15, lp = (tid >> 2) & 31, vc = tid & 3, cp = lane, s8 = wave;
#define TOKROW(n, l) (row0 + (dir ? (L - 1 - (64 * (n) + (l))) : (64 * (n) + (l))))
#define HG_LOAD(n) do { _Pragma("unroll") for (int i_ = 0; i_ < 2; ++i_) { const size_t ro_ = (size_t)TOKROW(n, lr + 32 * i_) * DIN + 8 * lc; rl[i_] = *(const GAS v4u*)(gl + ro_); rq[i_] = *(const GAS v4u*)(gq + ro_); \
        rv[i_] = *(const GAS v4u*)(gv + (size_t)TOKROW(n, 2 * lp + i_) * DIN + 8 * vc); } } while (0)
    v4u rl[2], rq[2], rv[2];
    HG_LOAD(0);
    f32x4 S0 = {0.f, 0.f, 0.f, 0.f}, S1 = {0.f, 0.f, 0.f, 0.f};
    for (int n = 0; n < nch; ++n) {
        const int vbuf = HG_VT + (n & 1) * 4608;
#pragma unroll
        for (int i = 0; i < 2; ++i) { *(LAS v4u*)(lds + HG_RAWLF + (lr + 32 * i) * 272 + lc * 16) = rl[i]; *(LAS v4u*)(lds + HG_RAWQ + (lr + 32 * i) * 272 + lc * 16) = rq[i]; }
        if (tid < 128) {
#pragma unroll
            for (int e = 0; e < 4; ++e) { const unsigned w0 = rv[0][e], w1 = rv[1][e];
                *(LAS unsigned*)(lds + vbuf + (8 * vc + 2 * e) * 144 + lp * 4) = (w0 & 0xffffu) | (w1 << 16);
                *(LAS unsigned*)(lds + vbuf + (8 * vc + 2 * e + 1) * 144 + lp * 4) = (w0 >> 16) | (w1 & 0xffff0000u); }
        }
        if (n + 1 < nch) HG_LOAD(n + 1);
        __syncthreads();
        float lfa[8], lfb[8], ava[8], avb[8]; float runa = 0.f, runb = 0.f;
#pragma unroll
        for (int j = 0; j < 8; ++j) { const unsigned w = *(const LAS unsigned*)(lds + HG_RAWLF + (8 * s8 + j) * 272 + cp * 4);
            lfa[j] = bflo(w); lfb[j] = bfhi(w); runa += lfa[j]; runb += lfb[j]; ava[j] = runa; avb[j] = runb; }
        *(LAS v2u*)(lds + HG_SEG + (s8 * 128 + 2 * cp) * 4) = (v2u){__builtin_bit_cast(unsigned, runa), __builtin_bit_cast(unsigned, runb)};
        __syncthreads();
        {
            typedef float f32x2v __attribute__((ext_vector_type(2)));
            f32x2v sg_[8];
#pragma unroll
            for (int q = 0; q < 8; ++q) sg_[q] = *(const LAS f32x2v*)(lds + HG_SEG + (q * 128 + 2 * cp) * 4);
            const f32x2v amid2 = (sg_[0] + sg_[1]) + (sg_[2] + sg_[3]);
            const f32x2v atot2 = amid2 + ((sg_[4] + sg_[5]) + (sg_[6] + sg_[7]));
            f32x2v off2 = -amid2;
#pragma unroll
            for (int q = 0; q < 7; ++q) { const float mq = (q < s8) ? 1.0f : 0.0f; off2 = off2 + sg_[q] * mq; }
            const float amida = amid2.x, amidb = amid2.y, atota = atot2.x, atotb = atot2.y;
            const float offa = off2.x, offb = off2.y;
            unsigned kta[4], ktb[4];
#pragma unroll
            for (int j = 0; j < 8; ++j) {
                const float aa = offa + ava[j], ab = offb + avb[j];
                const unsigned qw = *(const LAS unsigned*)(lds + HG_RAWQ + (8 * s8 + j) * 272 + cp * 4);
                const float qta = bflo(qw) * ex2(aa), qtb = bfhi(qw) * ex2(ab);
                const float k_a = (1.0f - ex2(lfa[j])) * ex2(-aa), k_b = (1.0f - ex2(lfb[j])) * ex2(-ab);
                const unsigned kba = f2bf(k_a), kbb = f2bf(k_b);
                *(LAS unsigned*)(lds + HG_QN + (8 * s8 + j) * 272 + cp * 4) = pk2(qta, qtb);
                *(LAS unsigned*)(lds + HG_KN + (8 * s8 + j) * 272 + cp * 4) = kba | (kbb << 16);
                if (j & 1) { kta[j >> 1] |= kba << 16; ktb[j >> 1] |= kbb << 16; } else { kta[j >> 1] = kba; ktb[j >> 1] = kbb; }
            }
            *(LAS v4u*)(lds + HG_KT + (2 * cp) * 144 + s8 * 16) = (v4u){kta[0], kta[1], kta[2], kta[3]};
            *(LAS v4u*)(lds + HG_KT + (2 * cp + 1) * 144 + s8 * 16) = (v4u){ktb[0], ktb[1], ktb[2], ktb[3]};
            if (s8 == 0) { *(LAS v2u*)(lds + HG_SA + (2 * cp) * 4) = (v2u){__builtin_bit_cast(unsigned, ex2(amida)), __builtin_bit_cast(unsigned, ex2(amidb))};
                           *(LAS v2u*)(lds + HG_SB + (2 * cp) * 4) = (v2u){__builtin_bit_cast(unsigned, ex2(atota - amida)), __builtin_bit_cast(unsigned, ex2(atotb - amidb))}; }
        }
        __syncthreads();
        {
            const f32x4 sa = *(const LAS f32x4*)(lds + HG_SA + (16 * wave + 4 * fq) * 4);
            S0 = S0 * sa; S1 = S1 * sa;
#ifdef DBG_NOSTATE
            S0 = (f32x4){0.f,0.f,0.f,0.f}; S1 = S0;
#endif
            v2u w0, w1; w0.x = pk2(S0[0], S0[1]); w0.y = pk2(S0[2], S0[3]); w1.x = pk2(S1[0], S1[1]); w1.y = pk2(S1[2], S1[3]);
            *(LAS v2u*)(lds + HG_ST + fr * 272 + (16 * wave + 4 * fq) * 2) = w0;
            *(LAS v2u*)(lds + HG_ST + (16 + fr) * 272 + (16 * wave + 4 * fq) * 2) = w1;
        }
        {
            const int ib = wave & 3, jp = wave >> 2;
#pragma unroll
            for (int t = 0; t < 2; ++t) {
                const int jb = 2 * jp + t;
                f32x4 sc = {0.f, 0.f, 0.f, 0.f};
                if (jb <= ib) {
#pragma unroll
                    for (int ks = 0; ks < 4; ++ks) {
                        const bf16x8 x = *(const LAS bf16x8*)(lds + HG_KN + (16 * jb + fr) * 272 + ks * 64 + fq * 16);
                        const bf16x8 y = *(const LAS bf16x8*)(lds + HG_QN + (16 * ib + fr) * 272 + ks * 64 + fq * 16);
                        sc = __builtin_amdgcn_mfma_f32_16x16x32_bf16(x, y, sc, 0, 0, 0);
                    }
                    if (jb == ib) {
#pragma unroll
                        for (int r = 0; r < 4; ++r) if (4 * fq + r > fr) sc[r] = 0.f;
                    }
                }
                v2u w; w.x = pk2(sc[0], sc[1]); w.y = pk2(sc[2], sc[3]);
                *(LAS v2u*)(lds + HG_SCL + (16 * ib + fr) * 144 + (16 * jb + 4 * fq) * 2) = w;
            }
        }
        __syncthreads();
        {
            const int ib2 = wave >> 1, db = wave & 1;
            f32x4 O = {0.f, 0.f, 0.f, 0.f};
#pragma unroll
            for (int ks = 0; ks < 2; ++ks) {
                const bf16x8 x = *(const LAS bf16x8*)(lds + vbuf + (16 * db + fr) * 144 + ks * 64 + fq * 16);
                const bf16x8 y = *(const LAS bf16x8*)(lds + HG_SCL + (16 * ib2 + fr) * 144 + ks * 64 + fq * 16);
                O = __builtin_amdgcn_mfma_f32_16x16x32_bf16(x, y, O, 0, 0, 0);
            }
#pragma unroll
            for (int ks = 0; ks < 4; ++ks) {
                const bf16x8 x = *(const LAS bf16x8*)(lds + HG_ST + (16 * db + fr) * 272 + ks * 64 + fq * 16);
                const bf16x8 y = *(const LAS bf16x8*)(lds + HG_QN + (16 * ib2 + fr) * 272 + ks * 64 + fq * 16);
                O = __builtin_amdgcn_mfma_f32_16x16x32_bf16(x, y, O, 0, 0, 0);
            }
#if defined(DBG_HG) && DBG_HG == 1
            { const v2u w = *(const LAS v2u*)(lds + HG_QN + (16 * ib2 + fr) * 272 + (16 * db + 4 * fq) * 2); O = (f32x4){bflo(w.x), bfhi(w.x), bflo(w.y), bfhi(w.y)}; }
#elif defined(DBG_HG) && DBG_HG == 2
            { const v2u w = *(const LAS v2u*)(lds + HG_SCL + (16 * ib2 + fr) * 144 + (16 * db + 4 * fq) * 2); O = (f32x4){bflo(w.x), bfhi(w.x), bflo(w.y), bfhi(w.y)}; }
#elif defined(DBG_HG) && DBG_HG == 3
            { const v2u w = *(const LAS v2u*)(lds + vbuf + (16 * db + fr) * 144 + (16 * (ib2 & 3) + 4 * fq) * 2); O = (f32x4){bflo(w.x), bfhi(w.x), bflo(w.y), bfhi(w.y)}; }
#elif defined(DBG_HG) && DBG_HG == 5
            { const v2u w = *(const GAS v2u*)(gq + (size_t)TOKROW(n, 16 * ib2 + fr) * DIN + 16 * db + 4 * fq); O = (f32x4){bflo(w.x), bfhi(w.x), bflo(w.y), bfhi(w.y)}; }
#elif defined(DBG_HG) && DBG_HG == 9
            { const v2u w = *(const GAS v2u*)(gl + (size_t)TOKROW(n, 16 * ib2 + fr) * DIN + 16 * db + 4 * fq); O = (f32x4){bflo(w.x), bfhi(w.x), bflo(w.y), bfhi(w.y)}; }
#elif defined(DBG_HG) && DBG_HG == 10
            { const v2u w = *(const LAS v2u*)(lds + HG_RAWLF + (16 * ib2 + fr) * 272 + (16 * db + 4 * fq) * 2); O = (f32x4){bflo(w.x), bfhi(w.x), bflo(w.y), bfhi(w.y)}; }
#elif defined(DBG_HG) && DBG_HG == 7
            { const v2u w = *(const GAS v2u*)(P + COL_U + h * 128 + (size_t)TOKROW(n, 16 * ib2 + fr) * DIN + 16 * db + 4 * fq); O = (f32x4){bflo(w.x), bfhi(w.x), bflo(w.y), bfhi(w.y)}; }
#elif defined(DBG_HG) && DBG_HG == 8
            { O = (f32x4){(float)TOKROW(n, 16 * ib2 + fr), (float)(16 * db + 4 * fq), (float)h, (float)dq}; }
#elif defined(DBG_HG) && DBG_HG == 6
            { const v2u w = *(const LAS v2u*)(lds + HG_RAWQ + (16 * ib2 + fr) * 272 + (16 * db + 4 * fq) * 2); O = (f32x4){bflo(w.x), bfhi(w.x), bflo(w.y), bfhi(w.y)}; }
#elif defined(DBG_HG) && DBG_HG == 4
            { const v2u w = *(const LAS v2u*)(lds + HG_KN + (16 * ib2 + fr) * 272 + (16 * db + 4 * fq) * 2); O = (f32x4){bflo(w.x), bfhi(w.x), bflo(w.y), bfhi(w.y)}; }
#endif
            *(GAS f32x4*)(go + (size_t)TOKROW(n, 16 * ib2 + fr) * 512 + 16 * db + 4 * fq) = O;
        }
        {
#pragma unroll
            for (int ks = 0; ks < 2; ++ks) {
                const bf16x8 x = *(const LAS bf16x8*)(lds + HG_KT + (16 * wave + fr) * 144 + ks * 64 + fq * 16);
                const bf16x8 y0 = *(const LAS bf16x8*)(lds + vbuf + fr * 144 + ks * 64 + fq * 16);
                const bf16x8 y1 = *(const LAS bf16x8*)(lds + vbuf + (16 + fr) * 144 + ks * 64 + fq * 16);
                S0 = __builtin_amdgcn_mfma_f32_16x16x32_bf16(x, y0, S0, 0, 0, 0);
                S1 = __builtin_amdgcn_mfma_f32_16x16x32_bf16(x, y1, S1, 0, 0, 0);
            }
            const f32x4 sb = *(const LAS f32x4*)(lds + HG_SB + (16 * wave + 4 * fq) * 4);
            S0 = S0 * sb; S1 = S1 * sb;
        }
        __syncthreads();
    }
#undef HG_LOAD
#undef TOKROW
}

constexpr int H2_RAWLF = 0, H2_RAWQ = 17408, H2_ST = 0, H2_QN = 34816, H2_KN = 52224, H2_KT = 69632, H2_VT = 88064, H2_SCL = 106496, H2_SEG = 115712, H2_SA = 119808, H2_SB = 120320, H2_END = 120832;
static_assert(H2_END <= RING_BYTES, "hgrn v2 LDS");
struct Hg2Inst { int row0, L, h, dir, sc, seqid; };
__device__ __forceinline__ Hg2Inst hg2_decode(int i) {
    Hg2Inst I; const int hd = i & 7, sp = i >> 3; I.h = hd >> 1; I.dir = hd & 1;
    if (sp < 32) { const int b = sp >> 2; I.sc = sp & 3; I.row0 = 2048 * b; I.L = 2048; I.seqid = b; }
    else { const int b = (sp - 32) >> 3; I.sc = (sp - 32) & 7; I.row0 = NPROMPT + 4096 * b; I.L = 4096; I.seqid = 8 + b; }
    return I;
}
__device__ __forceinline__ int hg2_index(int seqid, int h, int dir, int sc) { const int sp = seqid < 8 ? seqid * 4 + sc : 32 + (seqid - 8) * 8 + sc; return sp * 8 + h * 2 + dir; }
__device__ __forceinline__ int hg2_xcc_inst(int x, int k) { const int hd = k & 7, sq = k >> 3; const int seqid = x < 4 ? 2 * x + (sq >> 2) : 8 + (x - 4), sc = x < 4 ? (sq & 3) : sq; return hg2_index(seqid, hd >> 1, hd & 1, sc); }
#define H2_TOKROW(p) (row0 + (dir ? (L - 1 - (p)) : (p)))
typedef float f32x2v __attribute__((ext_vector_type(2)));

__device__ __forceinline__ void hg2_state_pass(LAS unsigned char* lds, const bf16* P, float* Ebuf, float* Dbuf, int inst, int tid, int lane, int wave) {
    const Hg2Inst I = hg2_decode(inst); const int row0 = I.row0, L = I.L, h = I.h, dir = I.dir;
    const int fr = lane & 15, fq = lane >> 4, cp = lane, s8 = wave;
    const bf16* gl = P + (dir ? COL_FB : COL_FF) + h * 128;
    const bf16* gv = P + COL_I + h * 128;
    const int lr = tid >> 4, lc = tid & 15, vc = 4 * (wave & 3) + (lane & 3), lp = 16 * (wave >> 2) + (lane >> 2);
    const int p0 = 512 * I.sc;
#define H2_LOAD1(n) do { _Pragma("unroll") for (int i_ = 0; i_ < 2; ++i_) { rl[i_] = *(const GAS v4u*)(gl + (size_t)H2_TOKROW(p0 + 64 * (n) + lr + 32 * i_) * DIN + 8 * lc); \
        rv[i_] = *(const GAS v4u*)(gv + (size_t)H2_TOKROW(p0 + 64 * (n) + 2 * lp + i_) * DIN + 8 * vc); } } while (0)
    v4u rl[2], rv[2];
    H2_LOAD1(0);
    f32x4 S[8];
#pragma unroll
    for (int t = 0; t < 8; ++t) S[t] = (f32x4){0.f, 0.f, 0.f, 0.f};
    f32x2v dlog = {0.f, 0.f};
    for (int n = 0; n < 8; ++n) {
#pragma unroll
        for (int i = 0; i < 2; ++i) *(LAS v4u*)(lds + H2_RAWLF + (lr + 32 * i) * 272 + lc * 16) = rl[i];
#pragma unroll
        for (int e = 0; e < 4; ++e) { const unsigned w0 = rv[0][e], w1 = rv[1][e];
            *(LAS unsigned*)(lds + H2_VT + (8 * vc + 2 * e) * 144 + lp * 4) = (w0 & 0xffffu) | (w1 << 16);
            *(LAS unsigned*)(lds + H2_VT + (8 * vc + 2 * e + 1) * 144 + lp * 4) = (w0 >> 16) | (w1 & 0xffff0000u); }
        if (n + 1 < 8) H2_LOAD1(n + 1);
        __syncthreads();
        float lfa[8], lfb[8]; f32x2v av[8]; f32x2v run = {0.f, 0.f};
#pragma unroll
        for (int j = 0; j < 8; ++j) { const unsigned w = *(const LAS unsigned*)(lds + H2_RAWLF + (8 * s8 + j) * 272 + cp * 4);
            lfa[j] = bflo(w); lfb[j] = bfhi(w); run = run + (f32x2v){lfa[j], lfb[j]}; av[j] = run; }
        *(LAS f32x2v*)(lds + H2_SEG + (s8 * 128 + 2 * cp) * 4) = run;
        __syncthreads();
        {
            f32x2v sg_[8];
#pragma unroll
            for (int q = 0; q < 8; ++q) sg_[q] = *(const LAS f32x2v*)(lds + H2_SEG + (q * 128 + 2 * cp) * 4);
            const f32x2v amid2 = (sg_[0] + sg_[1]) + (sg_[2] + sg_[3]);
            const f32x2v atot2 = amid2 + ((sg_[4] + sg_[5]) + (sg_[6] + sg_[7]));
            f32x2v off2 = -amid2;
#pragma unroll
            for (int q = 0; q < 7; ++q) { const float mq = (q < s8) ? 1.0f : 0.0f; off2 = off2 + sg_[q] * mq; }
            unsigned kta[4], ktb[4];
#pragma unroll
            for (int j = 0; j < 8; ++j) {
                const f32x2v aa = off2 + av[j];
                const unsigned kba = f2bf((1.0f - ex2(lfa[j])) * ex2(-aa.x)), kbb = f2bf((1.0f - ex2(lfb[j])) * ex2(-aa.y));
                if (j & 1) { kta[j >> 1] |= kba << 16; ktb[j >> 1] |= kbb << 16; } else { kta[j >> 1] = kba; ktb[j >> 1] = kbb; }
            }
            *(LAS v4u*)(lds + H2_KT + (2 * cp) * 144 + s8 * 16) = (v4u){kta[0], kta[1], kta[2], kta[3]};
            *(LAS v4u*)(lds + H2_KT + (2 * cp + 1) * 144 + s8 * 16) = (v4u){ktb[0], ktb[1], ktb[2], ktb[3]};
            if (s8 == 0) { *(LAS f32x2v*)(lds + H2_SA + (2 * cp) * 4) = (f32x2v){ex2(amid2.x), ex2(amid2.y)};
                           *(LAS f32x2v*)(lds + H2_SB + (2 * cp) * 4) = (f32x2v){ex2(atot2.x - amid2.x), ex2(atot2.y - amid2.y)}; dlog = dlog + atot2; }
        }
        __syncthreads();
        {
            const f32x4 sa = *(const LAS f32x4*)(lds + H2_SA + (16 * wave + 4 * fq) * 4), sb = *(const LAS f32x4*)(lds + H2_SB + (16 * wave + 4 * fq) * 4);
            bf16x8 x[2];
#pragma unroll
            for (int ks = 0; ks < 2; ++ks) x[ks] = *(const LAS bf16x8*)(lds + H2_KT + (16 * wave + fr) * 144 + ks * 64 + fq * 16);
#pragma unroll
            for (int t = 0; t < 8; ++t) S[t] = S[t] * sa;
#pragma unroll
            for (int ks = 0; ks < 2; ++ks) { bf16x8 y[8];
#pragma unroll
                for (int t = 0; t < 8; ++t) y[t] = *(const LAS bf16x8*)(lds + H2_VT + (16 * t + fr) * 144 + ks * 64 + fq * 16);
#pragma unroll
                for (int t = 0; t < 8; ++t) S[t] = __builtin_amdgcn_mfma_f32_16x16x32_bf16(x[ks], y[t], S[t], 0, 0, 0); }
#pragma unroll
            for (int t = 0; t < 8; ++t) S[t] = S[t] * sb;
        }
        __syncthreads();
    }
    float* E = Ebuf + (size_t)inst * 16384;
#pragma unroll
    for (int t = 0; t < 8; ++t) *(GAS f32x4*)(E + ((wave * 8 + t) * 64 + lane) * 4) = S[t];
    if (s8 == 0) *(GAS f32x2v*)(Dbuf + (size_t)inst * 128 + 2 * cp) = dlog;
#undef H2_LOAD1
}

__device__ __forceinline__ void hg2_out_pass(LAS unsigned char* lds, const bf16* P, bf16* ob, const float* Ebuf, const float* Dbuf, int inst, int tid, int lane, int wave) {
    const Hg2Inst I = hg2_decode(inst); const int row0 = I.row0, L = I.L, h = I.h, dir = I.dir;
    const int fr = lane & 15, fq = lane >> 4, cp = lane, s8 = wave;
    const bf16* gq = P + COL_Q + h * 128;
    const bf16* gl = P + (dir ? COL_FB : COL_FF) + h * 128;
    const bf16* gv = P + COL_I + h * 128;
    bf16* go = ob + h * 128;
    const int lr = tid >> 4, lc = tid & 15, vc = 4 * (wave & 3) + (lane & 3), lp = 16 * (wave >> 2) + (lane >> 2);
    const int p0 = 512 * I.sc;
#define H2_LOAD2(n) do { _Pragma("unroll") for (int i_ = 0; i_ < 2; ++i_) { const size_t ro_ = (size_t)H2_TOKROW(p0 + 64 * (n) + lr + 32 * i_) * DIN + 8 * lc; rl[i_] = *(const GAS v4u*)(gl + ro_); rq[i_] = *(const GAS v4u*)(gq + ro_); \
        rv[i_] = *(const GAS v4u*)(gv + (size_t)H2_TOKROW(p0 + 64 * (n) + 2 * lp + i_) * DIN + 8 * vc); } } while (0)
    v4u rl[2], rq[2], rv[2];
    H2_LOAD2(0);
    f32x4 S[8];
#pragma unroll
    for (int t = 0; t < 8; ++t) S[t] = (f32x4){0.f, 0.f, 0.f, 0.f};
    for (int j = 0; j < I.sc; ++j) {
        const int ij = hg2_index(I.seqid, h, dir, j);
        const f32x4 dl = *(const GAS f32x4*)(Dbuf + (size_t)ij * 128 + 16 * wave + 4 * fq);
        const f32x4 dec = {ex2(dl[0]), ex2(dl[1]), ex2(dl[2]), ex2(dl[3])};
        const float* E = Ebuf + (size_t)ij * 16384;
#pragma unroll
        for (int t = 0; t < 8; ++t) S[t] = S[t] * dec + *(const GAS f32x4*)(E + ((wave * 8 + t) * 64 + lane) * 4);
    }
    for (int n = 0; n < 8; ++n) {
#pragma unroll
        for (int i = 0; i < 2; ++i) { *(LAS v4u*)(lds + H2_RAWLF + (lr + 32 * i) * 272 + lc * 16) = rl[i]; *(LAS v4u*)(lds + H2_RAWQ + (lr + 32 * i) * 272 + lc * 16) = rq[i]; }
#pragma unroll
        for (int e = 0; e < 4; ++e) { const unsigned w0 = rv[0][e], w1 = rv[1][e];
            *(LAS unsigned*)(lds + H2_VT + (8 * vc + 2 * e) * 144 + lp * 4) = (w0 & 0xffffu) | (w1 << 16);
            *(LAS unsigned*)(lds + H2_VT + (8 * vc + 2 * e + 1) * 144 + lp * 4) = (w0 >> 16) | (w1 & 0xffff0000u); }
        if (n + 1 < 8) H2_LOAD2(n + 1);
        __syncthreads();
        float lfa[8], lfb[8]; f32x2v av[8]; f32x2v run = {0.f, 0.f};
#pragma unroll
        for (int j = 0; j < 8; ++j) { const unsigned w = *(const LAS unsigned*)(lds + H2_RAWLF + (8 * s8 + j) * 272 + cp * 4);
            lfa[j] = bflo(w); lfb[j] = bfhi(w); run = run + (f32x2v){lfa[j], lfb[j]}; av[j] = run; }
        *(LAS f32x2v*)(lds + H2_SEG + (s8 * 128 + 2 * cp) * 4) = run;
        __syncthreads();
        {
            f32x2v sg_[8];
#pragma unroll
            for (int q = 0; q < 8; ++q) sg_[q] = *(const LAS f32x2v*)(lds + H2_SEG + (q * 128 + 2 * cp) * 4);
            const f32x2v amid2 = (sg_[0] + sg_[1]) + (sg_[2] + sg_[3]);
            const f32x2v atot2 = amid2 + ((sg_[4] + sg_[5]) + (sg_[6] + sg_[7]));
            f32x2v off2 = -amid2;
#pragma unroll
            for (int q = 0; q < 7; ++q) { const float mq = (q < s8) ? 1.0f : 0.0f; off2 = off2 + sg_[q] * mq; }
            unsigned kta[4], ktb[4];
#pragma unroll
            for (int j = 0; j < 8; ++j) {
                const f32x2v aa = off2 + av[j];
                const unsigned qw = *(const LAS unsigned*)(lds + H2_RAWQ + (8 * s8 + j) * 272 + cp * 4);
                const float qta = bflo(qw) * ex2(aa.x), qtb = bfhi(qw) * ex2(aa.y);
                const unsigned kba = f2bf((1.0f - ex2(lfa[j])) * ex2(-aa.x)), kbb = f2bf((1.0f - ex2(lfb[j])) * ex2(-aa.y));
                *(LAS unsigned*)(lds + H2_QN + (8 * s8 + j) * 272 + cp * 4) = pk2(qta, qtb);
                *(LAS unsigned*)(lds + H2_KN + (8 * s8 + j) * 272 + cp * 4) = kba | (kbb << 16);
                if (j & 1) { kta[j >> 1] |= kba << 16; ktb[j >> 1] |= kbb << 16; } else { kta[j >> 1] = kba; ktb[j >> 1] = kbb; }
            }
            *(LAS v4u*)(lds + H2_KT + (2 * cp) * 144 + s8 * 16) = (v4u){kta[0], kta[1], kta[2], kta[3]};
            *(LAS v4u*)(lds + H2_KT + (2 * cp + 1) * 144 + s8 * 16) = (v4u){ktb[0], ktb[1], ktb[2], ktb[3]};
            if (s8 == 0) { *(LAS f32x2v*)(lds + H2_SA + (2 * cp) * 4) = (f32x2v){ex2(amid2.x), ex2(amid2.y)};
                           *(LAS f32x2v*)(lds + H2_SB + (2 * cp) * 4) = (f32x2v){ex2(atot2.x - amid2.x), ex2(atot2.y - amid2.y)}; }
        }
        __syncthreads();
        {
            const f32x4 sa = *(const LAS f32x4*)(lds + H2_SA + (16 * wave + 4 * fq) * 4);
#pragma unroll
            for (int t = 0; t < 8; ++t) { S[t] = S[t] * sa; v2u w; w.x = pk2(S[t][0], S[t][1]); w.y = pk2(S[t][2], S[t][3]);
                *(LAS v2u*)(lds + H2_ST + (16 * t + fr) * 272 + (16 * wave + 4 * fq) * 2) = w; }
        }
        {
            const int ib = wave & 3, jp = wave >> 2;
#pragma unroll
            for (int t = 0; t < 2; ++t) {
                const int jb = 2 * jp + t;
                f32x4 sc = {0.f, 0.f, 0.f, 0.f};
                if (jb <= ib) {
#pragma unroll
                    for (int ks = 0; ks < 4; ++ks) {
                        const bf16x8 x = *(const LAS bf16x8*)(lds + H2_KN + (16 * jb + fr) * 272 + ks * 64 + fq * 16);
                        const bf16x8 y = *(const LAS bf16x8*)(lds + H2_QN + (16 * ib + fr) * 272 + ks * 64 + fq * 16);
                        sc = __builtin_amdgcn_mfma_f32_16x16x32_bf16(x, y, sc, 0, 0, 0);
                    }
                    if (jb == ib) {
#pragma unroll
                        for (int r = 0; r < 4; ++r) if (4 * fq + r > fr) sc[r] = 0.f;
                    }
                }
                v2u w; w.x = pk2(sc[0], sc[1]); w.y = pk2(sc[2], sc[3]);
                *(LAS v2u*)(lds + H2_SCL + (16 * ib + fr) * 144 + (16 * jb + 4 * fq) * 2) = w;
            }
        }
        __syncthreads();
        {
            const int ib2 = wave >> 1, dh = wave & 1;
            bf16x8 ys[2], yq[4];
#pragma unroll
            for (int ks = 0; ks < 2; ++ks) ys[ks] = *(const LAS bf16x8*)(lds + H2_SCL + (16 * ib2 + fr) * 144 + ks * 64 + fq * 16);
#pragma unroll
            for (int ks = 0; ks < 4; ++ks) yq[ks] = *(const LAS bf16x8*)(lds + H2_QN + (16 * ib2 + fr) * 272 + ks * 64 + fq * 16);
            const size_t orow = (size_t)H2_TOKROW(p0 + 64 * n + 16 * ib2 + fr) * 512;
            f32x4 O[4];
#pragma unroll
            for (int t = 0; t < 4; ++t) O[t] = (f32x4){0.f, 0.f, 0.f, 0.f};
#pragma unroll
            for (int ks = 0; ks < 2; ++ks) { bf16x8 x[4];
#pragma unroll
                for (int t = 0; t < 4; ++t) x[t] = *(const LAS bf16x8*)(lds + H2_VT + (16 * (4 * dh + t) + fr) * 144 + ks * 64 + fq * 16);
#pragma unroll
                for (int t = 0; t < 4; ++t) O[t] = __builtin_amdgcn_mfma_f32_16x16x32_bf16(x[t], ys[ks], O[t], 0, 0, 0); }
#pragma unroll
            for (int ks = 0; ks < 4; ++ks) { bf16x8 x[4];
#pragma unroll
                for (int t = 0; t < 4; ++t) x[t] = *(const LAS bf16x8*)(lds + H2_ST + (16 * (4 * dh + t) + fr) * 272 + ks * 64 + fq * 16);
#pragma unroll
                for (int t = 0; t < 4; ++t) O[t] = __builtin_amdgcn_mfma_f32_16x16x32_bf16(x[t], yq[ks], O[t], 0, 0, 0); }
#pragma unroll
            for (int t = 0; t < 4; ++t) { v2u w; w.x = pk2(O[t][0], O[t][1]); w.y = pk2(O[t][2], O[t][3]); *(GAS v2u*)(go + orow + 16 * (4 * dh + t) + 4 * fq) = w; }
        }
        {
            const f32x4 sb = *(const LAS f32x4*)(lds + H2_SB + (16 * wave + 4 * fq) * 4);
            bf16x8 x[2];
#pragma unroll
            for (int ks = 0; ks < 2; ++ks) x[ks] = *(const LAS bf16x8*)(lds + H2_KT + (16 * wave + fr) * 144 + ks * 64 + fq * 16);
#pragma unroll
            for (int ks = 0; ks < 2; ++ks) { bf16x8 y[8];
#pragma unroll
                for (int t = 0; t < 8; ++t) y[t] = *(const LAS bf16x8*)(lds + H2_VT + (16 * t + fr) * 144 + ks * 64 + fq * 16);
#pragma unroll
                for (int t = 0; t < 8; ++t) S[t] = __builtin_amdgcn_mfma_f32_16x16x32_bf16(x[ks], y[t], S[t], 0, 0, 0); }
#pragma unroll
            for (int t = 0; t < 8; ++t) S[t] = S[t] * sb;
        }
        __syncthreads();
    }
#undef H2_LOAD2
}

#ifdef DBG_NAIVE_HGRN
__device__ __forceinline__ void naive_hgrn_item(LAS unsigned char* lds, const bf16* P, float* ob, int row0, int L, int h, int dir, int tid) {
    LAS float* LQ = (LAS float*)lds; LAS float* LF = LQ + 2048; LAS float* LK = LF + 2048;
    const unsigned short* Pu = (const unsigned short*)P;
    float S[128];
#pragma unroll
    for (int k = 0; k < 128; ++k) S[k] = 0.f;
    for (int t0 = 0; t0 < L; t0 += 16) {
        __syncthreads();
#pragma unroll
        for (int i = 0; i < 4; ++i) { const int idx = tid + 512 * i, st = idx >> 7, k = idx & 127; const size_t row = (size_t)(row0 + (dir ? (L - 1 - (t0 + st)) : (t0 + st)));
            const float qv = bf1(Pu[row * DIN + COL_Q + h * 128 + k]), l2 = bf1(Pu[row * DIN + (dir ? COL_FB : COL_FF) + h * 128 + k]), f = exp2f(l2);
            LQ[st * 128 + k] = qv; LF[st * 128 + k] = f; LK[st * 128 + k] = 1.0f - f; }
        __syncthreads();
        if (tid < 128) {
#pragma unroll 1
            for (int st = 0; st < 16; ++st) { const size_t row = (size_t)(row0 + (dir ? (L - 1 - (t0 + st)) : (t0 + st)));
                const float v = bf1(Pu[row * DIN + COL_I + h * 128 + tid]); float o = 0.f;
#pragma unroll
                for (int k4 = 0; k4 < 32; ++k4) { const f32x4 f4 = *(const LAS f32x4*)(LF + st * 128 + 4 * k4), k4v = *(const LAS f32x4*)(LK + st * 128 + 4 * k4), q4 = *(const LAS f32x4*)(LQ + st * 128 + 4 * k4);
#pragma unroll
                    for (int e = 0; e < 4; ++e) { S[4 * k4 + e] = f4[e] * S[4 * k4 + e] + k4v[e] * v; o += q4[e] * S[4 * k4 + e]; } }
                ob[row * 512 + h * 128 + tid] = o; }
        }
    }
    __syncthreads();
}
#endif
__device__ __forceinline__ void hgrn_combine(const bf16* ob0, const bf16* ob1, const bf16* P, const float* onorm, const float* ssg, const float* gon, bf16* Y, int rbeg, int rend, int gw, int NGW, int lane) {
    const int c = 8 * lane;
    const f32x4 g0 = *(const GAS f32x4*)(onorm + c), g1 = *(const GAS f32x4*)(onorm + c + 4);
    const f32x4 n0 = *(const GAS f32x4*)(gon + c), n1 = *(const GAS f32x4*)(gon + c + 4);
    for (int m = rbeg + gw; m < rend; m += NGW) {
        const v4u aw = *(const GAS v4u*)(ob0 + (size_t)m * 512 + c), bw = *(const GAS v4u*)(ob1 + (size_t)m * 512 + c);
        const f32x4 a0 = {bflo(aw.x), bfhi(aw.x), bflo(aw.y), bfhi(aw.y)}, a1 = {bflo(aw.z), bfhi(aw.z), bflo(aw.w), bfhi(aw.w)};
        const f32x4 b0 = {bflo(bw.x), bfhi(bw.x), bflo(bw.y), bfhi(bw.y)}, b1 = {bflo(bw.z), bfhi(bw.z), bflo(bw.w), bfhi(bw.w)};
        const v4u sgw = *(const GAS v4u*)(P + (size_t)m * DIN + COL_G + c);
#ifdef DBG_PCOPY
        f32x4 o0 = {0.f,0.f,0.f,0.f}, o1 = o0;
        { const int segs[4] = {COL_Q, COL_I, COL_FF, COL_FB};
#pragma unroll
          for (int q_ = 0; q_ < 4; ++q_) { const v4u pw = *(const GAS v4u*)(P + (size_t)m * DIN + segs[q_] + c);
            o0 += (f32x4){bflo(pw.x), bfhi(pw.x), bflo(pw.y), bfhi(pw.y)}; o1 += (f32x4){bflo(pw.z), bfhi(pw.z), bflo(pw.w), bfhi(pw.w)}; } }
#else
        const f32x4 o0 = a0 + b0, o1 = a1 + b1;
#endif
        float s = ((o0[0] * o0[0] + o0[1] * o0[1]) + (o0[2] * o0[2] + o0[3] * o0[3])) + ((o1[0] * o1[0] + o1[1] * o1[1]) + (o1[2] * o1[2] + o1[3] * o1[3]));
        s += __shfl_xor(s, 1); s += __shfl_xor(s, 2); s += __shfl_xor(s, 4); s += __shfl_xor(s, 8);
        const float r = rsq(s * (1.0f / 128.0f) + EPS);
        const f32x4 y0 = o0 * r * g0 * (f32x4){bflo(sgw.x), bfhi(sgw.x), bflo(sgw.y), bfhi(sgw.y)};
        const f32x4 y1 = o1 * r * g1 * (f32x4){bflo(sgw.z), bfhi(sgw.z), bflo(sgw.w), bfhi(sgw.w)};
        v4u w; w.x = pk2(y0[0], y0[1]); w.y = pk2(y0[2], y0[3]); w.z = pk2(y1[0], y1[1]); w.w = pk2(y1[2], y1[3]);
        *(GAS v4u*)(Y + (size_t)m * DMODEL + 512 + c) = w;
#ifndef NO_GMLP
        const f32x4 sv = *(const GAS f32x4*)(ssg + (size_t)m * 4);
        const float rg = rsq(((sv[0] + sv[1]) + (sv[2] + sv[3])) * (1.0f / 512.0f) + EPS);
        const v4u yw = *(const GAS v4u*)(Y + (size_t)m * DMODEL + c);
        const f32x4 z0 = (f32x4){bflo(yw.x), bfhi(yw.x), bflo(yw.y), bfhi(yw.y)} * rg * n0, z1 = (f32x4){bflo(yw.z), bfhi(yw.z), bflo(yw.w), bfhi(yw.w)} * rg * n1;
        v4u zw; zw.x = pk2(z0[0], z0[1]); zw.y = pk2(z0[2], z0[3]); zw.z = pk2(z1[0], z1[1]); zw.w = pk2(z1[2], z1[3]);
        *(GAS v4u*)(Y + (size_t)m * DMODEL + c) = zw;
#endif
    }
}

constexpr int GM_RAWV = 0, GM_VLT = 34816, GM_WL = 69632, GM_MEAN = 104448, GM_RSTD = 104960, GM_END = 105472;
static_assert(GM_END <= RING_BYTES, "gmlp LDS");
__device__ __forceinline__ void gmlp_item(LAS unsigned char* lds, const bf16* P, bf16* Y, float* ssg, const float* ln_g, const float* ln_b, const float* w_s, const float* b_s, int c, int h, int tid, int lane, int wave) {
    const int fr = lane & 15, fq = lane >> 4, R0 = 128 * c;
#pragma unroll 1
    for (int jj = 0; jj < 4; ++jj) {
        float sm[4], sq[4];
#pragma unroll
        for (int j = 0; j < 4; ++j) {
            const int s = 16 * wave + 4 * jj + j;
            const v4u raw = *(const GAS v4u*)(P + (size_t)(R0 + s) * DIN + COL_V + 8 * lane);
            const float x0 = bflo(raw.x), x1 = bfhi(raw.x), x2 = bflo(raw.y), x3 = bfhi(raw.y), x4 = bflo(raw.z), x5 = bfhi(raw.z), x6 = bflo(raw.w), x7 = bfhi(raw.w);
            sm[j] = ((x0 + x1) + (x2 + x3)) + ((x4 + x5) + (x6 + x7));
            sq[j] = ((x0 * x0 + x1 * x1) + (x2 * x2 + x3 * x3)) + ((x4 * x4 + x5 * x5) + (x6 * x6 + x7 * x7));
        }
#pragma unroll
        for (int o = 1; o < 64; o <<= 1) {
#pragma unroll
            for (int j = 0; j < 4; ++j) { sm[j] += __shfl_xor(sm[j], o); sq[j] += __shfl_xor(sq[j], o); }
        }
        if (lane == 0) {
#pragma unroll
            for (int j = 0; j < 4; ++j) { const int s = 16 * wave + 4 * jj + j; const float mean = sm[j] * (1.0f / 512.0f), var = fmaxf(sq[j] * (1.0f / 512.0f) - mean * mean, 0.f);
                *(LAS float*)(lds + GM_MEAN + s * 4) = mean; *(LAS float*)(lds + GM_RSTD + s * 4) = rsq(var + EPS); }
        }
    }
#pragma unroll
    for (int i = 0; i < 4; ++i) { const int idx = tid + 512 * i, row = idx >> 4, c16 = idx & 15;
        *(LAS v4u*)(lds + GM_RAWV + row * 272 + c16 * 16) = *(const GAS v4u*)(P + (size_t)(R0 + row) * DIN + COL_V + 128 * h + 8 * c16); }
#pragma unroll
    for (int i = 0; i < 8; ++i) { const int idx = tid + 512 * i, tt = idx >> 5, s4 = idx & 31;
        const f32x4 w = *(const GAS f32x4*)(w_s + (size_t)h * 16384 + tt * 128 + 4 * s4);
        v2u o; o.x = pk2(w[0], w[1]); o.y = pk2(w[2], w[3]);
        *(LAS v2u*)(lds + GM_WL + tt * 272 + s4 * 8) = o; }
    __syncthreads();
    {
        const int ch = tid & 127, sq4 = tid >> 7;
        const float g = ln_g[128 * h + ch], b = ln_b[128 * h + ch];
#pragma unroll
        for (int i = 0; i < 4; ++i) {
            unsigned wv[4];
#pragma unroll
            for (int e = 0; e < 8; ++e) { const int s = 32 * sq4 + 8 * i + e;
                const float x = bf1(*(const LAS unsigned short*)(lds + GM_RAWV + s * 272 + ch * 2));
                const float y = (x - *(const LAS float*)(lds + GM_MEAN + s * 4)) * *(const LAS float*)(lds + GM_RSTD + s * 4) * g + b;
                const unsigned yb = f2bf(y);
                if (e & 1) wv[e >> 1] |= yb << 16; else wv[e >> 1] = yb; }
            *(LAS v4u*)(lds + GM_VLT + ch * 272 + (32 * sq4 + 8 * i) * 2) = (v4u){wv[0], wv[1], wv[2], wv[3]};
        }
    }
    __syncthreads();
    const int t = 16 * wave + fr;
    bf16x8 yf[4];
#pragma unroll
    for (int ks = 0; ks < 4; ++ks) yf[ks] = *(const LAS bf16x8*)(lds + GM_WL + (16 * wave + fr) * 272 + ks * 64 + fq * 16);
    const float bs = b_s[h * 128 + t];
    float ss = 0.f;
#pragma unroll
    for (int cb = 0; cb < 8; ++cb) {
        f32x4 a = {0.f, 0.f, 0.f, 0.f};
#pragma unroll
        for (int ks = 0; ks < 4; ++ks) {
            const bf16x8 x = *(const LAS bf16x8*)(lds + GM_VLT + (16 * cb + fr) * 272 + ks * 64 + fq * 16);
            a = __builtin_amdgcn_mfma_f32_16x16x32_bf16(x, yf[ks], a, 0, 0, 0);
        }
        const int ch = 128 * h + 16 * cb + 4 * fq;
        const v2u uw = *(const GAS v2u*)(P + (size_t)(R0 + t) * DIN + COL_U + ch);
        const f32x4 uu = {bflo(uw.x), bfhi(uw.x), bflo(uw.y), bfhi(uw.y)};
        a = (a + bs) * uu;
        ss += (a[0] * a[0] + a[1] * a[1]) + (a[2] * a[2] + a[3] * a[3]);
        v2u w; w.x = pk2(a[0], a[1]); w.y = pk2(a[2], a[3]);
        *(GAS v2u*)(Y + (size_t)(R0 + t) * DMODEL + ch) = w;
    }
    ss += __shfl_xor(ss, 16); ss += __shfl_xor(ss, 32);
    if (fq == 0) ssg[(size_t)(R0 + t) * 4 + h] = ss;
    __syncthreads();
}

struct Args { const float* in[22]; float* out; unsigned char* ws; int ph_lo, ph_hi, li, pad; };
constexpr int N_PHASES = 11;
#ifndef MK_N_LAUNCHES
#define MK_N_LAUNCHES 1
#endif
#ifndef DUP_PHASE
#define DUP_PHASE (-1)
#endif
__global__ void __launch_bounds__(NWAVES * 64, 2) fwd_kernel(Args args) {
    extern __shared__ __attribute__((aligned(16))) unsigned char lds_raw[];
    LAS unsigned char* lds = (LAS unsigned char*)lds_raw;
    volatile LAS unsigned* MISC = (volatile LAS unsigned*)(lds + MISC_OFF);
    const int tid = threadIdx.x, lane = tid & 63, wave = __builtin_amdgcn_readfirstlane(tid >> 6);
    const int G = gridDim.x, bx = blockIdx.x;
    const int vcu = (G % 8 == 0) ? (bx % 8) * (G / 8) + bx / 8 : bx;
    const int gw = vcu * NWAVES + wave, NGW = G * NWAVES;
    unsigned char* ws = args.ws;
    gu32* ctl = (gu32*)(ws + WS_CTL);
    for (int u = tid; u < (LDS_BYTES - LDSCTL_OFF) / 4; u += NWAVES * 64) ((LAS unsigned*)(lds + LDSCTL_OFF))[u] = 0u;
    __syncthreads();
    XcdBarrier bar = xcd_barrier_post((unsigned*)(ctl + CW_BAR) + args.li * XCD_BAR_WORDS, MISC + 8);
    const int lo = args.ph_lo, hi = args.ph_hi;
#define IN(k) (lo <= (k) && (k) < hi)
    int uni = 0, cid = bx, xr = 0, xx = 0; unsigned lseq = 0;
#define SEAM(k) do { if (IN(k) && IN((k) + 1)) { if (uni) xcd_local_barrier(bar, ++lseq); else xcd_barrier(bar); } } while (0)
    bf16* XB = (bf16*)(ws + WS_BUFA); bf16* Y = (bf16*)(ws + WS_BUFB); bf16* BIG = (bf16*)(ws + WS_BIG);
    bf16* OB0 = (bf16*)args.out; bf16* OB1 = (bf16*)args.out + (size_t)TOK * 512;
    float* SSG = (float*)(ws + WS_SSG); float* HGE = (float*)(ws + WS_HGE); float* HGD = (float*)(ws + WS_HGD);
    float* P16_0 = (float*)(ws + WS_P16); float* P16_1 = (float*)(ws + WS_P16 + 2 * MiB); float* P16_2 = (float*)(ws + WS_P16 + 4 * MiB);

    for (int rep_ = 0; rep_ < ((DUP_PHASE == 0) ? 2 : 1); ++rep_) if (IN(0)) { p0_prologue(lds, args.in, ws, gw, NGW, wave, lane); }
    if (IN(0) && IN(1)) { xcd_barrier(bar);
        if (MISC[10] != 0u && G == 256) { uni = 1; xr = (int)MISC[11]; xx = (int)bar.x; cid = 8 * xr + xx; } }
#define PHASE1 if (IN(1)) { pg8::Gemm g{XB, (const bf16*)(ws + WS_WGU1), TOK, 2 * DFF, DMODEL}; pg8::StaticOrder S; S.init(TOK, 2 * DFF, G, cid); \
        pg8::EpiSwiGLU E{BIG, DFF, P16_0}; pg8::gemm_phase<pg8::EpiSwiGLU, pg8::StaticOrder, PG8_ALIGN, PG8_SP2>(lds + RING_OFF, g, S, E); }
    PHASE1
#if DUP_PHASE == 1
    PHASE1
#endif
    SEAM(1);
#if DUP_PHASE == 90
    for (int r_ = 0; r_ < 10; ++r_) { if (uni) xcd_local_barrier(bar, ++lseq); else xcd_barrier(bar); }
#endif
#define PHASE2 if (IN(2)) { pg8::Gemm g{BIG, (const bf16*)(ws + WS_WD1), TOK, DMODEL, DFF}; pg8::StaticOrder S; S.init(TOK, DMODEL, G, cid); \
        pg8::EpiResidBf<true> E{XB, P16_1, 0.5f}; pg8::gemm_phase<pg8::EpiResidBf<true>, pg8::StaticOrder, PG8_ALIGN, PG8_SP2>(lds + RING_OFF, g, S, E); }
    PHASE2
#if DUP_PHASE == 2
    PHASE2
#endif
#if DUP_PHASE == 20
    if (IN(2)) { pg8::Gemm g{BIG, (const bf16*)(ws + WS_WD1), TOK, DMODEL, DFF}; pg8::StaticOrder S; S.init(TOK, DMODEL, G, cid);
        pg8::EpiNull E{SSG}; pg8::gemm_phase<pg8::EpiNull, pg8::StaticOrder, PG8_ALIGN, PG8_SP2>(lds + RING_OFF, g, S, E); }
#endif
#if DUP_PHASE == 10
    if (IN(2)) { pg8::Gemm g{XB, (const bf16*)(ws + WS_WGU1), TOK, 2 * DFF, DMODEL}; pg8::StaticOrder S; S.init(TOK, 2 * DFF, G, cid);
        pg8::EpiNull E{SSG}; pg8::gemm_phase<pg8::EpiNull, pg8::StaticOrder, PG8_ALIGN, PG8_SP2>(lds + RING_OFF, g, S, E); }
#endif
    SEAM(2);
#define PHASE3 if (IN(3)) { pg8::Gemm g{XB, (const bf16*)(ws + WS_WIN), TOK, DIN, DMODEL}; pg8::StaticOrder S; S.init(TOK, DIN, G, cid); \
        pg8::EpiMix E{BIG, DIN, P16_1, args.in[13], args.in[14]}; pg8::gemm_phase<pg8::EpiMix, pg8::StaticOrder, PG8_ALIGN, PG8_SP2>(lds + RING_OFF, g, S, E); }
    PHASE3
#if DUP_PHASE == 3
    PHASE3
#endif
    SEAM(3);
    for (int rep_ = 0; rep_ < ((DUP_PHASE == 4 || DUP_PHASE == 40 || DUP_PHASE == 41) ? 2 : 1); ++rep_) if (IN(4)) {
        if (uni) {
            for (int k = xr; k < 64; k += 32) hg2_state_pass(lds, BIG, HGE, HGD, hg2_xcc_inst(xx, k), tid, lane, wave);
            for (int k = xr; k < 128; k += 32) gmlp_item(lds, BIG, Y, SSG, args.in[8], args.in[9], args.in[10], args.in[11], 32 * xx + (k >> 2), k & 3, tid, lane, wave);
        } else {
        if (rep_ == 0 || DUP_PHASE != 41) for (int i = bx; i < 512; i += G) hg2_state_pass(lds, BIG, HGE, HGD, i, tid, lane, wave);
        if (rep_ == 0 || DUP_PHASE != 40) for (int it = bx; it < 1024; it += G) gmlp_item(lds, BIG, Y, SSG, args.in[8], args.in[9], args.in[10], args.in[11], it >> 2, it & 3, tid, lane, wave);
        }
    }
    SEAM(4);
    for (int rep_ = 0; rep_ < ((DUP_PHASE == 5) ? 2 : 1); ++rep_) if (IN(5)) {
        if (uni) { for (int k = xr; k < 64; k += 32) { const int i = hg2_xcc_inst(xx, k); const Hg2Inst I = hg2_decode(i); hg2_out_pass(lds, BIG, I.dir ? OB1 : OB0, HGE, HGD, i, tid, lane, wave); } }
        else { for (int i = bx; i < 512; i += G) { const Hg2Inst I = hg2_decode(i); hg2_out_pass(lds, BIG, I.dir ? OB1 : OB0, HGE, HGD, i, tid, lane, wave); } }
    }
    SEAM(5);
    if (IN(6)) { if (uni) hgrn_combine(OB0, OB1, BIG, args.in[15], SSG, args.in[12], Y, 4096 * xx, 4096 * xx + 4096, 8 * xr + wave, 256, lane);
                 else hgrn_combine(OB0, OB1, BIG, args.in[15], SSG, args.in[12], Y, 0, TOK, gw, NGW, lane); }
    SEAM(6);
    if (IN(7)) { pg8::Gemm g{Y, (const bf16*)(ws + WS_WOUT), TOK, DMODEL, DMODEL}; pg8::StaticOrder S; S.init(TOK, DMODEL, G, cid);
        pg8::EpiResidBf<true> E{XB, P16_2, 1.0f};
        pg8::gemm_phase<pg8::EpiResidBf<true>, pg8::StaticOrder, PG8_ALIGN, PG8_SP2>(lds + RING_OFF, g, S, E); }
    SEAM(7);
    if (IN(8)) { pg8::Gemm g{XB, (const bf16*)(ws + WS_WGU2), TOK, 2 * DFF, DMODEL}; pg8::StaticOrder S; S.init(TOK, 2 * DFF, G, cid);
        pg8::EpiSwiGLU E{BIG, DFF, P16_2};
        pg8::gemm_phase<pg8::EpiSwiGLU, pg8::StaticOrder, PG8_ALIGN, PG8_SP2>(lds + RING_OFF, g, S, E); }
    SEAM(8);
    if (IN(9)) { pg8::Gemm g{BIG, (const bf16*)(ws + WS_WD2), TOK, DMODEL, DFF}; pg8::StaticOrder S; S.init(TOK, DMODEL, G, cid);
        pg8::EpiResidBf<false> E{XB, nullptr, 0.5f};
        pg8::gemm_phase<pg8::EpiResidBf<false>, pg8::StaticOrder, PG8_ALIGN, PG8_SP2>(lds + RING_OFF, g, S, E); }
    SEAM(9);
    if (IN(10)) { if (uni) final_norm(XB, args.out, args.in[21], 4096 * xx, 4096 * xx + 4096, 8 * xr + wave, 256, lane); else final_norm(XB, args.out, args.in[21], 0, TOK, gw, NGW, lane); }
#undef IN
#undef SEAM
}

extern "C" void kernel_launch(void* const* d_in, const int* in_sizes, int n_in, void* d_out, int out_size, void* d_ws, size_t ws_size, hipStream_t stream) {
    static int grid = 0;
    if (grid == 0) {
        if (n_in != 22 || out_size != TOK * DMODEL || ws_size < WS_END) { fprintf(stderr, "kernel_launch: unexpected problem (n_in %d, out %d, ws %zu); nothing launched\n", n_in, out_size, ws_size); grid = -1; return; }
        int dev = 0, cus = 0, per_cu = 0;
        if (hipGetDevice(&dev) != hipSuccess || hipDeviceGetAttribute(&cus, hipDeviceAttributeMultiprocessorCount, dev) != hipSuccess) { grid = -1; return; }
        if (hipFuncSetAttribute((const void*)fwd_kernel, hipFuncAttributeMaxDynamicSharedMemorySize, LDS_BYTES) != hipSuccess) { fprintf(stderr, "kernel_launch: hipFuncSetAttribute failed\n"); grid = -1; return; }
        if (hipOccupancyMaxActiveBlocksPerMultiprocessor(&per_cu, (const void*)fwd_kernel, NWAVES * 64, LDS_BYTES) != hipSuccess || per_cu < 1) { fprintf(stderr, "kernel_launch: occupancy query says %d blocks per CU; nothing launched\n", per_cu); (void)hipGetLastError(); grid = -1; return; }
        grid = cus;
    }
    if (grid < 0) return;
    if (hipMemsetAsync((char*)d_ws + WS_CTL, 0, CTL_ZERO_BYTES, stream) != hipSuccess) return;
    Args a{};
    for (int i = 0; i < 22; ++i) a.in[i] = (const float*)d_in[i];
    a.out = (float*)d_out; a.ws = (unsigned char*)d_ws;
    constexpr int NL = MK_N_LAUNCHES;
    for (int li = 0; li < NL; ++li) {
        a.ph_lo = (NL == 1) ? 0 : li; a.ph_hi = (NL == 1) ? N_PHASES : li + 1; a.li = 0;
        hipLaunchKernelGGL(fwd_kernel, dim3(grid), dim3(NWAVES * 64), LDS_BYTES, stream, a);
        if (hipPeekAtLastError() != hipSuccess) { fprintf(stderr, "kernel_launch: launch %d failed\n", li); break; }
    }
}
```

```cpp
#include <hip/hip_runtime.h>
#include <cstdio>
#include <cstdint>
namespace pg8 {
#define PG8_LAS __attribute__((address_space(3)))
typedef unsigned short bf16_t;
typedef short bf16x8 __attribute__((ext_vector_type(8)));
typedef float f32x4 __attribute__((ext_vector_type(4)));
typedef unsigned u32x4 __attribute__((ext_vector_type(4)));
constexpr int BM = 256, BK = 64, HALF = 128, HTB = HALF * BK * 2  , STAGE_BYTES = 8 * HTB, NXCD = 8, WGM = 8;

__host__ __device__ __forceinline__ int lds_byte(int r, int c) { const int st = (r >> 4) * 2 + (c >> 5), rr = r & 15, cc = c & 31, ob = rr * 64 + cc * 2; return st * 1024 + (ob ^ (((ob >> 9) & 1) << 5)); }
__host__ __device__ __forceinline__ void stage_rc(int b, int& R, int& C) { const int st = b / 1024, sb = b % 1024, swz = sb ^ (((sb >> 9) & 1) << 5); R = (st >> 1) * 16 + swz / 64; C = (st & 1) * 32 + (swz % 64) / 2; }
__host__ __device__ __forceinline__ int perm32(int rho) { const int n = rho >> 4, i = rho & 15; return 8 * (i >> 2) + 4 * n + (i & 3); }

struct Unit { int pm, pn; };
struct Gemm { const bf16_t* A; const bf16_t* Bt; int M, N, K; };

struct StaticOrder {
    int nM, nN, nwg, G, c;
    __host__ __device__ void init(int M, int N, int G_, int c_) { nM = M / BM; nN = N / BM; nwg = nM * nN; G = G_; c = c_; }
    __host__ __device__ bool next(int i, Unit& u) const {
        const long L = (long)i * G + c; if (L >= nwg) return false;
        int wgid = (int)L; { const int q = nwg / NXCD, r = nwg % NXCD, xcd = wgid % NXCD, off = wgid / NXCD; wgid = (xcd < r ? xcd * (q + 1) : r * (q + 1) + (xcd - r) * q) + off; }
        const int nig = WGM * nN, gid = wgid / nig, fm = gid * WGM, gsz = (nM - fm) < WGM ? (nM - fm) : WGM;
        u.pm = fm + ((wgid % nig) % gsz); u.pn = (wgid % nig) / gsz; return true;
    }
    __device__ __forceinline__ void a_ready(const Unit&) const {}
    __device__ __forceinline__ void done(const Unit&) const {}
};

typedef __bf16 bf16x2_hw __attribute__((ext_vector_type(2)));
typedef float f32x2_hw __attribute__((ext_vector_type(2)));
__device__ __forceinline__ unsigned cvt_pk_bf16(float lo, float hi) { const f32x2_hw v = {lo, hi}; const bf16x2_hw b = __builtin_convertvector(v, bf16x2_hw); return __builtin_bit_cast(unsigned, b); }
typedef float f32x2 __attribute__((ext_vector_type(2)));
__device__ __forceinline__ f32x2 gelu_pk(f32x2 v) {
    const f32x2 av = __builtin_elementwise_abs(v), d = av * 0.2316418882f + 1.0f;
    f32x2 t; t.x = __builtin_amdgcn_rcpf(d.x); t.y = __builtin_amdgcn_rcpf(d.y);
    f32x2 q = t * 0.5307027145f + (-0.7265760135f); q = q * t + 0.7107068705f; q = q * t + (-0.142248368f); q = q * t + 0.127414796f; q = q * t;
    const f32x2 s = (v * v) * (-0.72134752044f);
    f32x2 e; e.x = __builtin_amdgcn_exp2f(s.x); e.y = __builtin_amdgcn_exp2f(s.y);
    const f32x2 m = v * (q * e), r = v - m;
    f32x2 o; o.x = v.x < 0.f ? m.x : r.x; o.y = v.y < 0.f ? m.y : r.y; return o;
}

constexpr float RMS_EPS = 1e-6f;
constexpr int DM = 1024;
__device__ __forceinline__ float row_rstd(const float* p16, int row, int fq) {
    const f32x4 v = *(const f32x4*)(p16 + (size_t)row * 16 + 4 * fq);
    float s = (v[0] + v[1]) + (v[2] + v[3]);
    s += __shfl_xor(s, 16); s += __shfl_xor(s, 32);
    return __builtin_amdgcn_rsqf(s * (1.0f / DM) + RMS_EPS);
}
__device__ __forceinline__ void row_rstd8(const float* p16, int row0, int fq, float (&rr)[8]) {
    f32x4 pv[8];
#pragma unroll
    for (int i = 0; i < 8; ++i) pv[i] = *(const f32x4*)(p16 + (size_t)(row0 + (i >> 2) * HALF + (i & 3) * 16) * 16 + 4 * fq);
#pragma unroll
    for (int i = 0; i < 8; ++i) { float s = (pv[i][0] + pv[i][1]) + (pv[i][2] + pv[i][3]); s += __shfl_xor(s, 16); s += __shfl_xor(s, 32); rr[i] = __builtin_amdgcn_rsqf(s * (1.0f / DM) + RMS_EPS); }
}
__device__ __forceinline__ float fast_sigmoid(float z) { return __builtin_amdgcn_rcpf(1.0f + __builtin_amdgcn_exp2f(-1.44269504089f * z)); }

struct EpiSwiGLU {
    static constexpr bool PERM = true, AFTER_DRAIN = false;
    bf16_t* O; int ldo; const float* p16;
    __device__ __forceinline__ void operator()(const f32x4 (&acc)[2][2][4][2], const Unit& u, int wr, int wc, int fr, int fq) const {
        const int row0 = u.pm * BM + wr * 64 + fr, col0 = u.pn * HALF + wc * 32 + 8 * fq;
        float rr[8];
        row_rstd8(p16, row0, fq, rr);
#pragma unroll
        for (int ai = 0; ai < 2; ++ai)
#pragma unroll
            for (int m = 0; m < 4; ++m) {
                const int row = row0 + ai * HALF + m * 16;
                const float r = rr[ai * 4 + m];
                float h[8];
#pragma unroll
                for (int n = 0; n < 2; ++n)
#pragma unroll
                    for (int e = 0; e < 4; ++e) { const float g = acc[ai][0][m][n][e] * r, up = acc[ai][1][m][n][e] * r; h[4 * n + e] = g * up * fast_sigmoid(g); }
                u32x4 w; w.x = cvt_pk_bf16(h[0], h[1]); w.y = cvt_pk_bf16(h[2], h[3]); w.z = cvt_pk_bf16(h[4], h[5]); w.w = cvt_pk_bf16(h[6], h[7]);
                *(u32x4*)(O + (size_t)row * ldo + col0) = w;
            }
    }
};

template <bool WANT_BF16, bool WANT_SS> struct EpiResid {
    static constexpr bool PERM = true, AFTER_DRAIN = false;
    const float* base0; const float* base1;
    float* out; bf16_t* xb; float* p16; float alpha;
    __device__ __forceinline__ void operator()(const f32x4 (&acc)[2][2][4][2], const Unit& u, int wr, int wc, int fr, int fq) const {
        const int row0 = u.pm * BM + wr * 64 + fr, col0 = u.pn * BM + wc * 32 + 8 * fq;
        const float* bp = (u.pm < 64) ? base0 : base1; const int brow = (u.pm < 64) ? 0 : 16384;
        f32x4 bcur[4], bnxt[4];
#define RESID_LOAD(dst, it) do { const size_t bo_ = (size_t)(row0 + ((it) >> 2) * HALF + ((it) & 3) * 16 - brow) * DM + col0; \
            dst[0] = *(const f32x4*)(bp + bo_); dst[1] = *(const f32x4*)(bp + bo_ + 4); dst[2] = *(const f32x4*)(bp + bo_ + HALF); dst[3] = *(const f32x4*)(bp + bo_ + HALF + 4); } while (0)
        RESID_LOAD(bcur, 0);
#pragma unroll
        for (int it = 0; it < 8; ++it) {
            const int ai = it >> 2, m = it & 3;
            if (it + 1 < 8) RESID_LOAD(bnxt, it + 1);
            const int row = row0 + ai * HALF + m * 16; const size_t off = (size_t)row * DM + col0;
            float ss = 0.f;
#pragma unroll
            for (int bj = 0; bj < 2; ++bj) {
                const f32x4 v0 = bcur[2 * bj] + acc[ai][bj][m][0] * alpha, v1 = bcur[2 * bj + 1] + acc[ai][bj][m][1] * alpha;
                *(f32x4*)(out + off + bj * HALF) = v0; *(f32x4*)(out + off + bj * HALF + 4) = v1;
                if (WANT_BF16) { u32x4 w; w.x = cvt_pk_bf16(v0[0], v0[1]); w.y = cvt_pk_bf16(v0[2], v0[3]); w.z = cvt_pk_bf16(v1[0], v1[1]); w.w = cvt_pk_bf16(v1[2], v1[3]);
                    *(u32x4*)(xb + off + bj * HALF) = w; }
                if (WANT_SS) ss += ((v0[0] * v0[0] + v0[1] * v0[1]) + (v0[2] * v0[2] + v0[3] * v0[3])) + ((v1[0] * v1[0] + v1[1] * v1[1]) + (v1[2] * v1[2] + v1[3] * v1[3]));
            }
            if (WANT_SS) { ss += __shfl_xor(ss, 16); ss += __shfl_xor(ss, 32); if (fq == 0) p16[(size_t)row * 16 + 4 * u.pn + wc] = ss; }
#pragma unroll
            for (int q = 0; q < 4; ++q) bcur[q] = bnxt[q];
            asm volatile("" ::: "memory");
        }
#undef RESID_LOAD
    }
};

template <bool WANT_SS> struct EpiResidBf {
    static constexpr bool PERM = true, AFTER_DRAIN = false;
    bf16_t* xb; float* p16; float alpha;
    __device__ __forceinline__ void operator()(const f32x4 (&acc)[2][2][4][2], const Unit& u, int wr, int wc, int fr, int fq) const {
        const int row0 = u.pm * BM + wr * 64 + fr, col0 = u.pn * BM + wc * 32 + 8 * fq;
        u32x4 bcur[2], bnxt[2];
#define RESB_LOAD(dst, it) do { const size_t bo_ = (size_t)(row0 + ((it) >> 2) * HALF + ((it) & 3) * 16) * DM + col0; dst[0] = *(const u32x4*)(xb + bo_); dst[1] = *(const u32x4*)(xb + bo_ + HALF); } while (0)
        RESB_LOAD(bcur, 0);
#pragma unroll
        for (int it = 0; it < 8; ++it) {
            const int ai = it >> 2, m = it & 3;
            if (it + 1 < 8) RESB_LOAD(bnxt, it + 1);
            const int row = row0 + ai * HALF + m * 16; const size_t off = (size_t)row * DM + col0;
            float ss = 0.f;
#pragma unroll
            for (int bj = 0; bj < 2; ++bj) {
                const u32x4 b = bcur[bj];
                const f32x4 b0 = {__builtin_bit_cast(float, b.x << 16), __builtin_bit_cast(float, b.x & 0xffff0000u), __builtin_bit_cast(float, b.y << 16), __builtin_bit_cast(float, b.y & 0xffff0000u)};
                const f32x4 b1 = {__builtin_bit_cast(float, b.z << 16), __builtin_bit_cast(float, b.z & 0xffff0000u), __builtin_bit_cast(float, b.w << 16), __builtin_bit_cast(float, b.w & 0xffff0000u)};
                const f32x4 v0 = b0 + acc[ai][bj][m][0] * alpha, v1 = b1 + acc[ai][bj][m][1] * alpha;
                u32x4 w; w.x = cvt_pk_bf16(v0[0], v0[1]); w.y = cvt_pk_bf16(v0[2], v0[3]); w.z = cvt_pk_bf16(v1[0], v1[1]); w.w = cvt_pk_bf16(v1[2], v1[3]);
                *(u32x4*)(xb + off + bj * HALF) = w;
                if (WANT_SS) ss += ((v0[0] * v0[0] + v0[1] * v0[1]) + (v0[2] * v0[2] + v0[3] * v0[3])) + ((v1[0] * v1[0] + v1[1] * v1[1]) + (v1[2] * v1[2] + v1[3] * v1[3]));
            }
            if (WANT_SS) { ss += __shfl_xor(ss, 16); ss += __shfl_xor(ss, 32); if (fq == 0) p16[(size_t)row * 16 + 4 * u.pn + wc] = ss; }
            bcur[0] = bnxt[0]; bcur[1] = bnxt[1];
            asm volatile("" ::: "memory");
        }
#undef RESB_LOAD
    }
};
struct EpiNull { static constexpr bool PERM = true, AFTER_DRAIN = false; float* sink;
    __device__ __forceinline__ void operator()(const f32x4 (&acc)[2][2][4][2], const Unit& u, int wr, int wc, int fr, int fq) const {
        float s = 0.f;
#pragma unroll
        for (int ai = 0; ai < 2; ++ai)
#pragma unroll
            for (int bj = 0; bj < 2; ++bj)
#pragma unroll
                for (int m = 0; m < 4; ++m)
#pragma unroll
                    for (int n = 0; n < 2; ++n) s += acc[ai][bj][m][n][0] + acc[ai][bj][m][n][1] + acc[ai][bj][m][n][2] + acc[ai][bj][m][n][3];
        if (s == 12345.678f) sink[0] = s;
    } };
struct EpiMix {
    static constexpr bool PERM = true, AFTER_DRAIN = false;
    bf16_t* P; int ldp; const float* p16; const float* lbf; const float* lbb;
    template <int ACT> __device__ __forceinline__ void run(const f32x4 (&acc)[2][2][4][2], const Unit& u, int wr, int wc, int fr, int fq) const {
        const int row0 = u.pm * BM + wr * 64 + fr, col0 = u.pn * BM + wc * 32 + 8 * fq;
        float oml[2][8];
        if (ACT == 3) { const float* lb = ((u.pn >> 1) == 4) ? lbf : lbb; const int c0 = (u.pn & 1) * BM + wc * 32 + 8 * fq;
#pragma unroll
            for (int bj = 0; bj < 2; ++bj)
#pragma unroll
                for (int e = 0; e < 8; ++e) { const float a0 = lb[c0 + bj * HALF + e], a1 = lb[512 + c0 + bj * HALF + e]; oml[bj][e] = fast_sigmoid(a1 - a0);
#ifdef DBG_OML
                    oml[bj][e] = 0.5f;
#endif
                } }
        float rr[8];
        row_rstd8(p16, row0, fq, rr);
#pragma unroll
        for (int ai = 0; ai < 2; ++ai)
#pragma unroll
            for (int m = 0; m < 4; ++m) {
                const int row = row0 + ai * HALF + m * 16;
                const float r = rr[ai * 4 + m];
#pragma unroll
                for (int bj = 0; bj < 2; ++bj) {
                    float h[8];
#pragma unroll
                    for (int n = 0; n < 2; ++n) {
                        const f32x4 z = acc[ai][bj][m][n] * r;
                        if (ACT == 0) { const f32x2 a = gelu_pk((f32x2){z[0], z[1]}), b = gelu_pk((f32x2){z[2], z[3]}); h[4 * n] = a.x; h[4 * n + 1] = a.y; h[4 * n + 2] = b.x; h[4 * n + 3] = b.y; }
                        else if (ACT == 1) {
#pragma unroll
                            for (int e = 0; e < 4; ++e) h[4 * n + e] = z[e] * fast_sigmoid(z[e]); }
                        else if (ACT == 2) {
#pragma unroll
                            for (int e = 0; e < 4; ++e) h[4 * n + e] = z[e]; }
                        else {
#pragma unroll
                            for (int e = 0; e < 4; ++e) { const float kk = oml[bj][4 * n + e] * __builtin_amdgcn_rcpf(1.0f + __builtin_amdgcn_exp2f(1.44269504089f * z[e]));
                                h[4 * n + e] = __builtin_amdgcn_logf(1.0f - kk); }
                        }
                    }
                    u32x4 w; w.x = cvt_pk_bf16(h[0], h[1]); w.y = cvt_pk_bf16(h[2], h[3]); w.z = cvt_pk_bf16(h[4], h[5]); w.w = cvt_pk_bf16(h[6], h[7]);
                    *(u32x4*)(P + (size_t)row * ldp + col0 + bj * HALF) = w;
                }
            }
    }
    __device__ __forceinline__ void operator()(const f32x4 (&acc)[2][2][4][2], const Unit& u, int wr, int wc, int fr, int fq) const {
        const int seg = u.pn >> 1;
        if (seg <= 1) run<0>(acc, u, wr, wc, fr, fq);
        else if (seg == 2 || seg == 6) run<1>(acc, u, wr, wc, fr, fq);
        else if (seg == 3) run<2>(acc, u, wr, wc, fr, fq);
        else run<3>(acc, u, wr, wc, fr, fq);
    }
};

template <class Epi, class Sched, bool ALIGN_EPI = false, bool SP2 = false>
__device__ __forceinline__ void gemm_phase(PG8_LAS unsigned char* lds, const Gemm g, const Sched& S, const Epi& E) {
    const int tid = threadIdx.x, wid = __builtin_amdgcn_readfirstlane(tid >> 6), lane = tid & 63, wr = wid >> 2, wc = wid & 3, fr = lane & 15, fq = lane >> 4;
    const int K = g.K, nt = K / BK;
    unsigned voffA[2], voffB[2];
#pragma unroll
    for (int i = 0; i < 2; ++i) { int R, C; stage_rc(tid * 16 + i * 8192, R, C); const int Rb = Epi::PERM ? ((R & ~31) + perm32(R & 31)) : R;
        voffA[i] = (unsigned)(R * K + C) * 2u; voffB[i] = (unsigned)(Rb * K + C) * 2u; }
    const size_t kstep = (size_t)(BK * 2);
    const size_t hstep = (size_t)HALF * K * 2;
    const size_t tstep = 2 * hstep;
    const unsigned ldsw = (unsigned)wid * 1024u;
    const int aoff = lds_byte(wr * 64 + fr, fq * 8), boff = lds_byte(wc * 32 + fr, fq * 8);
#define PG8_SA(b, h) (((b) * 2 + (h)) * HTB)
#define PG8_SB(b, h) ((4 + (b) * 2 + (h)) * HTB)
#define PG8_STAGE(bufoff, gbase, voff) do { _Pragma("unroll") for (int _i = 0; _i < 2; ++_i) \
        __builtin_amdgcn_global_load_lds((const unsigned*)((const char*)(gbase) + (voff)[_i]), (PG8_LAS unsigned*)(lds + (bufoff) + ldsw + _i * 8192), 16, 0, 0); } while (0)
#define PG8_LDA(dst, b, h) do { _Pragma("unroll") for (int m = 0; m < 4; ++m) _Pragma("unroll") for (int k = 0; k < 2; ++k) dst[m][k] = *(const PG8_LAS bf16x8*)(lds + PG8_SA(b, h) + aoff + m * 2048 + k * 1024); } while (0)
#define PG8_LDB(dst, b, h) do { _Pragma("unroll") for (int n = 0; n < 2; ++n) _Pragma("unroll") for (int k = 0; k < 2; ++k) dst[n][k] = *(const PG8_LAS bf16x8*)(lds + PG8_SB(b, h) + boff + n * 2048 + k * 1024); } while (0)
#define PG8_MMA(ai, bj, At, Bt) do { __builtin_amdgcn_s_setprio(1); _Pragma("unroll") for (int m = 0; m < 4; ++m) _Pragma("unroll") for (int n = 0; n < 2; ++n) _Pragma("unroll") for (int k = 0; k < 2; ++k) \
        acc[ai][bj][m][n] = __builtin_amdgcn_mfma_f32_16x16x32_bf16(Bt[n][k], At[m][k], acc[ai][bj][m][n], 0, 0, 0); __builtin_amdgcn_s_setprio(0); } while (0)
#define PG8_WAIT_V(n) asm volatile("s_waitcnt vmcnt(" #n ")" ::: "memory")
#define PG8_WAIT_L(n) asm volatile("s_waitcnt lgkmcnt(" #n ")" ::: "memory")
#define PG8_BAR __builtin_amdgcn_s_barrier()
#define PG8_SCHED __builtin_amdgcn_sched_barrier(0)
    Unit cur, nxt; int ui = 0;
    if (!S.next(0, cur)) return;
    f32x4 acc[2][2][4][2];
#pragma unroll
    for (int a = 0; a < 2; ++a)
#pragma unroll
        for (int b = 0; b < 2; ++b)
#pragma unroll
            for (int m = 0; m < 4; ++m)
#pragma unroll
                for (int n = 0; n < 2; ++n) acc[a][b][m][n] = (f32x4){0.f, 0.f, 0.f, 0.f};
    bf16x8 At[4][2], B0[2][2], B1[2][2];
    const char* cA = (const char*)g.A + (size_t)cur.pm * tstep; const char* cB = (const char*)g.Bt + (size_t)cur.pn * tstep;
    S.a_ready(cur);
    if constexpr (SP2) {
        PG8_STAGE(PG8_SB(0, 0), cB, voffB); PG8_STAGE(PG8_SB(0, 1), cB + hstep, voffB); PG8_STAGE(PG8_SA(0, 0), cA, voffA); PG8_STAGE(PG8_SA(0, 1), cA + hstep, voffA);
        if (wr == 1) PG8_BAR;
        PG8_WAIT_V(2); PG8_BAR;
        PG8_STAGE(PG8_SB(1, 0), cB + kstep, voffB); PG8_STAGE(PG8_SA(1, 0), cA + kstep, voffA); PG8_STAGE(PG8_SB(1, 1), cB + hstep + kstep, voffB);
        PG8_WAIT_V(6); PG8_BAR;
    } else {
        PG8_STAGE(PG8_SB(0, 0), cB, voffB); PG8_STAGE(PG8_SA(0, 0), cA, voffA); PG8_STAGE(PG8_SB(0, 1), cB + hstep, voffB); PG8_STAGE(PG8_SA(0, 1), cA + hstep, voffA);
        if (wr == 1) PG8_BAR;
        PG8_WAIT_V(4); PG8_BAR;
        PG8_STAGE(PG8_SB(1, 0), cB + kstep, voffB); PG8_STAGE(PG8_SA(1, 0), cA + kstep, voffA); PG8_STAGE(PG8_SB(1, 1), cB + hstep + kstep, voffB);
        PG8_WAIT_V(6); PG8_BAR;
    }
    for (;;) {
        const bool has_next = S.next(ui + 1, nxt);
        const char* nA = has_next ? (const char*)g.A + (size_t)nxt.pm * tstep : cA; const char* nB = has_next ? (const char*)g.Bt + (size_t)nxt.pn * tstep : cB;
        for (int t = 0; t < nt; t += 2) {
            const bool last = (t == nt - 2);
            const char* a1 = cA + (size_t)(t + 1) * kstep;
            const char* a2 = last ? nA : cA + (size_t)(t + 2) * kstep; const char* b2 = last ? nB : cB + (size_t)(t + 2) * kstep;
            const char* a3 = a2 + kstep; const char* b3 = b2 + kstep;
            if (last && has_next) S.a_ready(nxt);
            if constexpr (SP2) {
            PG8_LDB(B0, 0, 0); PG8_LDB(B1, 0, 1); PG8_SCHED; PG8_LDA(At, 0, 0); PG8_STAGE(PG8_SA(1, 1), a1 + hstep, voffA);
            PG8_WAIT_V(8); PG8_WAIT_L(0); PG8_BAR; PG8_MMA(0, 0, At, B0); PG8_MMA(0, 1, At, B1); PG8_BAR; PG8_SCHED;
            PG8_LDA(At, 0, 1); PG8_STAGE(PG8_SB(0, 0), b2, voffB); PG8_STAGE(PG8_SB(0, 1), b2 + hstep, voffB); PG8_STAGE(PG8_SA(0, 0), a2, voffA);
            PG8_WAIT_V(8); PG8_WAIT_L(0); PG8_BAR; PG8_MMA(1, 0, At, B0); PG8_MMA(1, 1, At, B1); PG8_BAR; PG8_SCHED;
            PG8_LDB(B0, 1, 0); PG8_LDB(B1, 1, 1); PG8_SCHED; PG8_LDA(At, 1, 0); PG8_STAGE(PG8_SA(0, 1), a2 + hstep, voffA);
            PG8_WAIT_V(8); PG8_WAIT_L(0); PG8_BAR; PG8_MMA(0, 0, At, B0); PG8_MMA(0, 1, At, B1); PG8_BAR; PG8_SCHED;
            PG8_LDA(At, 1, 1); PG8_STAGE(PG8_SB(1, 0), b3, voffB); PG8_STAGE(PG8_SB(1, 1), b3 + hstep, voffB); PG8_STAGE(PG8_SA(1, 0), a3, voffA);
            PG8_WAIT_V(8); PG8_WAIT_L(0); PG8_BAR; PG8_MMA(1, 0, At, B0); PG8_MMA(1, 1, At, B1); PG8_BAR; PG8_SCHED;
            } else {
            PG8_LDB(B0, 0, 0); PG8_SCHED; PG8_LDA(At, 0, 0); PG8_STAGE(PG8_SA(1, 1), a1 + hstep, voffA);
            PG8_WAIT_L(8); PG8_BAR; PG8_WAIT_L(0); PG8_MMA(0, 0, At, B0); PG8_BAR; PG8_SCHED;
            PG8_LDB(B1, 0, 1); PG8_STAGE(PG8_SB(0, 0), b2, voffB);
            PG8_BAR; PG8_WAIT_L(0); PG8_MMA(0, 1, At, B1); PG8_BAR;
            PG8_LDA(At, 0, 1); PG8_STAGE(PG8_SA(0, 0), a2, voffA);
            PG8_BAR; PG8_WAIT_L(0); PG8_MMA(1, 0, At, B0); PG8_BAR; PG8_SCHED;
            PG8_STAGE(PG8_SB(0, 1), b2 + hstep, voffB);
            PG8_WAIT_V(6); PG8_BAR; PG8_MMA(1, 1, At, B1); PG8_BAR;
            PG8_LDB(B0, 1, 0); PG8_SCHED; PG8_LDA(At, 1, 0); PG8_STAGE(PG8_SA(0, 1), a2 + hstep, voffA);
            PG8_WAIT_L(8); PG8_BAR; PG8_WAIT_L(0); PG8_MMA(0, 0, At, B0); PG8_BAR; PG8_SCHED;
            PG8_LDB(B1, 1, 1); PG8_STAGE(PG8_SB(1, 0), b3, voffB);
            PG8_BAR; PG8_WAIT_L(0); PG8_MMA(0, 1, At, B1); PG8_BAR;
            PG8_LDA(At, 1, 1); PG8_STAGE(PG8_SA(1, 0), a3, voffA);
            PG8_BAR; PG8_WAIT_L(0); PG8_MMA(1, 0, At, B0); PG8_BAR; PG8_SCHED;
            PG8_STAGE(PG8_SB(1, 1), b3 + hstep, voffB);
            PG8_WAIT_V(6); PG8_BAR; PG8_MMA(1, 1, At, B1); PG8_BAR;
            }
        }
        if constexpr (ALIGN_EPI) { if (wr == 0) PG8_BAR; }
        if constexpr (!Epi::AFTER_DRAIN) { E(acc, cur, wr, wc, fr, fq); S.done(cur); }
        if (!has_next) break;
#pragma unroll
        for (int a = 0; a < 2; ++a)
#pragma unroll
            for (int b = 0; b < 2; ++b)
#pragma unroll
                for (int m = 0; m < 4; ++m)
#pragma unroll
                    for (int n = 0; n < 2; ++n) acc[a][b][m][n] = (f32x4){0.f, 0.f, 0.f, 0.f};
        cur = nxt; cA = nA; cB = nB; ++ui;
        if constexpr (ALIGN_EPI) { if (wr == 1) PG8_BAR; }
    }
    PG8_WAIT_V(0);
    if constexpr (!ALIGN_EPI) { if (wr == 0) PG8_BAR; }
    PG8_BAR;
    if constexpr (Epi::AFTER_DRAIN) { E.fused(acc, cur, wr, wc, fr, fq, lds, wid, lane); S.done(cur); }
#undef PG8_SA
#undef PG8_SB
#undef PG8_STAGE
#undef PG8_LDA
#undef PG8_LDB
#undef PG8_MMA
#undef PG8_WAIT_V
#undef PG8_WAIT_L
#undef PG8_BAR
#undef PG8_SCHED
}
}

#ifndef PG8_SP2
#define PG8_SP2 true
#endif
#ifndef PG8_ALIGN
#define PG8_ALIGN true
#endif
constexpr int NWAVES = 8;
constexpr int TOK = 32768, NPROMPT = 16384;
constexpr int DMODEL = 1024, DFF = 2816, DIN = 3584;
constexpr int COL_U = 0, COL_V = 512, COL_Q = 1024, COL_I = 1536, COL_FF = 2048, COL_FB = 2560, COL_G = 3072;
constexpr float EPS = 1e-6f;
constexpr size_t MiB = 1u << 20;
constexpr size_t WS_CTL = 0, CTL_ZERO_BYTES = 1 * MiB;
constexpr size_t WS_SSG = 1 * MiB;
constexpr size_t WS_P16 = 2 * MiB;
constexpr size_t WS_WGU1 = 8 * MiB, WS_WD1 = 19 * MiB, WS_WIN = 25 * MiB, WS_WOUT = 32 * MiB, WS_WGU2 = 34 * MiB, WS_WD2 = 45 * MiB;
constexpr size_t WS_BUFA = 52 * MiB;
constexpr size_t WS_BUFB = 116 * MiB;
constexpr size_t WS_BIG = 180 * MiB;
constexpr size_t WS_OB1 = 404 * MiB;
constexpr size_t WS_HGE = 468 * MiB;
constexpr size_t WS_HGD = 500 * MiB;
constexpr size_t WS_END = 501 * MiB;
static_assert(WS_WGU1 + (size_t)2 * DFF * DMODEL * 2 <= WS_WD1 && WS_WD1 + (size_t)DMODEL * DFF * 2 <= WS_WIN && WS_WIN + (size_t)DIN * DMODEL * 2 <= WS_WOUT && WS_WOUT + (size_t)DMODEL * DMODEL * 2 <= WS_WGU2
              && WS_WGU2 + (size_t)2 * DFF * DMODEL * 2 <= WS_WD2 && WS_WD2 + (size_t)DMODEL * DFF * 2 <= WS_BUFA && WS_BUFA + (size_t)TOK * DMODEL * 2 <= WS_BUFB && WS_BUFB + (size_t)TOK * DMODEL * 2 <= WS_BIG
              && WS_BIG + (size_t)TOK * DIN * 2 <= WS_OB1 && WS_OB1 + (size_t)TOK * 512 * 4 <= WS_HGE && WS_HGE + (size_t)512 * 65536 <= WS_HGD && WS_P16 + 3 * 2 * MiB <= WS_WGU1, "d_ws map");
constexpr int CW_BAR = 4096;
constexpr int RING_OFF = 0, RING_BYTES = 131072;
constexpr int LDSCTL_OFF = RING_BYTES, MISC_OFF = LDSCTL_OFF + 320;
constexpr int LDS_BYTES = 147456;
static_assert(MISC_OFF + 128 <= LDS_BYTES, "LDS map");

#define GAS __attribute__((address_space(1)))
#define LAS __attribute__((address_space(3)))
typedef unsigned short bf16;
typedef unsigned v4u __attribute__((ext_vector_type(4)));
typedef float f32x4 __attribute__((ext_vector_type(4)));
typedef short bf16x8 __attribute__((ext_vector_type(8)));
typedef GAS unsigned gu32;
typedef GAS unsigned long long gu64;
#define RLX_AGENT __ATOMIC_RELAXED, __HIP_MEMORY_SCOPE_AGENT
#define LDS_WAIT() asm volatile("s_waitcnt lgkmcnt(0)" ::: "memory")
#define VM_WAIT() asm volatile("s_waitcnt vmcnt(0)" ::: "memory")
__device__ __forceinline__ unsigned long long rt() { return __builtin_amdgcn_s_memrealtime(); }
__device__ __forceinline__ unsigned f2bf(float f) { unsigned u = __builtin_bit_cast(unsigned, f); return (u + 0x7fffu + ((u >> 16) & 1u)) >> 16; }
__device__ __forceinline__ unsigned pk2(float lo, float hi) { return f2bf(lo) | (f2bf(hi) << 16); }

#define XB_TMO      128
#define XB_XCNT(j)  (256  + 64 * (j))
#define XB_XSUB(j)  (1280 + 64 * (j))
#define XB_XGEN(j)  (2304 + 64 * (j))
#define XB_TOP      3328
#define XB_TOPGEN   3392
#define XCD_BAR_WORDS 3456
#define XB_SPIN_CAP (1u << 18)

__device__ __forceinline__ unsigned xb_ld(unsigned* p)              { return __hip_atomic_load(p, __ATOMIC_RELAXED, __HIP_MEMORY_SCOPE_AGENT); }
__device__ __forceinline__ unsigned xb_add(unsigned* p, unsigned v) { return __hip_atomic_fetch_add(p, v, __ATOMIC_RELAXED, __HIP_MEMORY_SCOPE_AGENT); }
__device__ __forceinline__ unsigned xb_xcc_id() { return (unsigned)__builtin_amdgcn_s_getreg((3 << 11) | 20) & 0xFu; }
#define XB_SPIN(cond, bar) do { unsigned _sp = 0; while (cond) { __builtin_amdgcn_s_sleep(1); \
    if ((++_sp & 255u) == 0u) { if (xb_ld(&(bar)[XB_TMO])) break; if (_sp > XB_SPIN_CAP) { atomicAdd(&(bar)[XB_TMO], 1u); break; } } } } while (0)

struct XcdBarrier {
    unsigned* bar; unsigned x;
    volatile LAS unsigned* st;
};

__device__ __forceinline__ XcdBarrier xcd_barrier_post(unsigned* bar, volatile LAS unsigned* st) {
    XcdBarrier b; b.bar = bar; b.x = xb_xcc_id(); b.st = st;
    if (threadIdx.x == 0) st[3] = xb_add(&bar[XB_XCNT(b.x)], 1u);
    return b;
}
__device__ __forceinline__ void xcd_barrier_complete(unsigned* bar, unsigned x, unsigned& nloc, unsigned& nx) {
    const unsigned G = gridDim.x * gridDim.y * gridDim.z;
    unsigned sum, cnt, mine, sp = 0u;
    for (;;) {
        sum = 0u; cnt = 0u; mine = 0u;
#pragma unroll
        for (unsigned j = 0; j < 16; ++j) { const unsigned c = xb_ld(&bar[XB_XCNT(j)]); sum += c; cnt += (c > 0u) ? 1u : 0u; mine = (j == x) ? c : mine; }
        if (sum == G) break;
        __builtin_amdgcn_s_sleep(1);
        if ((++sp & 255u) == 0u) { if (xb_ld(&bar[XB_TMO])) break; if (sp > XB_SPIN_CAP) { atomicAdd(&bar[XB_TMO], 1u); break; } }
    }
    nloc = mine > 0u ? mine : 1u; nx = cnt > 0u ? cnt : 1u;
}
__device__ __forceinline__ unsigned xcd_census_uniform(unsigned* bar) {
    const unsigned G = gridDim.x * gridDim.y * gridDim.z; unsigned ok = (G % 8u == 0u) ? 1u : 0u;
#pragma unroll
    for (unsigned j = 0; j < 16; ++j) { const unsigned c = xb_ld(&bar[XB_XCNT(j)]); if (j < 8u ? (c != G / 8u) : (c != 0u)) ok = 0u; }
    return (xb_ld(&bar[XB_TMO]) == 0u) ? ok : 0u;
}

__device__ __forceinline__ void xcd_barrier(const XcdBarrier& b) {
    asm volatile("s_waitcnt vmcnt(0)" ::: "memory");
    __syncthreads();
    if (threadIdx.x == 0) {
        unsigned* bar = b.bar;
        __builtin_amdgcn_s_waitcnt(0);
        unsigned nloc = b.st[0], nx = b.st[1];
        if (nloc == 0u) { xcd_barrier_complete(bar, b.x, nloc, nx); b.st[0] = nloc; b.st[1] = nx; b.st[2] = xcd_census_uniform(bar); }
        const unsigned old = xb_add(&bar[XB_XSUB(b.x)], 1u);
        const unsigned gen = old / nloc;
        if (old + 1u == (gen + 1u) * nloc) {
            __builtin_amdgcn_fence(__ATOMIC_RELEASE, "agent");
            asm volatile("s_waitcnt vmcnt(0)" ::: "memory");
            const unsigned og = xb_add(&bar[XB_TOP], 1u);
            const unsigned tg = og / nx;
            if (og + 1u == (tg + 1u) * nx) xb_add(&bar[XB_TOPGEN], 1u);
            else XB_SPIN(xb_ld(&bar[XB_TOPGEN]) == tg, bar);
            __builtin_amdgcn_fence(__ATOMIC_ACQUIRE, "agent");
            xb_add(&bar[XB_XGEN(b.x)], 1u);
            asm volatile("s_waitcnt vmcnt(0)" ::: "memory");
        } else {
            XB_SPIN(xb_ld(&bar[XB_XGEN(b.x)]) == gen, bar);
            __builtin_amdgcn_fence(__ATOMIC_ACQUIRE, "agent");
            asm volatile("s_waitcnt vmcnt(0)" ::: "memory");
        }
    }
    __syncthreads();
}
#define XB_LSUB(j)  (3456 + 64 * (j))
#define XB_LGEN(j)  (4480 + 64 * (j))
__device__ __forceinline__ void xcd_local_barrier(const XcdBarrier& b, unsigned seq) {
    asm volatile("s_waitcnt vmcnt(0)" ::: "memory");
    __syncthreads();
    if (threadIdx.x == 0) {
        unsigned* bar = b.bar;
        const unsigned target = seq * b.st[0];
        __hip_atomic_fetch_add(&bar[XB_LSUB(b.x)], 1u, __ATOMIC_RELAXED, __HIP_MEMORY_SCOPE_AGENT);
        asm volatile("buffer_inv sc1" ::: "memory");
        XB_SPIN(xb_ld(&bar[XB_LSUB(b.x)]) < target, bar);
        asm volatile("s_waitcnt vmcnt(0)" ::: "memory");
    }
    __syncthreads();
}

typedef unsigned v2u __attribute__((ext_vector_type(2)));
__device__ __forceinline__ float wave_sum(float v) {
#pragma unroll
    for (int o = 1; o < 64; o <<= 1) v += __shfl_xor(v, o);
    return v;
}
__device__ __forceinline__ float bflo(unsigned w) { return __builtin_bit_cast(float, w << 16); }
__device__ __forceinline__ float bfhi(unsigned w) { return __builtin_bit_cast(float, w & 0xffff0000u); }
__device__ __forceinline__ float bf1(unsigned short h) { return __builtin_bit_cast(float, (unsigned)h << 16); }
__device__ __forceinline__ float ex2(float x) { return __builtin_amdgcn_exp2f(x); }
__device__ __forceinline__ float rsq(float x) { return __builtin_amdgcn_rsqf(x); }

__device__ __forceinline__ void p0_item(const float* W, int Nsrc, int k0, int scol0, const float* gain, bf16* WT, int K, int drow0, LAS float* scr, int lane) {
    const int r8 = lane >> 3, c4 = 4 * (lane & 7);
    f32x4 v[8];
#pragma unroll
    for (int i = 0; i < 8; ++i) v[i] = *(const GAS f32x4*)(W + (size_t)(k0 + 8 * i + r8) * Nsrc + scol0 + c4);
#pragma unroll
    for (int i = 0; i < 8; ++i) { const int kk = 8 * i + r8; f32x4 t = v[i]; if (gain) t = t * gain[k0 + kk];
        scr[kk * 33 + c4] = t[0]; scr[kk * 33 + c4 + 1] = t[1]; scr[kk * 33 + c4 + 2] = t[2]; scr[kk * 33 + c4 + 3] = t[3]; }
    LDS_WAIT(); asm volatile("" ::: "memory");
    const int c = lane & 7;
#pragma unroll
    for (int j = 0; j < 4; ++j) { const int n = (lane >> 3) + 8 * j; const LAS float* s = scr + (8 * c) * 33 + n;
        v4u o; o.x = pk2(s[0 * 33], s[1 * 33]); o.y = pk2(s[2 * 33], s[3 * 33]); o.z = pk2(s[4 * 33], s[5 * 33]); o.w = pk2(s[6 * 33], s[7 * 33]);
        *(GAS v4u*)(WT + (size_t)(drow0 + n) * K + k0 + 8 * c) = o; }
    LDS_WAIT(); asm volatile("" ::: "memory");
}
__device__ __forceinline__ void p0_gu(const float* Wg, const float* Wu, const float* gain, bf16* WT, int r, LAS float* scr, int lane) {
    const int nblk = 2 * DFF / 32, kb = r / nblk, nb = r % nblk, n0 = 32 * nb, pn = n0 >> 8, bj = (n0 >> 7) & 1, j0 = n0 & 127;
    p0_item(bj ? Wu : Wg, DFF, 64 * kb, 128 * pn + j0, gain, WT, DMODEL, n0, scr, lane);
}
__device__ __forceinline__ void p0_plain(const float* W, int K, int N, const float* gain, bf16* WT, int r, LAS float* scr, int lane) {
    const int nblk = N / 32, kb = r / nblk, nb = r % nblk;
    p0_item(W, N, 64 * kb, 32 * nb, gain, WT, K, 32 * nb, scr, lane);
}
__device__ __forceinline__ void p0_prologue(LAS unsigned char* lds, const float* const* in, unsigned char* ws, int gw, int NGW, int wave, int lane) {
    LAS float* scr = (LAS float*)(lds + RING_OFF + wave * 16384);
    constexpr int I_GU = (DMODEL / 64) * (2 * DFF / 32), I_D = (DFF / 64) * (DMODEL / 32), I_IN = (DMODEL / 64) * (DIN / 32), I_OUT = (DMODEL / 64) * (DMODEL / 32);
    constexpr int NITEMS = 2 * I_GU + 2 * I_D + I_IN + I_OUT;
    for (int it = gw; it < NITEMS; it += NGW) {
        int r = it;
        if (r < I_GU) { p0_gu(in[3], in[4], in[2], (bf16*)(ws + WS_WGU1), r, scr, lane); continue; } r -= I_GU;
        if (r < I_GU) { p0_gu(in[18], in[19], in[17], (bf16*)(ws + WS_WGU2), r, scr, lane); continue; } r -= I_GU;
        if (r < I_D) { p0_plain(in[5], DFF, DMODEL, nullptr, (bf16*)(ws + WS_WD1), r, scr, lane); continue; } r -= I_D;
        if (r < I_D) { p0_plain(in[20], DFF, DMODEL, nullptr, (bf16*)(ws + WS_WD2), r, scr, lane); continue; } r -= I_D;
        if (r < I_IN) { p0_plain(in[7], DMODEL, DIN, in[6], (bf16*)(ws + WS_WIN), r, scr, lane); continue; } r -= I_IN;
        p0_plain(in[16], DMODEL, DMODEL, nullptr, (bf16*)(ws + WS_WOUT), r, scr, lane);
    }
    bf16* XB = (bf16*)(ws + WS_BUFA); float* p16 = (float*)(ws + WS_P16);
    for (int m0 = gw; m0 < TOK; m0 += 4 * NGW) {
        f32x4 v[4][4]; float s[4];
#pragma unroll
        for (int q = 0; q < 4; ++q) { const int m = m0 + q * NGW;
            if (m < TOK) { const float* xrow = m < NPROMPT ? in[0] + (size_t)m * DMODEL : in[1] + (size_t)(m - NPROMPT) * DMODEL; const GAS f32x4* xr = (const GAS f32x4*)xrow + lane;
#pragma unroll
                for (int j = 0; j < 4; ++j) v[q][j] = xr[64 * j]; } }
#pragma unroll
        for (int q = 0; q < 4; ++q) { s[q] = 0.f;
#pragma unroll
            for (int j = 0; j < 4; ++j) s[q] += (v[q][j].x * v[q][j].x + v[q][j].y * v[q][j].y) + (v[q][j].z * v[q][j].z + v[q][j].w * v[q][j].w); }
#pragma unroll
        for (int o = 1; o < 64; o <<= 1) {
#pragma unroll
            for (int q = 0; q < 4; ++q) s[q] += __shfl_xor(s[q], o); }
#pragma unroll
        for (int q = 0; q < 4; ++q) { const int m = m0 + q * NGW;
            if (m < TOK) { GAS v2u* o8 = (GAS v2u*)(XB + (size_t)m * DMODEL) + lane;
#pragma unroll
                for (int j = 0; j < 4; ++j) { v2u w; w.x = pk2(v[q][j].x, v[q][j].y); w.y = pk2(v[q][j].z, v[q][j].w); o8[64 * j] = w; }
                if (lane < 16) p16[(size_t)m * 16 + lane] = lane == 0 ? s[q] : 0.f; } }
    }
}

__device__ __forceinline__ void final_norm(const bf16* XBr, float* out, const float* gfin, int rbeg, int rend, int gw, int NGW, int lane) {
    for (int m = rbeg + gw; m < rend; m += NGW) {
        const v4u w0 = *(const GAS v4u*)(XBr + (size_t)m * DMODEL + 8 * lane), w1 = *(const GAS v4u*)(XBr + (size_t)m * DMODEL + 512 + 8 * lane);
        float x[16] = {bflo(w0.x), bfhi(w0.x), bflo(w0.y), bfhi(w0.y), bflo(w0.z), bfhi(w0.z), bflo(w0.w), bfhi(w0.w), bflo(w1.x), bfhi(w1.x), bflo(w1.y), bfhi(w1.y), bflo(w1.z), bfhi(w1.z), bflo(w1.w), bfhi(w1.w)};
        float s = 0.f;
#pragma unroll
        for (int e = 0; e < 16; ++e) s += x[e] * x[e];
        const float r = rsq(wave_sum(s) * (1.0f / DMODEL) + EPS);
#pragma unroll
        for (int j = 0; j < 2; ++j) { const int c = 512 * j + 8 * lane;
            const f32x4 g0 = *(const GAS f32x4*)(gfin + c), g1 = *(const GAS f32x4*)(gfin + c + 4);
            *(GAS f32x4*)(out + (size_t)m * DMODEL + c) = (f32x4){x[8 * j] * r * g0[0], x[8 * j + 1] * r * g0[1], x[8 * j + 2] * r * g0[2], x[8 * j + 3] * r * g0[3]};
            *(GAS f32x4*)(out + (size_t)m * DMODEL + c + 4) = (f32x4){x[8 * j + 4] * r * g1[0], x[8 * j + 5] * r * g1[1], x[8 * j + 6] * r * g1[2], x[8 * j + 7] * r * g1[3]}; }
    }
}

constexpr int HG_RAWLF = 0, HG_RAWQ = 17408, HG_QN = 34816, HG_KN = 52224, HG_KT = 69632, HG_VT = 88064, HG_SCL = 97280, HG_ST = 106496, HG_SEG = 115200, HG_SA = 119296, HG_SB = 119808, HG_END = 120320;
static_assert(HG_END <= RING_BYTES, "hgrn LDS");
__device__ __forceinline__ void hgrn_item(LAS unsigned char* lds, const bf16* P, float* ob, int row0, int L, int h, int dir, int dq, int tid, int lane, int wave) {
    const int fr = lane & 15, fq = lane >> 4, nch = L >> 6;
    const bf16* gq = P + COL_Q + h * 128;
    const bf16* gl = P + (dir ? COL_FB : COL_FF) + h * 128;
    const bf16* gv = P + COL_I + h * 128 + dq * 32;
    float* go = ob + h * 128 + dq * 32;
    const int lr = tid >> 4, lc = tid & 15, lp = (tid >> 2) & 31, vc = tid & 3, cp = lane, s8 = wave;
#define TOKROW(n, l) (row0 + (dir ? (L - 1 - (64 * (n) + (l))) : (64 * (n) + (l))))
#define HG_LOAD(n) do { _Pragma("unroll") for (int i_ = 0; i_ < 2; ++i_) { const size_t ro_ = (size_t)TOKROW(n, lr + 32 * i_) * DIN + 8 * lc; rl[i_] = *(const GAS v4u*)(gl + ro_); rq[i_] = *(const GAS v4u*)(gq + ro_); \
        rv[i_] = *(const GAS v4u*)(gv + (size_t)TOKROW(n, 2 * lp + i_) * DIN + 8 * vc); } } while (0)
    v4u rl[2], rq[2], rv[2];
    HG_LOAD(0);
    f32x4 S0 = {0.f, 0.f, 0.f, 0.f}, S1 = {0.f, 0.f, 0.f, 0.f};
    for (int n = 0; n < nch; ++n) {
        const int vbuf = HG_VT + (n & 1) * 4608;
#pragma unroll
        for (int i = 0; i < 2; ++i) { *(LAS v4u*)(lds + HG_RAWLF + (lr + 32 * i) * 272 + lc * 16) = rl[i]; *(LAS v4u*)(lds + HG_RAWQ + (lr + 32 * i) * 272 + lc * 16) = rq[i]; }
        if (tid < 128) {
#pragma unroll
            for (int e = 0; e < 4; ++e) { const unsigned w0 = rv[0][e], w1 = rv[1][e];
                *(LAS unsigned*)(lds + vbuf + (8 * vc + 2 * e) * 144 + lp * 4) = (w0 & 0xffffu) | (w1 << 16);
                *(LAS unsigned*)(lds + vbuf + (8 * vc + 2 * e + 1) * 144 + lp * 4) = (w0 >> 16) | (w1 & 0xffff0000u); }
        }
        if (n + 1 < nch) HG_LOAD(n + 1);
        __syncthreads();
        float lfa[8], lfb[8], ava[8], avb[8]; float runa = 0.f, runb = 0.f;
#pragma unroll
        for (int j = 0; j < 8; ++j) { const unsigned w = *(const LAS unsigned*)(lds + HG_RAWLF + (8 * s8 + j) * 272 + cp * 4);
            lfa[j] = bflo(w); lfb[j] = bfhi(w); runa += lfa[j]; runb += lfb[j]; ava[j] = runa; avb[j] = runb; }
        *(LAS v2u*)(lds + HG_SEG + (s8 * 128 + 2 * cp) * 4) = (v2u){__builtin_bit_cast(unsigned, runa), __builtin_bit_cast(unsigned, runb)};
        __syncthreads();
        {
            typedef float f32x2v __attribute__((ext_vector_type(2)));
            f32x2v sg_[8];
#pragma unroll
            for (int q = 0; q < 8; ++q) sg_[q] = *(const LAS f32x2v*)(lds + HG_SEG + (q * 128 + 2 * cp) * 4);
            const f32x2v amid2 = (sg_[0] + sg_[1]) + (sg_[2] + sg_[3]);
            const f32x2v atot2 = amid2 + ((sg_[4] + sg_[5]) + (sg_[6] + sg_[7]));
            f32x2v off2 = -amid2;
#pragma unroll
            for (int q = 0; q < 7; ++q) { const float mq = (q < s8) ? 1.0f : 0.0f; off2 = off2 + sg_[q] * mq; }
            const float amida = amid2.x, amidb = amid2.y, atota = atot2.x, atotb = atot2.y;
            const float offa = off2.x, offb = off2.y;
            unsigned kta[4], ktb[4];
#pragma unroll
            for (int j = 0; j < 8; ++j) {
                const float aa = offa + ava[j], ab = offb + avb[j];
                const unsigned qw = *(const LAS unsigned*)(lds + HG_RAWQ + (8 * s8 + j) * 272 + cp * 4);
                const float qta = bflo(qw) * ex2(aa), qtb = bfhi(qw) * ex2(ab);
                const float k_a = (1.0f - ex2(lfa[j])) * ex2(-aa), k_b = (1.0f - ex2(lfb[j])) * ex2(-ab);
                const unsigned kba = f2bf(k_a), kbb = f2bf(k_b);
                *(LAS unsigned*)(lds + HG_QN + (8 * s8 + j) * 272 + cp * 4) = pk2(qta, qtb);
                *(LAS unsigned*)(lds + HG_KN + (8 * s8 + j) * 272 + cp * 4) = kba | (kbb << 16);
                if (j & 1) { kta[j >> 1] |= kba << 16; ktb[j >> 1] |= kbb << 16; } else { kta[j >> 1] = kba; ktb[j >> 1] = kbb; }
            }
            *(LAS v4u*)(lds + HG_KT + (2 * cp) * 144 + s8 * 16) = (v4u){kta[0], kta[1], kta[2], kta[3]};
            *(LAS v4u*)(lds + HG_KT + (2 * cp + 1) * 144 + s8 * 16) = (v4u){ktb[0], ktb[1], ktb[2], ktb[3]};
            if (s8 == 0) { *(LAS v2u*)(lds + HG_SA + (2 * cp) * 4) = (v2u){__builtin_bit_cast(unsigned, ex2(amida)), __builtin_bit_cast(unsigned, ex2(amidb))};
                           *(LAS v2u*)(lds + HG_SB + (2 * cp) * 4) = (v2u){__builtin_bit_cast(unsigned, ex2(atota - amida)), __builtin_bit_cast(unsigned, ex2(atotb - amidb))}; }
        }
        __syncthreads();
        {
            const f32x4 sa = *(const LAS f32x4*)(lds + HG_SA + (16 * wave + 4 * fq) * 4);
            S0 = S0 * sa; S1 = S1 * sa;
#ifdef DBG_NOSTATE
            S0 = (f32x4){0.f,0.f,0.f,0.f}; S1 = S0;
#endif
            v2u w0, w1; w0.x = pk2(S0[0], S0[1]); w0.y = pk2(S0[2], S0[3]); w1.x = pk2(S1[0], S1[1]); w1.y = pk2(S1[2], S1[3]);
            *(LAS v2u*)(lds + HG_ST + fr * 272 + (16 * wave + 4 * fq) * 2) = w0;
            *(LAS v2u*)(lds + HG_ST + (16 + fr) * 272 + (16 * wave + 4 * fq) * 2) = w1;
        }
        {
            const int ib = wave & 3, jp = wave >> 2;
#pragma unroll
            for (int t = 0; t < 2; ++t) {
                const int jb = 2 * jp + t;
                f32x4 sc = {0.f, 0.f, 0.f, 0.f};
                if (jb <= ib) {
#pragma unroll
                    for (int ks = 0; ks < 4; ++ks) {
                        const bf16x8 x = *(const LAS bf16x8*)(lds + HG_KN + (16 * jb + fr) * 272 + ks * 64 + fq * 16);
                        const bf16x8 y = *(const LAS bf16x8*)(lds + HG_QN + (16 * ib + fr) * 272 + ks * 64 + fq * 16);
                        sc = __builtin_amdgcn_mfma_f32_16x16x32_bf16(x, y, sc, 0, 0, 0);
                    }
                    if (jb == ib) {
#pragma unroll
                        for (int r = 0; r < 4; ++r) if (4 * fq + r > fr) sc[r] = 0.f;
                    }
                }
                v2u w; w.x = pk2(sc[0], sc[1]); w.y = pk2(sc[2], sc[3]);
                *(LAS v2u*)(lds + HG_SCL + (16 * ib + fr) * 144 + (16 * jb + 4 * fq) * 2) = w;
            }
        }
        __syncthreads();
        {
            const int ib2 = wave >> 1, db = wave & 1;
            f32x4 O = {0.f, 0.f, 0.f, 0.f};
#pragma unroll
            for (int ks = 0; ks < 2; ++ks) {
                const bf16x8 x = *(const LAS bf16x8*)(lds + vbuf + (16 * db + fr) * 144 + ks * 64 + fq * 16);
                const bf16x8 y = *(const LAS bf16x8*)(lds + HG_SCL + (16 * ib2 + fr) * 144 + ks * 64 + fq * 16);
                O = __builtin_amdgcn_mfma_f32_16x16x32_bf16(x, y, O, 0, 0, 0);
            }
#pragma unroll
            for (int ks = 0; ks < 4; ++ks) {
                const bf16x8 x = *(const LAS bf16x8*)(lds + HG_ST + (16 * db + fr) * 272 + ks * 64 + fq * 16);
                const bf16x8 y = *(const LAS bf16x8*)(lds + HG_QN + (16 * ib2 + fr) * 272 + ks * 64 + fq * 16);
                O = __builtin_amdgcn_mfma_f32_16x16x32_bf16(x, y, O, 0, 0, 0);
            }
#if defined(DBG_HG) && DBG_HG == 1
            { const v2u w = *(const LAS v2u*)(lds + HG_QN + (16 * ib2 + fr) * 272 + (16 * db + 4 * fq) * 2); O = (f32x4){bflo(w.x), bfhi(w.x), bflo(w.y), bfhi(w.y)}; }
#elif defined(DBG_HG) && DBG_HG == 2
            { const v2u w = *(const LAS v2u*)(lds + HG_SCL + (16 * ib2 + fr) * 144 + (16 * db + 4 * fq) * 2); O = (f32x4){bflo(w.x), bfhi(w.x), bflo(w.y), bfhi(w.y)}; }
#elif defined(DBG_HG) && DBG_HG == 3
            { const v2u w = *(const LAS v2u*)(lds + vbuf + (16 * db + fr) * 144 + (16 * (ib2 & 3) + 4 * fq) * 2); O = (f32x4){bflo(w.x), bfhi(w.x), bflo(w.y), bfhi(w.y)}; }
#elif defined(DBG_HG) && DBG_HG == 5
            { const v2u w = *(const GAS v2u*)(gq + (size_t)TOKROW(n, 16 * ib2 + fr) * DIN + 16 * db + 4 * fq); O = (f32x4){bflo(w.x), bfhi(w.x), bflo(w.y), bfhi(w.y)}; }
#elif defined(DBG_HG) && DBG_HG == 9
            { const v2u w = *(const GAS v2u*)(gl + (size_t)TOKROW(n, 16 * ib2 + fr) * DIN + 16 * db + 4 * fq); O = (f32x4){bflo(w.x), bfhi(w.x), bflo(w.y), bfhi(w.y)}; }
#elif defined(DBG_HG) && DBG_HG == 10
            { const v2u w = *(const LAS v2u*)(lds + HG_RAWLF + (16 * ib2 + fr) * 272 + (16 * db + 4 * fq) * 2); O = (f32x4){bflo(w.x), bfhi(w.x), bflo(w.y), bfhi(w.y)}; }
#elif defined(DBG_HG) && DBG_HG == 7
            { const v2u w = *(const GAS v2u*)(P + COL_U + h * 128 + (size_t)TOKROW(n, 16 * ib2 + fr) * DIN + 16 * db + 4 * fq); O = (f32x4){bflo(w.x), bfhi(w.x), bflo(w.y), bfhi(w.y)}; }
#elif defined(DBG_HG) && DBG_HG == 8
            { O = (f32x4){(float)TOKROW(n, 16 * ib2 + fr), (float)(16 * db + 4 * fq), (float)h, (float)dq}; }
#elif defined(DBG_HG) && DBG_HG == 6
            { const v2u w = *(const LAS v2u*)(lds + HG_RAWQ + (16 * ib2 + fr) * 272 + (16 * db + 4 * fq) * 2); O = (f32x4){bflo(w.x), bfhi(w.x), bflo(w.y), bfhi(w.y)}; }
#elif defined(DBG_HG) && DBG_HG == 4
            { const v2u w = *(const LAS v2u*)(lds + HG_KN + (16 * ib2 + fr) * 272 + (16 * db + 4 * fq) * 2); O = (f32x4){bflo(w.x), bfhi(w.x), bflo(w.y), bfhi(w.y)}; }
#endif
            *(GAS f32x4*)(go + (size_t)TOKROW(n, 16 * ib2 + fr) * 512 + 16 * db + 4 * fq) = O;
        }
        {
#pragma unroll
            for (int ks = 0; ks < 2; ++ks) {
                const bf16x8 x = *(const LAS bf16x8*)(lds + HG_KT + (16 * wave + fr) * 144 + ks * 64 + fq * 16);
                const bf16x8 y0 = *(const LAS bf16x8*)(lds + vbuf + fr * 144 + ks * 64 + fq * 16);
                const bf16x8 y1 = *(const LAS bf16x8*)(lds + vbuf + (16 + fr) * 144 + ks * 64 + fq * 16);
                S0 = __builtin_amdgcn_mfma_f32_16x16x32_bf16(x, y0, S0, 0, 0, 0);
                S1 = __builtin_amdgcn_mfma_f32_16x16x32_bf16(x, y1, S1, 0, 0, 0);
            }
            const f32x4 sb = *(const LAS f32x4*)(lds + HG_SB + (16 * wave + 4 * fq) * 4);
            S0 = S0 * sb; S1 = S1 * sb;
        }
        __syncthreads();
    }
#undef HG_LOAD
#undef TOKROW
}

constexpr int H2_RAWLF = 0, H2_RAWQ = 17408, H2_ST = 0, H2_QN = 34816, H2_KN = 52224, H2_KT = 69632, H2_VT = 88064, H2_SCL = 106496, H2_SEG = 115712, H2_SA = 119808, H2_SB = 120320, H2_END = 120832;
static_assert(H2_END <= RING_BYTES, "hgrn v2 LDS");
struct Hg2Inst { int row0, L, h, dir, sc, seqid; };
__device__ __forceinline__ Hg2Inst hg2_decode(int i) {
    Hg2Inst I; const int hd = i & 7, sp = i >> 3; I.h = hd >> 1; I.dir = hd & 1;
    if (sp < 32) { const int b = sp >> 2; I.sc = sp & 3; I.row0 = 2048 * b; I.L = 2048; I.seqid = b; }
    else { const int b = (sp - 32) >> 3; I.sc = (sp - 32) & 7; I.row0 = NPROMPT + 4096 * b; I.L = 4096; I.seqid = 8 + b; }
    return I;
}
__device__ __forceinline__ int hg2_index(int seqid, int h, int dir, int sc) { const int sp = seqid < 8 ? seqid * 4 + sc : 32 + (seqid - 8) * 8 + sc; return sp * 8 + h * 2 + dir; }
__device__ __forceinline__ int hg2_xcc_inst(int x, int k) { const int hd = k & 7, sq = k >> 3; const int seqid = x < 4 ? 2 * x + (sq >> 2) : 8 + (x - 4), sc = x < 4 ? (sq & 3) : sq; return hg2_index(seqid, hd >> 1, hd & 1, sc); }
#define H2_TOKROW(p) (row0 + (dir ? (L - 1 - (p)) : (p)))
typedef float f32x2v __attribute__((ext_vector_type(2)));

__device__ __forceinline__ void hg2_state_pass(LAS unsigned char* lds, const bf16* P, float* Ebuf, float* Dbuf, int inst, int tid, int lane, int wave) {
    const Hg2Inst I = hg2_decode(inst); const int row0 = I.row0, L = I.L, h = I.h, dir = I.dir;
    const int fr = lane & 15, fq = lane >> 4, cp = lane, s8 = wave;
    const bf16* gl = P + (dir ? COL_FB : COL_FF) + h * 128;
    const bf16* gv = P + COL_I + h * 128;
    const int lr = tid >> 4, lc = tid & 15, vc = 4 * (wave & 3) + (lane & 3), lp = 16 * (wave >> 2) + (lane >> 2);
    const int p0 = 512 * I.sc;
#define H2_LOAD1(n) do { _Pragma("unroll") for (int i_ = 0; i_ < 2; ++i_) { rl[i_] = *(const GAS v4u*)(gl + (size_t)H2_TOKROW(p0 + 64 * (n) + lr + 32 * i_) * DIN + 8 * lc); \
        rv[i_] = *(const GAS v4u*)(gv + (size_t)H2_TOKROW(p0 + 64 * (n) + 2 * lp + i_) * DIN + 8 * vc); } } while (0)
    v4u rl[2], rv[2];
    H2_LOAD1(0);
    f32x4 S[8];
#pragma unroll
    for (int t = 0; t < 8; ++t) S[t] = (f32x4){0.f, 0.f, 0.f, 0.f};
    f32x2v dlog = {0.f, 0.f};
    for (int n = 0; n < 8; ++n) {
#pragma unroll
        for (int i = 0; i < 2; ++i) *(LAS v4u*)(lds + H2_RAWLF + (lr + 32 * i) * 272 + lc * 16) = rl[i];
#pragma unroll
        for (int e = 0; e < 4; ++e) { const unsigned w0 = rv[0][e], w1 = rv[1][e];
            *(LAS unsigned*)(lds + H2_VT + (8 * vc + 2 * e) * 144 + lp * 4) = (w0 & 0xffffu) | (w1 << 16);
            *(LAS unsigned*)(lds + H2_VT + (8 * vc + 2 * e + 1) * 144 + lp * 4) = (w0 >> 16) | (w1 & 0xffff0000u); }
        if (n + 1 < 8) H2_LOAD1(n + 1);
        __syncthreads();
        float lfa[8], lfb[8]; f32x2v av[8]; f32x2v run = {0.f, 0.f};
#pragma unroll
        for (int j = 0; j < 8; ++j) { const unsigned w = *(const LAS unsigned*)(lds + H2_RAWLF + (8 * s8 + j) * 272 + cp * 4);
            lfa[j] = bflo(w); lfb[j] = bfhi(w); run = run + (f32x2v){lfa[j], lfb[j]}; av[j] = run; }
        *(LAS f32x2v*)(lds + H2_SEG + (s8 * 128 + 2 * cp) * 4) = run;
        __syncthreads();
        {
            f32x2v sg_[8];
#pragma unroll
            for (int q = 0; q < 8; ++q) sg_[q] = *(const LAS f32x2v*)(lds + H2_SEG + (q * 128 + 2 * cp) * 4);
            const f32x2v amid2 = (sg_[0] + sg_[1]) + (sg_[2] + sg_[3]);
            const f32x2v atot2 = amid2 + ((sg_[4] + sg_[5]) + (sg_[6] + sg_[7]));
            f32x2v off2 = -amid2;
#pragma unroll
            for (int q = 0; q < 7; ++q) { const float mq = (q < s8) ? 1.0f : 0.0f; off2 = off2 + sg_[q] * mq; }
            unsigned kta[4], ktb[4];
#pragma unroll
            for (int j = 0; j < 8; ++j) {
                const f32x2v aa = off2 + av[j];
                const unsigned kba = f2bf((1.0f - ex2(lfa[j])) * ex2(-aa.x)), kbb = f2bf((1.0f - ex2(lfb[j])) * ex2(-aa.y));
                if (j & 1) { kta[j >> 1] |= kba << 16; ktb[j >> 1] |= kbb << 16; } else { kta[j >> 1] = kba; ktb[j >> 1] = kbb; }
            }
            *(LAS v4u*)(lds + H2_KT + (2 * cp) * 144 + s8 * 16) = (v4u){kta[0], kta[1], kta[2], kta[3]};
            *(LAS v4u*)(lds + H2_KT + (2 * cp + 1) * 144 + s8 * 16) = (v4u){ktb[0], ktb[1], ktb[2], ktb[3]};
            if (s8 == 0) { *(LAS f32x2v*)(lds + H2_SA + (2 * cp) * 4) = (f32x2v){ex2(amid2.x), ex2(amid2.y)};
                           *(LAS f32x2v*)(lds + H2_SB + (2 * cp) * 4) = (f32x2v){ex2(atot2.x - amid2.x), ex2(atot2.y - amid2.y)}; dlog = dlog + atot2; }
        }
        __syncthreads();
        {
            const f32x4 sa = *(const LAS f32x4*)(lds + H2_SA + (16 * wave + 4 * fq) * 4), sb = *(const LAS f32x4*)(lds + H2_SB + (16 * wave + 4 * fq) * 4);
            bf16x8 x[2];
#pragma unroll
            for (int ks = 0; ks < 2; ++ks) x[ks] = *(const LAS bf16x8*)(lds + H2_KT + (16 * wave + fr) * 144 + ks * 64 + fq * 16);
#pragma unroll
            for (int t = 0; t < 8; ++t) S[t] = S[t] * sa;
#pragma unroll
            for (int ks = 0; ks < 2; ++ks) { bf16x8 y[8];
#pragma unroll
                for (int t = 0; t < 8; ++t) y[t] = *(const LAS bf16x8*)(lds + H2_VT + (16 * t + fr) * 144 + ks * 64 + fq * 16);
#pragma unroll
                for (int t = 0; t < 8; ++t) S[t] = __builtin_amdgcn_mfma_f32_16x16x32_bf16(x[ks], y[t], S[t], 0, 0, 0); }
#pragma unroll
            for (int t = 0; t < 8; ++t) S[t] = S[t] * sb;
        }
        __syncthreads();
    }
    float* E = Ebuf + (size_t)inst * 16384;
#pragma unroll
    for (int t = 0; t < 8; ++t) *(GAS f32x4*)(E + ((wave * 8 + t) * 64 + lane) * 4) = S[t];
    if (s8 == 0) *(GAS f32x2v*)(Dbuf + (size_t)inst * 128 + 2 * cp) = dlog;
#undef H2_LOAD1
}

__device__ __forceinline__ void hg2_out_pass(LAS unsigned char* lds, const bf16* P, bf16* ob, const float* Ebuf, const float* Dbuf, int inst, int tid, int lane, int wave) {
    const Hg2Inst I = hg2_decode(inst); const int row0 = I.row0, L = I.L, h = I.h, dir = I.dir;
    const int fr = lane & 15, fq = lane >> 4, cp = lane, s8 = wave;
    const bf16* gq = P + COL_Q + h * 128;
    const bf16* gl = P + (dir ? COL_FB : COL_FF) + h * 128;
    const bf16* gv = P + COL_I + h * 128;
    bf16* go = ob + h * 128;
    const int lr = tid >> 4, lc = tid & 15, vc = 4 * (wave & 3) + (lane & 3), lp = 16 * (wave >> 2) + (lane >> 2);
    const int p0 = 512 * I.sc;
#define H2_LOAD2(n) do { _Pragma("unroll") for (int i_ = 0; i_ < 2; ++i_) { const size_t ro_ = (size_t)H2_TOKROW(p0 + 64 * (n) + lr + 32 * i_) * DIN + 8 * lc; rl[i_] = *(const GAS v4u*)(gl + ro_); rq[i_] = *(const GAS v4u*)(gq + ro_); \
        rv[i_] = *(const GAS v4u*)(gv + (size_t)H2_TOKROW(p0 + 64 * (n) + 2 * lp + i_) * DIN + 8 * vc); } } while (0)
    v4u rl[2], rq[2], rv[2];
    H2_LOAD2(0);
    f32x4 S[8];
#pragma unroll
    for (int t = 0; t < 8; ++t) S[t] = (f32x4){0.f, 0.f, 0.f, 0.f};
    for (int j = 0; j < I.sc; ++j) {
        const int ij = hg2_index(I.seqid, h, dir, j);
        const f32x4 dl = *(const GAS f32x4*)(Dbuf + (size_t)ij * 128 + 16 * wave + 4 * fq);
        const f32x4 dec = {ex2(dl[0]), ex2(dl[1]), ex2(dl[2]), ex2(dl[3])};
        const float* E = Ebuf + (size_t)ij * 16384;
#pragma unroll
        for (int t = 0; t < 8; ++t) S[t] = S[t] * dec + *(const GAS f32x4*)(E + ((wave * 8 + t) * 64 + lane) * 4);
    }
    for (int n = 0; n < 8; ++n) {
#pragma unroll
        for (int i = 0; i < 2; ++i) { *(LAS v4u*)(lds + H2_RAWLF + (lr + 32 * i) * 272 + lc * 16) = rl[i]; *(LAS v4u*)(lds + H2_RAWQ + (lr + 32 * i) * 272 + lc * 16) = rq[i]; }
#pragma unroll
        for (int e = 0; e < 4; ++e) { const unsigned w0 = rv[0][e], w1 = rv[1][e];
            *(LAS unsigned*)(lds + H2_VT + (8 * vc + 2 * e) * 144 + lp * 4) = (w0 & 0xffffu) | (w1 << 16);
            *(LAS unsigned*)(lds + H2_VT + (8 * vc + 2 * e + 1) * 144 + lp * 4) = (w0 >> 16) | (w1 & 0xffff0000u); }
        if (n + 1 < 8) H2_LOAD2(n + 1);
        __syncthreads();
        float lfa[8], lfb[8]; f32x2v av[8]; f32x2v run = {0.f, 0.f};
#pragma unroll
        for (int j = 0; j < 8; ++j) { const unsigned w = *(const LAS unsigned*)(lds + H2_RAWLF + (8 * s8 + j) * 272 + cp * 4);
            lfa[j] = bflo(w); lfb[j] = bfhi(w); run = run + (f32x2v){lfa[j], lfb[j]}; av[j] = run; }
        *(LAS f32x2v*)(lds + H2_SEG + (s8 * 128 + 2 * cp) * 4) = run;
        __syncthreads();
        {
            f32x2v sg_[8];
#pragma unroll
            for (int q = 0; q < 8; ++q) sg_[q] = *(const LAS f32x2v*)(lds + H2_SEG + (q * 128 + 2 * cp) * 4);
            const f32x2v amid2 = (sg_[0] + sg_[1]) + (sg_[2] + sg_[3]);
            const f32x2v atot2 = amid2 + ((sg_[4] + sg_[5]) + (sg_[6] + sg_[7]));
            f32x2v off2 = -amid2;
#pragma unroll
            for (int q = 0; q < 7; ++q) { const float mq = (q < s8) ? 1.0f : 0.0f; off2 = off2 + sg_[q] * mq; }
            unsigned kta[4], ktb[4];
#pragma unroll
            for (int j = 0; j < 8; ++j) {
                const f32x2v aa = off2 + av[j];
                const unsigned qw = *(const LAS unsigned*)(lds + H2_RAWQ + (8 * s8 + j) * 272 + cp * 4);
                const float qta = bflo(qw) * ex2(aa.x), qtb = bfhi(qw) * ex2(aa.y);
                const unsigned kba = f2bf((1.0f - ex2(lfa[j])) * ex2(-aa.x)), kbb = f2bf((1.0f - ex2(lfb[j])) * ex2(-aa.y));
                *(LAS unsigned*)(lds + H2_QN + (8 * s8 + j) * 272 + cp * 4) = pk2(qta, qtb);
                *(LAS unsigned*)(lds + H2_KN + (8 * s8 + j) * 272 + cp * 4) = kba | (kbb << 16);
                if (j & 1) { kta[j >> 1] |= kba << 16; ktb[j >> 1] |= kbb << 16; } else { kta[j >> 1] = kba; ktb[j >> 1] = kbb; }
            }
            *(LAS v4u*)(lds + H2_KT + (2 * cp) * 144 + s8 * 16) = (v4u){kta[0], kta[1], kta[2], kta[3]};
            *(LAS v4u*)(lds + H2_KT + (2 * cp + 1) * 144 + s8 * 16) = (v4u){ktb[0], ktb[1], ktb[2], ktb[3]};
            if (s8 == 0) { *(LAS f32x2v*)(lds + H2_SA + (2 * cp) * 4) = (f32x2v){ex2(amid2.x), ex2(amid2.y)};
                           *(LAS f32x2v*)(lds + H2_SB + (2 * cp) * 4) = (f32x2v){ex2(atot2.x - amid2.x), ex2(atot2.y - amid2.y)}; }
        }
        __syncthreads();
        {
            const f32x4 sa = *(const LAS f32x4*)(lds + H2_SA + (16 * wave + 4 * fq) * 4);
#pragma unroll
            for (int t = 0; t < 8; ++t) { S[t] = S[t] * sa; v2u w; w.x = pk2(S[t][0], S[t][1]); w.y = pk2(S[t][2], S[t][3]);
                *(LAS v2u*)(lds + H2_ST + (16 * t + fr) * 272 + (16 * wave + 4 * fq) * 2) = w; }
        }
        {
            const int ib = wave & 3, jp = wave >> 2;
#pragma unroll
            for (int t = 0; t < 2; ++t) {
                const int jb = 2 * jp + t;
                f32x4 sc = {0.f, 0.f, 0.f, 0.f};
                if (jb <= ib) {
#pragma unroll
                    for (int ks = 0; ks < 4; ++ks) {
                        const bf16x8 x = *(const LAS bf16x8*)(lds + H2_KN + (16 * jb + fr) * 272 + ks * 64 + fq * 16);
                        const bf16x8 y = *(const LAS bf16x8*)(lds + H2_QN + (16 * ib + fr) * 272 + ks * 64 + fq * 16);
                        sc = __builtin_amdgcn_mfma_f32_16x16x32_bf16(x, y, sc, 0, 0, 0);
                    }
                    if (jb == ib) {
#pragma unroll
                        for (int r = 0; r < 4; ++r) if (4 * fq + r > fr) sc[r] = 0.f;
                    }
                }
                v2u w; w.x = pk2(sc[0], sc[1]); w.y = pk2(sc[2], sc[3]);
                *(LAS v2u*)(lds + H2_SCL + (16 * ib + fr) * 144 + (16 * jb + 4 * fq) * 2) = w;
            }
        }
        __syncthreads();
        {
            const int ib2 = wave >> 1, dh = wave & 1;
            bf16x8 ys[2], yq[4];
#pragma unroll
            for (int ks = 0; ks < 2; ++ks) ys[ks] = *(const LAS bf16x8*)(lds + H2_SCL + (16 * ib2 + fr) * 144 + ks * 64 + fq * 16);
#pragma unroll
            for (int ks = 0; ks < 4; ++ks) yq[ks] = *(const LAS bf16x8*)(lds + H2_QN + (16 * ib2 + fr) * 272 + ks * 64 + fq * 16);
            const size_t orow = (size_t)H2_TOKROW(p0 + 64 * n + 16 * ib2 + fr) * 512;
            f32x4 O[4];
#pragma unroll
            for (int t = 0; t < 4; ++t) O[t] = (f32x4){0.f, 0.f, 0.f, 0.f};
#pragma unroll
            for (int ks = 0; ks < 2; ++ks) { bf16x8 x[4];
#pragma unroll
                for (int t = 0; t < 4; ++t) x[t] = *(const LAS bf16x8*)(lds + H2_VT + (16 * (4 * dh + t) + fr) * 144 + ks * 64 + fq * 16);
#pragma unroll
                for (int t = 0; t < 4; ++t) O[t] = __builtin_amdgcn_mfma_f32_16x16x32_bf16(x[t], ys[ks], O[t], 0, 0, 0); }
#pragma unroll
            for (int ks = 0; ks < 4; ++ks) { bf16x8 x[4];
#pragma unroll
                for (int t = 0; t < 4; ++t) x[t] = *(const LAS bf16x8*)(lds + H2_ST + (16 * (4 * dh + t) + fr) * 272 + ks * 64 + fq * 16);
#pragma unroll
                for (int t = 0; t < 4; ++t) O[t] = __builtin_amdgcn_mfma_f32_16x16x32_bf16(x[t], yq[ks], O[t], 0, 0, 0); }
#pragma unroll
            for (int t = 0; t < 4; ++t) { v2u w; w.x = pk2(O[t][0], O[t][1]); w.y = pk2(O[t][2], O[t][3]); *(GAS v2u*)(go + orow + 16 * (4 * dh + t) + 4 * fq) = w; }
        }
        {
            const f32x4 sb = *(const LAS f32x4*)(lds + H2_SB + (16 * wave + 4 * fq) * 4);
            bf16x8 x[2];
#pragma unroll
            for (int ks = 0; ks < 2; ++ks) x[ks] = *(const LAS bf16x8*)(lds + H2_KT + (16 * wave + fr) * 144 + ks * 64 + fq * 16);
#pragma unroll
            for (int ks = 0; ks < 2; ++ks) { bf16x8 y[8];
#pragma unroll
                for (int t = 0; t < 8; ++t) y[t] = *(const LAS bf16x8*)(lds + H2_VT + (16 * t + fr) * 144 + ks * 64 + fq * 16);
#pragma unroll
                for (int t = 0; t < 8; ++t) S[t] = __builtin_amdgcn_mfma_f32_16x16x32_bf16(x[ks], y[t], S[t], 0, 0, 0); }
#pragma unroll
            for (int t = 0; t < 8; ++t) S[t] = S[t] * sb;
        }
        __syncthreads();
    }
#undef H2_LOAD2
}

#ifdef DBG_NAIVE_HGRN
__device__ __forceinline__ void naive_hgrn_item(LAS unsigned char* lds, const bf16* P, float* ob, int row0, int L, int h, int dir, int tid) {
    LAS float* LQ = (LAS float*)lds; LAS float* LF = LQ + 2048; LAS float* LK = LF + 2048;
    const unsigned short* Pu = (const unsigned short*)P;
    float S[128];
#pragma unroll
    for (int k = 0; k < 128; ++k) S[k] = 0.f;
    for (int t0 = 0; t0 < L; t0 += 16) {
        __syncthreads();
#pragma unroll
        for (int i = 0; i < 4; ++i) { const int idx = tid + 512 * i, st = idx >> 7, k = idx & 127; const size_t row = (size_t)(row0 + (dir ? (L - 1 - (t0 + st)) : (t0 + st)));
            const float qv = bf1(Pu[row * DIN + COL_Q + h * 128 + k]), l2 = bf1(Pu[row * DIN + (dir ? COL_FB : COL_FF) + h * 128 + k]), f = exp2f(l2);
            LQ[st * 128 + k] = qv; LF[st * 128 + k] = f; LK[st * 128 + k] = 1.0f - f; }
        __syncthreads();
        if (tid < 128) {
#pragma unroll 1
            for (int st = 0; st < 16; ++st) { const size_t row = (size_t)(row0 + (dir ? (L - 1 - (t0 + st)) : (t0 + st)));
                const float v = bf1(Pu[row * DIN + COL_I + h * 128 + tid]); float o = 0.f;
#pragma unroll
                for (int k4 = 0; k4 < 32; ++k4) { const f32x4 f4 = *(const LAS f32x4*)(LF + st * 128 + 4 * k4), k4v = *(const LAS f32x4*)(LK + st * 128 + 4 * k4), q4 = *(const LAS f32x4*)(LQ + st * 128 + 4 * k4);
#pragma unroll
                    for (int e = 0; e < 4; ++e) { S[4 * k4 + e] = f4[e] * S[4 * k4 + e] + k4v[e] * v; o += q4[e] * S[4 * k4 + e]; } }
                ob[row * 512 + h * 128 + tid] = o; }
        }
    }
    __syncthreads();
}
#endif
__device__ __forceinline__ void hgrn_combine(const bf16* ob0, const bf16* ob1, const bf16* P, const float* onorm, const float* ssg, const float* gon, bf16* Y, int rbeg, int rend, int gw, int NGW, int lane) {
    const int c = 8 * lane;
    const f32x4 g0 = *(const GAS f32x4*)(onorm + c), g1 = *(const GAS f32x4*)(onorm + c + 4);
    const f32x4 n0 = *(const GAS f32x4*)(gon + c), n1 = *(const GAS f32x4*)(gon + c + 4);
    for (int m = rbeg + gw; m < rend; m += NGW) {
        const v4u aw = *(const GAS v4u*)(ob0 + (size_t)m * 512 + c), bw = *(const GAS v4u*)(ob1 + (size_t)m * 512 + c);
        const f32x4 a0 = {bflo(aw.x), bfhi(aw.x), bflo(aw.y), bfhi(aw.y)}, a1 = {bflo(aw.z), bfhi(aw.z), bflo(aw.w), bfhi(aw.w)};
        const f32x4 b0 = {bflo(bw.x), bfhi(bw.x), bflo(bw.y), bfhi(bw.y)}, b1 = {bflo(bw.z), bfhi(bw.z), bflo(bw.w), bfhi(bw.w)};
        const v4u sgw = *(const GAS v4u*)(P + (size_t)m * DIN + COL_G + c);
#ifdef DBG_PCOPY
        f32x4 o0 = {0.f,0.f,0.f,0.f}, o1 = o0;
        { const int segs[4] = {COL_Q, COL_I, COL_FF, COL_FB};
#pragma unroll
          for (int q_ = 0; q_ < 4; ++q_) { const v4u pw = *(const GAS v4u*)(P + (size_t)m * DIN + segs[q_] + c);
            o0 += (f32x4){bflo(pw.x), bfhi(pw.x), bflo(pw.y), bfhi(pw.y)}; o1 += (f32x4){bflo(pw.z), bfhi(pw.z), bflo(pw.w), bfhi(pw.w)}; } }
#else
        const f32x4 o0 = a0 + b0, o1 = a1 + b1;
#endif
        float s = ((o0[0] * o0[0] + o0[1] * o0[1]) + (o0[2] * o0[2] + o0[3] * o0[3])) + ((o1[0] * o1[0] + o1[1] * o1[1]) + (o1[2] * o1[2] + o1[3] * o1[3]));
        s += __shfl_xor(s, 1); s += __shfl_xor(s, 2); s += __shfl_xor(s, 4); s += __shfl_xor(s, 8);
        const float r = rsq(s * (1.0f / 128.0f) + EPS);
        const f32x4 y0 = o0 * r * g0 * (f32x4){bflo(sgw.x), bfhi(sgw.x), bflo(sgw.y), bfhi(sgw.y)};
        const f32x4 y1 = o1 * r * g1 * (f32x4){bflo(sgw.z), bfhi(sgw.z), bflo(sgw.w), bfhi(sgw.w)};
        v4u w; w.x = pk2(y0[0], y0[1]); w.y = pk2(y0[2], y0[3]); w.z = pk2(y1[0], y1[1]); w.w = pk2(y1[2], y1[3]);
        *(GAS v4u*)(Y + (size_t)m * DMODEL + 512 + c) = w;
#ifndef NO_GMLP
        const f32x4 sv = *(const GAS f32x4*)(ssg + (size_t)m * 4);
        const float rg = rsq(((sv[0] + sv[1]) + (sv[2] + sv[3])) * (1.0f / 512.0f) + EPS);
        const v4u yw = *(const GAS v4u*)(Y + (size_t)m * DMODEL + c);
        const f32x4 z0 = (f32x4){bflo(yw.x), bfhi(yw.x), bflo(yw.y), bfhi(yw.y)} * rg * n0, z1 = (f32x4){bflo(yw.z), bfhi(yw.z), bflo(yw.w), bfhi(yw.w)} * rg * n1;
        v4u zw; zw.x = pk2(z0[0], z0[1]); zw.y = pk2(z0[2], z0[3]); zw.z = pk2(z1[0], z1[1]); zw.w = pk2(z1[2], z1[3]);
        *(GAS v4u*)(Y + (size_t)m * DMODEL + c) = zw;
#endif
    }
}

__device__ __forceinline__ void hgrn_combine_local(const bf16* ob0, const bf16* ob1, const bf16* P, const float* onorm, bf16* Y, int rbase, int h, int tid) {
    const int l16 = tid & 15, tg = tid >> 4;
    const int c = h * 128 + 8 * l16;
    const f32x4 g0 = *(const GAS f32x4*)(onorm + c), g1 = *(const GAS f32x4*)(onorm + c + 4);
#pragma unroll 1
    for (int t0 = 0; t0 < 512; t0 += 128) {
        v4u aw[4], bw[4], sw[4];
#pragma unroll
        for (int q = 0; q < 4; ++q) { const size_t m = (size_t)(rbase + t0 + 32 * q + tg);
            aw[q] = *(const GAS v4u*)(ob0 + m * 512 + c); bw[q] = *(const GAS v4u*)(ob1 + m * 512 + c); sw[q] = *(const GAS v4u*)(P + m * DIN + COL_G + c); }
#pragma unroll
        for (int q = 0; q < 4; ++q) { const size_t m = (size_t)(rbase + t0 + 32 * q + tg);
            const f32x4 o0 = (f32x4){bflo(aw[q].x), bfhi(aw[q].x), bflo(aw[q].y), bfhi(aw[q].y)} + (f32x4){bflo(bw[q].x), bfhi(bw[q].x), bflo(bw[q].y), bfhi(bw[q].y)};
            const f32x4 o1 = (f32x4){bflo(aw[q].z), bfhi(aw[q].z), bflo(aw[q].w), bfhi(aw[q].w)} + (f32x4){bflo(bw[q].z), bfhi(bw[q].z), bflo(bw[q].w), bfhi(bw[q].w)};
            float sq = ((o0[0] * o0[0] + o0[1] * o0[1]) + (o0[2] * o0[2] + o0[3] * o0[3])) + ((o1[0] * o1[0] + o1[1] * o1[1]) + (o1[2] * o1[2] + o1[3] * o1[3]));
            sq += __shfl_xor(sq, 1); sq += __shfl_xor(sq, 2); sq += __shfl_xor(sq, 4); sq += __shfl_xor(sq, 8);
            const float r = rsq(sq * (1.0f / 128.0f) + EPS);
            const f32x4 y0 = o0 * r * g0 * (f32x4){bflo(sw[q].x), bfhi(sw[q].x), bflo(sw[q].y), bfhi(sw[q].y)};
            const f32x4 y1 = o1 * r * g1 * (f32x4){bflo(sw[q].z), bfhi(sw[q].z), bflo(sw[q].w), bfhi(sw[q].w)};
            v4u w; w.x = pk2(y0[0], y0[1]); w.y = pk2(y0[2], y0[3]); w.z = pk2(y1[0], y1[1]); w.w = pk2(y1[2], y1[3]);
            *(GAS v4u*)(Y + m * DMODEL + 512 + c) = w; }
    }
}
__device__ __forceinline__ void yg_fixup(const float* ssg, const float* gon, bf16* Y, int rbeg, int rend, int gw, int NGW, int lane) {
    const int c = 8 * lane;
    const f32x4 n0 = *(const GAS f32x4*)(gon + c), n1 = *(const GAS f32x4*)(gon + c + 4);
    for (int m0 = rbeg + gw; m0 < rend; m0 += 4 * NGW) {
        f32x4 sv[4]; v4u yw[4];
#pragma unroll
        for (int q = 0; q < 4; ++q) { const int m = m0 + q * NGW; if (m < rend) { sv[q] = *(const GAS f32x4*)(ssg + (size_t)m * 4); yw[q] = *(const GAS v4u*)(Y + (size_t)m * DMODEL + c); } }
#pragma unroll
        for (int q = 0; q < 4; ++q) { const int m = m0 + q * NGW; if (m < rend) {
            const float rg = rsq(((sv[q][0] + sv[q][1]) + (sv[q][2] + sv[q][3])) * (1.0f / 512.0f) + EPS);
            const f32x4 z0 = (f32x4){bflo(yw[q].x), bfhi(yw[q].x), bflo(yw[q].y), bfhi(yw[q].y)} * rg * n0, z1 = (f32x4){bflo(yw[q].z), bfhi(yw[q].z), bflo(yw[q].w), bfhi(yw[q].w)} * rg * n1;
            v4u zw; zw.x = pk2(z0[0], z0[1]); zw.y = pk2(z0[2], z0[3]); zw.z = pk2(z1[0], z1[1]); zw.w = pk2(z1[2], z1[3]);
            *(GAS v4u*)(Y + (size_t)m * DMODEL + c) = zw; } }
    }
}
constexpr int GM_RAWV = 0, GM_VLT = 34816, GM_WL = 69632, GM_MEAN = 104448, GM_RSTD = 104960, GM_END = 105472;
static_assert(GM_END <= RING_BYTES, "gmlp LDS");
__device__ __forceinline__ void gmlp_item(LAS unsigned char* lds, const bf16* P, bf16* Y, float* ssg, const float* ln_g, const float* ln_b, const float* w_s, const float* b_s, int c, int h, int tid, int lane, int wave) {
    const int fr = lane & 15, fq = lane >> 4, R0 = 128 * c;
#pragma unroll 1
    for (int jj = 0; jj < 4; ++jj) {
        float sm[4], sq[4];
#pragma unroll
        for (int j = 0; j < 4; ++j) {
            const int s = 16 * wave + 4 * jj + j;
            const v4u raw = *(const GAS v4u*)(P + (size_t)(R0 + s) * DIN + COL_V + 8 * lane);
            const float x0 = bflo(raw.x), x1 = bfhi(raw.x), x2 = bflo(raw.y), x3 = bfhi(raw.y), x4 = bflo(raw.z), x5 = bfhi(raw.z), x6 = bflo(raw.w), x7 = bfhi(raw.w);
            sm[j] = ((x0 + x1) + (x2 + x3)) + ((x4 + x5) + (x6 + x7));
            sq[j] = ((x0 * x0 + x1 * x1) + (x2 * x2 + x3 * x3)) + ((x4 * x4 + x5 * x5) + (x6 * x6 + x7 * x7));
        }
#pragma unroll
        for (int o = 1; o < 64; o <<= 1) {
#pragma unroll
            for (int j = 0; j < 4; ++j) { sm[j] += __shfl_xor(sm[j], o); sq[j] += __shfl_xor(sq[j], o); }
        }
        if (lane == 0) {
#pragma unroll
            for (int j = 0; j < 4; ++j) { const int s = 16 * wave + 4 * jj + j; const float mean = sm[j] * (1.0f / 512.0f), var = fmaxf(sq[j] * (1.0f / 512.0f) - mean * mean, 0.f);
                *(LAS float*)(lds + GM_MEAN + s * 4) = mean; *(LAS float*)(lds + GM_RSTD + s * 4) = rsq(var + EPS); }
        }
    }
#pragma unroll
    for (int i = 0; i < 4; ++i) { const int idx = tid + 512 * i, row = idx >> 4, c16 = idx & 15;
        *(LAS v4u*)(lds + GM_RAWV + row * 272 + c16 * 16) = *(const GAS v4u*)(P + (size_t)(R0 + row) * DIN + COL_V + 128 * h + 8 * c16); }
#pragma unroll
    for (int i = 0; i < 8; ++i) { const int idx = tid + 512 * i, tt = idx >> 5, s4 = idx & 31;
        const f32x4 w = *(const GAS f32x4*)(w_s + (size_t)h * 16384 + tt * 128 + 4 * s4);
        v2u o; o.x = pk2(w[0], w[1]); o.y = pk2(w[2], w[3]);
        *(LAS v2u*)(lds + GM_WL + tt * 272 + s4 * 8) = o; }
    __syncthreads();
    {
        const int ch = tid & 127, sq4 = tid >> 7;
        const float g = ln_g[128 * h + ch], b = ln_b[128 * h + ch];
#pragma unroll
        for (int i = 0; i < 4; ++i) {
            unsigned wv[4];
#pragma unroll
            for (int e = 0; e < 8; ++e) { const int s = 32 * sq4 + 8 * i + e;
                const float x = bf1(*(const LAS unsigned short*)(lds + GM_RAWV + s * 272 + ch * 2));
                const float y = (x - *(const LAS float*)(lds + GM_MEAN + s * 4)) * *(const LAS float*)(lds + GM_RSTD + s * 4) * g + b;
                const unsigned yb = f2bf(y);
                if (e & 1) wv[e >> 1] |= yb << 16; else wv[e >> 1] = yb; }
            *(LAS v4u*)(lds + GM_VLT + ch * 272 + (32 * sq4 + 8 * i) * 2) = (v4u){wv[0], wv[1], wv[2], wv[3]};
        }
    }
    __syncthreads();
    const int t = 16 * wave + fr;
    bf16x8 yf[4];
#pragma unroll
    for (int ks = 0; ks < 4; ++ks) yf[ks] = *(const LAS bf16x8*)(lds + GM_WL + (16 * wave + fr) * 272 + ks * 64 + fq * 16);
    const float bs = b_s[h * 128 + t];
    float ss = 0.f;
#pragma unroll
    for (int cb = 0; cb < 8; ++cb) {
        f32x4 a = {0.f, 0.f, 0.f, 0.f};
#pragma unroll
        for (int ks = 0; ks < 4; ++ks) {
            const bf16x8 x = *(const LAS bf16x8*)(lds + GM_VLT + (16 * cb + fr) * 272 + ks * 64 + fq * 16);
            a = __builtin_amdgcn_mfma_f32_16x16x32_bf16(x, yf[ks], a, 0, 0, 0);
        }
        const int ch = 128 * h + 16 * cb + 4 * fq;
        const v2u uw = *(const GAS v2u*)(P + (size_t)(R0 + t) * DIN + COL_U + ch);
        const f32x4 uu = {bflo(uw.x), bfhi(uw.x), bflo(uw.y), bfhi(uw.y)};
        a = (a + bs) * uu;
        ss += (a[0] * a[0] + a[1] * a[1]) + (a[2] * a[2] + a[3] * a[3]);
        v2u w; w.x = pk2(a[0], a[1]); w.y = pk2(a[2], a[3]);
        *(GAS v2u*)(Y + (size_t)(R0 + t) * DMODEL + ch) = w;
    }
    ss += __shfl_xor(ss, 16); ss += __shfl_xor(ss, 32);
    if (fq == 0) ssg[(size_t)(R0 + t) * 4 + h] = ss;
    __syncthreads();
}

struct Args { const float* in[22]; float* out; unsigned char* ws; int ph_lo, ph_hi, li, pad; };
constexpr int N_PHASES = 11;
#ifndef MK_N_LAUNCHES
#define MK_N_LAUNCHES 1
#endif
#ifndef DUP_PHASE
#define DUP_PHASE (-1)
#endif
__global__ void __launch_bounds__(NWAVES * 64, 2) fwd_kernel(Args args) {
    extern __shared__ __attribute__((aligned(16))) unsigned char lds_raw[];
    LAS unsigned char* lds = (LAS unsigned char*)lds_raw;
    volatile LAS unsigned* MISC = (volatile LAS unsigned*)(lds + MISC_OFF);
    const int tid = threadIdx.x, lane = tid & 63, wave = __builtin_amdgcn_readfirstlane(tid >> 6);
    const int G = gridDim.x, bx = blockIdx.x;
    const int vcu = (G % 8 == 0) ? (bx % 8) * (G / 8) + bx / 8 : bx;
    const int gw = vcu * NWAVES + wave, NGW = G * NWAVES;
    unsigned char* ws = args.ws;
    gu32* ctl = (gu32*)(ws + WS_CTL);
    for (int u = tid; u < (LDS_BYTES - LDSCTL_OFF) / 4; u += NWAVES * 64) ((LAS unsigned*)(lds + LDSCTL_OFF))[u] = 0u;
    __syncthreads();
    XcdBarrier bar = xcd_barrier_post((unsigned*)(ctl + CW_BAR) + args.li * XCD_BAR_WORDS, MISC + 8);
    const int lo = args.ph_lo, hi = args.ph_hi;
#define IN(k) (lo <= (k) && (k) < hi)
    int uni = 0, cid = bx, xr = 0, xx = 0; unsigned lseq = 0;
#define SEAM(k) do { if (IN(k) && IN((k) + 1)) { if (uni) xcd_local_barrier(bar, ++lseq); else xcd_barrier(bar); } } while (0)
    bf16* XB = (bf16*)(ws + WS_BUFA); bf16* Y = (bf16*)(ws + WS_BUFB); bf16* BIG = (bf16*)(ws + WS_BIG);
    bf16* OB0 = (bf16*)args.out; bf16* OB1 = (bf16*)args.out + (size_t)TOK * 512;
    float* SSG = (float*)(ws + WS_SSG); float* HGE = (float*)(ws + WS_HGE); float* HGD = (float*)(ws + WS_HGD);
    float* P16_0 = (float*)(ws + WS_P16); float* P16_1 = (float*)(ws + WS_P16 + 2 * MiB); float* P16_2 = (float*)(ws + WS_P16 + 4 * MiB);

    for (int rep_ = 0; rep_ < ((DUP_PHASE == 0) ? 2 : 1); ++rep_) if (IN(0)) { p0_prologue(lds, args.in, ws, gw, NGW, wave, lane); }
    if (IN(0) && IN(1)) { xcd_barrier(bar);
        if (MISC[10] != 0u && G == 256) { uni = 1; xr = (int)MISC[11]; xx = (int)bar.x; cid = 8 * xr + xx; } }
#define PHASE1 if (IN(1)) { pg8::Gemm g{XB, (const bf16*)(ws + WS_WGU1), TOK, 2 * DFF, DMODEL}; pg8::StaticOrder S; S.init(TOK, 2 * DFF, G, cid); \
        pg8::EpiSwiGLU E{BIG, DFF, P16_0}; pg8::gemm_phase<pg8::EpiSwiGLU, pg8::StaticOrder, PG8_ALIGN, PG8_SP2>(lds + RING_OFF, g, S, E); }
    PHASE1
#if DUP_PHASE == 1
    PHASE1
#endif
    SEAM(1);
#if DUP_PHASE == 90
    for (int r_ = 0; r_ < 10; ++r_) { if (uni) xcd_local_barrier(bar, ++lseq); else xcd_barrier(bar); }
#endif
#define PHASE2 if (IN(2)) { pg8::Gemm g{BIG, (const bf16*)(ws + WS_WD1), TOK, DMODEL, DFF}; pg8::StaticOrder S; S.init(TOK, DMODEL, G, cid); \
        pg8::EpiResidBf<true> E{XB, P16_1, 0.5f}; pg8::gemm_phase<pg8::EpiResidBf<true>, pg8::StaticOrder, PG8_ALIGN, PG8_SP2>(lds + RING_OFF, g, S, E); }
    PHASE2
#if DUP_PHASE == 2
    PHASE2
#endif
#if DUP_PHASE == 20
    if (IN(2)) { pg8::Gemm g{BIG, (const bf16*)(ws + WS_WD1), TOK, DMODEL, DFF}; pg8::StaticOrder S; S.init(TOK, DMODEL, G, cid);
        pg8::EpiNull E{SSG}; pg8::gemm_phase<pg8::EpiNull, pg8::StaticOrder, PG8_ALIGN, PG8_SP2>(lds + RING_OFF, g, S, E); }
#endif
#if DUP_PHASE == 10
    if (IN(2)) { pg8::Gemm g{XB, (const bf16*)(ws + WS_WGU1), TOK, 2 * DFF, DMODEL}; pg8::StaticOrder S; S.init(TOK, 2 * DFF, G, cid);
        pg8::EpiNull E{SSG}; pg8::gemm_phase<pg8::EpiNull, pg8::StaticOrder, PG8_ALIGN, PG8_SP2>(lds + RING_OFF, g, S, E); }
#endif
    SEAM(2);
#define PHASE3 if (IN(3)) { pg8::Gemm g{XB, (const bf16*)(ws + WS_WIN), TOK, DIN, DMODEL}; pg8::StaticOrder S; S.init(TOK, DIN, G, cid); \
        pg8::EpiMix E{BIG, DIN, P16_1, args.in[13], args.in[14]}; pg8::gemm_phase<pg8::EpiMix, pg8::StaticOrder, PG8_ALIGN, PG8_SP2>(lds + RING_OFF, g, S, E); }
    PHASE3
#if DUP_PHASE == 3
    PHASE3
#endif
    SEAM(3);
    for (int rep_ = 0; rep_ < ((DUP_PHASE == 4 || DUP_PHASE == 40 || DUP_PHASE == 41) ? 2 : 1); ++rep_) if (IN(4)) {
        if (uni) {
            for (int k = xr; k < 64; k += 32) hg2_state_pass(lds, BIG, HGE, HGD, hg2_xcc_inst(xx, k), tid, lane, wave);
            for (int k = xr; k < 128; k += 32) gmlp_item(lds, BIG, Y, SSG, args.in[8], args.in[9], args.in[10], args.in[11], 32 * xx + (k >> 2), k & 3, tid, lane, wave);
        } else {
        if (rep_ == 0 || DUP_PHASE != 41) for (int i = bx; i < 512; i += G) hg2_state_pass(lds, BIG, HGE, HGD, i, tid, lane, wave);
        if (rep_ == 0 || DUP_PHASE != 40) for (int it = bx; it < 1024; it += G) gmlp_item(lds, BIG, Y, SSG, args.in[8], args.in[9], args.in[10], args.in[11], it >> 2, it & 3, tid, lane, wave);
        }
    }
    SEAM(4);
    for (int rep_ = 0; rep_ < ((DUP_PHASE == 5) ? 2 : 1); ++rep_) if (IN(5)) {
        if (uni) {
            const int h = xr & 3, sq = xr >> 2;
            const int seqid = xx < 4 ? 2 * xx + (sq >> 2) : 8 + (xx - 4), scf = xx < 4 ? (sq & 3) : sq, nsc = xx < 4 ? 4 : 8;
            hg2_out_pass(lds, BIG, OB1, HGE, HGD, hg2_index(seqid, h, 1, nsc - 1 - scf), tid, lane, wave);
            hg2_out_pass(lds, BIG, OB0, HGE, HGD, hg2_index(seqid, h, 0, scf), tid, lane, wave);
            asm volatile("s_waitcnt vmcnt(0)" ::: "memory"); __syncthreads();
            if (tid == 0) { asm volatile("buffer_inv sc1" ::: "memory"); asm volatile("s_waitcnt vmcnt(0)" ::: "memory"); }
            __syncthreads();
            hgrn_combine_local(OB0, OB1, BIG, args.in[15], Y, 4096 * xx + 512 * sq, h, tid);
            yg_fixup(SSG, args.in[12], Y, 4096 * xx, 4096 * xx + 4096, 8 * xr + wave, 256, lane);
        }
        else { for (int i = bx; i < 512; i += G) { const Hg2Inst I = hg2_decode(i); hg2_out_pass(lds, BIG, I.dir ? OB1 : OB0, HGE, HGD, i, tid, lane, wave); } }
    }
    if (!uni) SEAM(5);
    if (IN(6) && !uni) { if (uni) hgrn_combine(OB0, OB1, BIG, args.in[15], SSG, args.in[12], Y, 4096 * xx, 4096 * xx + 4096, 8 * xr + wave, 256, lane);
                 else hgrn_combine(OB0, OB1, BIG, args.in[15], SSG, args.in[12], Y, 0, TOK, gw, NGW, lane); }
    SEAM(6);
    if (IN(7)) { pg8::Gemm g{Y, (const bf16*)(ws + WS_WOUT), TOK, DMODEL, DMODEL}; pg8::StaticOrder S; S.init(TOK, DMODEL, G, cid);
        pg8::EpiResidBf<true> E{XB, P16_2, 1.0f};
        pg8::gemm_phase<pg8::EpiResidBf<true>, pg8::StaticOrder, PG8_ALIGN, PG8_SP2>(lds + RING_OFF, g, S, E); }
    SEAM(7);
    if (IN(8)) { pg8::Gemm g{XB, (const bf16*)(ws + WS_WGU2), TOK, 2 * DFF, DMODEL}; pg8::StaticOrder S; S.init(TOK, 2 * DFF, G, cid);
        pg8::EpiSwiGLU E{BIG, DFF, P16_2};
        pg8::gemm_phase<pg8::EpiSwiGLU, pg8::StaticOrder, PG8_ALIGN, PG8_SP2>(lds + RING_OFF, g, S, E); }
    SEAM(8);
    if (IN(9)) { pg8::Gemm g{BIG, (const bf16*)(ws + WS_WD2), TOK, DMODEL, DFF}; pg8::StaticOrder S; S.init(TOK, DMODEL, G, cid);
        pg8::EpiResidBf<false> E{XB, nullptr, 0.5f};
        pg8::gemm_phase<pg8::EpiResidBf<false>, pg8::StaticOrder, PG8_ALIGN, PG8_SP2>(lds + RING_OFF, g, S, E); }
    SEAM(9);
    if (IN(10)) { if (uni) final_norm(XB, args.out, args.in[21], 4096 * xx, 4096 * xx + 4096, 8 * xr + wave, 256, lane); else final_norm(XB, args.out, args.in[21], 0, TOK, gw, NGW, lane); }
#undef IN
#undef SEAM
}

extern "C" void kernel_launch(void* const* d_in, const int* in_sizes, int n_in, void* d_out, int out_size, void* d_ws, size_t ws_size, hipStream_t stream) {
    static int grid = 0;
    if (grid == 0) {
        if (n_in != 22 || out_size != TOK * DMODEL || ws_size < WS_END) { fprintf(stderr, "kernel_launch: unexpected problem (n_in %d, out %d, ws %zu); nothing launched\n", n_in, out_size, ws_size); grid = -1; return; }
        int dev = 0, cus = 0, per_cu = 0;
        if (hipGetDevice(&dev) != hipSuccess || hipDeviceGetAttribute(&cus, hipDeviceAttributeMultiprocessorCount, dev) != hipSuccess) { grid = -1; return; }
        if (hipFuncSetAttribute((const void*)fwd_kernel, hipFuncAttributeMaxDynamicSharedMemorySize, LDS_BYTES) != hipSuccess) { fprintf(stderr, "kernel_launch: hipFuncSetAttribute failed\n"); grid = -1; return; }
        if (hipOccupancyMaxActiveBlocksPerMultiprocessor(&per_cu, (const void*)fwd_kernel, NWAVES * 64, LDS_BYTES) != hipSuccess || per_cu < 1) { fprintf(stderr, "kernel_launch: occupancy query says %d blocks per CU; nothing launched\n", per_cu); (void)hipGetLastError(); grid = -1; return; }
        grid = cus;
    }
    if (grid < 0) return;
    if (hipMemsetAsync((char*)d_ws + WS_CTL, 0, CTL_ZERO_BYTES, stream) != hipSuccess) return;
    Args a{};
    for (int i = 0; i < 22; ++i) a.in[i] = (const float*)d_in[i];
    a.out = (float*)d_out; a.ws = (unsigned char*)d_ws;
    constexpr int NL = MK_N_LAUNCHES;
    for (int li = 0; li < NL; ++li) {
        a.ph_lo = (NL == 1) ? 0 : li; a.ph_hi = (NL == 1) ? N_PHASES : li + 1; a.li = 0;
        hipLaunchKernelGGL(fwd_kernel, dim3(grid), dim3(NWAVES * 64), LDS_BYTES, stream, a);
        if (hipPeekAtLastError() != hipSuccess) { fprintf(stderr, "kernel_launch: launch %d failed\n", li); break; }
    }
}
```

```cpp
#include <hip/hip_runtime.h>
#include <cstdio>
#include <cstdint>
namespace pg8 {
#define PG8_LAS __attribute__((address_space(3)))
typedef unsigned short bf16_t;
typedef short bf16x8 __attribute__((ext_vector_type(8)));
typedef float f32x4 __attribute__((ext_vector_type(4)));
typedef unsigned u32x4 __attribute__((ext_vector_type(4)));
constexpr int BM = 256, BK = 64, HALF = 128, HTB = HALF * BK * 2  , STAGE_BYTES = 8 * HTB, NXCD = 8, WGM = 8;

__host__ __device__ __forceinline__ int lds_byte(int r, int c) { const int st = (r >> 4) * 2 + (c >> 5), rr = r & 15, cc = c & 31, ob = rr * 64 + cc * 2; return st * 1024 + (ob ^ (((ob >> 9) & 1) << 5)); }
__host__ __device__ __forceinline__ void stage_rc(int b, int& R, int& C) { const int st = b / 1024, sb = b % 1024, swz = sb ^ (((sb >> 9) & 1) << 5); R = (st >> 1) * 16 + swz / 64; C = (st & 1) * 32 + (swz % 64) / 2; }
__host__ __device__ __forceinline__ int perm32(int rho) { const int n = rho >> 4, i = rho & 15; return 8 * (i >> 2) + 4 * n + (i & 3); }

struct Unit { int pm, pn; };
struct Gemm { const bf16_t* A; const bf16_t* Bt; int M, N, K; };

struct StaticOrder {
    int nM, nN, nwg, G, c;
    __host__ __device__ void init(int M, int N, int G_, int c_) { nM = M / BM; nN = N / BM; nwg = nM * nN; G = G_; c = c_; }
    __host__ __device__ bool next(int i, Unit& u) const {
        const long L = (long)i * G + c; if (L >= nwg) return false;
        int wgid = (int)L; { const int q = nwg / NXCD, r = nwg % NXCD, xcd = wgid % NXCD, off = wgid / NXCD; wgid = (xcd < r ? xcd * (q + 1) : r * (q + 1) + (xcd - r) * q) + off; }
        const int nig = WGM * nN, gid = wgid / nig, fm = gid * WGM, gsz = (nM - fm) < WGM ? (nM - fm) : WGM;
        u.pm = fm + ((wgid % nig) % gsz); u.pn = (wgid % nig) / gsz; return true;
    }
    __device__ __forceinline__ void a_ready(const Unit&) const {}
    __device__ __forceinline__ void done(const Unit&) const {}
};

typedef __bf16 bf16x2_hw __attribute__((ext_vector_type(2)));
typedef float f32x2_hw __attribute__((ext_vector_type(2)));
__device__ __forceinline__ unsigned cvt_pk_bf16(float lo, float hi) { const f32x2_hw v = {lo, hi}; const bf16x2_hw b = __builtin_convertvector(v, bf16x2_hw); return __builtin_bit_cast(unsigned, b); }
typedef float f32x2 __attribute__((ext_vector_type(2)));
__device__ __forceinline__ f32x2 gelu_pk(f32x2 v) {
    const f32x2 av = __builtin_elementwise_abs(v), d = av * 0.2316418882f + 1.0f;
    f32x2 t; t.x = __builtin_amdgcn_rcpf(d.x); t.y = __builtin_amdgcn_rcpf(d.y);
    f32x2 q = t * 0.5307027145f + (-0.7265760135f); q = q * t + 0.7107068705f; q = q * t + (-0.142248368f); q = q * t + 0.127414796f; q = q * t;
    const f32x2 s = (v * v) * (-0.72134752044f);
    f32x2 e; e.x = __builtin_amdgcn_exp2f(s.x); e.y = __builtin_amdgcn_exp2f(s.y);
    const f32x2 m = v * (q * e), r = v - m;
    f32x2 o; o.x = v.x < 0.f ? m.x : r.x; o.y = v.y < 0.f ? m.y : r.y; return o;
}

constexpr float RMS_EPS = 1e-6f;
constexpr int DM = 1024;
__device__ __forceinline__ float row_rstd(const float* p16, int row, int fq) {
    const f32x4 v = *(const f32x4*)(p16 + (size_t)row * 16 + 4 * fq);
    float s = (v[0] + v[1]) + (v[2] + v[3]);
    s += __shfl_xor(s, 16); s += __shfl_xor(s, 32);
    return __builtin_amdgcn_rsqf(s * (1.0f / DM) + RMS_EPS);
}
__device__ __forceinline__ void row_rstd8(const float* p16, int row0, int fq, float (&rr)[8]) {
    f32x4 pv[8];
#pragma unroll
    for (int i = 0; i < 8; ++i) pv[i] = *(const f32x4*)(p16 + (size_t)(row0 + (i >> 2) * HALF + (i & 3) * 16) * 16 + 4 * fq);
#pragma unroll
    for (int i = 0; i < 8; ++i) { float s = (pv[i][0] + pv[i][1]) + (pv[i][2] + pv[i][3]); s += __shfl_xor(s, 16); s += __shfl_xor(s, 32); rr[i] = __builtin_amdgcn_rsqf(s * (1.0f / DM) + RMS_EPS); }
}
__device__ __forceinline__ float fast_sigmoid(float z) { return __builtin_amdgcn_rcpf(1.0f + __builtin_amdgcn_exp2f(-1.44269504089f * z)); }

struct EpiSwiGLU {
    static constexpr bool PERM = true, AFTER_DRAIN = false;
    bf16_t* O; int ldo; const float* p16;
    __device__ __forceinline__ void operator()(const f32x4 (&acc)[2][2][4][2], const Unit& u, int wr, int wc, int fr, int fq) const {
        const int row0 = u.pm * BM + wr * 64 + fr, col0 = u.pn * HALF + wc * 32 + 8 * fq;
        float rr[8];
        row_rstd8(p16, row0, fq, rr);
#pragma unroll
        for (int ai = 0; ai < 2; ++ai)
#pragma unroll
            for (int m = 0; m < 4; ++m) {
                const int row = row0 + ai * HALF + m * 16;
                const float r = rr[ai * 4 + m];
                float h[8];
#pragma unroll
                for (int n = 0; n < 2; ++n)
#pragma unroll
                    for (int e = 0; e < 4; ++e) { const float g = acc[ai][0][m][n][e] * r, up = acc[ai][1][m][n][e] * r; h[4 * n + e] = g * up * fast_sigmoid(g); }
                u32x4 w; w.x = cvt_pk_bf16(h[0], h[1]); w.y = cvt_pk_bf16(h[2], h[3]); w.z = cvt_pk_bf16(h[4], h[5]); w.w = cvt_pk_bf16(h[6], h[7]);
                *(u32x4*)(O + (size_t)row * ldo + col0) = w;
            }
    }
};

template <bool WANT_BF16, bool WANT_SS> struct EpiResid {
    static constexpr bool PERM = true, AFTER_DRAIN = false;
    const float* base0; const float* base1;
    float* out; bf16_t* xb; float* p16; float alpha;
    __device__ __forceinline__ void operator()(const f32x4 (&acc)[2][2][4][2], const Unit& u, int wr, int wc, int fr, int fq) const {
        const int row0 = u.pm * BM + wr * 64 + fr, col0 = u.pn * BM + wc * 32 + 8 * fq;
        const float* bp = (u.pm < 64) ? base0 : base1; const int brow = (u.pm < 64) ? 0 : 16384;
        f32x4 bcur[4], bnxt[4];
#define RESID_LOAD(dst, it) do { const size_t bo_ = (size_t)(row0 + ((it) >> 2) * HALF + ((it) & 3) * 16 - brow) * DM + col0; \
            dst[0] = *(const f32x4*)(bp + bo_); dst[1] = *(const f32x4*)(bp + bo_ + 4); dst[2] = *(const f32x4*)(bp + bo_ + HALF); dst[3] = *(const f32x4*)(bp + bo_ + HALF + 4); } while (0)
        RESID_LOAD(bcur, 0);
#pragma unroll
        for (int it = 0; it < 8; ++it) {
            const int ai = it >> 2, m = it & 3;
            if (it + 1 < 8) RESID_LOAD(bnxt, it + 1);
            const int row = row0 + ai * HALF + m * 16; const size_t off = (size_t)row * DM + col0;
            float ss = 0.f;
#pragma unroll
            for (int bj = 0; bj < 2; ++bj) {
                const f32x4 v0 = bcur[2 * bj] + acc[ai][bj][m][0] * alpha, v1 = bcur[2 * bj + 1] + acc[ai][bj][m][1] * alpha;
                *(f32x4*)(out + off + bj * HALF) = v0; *(f32x4*)(out + off + bj * HALF + 4) = v1;
                if (WANT_BF16) { u32x4 w; w.x = cvt_pk_bf16(v0[0], v0[1]); w.y = cvt_pk_bf16(v0[2], v0[3]); w.z = cvt_pk_bf16(v1[0], v1[1]); w.w = cvt_pk_bf16(v1[2], v1[3]);
                    *(u32x4*)(xb + off + bj * HALF) = w; }
                if (WANT_SS) ss += ((v0[0] * v0[0] + v0[1] * v0[1]) + (v0[2] * v0[2] + v0[3] * v0[3])) + ((v1[0] * v1[0] + v1[1] * v1[1]) + (v1[2] * v1[2] + v1[3] * v1[3]));
            }
            if (WANT_SS) { ss += __shfl_xor(ss, 16); ss += __shfl_xor(ss, 32); if (fq == 0) p16[(size_t)row * 16 + 4 * u.pn + wc] = ss; }
#pragma unroll
            for (int q = 0; q < 4; ++q) bcur[q] = bnxt[q];
            asm volatile("" ::: "memory");
        }
#undef RESID_LOAD
    }
};

template <bool WANT_SS> struct EpiResidBf {
    static constexpr bool PERM = true, AFTER_DRAIN = false;
    bf16_t* xb; float* p16; float alpha;
    __device__ __forceinline__ void operator()(const f32x4 (&acc)[2][2][4][2], const Unit& u, int wr, int wc, int fr, int fq) const {
        const int row0 = u.pm * BM + wr * 64 + fr, col0 = u.pn * BM + wc * 32 + 8 * fq;
        u32x4 bcur[2], bnxt[2];
#define RESB_LOAD(dst, it) do { const size_t bo_ = (size_t)(row0 + ((it) >> 2) * HALF + ((it) & 3) * 16) * DM + col0; dst[0] = *(const u32x4*)(xb + bo_); dst[1] = *(const u32x4*)(xb + bo_ + HALF); } while (0)
        RESB_LOAD(bcur, 0);
#pragma unroll
        for (int it = 0; it < 8; ++it) {
            const int ai = it >> 2, m = it & 3;
            if (it + 1 < 8) RESB_LOAD(bnxt, it + 1);
            const int row = row0 + ai * HALF + m * 16; const size_t off = (size_t)row * DM + col0;
            float ss = 0.f;
#pragma unroll
            for (int bj = 0; bj < 2; ++bj) {
                const u32x4 b = bcur[bj];
                const f32x4 b0 = {__builtin_bit_cast(float, b.x << 16), __builtin_bit_cast(float, b.x & 0xffff0000u), __builtin_bit_cast(float, b.y << 16), __builtin_bit_cast(float, b.y & 0xffff0000u)};
                const f32x4 b1 = {__builtin_bit_cast(float, b.z << 16), __builtin_bit_cast(float, b.z & 0xffff0000u), __builtin_bit_cast(float, b.w << 16), __builtin_bit_cast(float, b.w & 0xffff0000u)};
                const f32x4 v0 = b0 + acc[ai][bj][m][0] * alpha, v1 = b1 + acc[ai][bj][m][1] * alpha;
                u32x4 w; w.x = cvt_pk_bf16(v0[0], v0[1]); w.y = cvt_pk_bf16(v0[2], v0[3]); w.z = cvt_pk_bf16(v1[0], v1[1]); w.w = cvt_pk_bf16(v1[2], v1[3]);
                *(u32x4*)(xb + off + bj * HALF) = w;
                if (WANT_SS) ss += ((v0[0] * v0[0] + v0[1] * v0[1]) + (v0[2] * v0[2] + v0[3] * v0[3])) + ((v1[0] * v1[0] + v1[1] * v1[1]) + (v1[2] * v1[2] + v1[3] * v1[3]));
            }
            if (WANT_SS) { ss += __shfl_xor(ss, 16); ss += __shfl_xor(ss, 32); if (fq == 0) p16[(size_t)row * 16 + 4 * u.pn + wc] = ss; }
            bcur[0] = bnxt[0]; bcur[1] = bnxt[1];
            asm volatile("" ::: "memory");
        }
#undef RESB_LOAD
    }
};
struct EpiNull { static constexpr bool PERM = true, AFTER_DRAIN = false; float* sink;
    __device__ __forceinline__ void operator()(const f32x4 (&acc)[2][2][4][2], const Unit& u, int wr, int wc, int fr, int fq) const {
        float s = 0.f;
#pragma unroll
        for (int ai = 0; ai < 2; ++ai)
#pragma unroll
            for (int bj = 0; bj < 2; ++bj)
#pragma unroll
                for (int m = 0; m < 4; ++m)
#pragma unroll
                    for (int n = 0; n < 2; ++n) s += acc[ai][bj][m][n][0] + acc[ai][bj][m][n][1] + acc[ai][bj][m][n][2] + acc[ai][bj][m][n][3];
        if (s == 12345.678f) sink[0] = s;
    } };
struct EpiMix {
    static constexpr bool PERM = true, AFTER_DRAIN = false;
    bf16_t* P; int ldp; const float* p16; const float* lbf; const float* lbb;
    template <int ACT> __device__ __forceinline__ void run(const f32x4 (&acc)[2][2][4][2], const Unit& u, int wr, int wc, int fr, int fq) const {
        const int row0 = u.pm * BM + wr * 64 + fr, col0 = u.pn * BM + wc * 32 + 8 * fq;
        float oml[2][8];
        if (ACT == 3) { const float* lb = ((u.pn >> 1) == 4) ? lbf : lbb; const int c0 = (u.pn & 1) * BM + wc * 32 + 8 * fq;
#pragma unroll
            for (int bj = 0; bj < 2; ++bj)
#pragma unroll
                for (int e = 0; e < 8; ++e) { const float a0 = lb[c0 + bj * HALF + e], a1 = lb[512 + c0 + bj * HALF + e]; oml[bj][e] = fast_sigmoid(a1 - a0);
#ifdef DBG_OML
                    oml[bj][e] = 0.5f;
#endif
                } }
        float rr[8];
        row_rstd8(p16, row0, fq, rr);
#pragma unroll
        for (int ai = 0; ai < 2; ++ai)
#pragma unroll
            for (int m = 0; m < 4; ++m) {
                const int row = row0 + ai * HALF + m * 16;
                const float r = rr[ai * 4 + m];
#pragma unroll
                for (int bj = 0; bj < 2; ++bj) {
                    float h[8];
#pragma unroll
                    for (int n = 0; n < 2; ++n) {
                        const f32x4 z = acc[ai][bj][m][n] * r;
                        if (ACT == 0) { const f32x2 a = gelu_pk((f32x2){z[0], z[1]}), b = gelu_pk((f32x2){z[2], z[3]}); h[4 * n] = a.x; h[4 * n + 1] = a.y; h[4 * n + 2] = b.x; h[4 * n + 3] = b.y; }
                        else if (ACT == 1) {
#pragma unroll
                            for (int e = 0; e < 4; ++e) h[4 * n + e] = z[e] * fast_sigmoid(z[e]); }
                        else if (ACT == 2) {
#pragma unroll
                            for (int e = 0; e < 4; ++e) h[4 * n + e] = z[e]; }
                        else {
#pragma unroll
                            for (int e = 0; e < 4; ++e) { const float kk = oml[bj][4 * n + e] * __builtin_amdgcn_rcpf(1.0f + __builtin_amdgcn_exp2f(1.44269504089f * z[e]));
                                h[4 * n + e] = __builtin_amdgcn_logf(1.0f - kk); }
                        }
                    }
                    u32x4 w; w.x = cvt_pk_bf16(h[0], h[1]); w.y = cvt_pk_bf16(h[2], h[3]); w.z = cvt_pk_bf16(h[4], h[5]); w.w = cvt_pk_bf16(h[6], h[7]);
                    *(u32x4*)(P + (size_t)row * ldp + col0 + bj * HALF) = w;
                }
            }
    }
    __device__ __forceinline__ void operator()(const f32x4 (&acc)[2][2][4][2], const Unit& u, int wr, int wc, int fr, int fq) const {
        const int seg = u.pn >> 1;
        if (seg <= 1) run<0>(acc, u, wr, wc, fr, fq);
        else if (seg == 2 || seg == 6) run<1>(acc, u, wr, wc, fr, fq);
        else if (seg == 3) run<2>(acc, u, wr, wc, fr, fq);
        else run<3>(acc, u, wr, wc, fr, fq);
    }
};

template <class Epi, class Sched, bool ALIGN_EPI = false, bool SP2 = false>
__device__ __forceinline__ void gemm_phase(PG8_LAS unsigned char* lds, const Gemm g, const Sched& S, const Epi& E) {
    const int tid = threadIdx.x, wid = __builtin_amdgcn_readfirstlane(tid >> 6), lane = tid & 63, wr = wid >> 2, wc = wid & 3, fr = lane & 15, fq = lane >> 4;
    const int K = g.K, nt = K / BK;
    unsigned voffA[2], voffB[2];
#pragma unroll
    for (int i = 0; i < 2; ++i) { int R, C; stage_rc(tid * 16 + i * 8192, R, C); const int Rb = Epi::PERM ? ((R & ~31) + perm32(R & 31)) : R;
        voffA[i] = (unsigned)(R * K + C) * 2u; voffB[i] = (unsigned)(Rb * K + C) * 2u; }
    const size_t kstep = (size_t)(BK * 2);
    const size_t hstep = (size_t)HALF * K * 2;
    const size_t tstep = 2 * hstep;
    const unsigned ldsw = (unsigned)wid * 1024u;
    const int aoff = lds_byte(wr * 64 + fr, fq * 8), boff = lds_byte(wc * 32 + fr, fq * 8);
#define PG8_SA(b, h) (((b) * 2 + (h)) * HTB)
#define PG8_SB(b, h) ((4 + (b) * 2 + (h)) * HTB)
#define PG8_STAGE(bufoff, gbase, voff) do { _Pragma("unroll") for (int _i = 0; _i < 2; ++_i) \
        __builtin_amdgcn_global_load_lds((const unsigned*)((const char*)(gbase) + (voff)[_i]), (PG8_LAS unsigned*)(lds + (bufoff) + ldsw + _i * 8192), 16, 0, 0); } while (0)
#define PG8_LDA(dst, b, h) do { _Pragma("unroll") for (int m = 0; m < 4; ++m) _Pragma("unroll") for (int k = 0; k < 2; ++k) dst[m][k] = *(const PG8_LAS bf16x8*)(lds + PG8_SA(b, h) + aoff + m * 2048 + k * 1024); } while (0)
#define PG8_LDB(dst, b, h) do { _Pragma("unroll") for (int n = 0; n < 2; ++n) _Pragma("unroll") for (int k = 0; k < 2; ++k) dst[n][k] = *(const PG8_LAS bf16x8*)(lds + PG8_SB(b, h) + boff + n * 2048 + k * 1024); } while (0)
#define PG8_MMA(ai, bj, At, Bt) do { __builtin_amdgcn_s_setprio(1); _Pragma("unroll") for (int m = 0; m < 4; ++m) _Pragma("unroll") for (int n = 0; n < 2; ++n) _Pragma("unroll") for (int k = 0; k < 2; ++k) \
        acc[ai][bj][m][n] = __builtin_amdgcn_mfma_f32_16x16x32_bf16(Bt[n][k], At[m][k], acc[ai][bj][m][n], 0, 0, 0); __builtin_amdgcn_s_setprio(0); } while (0)
#define PG8_WAIT_V(n) asm volatile("s_waitcnt vmcnt(" #n ")" ::: "memory")
#define PG8_WAIT_L(n) asm volatile("s_waitcnt lgkmcnt(" #n ")" ::: "memory")
#define PG8_BAR __builtin_amdgcn_s_barrier()
#define PG8_SCHED __builtin_amdgcn_sched_barrier(0)
    Unit cur, nxt; int ui = 0;
    if (!S.next(0, cur)) return;
    f32x4 acc[2][2][4][2];
#pragma unroll
    for (int a = 0; a < 2; ++a)
#pragma unroll
        for (int b = 0; b < 2; ++b)
#pragma unroll
            for (int m = 0; m < 4; ++m)
#pragma unroll
                for (int n = 0; n < 2; ++n) acc[a][b][m][n] = (f32x4){0.f, 0.f, 0.f, 0.f};
    bf16x8 At[4][2], B0[2][2], B1[2][2];
    const char* cA = (const char*)g.A + (size_t)cur.pm * tstep; const char* cB = (const char*)g.Bt + (size_t)cur.pn * tstep;
    S.a_ready(cur);
    if constexpr (SP2) {
        PG8_STAGE(PG8_SB(0, 0), cB, voffB); PG8_STAGE(PG8_SB(0, 1), cB + hstep, voffB); PG8_STAGE(PG8_SA(0, 0), cA, voffA); PG8_STAGE(PG8_SA(0, 1), cA + hstep, voffA);
        if (wr == 1) PG8_BAR;
        PG8_WAIT_V(2); PG8_BAR;
        PG8_STAGE(PG8_SB(1, 0), cB + kstep, voffB); PG8_STAGE(PG8_SA(1, 0), cA + kstep, voffA); PG8_STAGE(PG8_SB(1, 1), cB + hstep + kstep, voffB);
        PG8_WAIT_V(6); PG8_BAR;
    } else {
        PG8_STAGE(PG8_SB(0, 0), cB, voffB); PG8_STAGE(PG8_SA(0, 0), cA, voffA); PG8_STAGE(PG8_SB(0, 1), cB + hstep, voffB); PG8_STAGE(PG8_SA(0, 1), cA + hstep, voffA);
        if (wr == 1) PG8_BAR;
        PG8_WAIT_V(4); PG8_BAR;
        PG8_STAGE(PG8_SB(1, 0), cB + kstep, voffB); PG8_STAGE(PG8_SA(1, 0), cA + kstep, voffA); PG8_STAGE(PG8_SB(1, 1), cB + hstep + kstep, voffB);
        PG8_WAIT_V(6); PG8_BAR;
    }
    for (;;) {
        const bool has_next = S.next(ui + 1, nxt);
        const char* nA = has_next ? (const char*)g.A + (size_t)nxt.pm * tstep : cA; const char* nB = has_next ? (const char*)g.Bt + (size_t)nxt.pn * tstep : cB;
        for (int t = 0; t < nt; t += 2) {
            const bool last = (t == nt - 2);
            const char* a1 = cA + (size_t)(t + 1) * kstep;
            const char* a2 = last ? nA : cA + (size_t)(t + 2) * kstep; const char* b2 = last ? nB : cB + (size_t)(t + 2) * kstep;
            const char* a3 = a2 + kstep; const char* b3 = b2 + kstep;
            if (last && has_next) S.a_ready(nxt);
            if constexpr (SP2) {
            PG8_LDB(B0, 0, 0); PG8_LDB(B1, 0, 1); PG8_SCHED; PG8_LDA(At, 0, 0); PG8_STAGE(PG8_SA(1, 1), a1 + hstep, voffA);
            PG8_WAIT_V(8); PG8_WAIT_L(0); PG8_BAR; PG8_MMA(0, 0, At, B0); PG8_MMA(0, 1, At, B1); PG8_BAR; PG8_SCHED;
            PG8_LDA(At, 0, 1); PG8_STAGE(PG8_SB(0, 0), b2, voffB); PG8_STAGE(PG8_SB(0, 1), b2 + hstep, voffB); PG8_STAGE(PG8_SA(0, 0), a2, voffA);
            PG8_WAIT_V(8); PG8_WAIT_L(0); PG8_BAR; PG8_MMA(1, 0, At, B0); PG8_MMA(1, 1, At, B1); PG8_BAR; PG8_SCHED;
            PG8_LDB(B0, 1, 0); PG8_LDB(B1, 1, 1); PG8_SCHED; PG8_LDA(At, 1, 0); PG8_STAGE(PG8_SA(0, 1), a2 + hstep, voffA);
            PG8_WAIT_V(8); PG8_WAIT_L(0); PG8_BAR; PG8_MMA(0, 0, At, B0); PG8_MMA(0, 1, At, B1); PG8_BAR; PG8_SCHED;
            PG8_LDA(At, 1, 1); PG8_STAGE(PG8_SB(1, 0), b3, voffB); PG8_STAGE(PG8_SB(1, 1), b3 + hstep, voffB); PG8_STAGE(PG8_SA(1, 0), a3, voffA);
            PG8_WAIT_V(8); PG8_WAIT_L(0); PG8_BAR; PG8_MMA(1, 0, At, B0); PG8_MMA(1, 1, At, B1); PG8_BAR; PG8_SCHED;
            } else {
            PG8_LDB(B0, 0, 0); PG8_SCHED; PG8_LDA(At, 0, 0); PG8_STAGE(PG8_SA(1, 1), a1 + hstep, voffA);
            PG8_WAIT_L(8); PG8_BAR; PG8_WAIT_L(0); PG8_MMA(0, 0, At, B0); PG8_BAR; PG8_SCHED;
            PG8_LDB(B1, 0, 1); PG8_STAGE(PG8_SB(0, 0), b2, voffB);
            PG8_BAR; PG8_WAIT_L(0); PG8_MMA(0, 1, At, B1); PG8_BAR;
            PG8_LDA(At, 0, 1); PG8_STAGE(PG8_SA(0, 0), a2, voffA);
            PG8_BAR; PG8_WAIT_L(0); PG8_MMA(1, 0, At, B0); PG8_BAR; PG8_SCHED;
            PG8_STAGE(PG8_SB(0, 1), b2 + hstep, voffB);
            PG8_WAIT_V(6); PG8_BAR; PG8_MMA(1, 1, At, B1); PG8_BAR;
            PG8_LDB(B0, 1, 0); PG8_SCHED; PG8_LDA(At, 1, 0); PG8_STAGE(PG8_SA(0, 1), a2 + hstep, voffA);
            PG8_WAIT_L(8); PG8_BAR; PG8_WAIT_L(0); PG8_MMA(0, 0, At, B0); PG8_BAR; PG8_SCHED;
            PG8_LDB(B1, 1, 1); PG8_STAGE(PG8_SB(1, 0), b3, voffB);
            PG8_BAR; PG8_WAIT_L(0); PG8_MMA(0, 1, At, B1); PG8_BAR;
            PG8_LDA(At, 1, 1); PG8_STAGE(PG8_SA(1, 0), a3, voffA);
            PG8_BAR; PG8_WAIT_L(0); PG8_MMA(1, 0, At, B0); PG8_BAR; PG8_SCHED;
            PG8_STAGE(PG8_SB(1, 1), b3 + hstep, voffB);
            PG8_WAIT_V(6); PG8_BAR; PG8_MMA(1, 1, At, B1); PG8_BAR;
            }
        }
        if constexpr (ALIGN_EPI) { if (wr == 0) PG8_BAR; }
        if constexpr (!Epi::AFTER_DRAIN) { E(acc, cur, wr, wc, fr, fq); S.done(cur); }
        if (!has_next) break;
#pragma unroll
        for (int a = 0; a < 2; ++a)
#pragma unroll
            for (int b = 0; b < 2; ++b)
#pragma unroll
                for (int m = 0; m < 4; ++m)
#pragma unroll
                    for (int n = 0; n < 2; ++n) acc[a][b][m][n] = (f32x4){0.f, 0.f, 0.f, 0.f};
        cur = nxt; cA = nA; cB = nB; ++ui;
        if constexpr (ALIGN_EPI) { if (wr == 1) PG8_BAR; }
    }
    PG8_WAIT_V(0);
    if constexpr (!ALIGN_EPI) { if (wr == 0) PG8_BAR; }
    PG8_BAR;
    if constexpr (Epi::AFTER_DRAIN) { E.fused(acc, cur, wr, wc, fr, fq, lds, wid, lane); S.done(cur); }
#undef PG8_SA
#undef PG8_SB
#undef PG8_STAGE
#undef PG8_LDA
#undef PG8_LDB
#undef PG8_MMA
#undef PG8_WAIT_V
#undef PG8_WAIT_L
#undef PG8_BAR
#undef PG8_SCHED
}
}

#ifndef PG8_SP2
#define PG8_SP2 true
#endif
#ifndef PG8_ALIGN
#define PG8_ALIGN true
#endif
constexpr int NWAVES = 8;
constexpr int TOK = 32768, NPROMPT = 16384;
constexpr int DMODEL = 1024, DFF = 2816, DIN = 3584;
constexpr int COL_U = 0, COL_V = 512, COL_Q = 1024, COL_I = 1536, COL_FF = 2048, COL_FB = 2560, COL_G = 3072;
constexpr float EPS = 1e-6f;
constexpr size_t MiB = 1u << 20;
constexpr size_t WS_CTL = 0, CTL_ZERO_BYTES = 1 * MiB;
constexpr size_t WS_SSG = 1 * MiB;
constexpr size_t WS_P16 = 2 * MiB;
constexpr size_t WS_WGU1 = 8 * MiB, WS_WD1 = 19 * MiB, WS_WIN = 25 * MiB, WS_WOUT = 32 * MiB, WS_WGU2 = 34 * MiB, WS_WD2 = 45 * MiB;
constexpr size_t WS_BUFA = 52 * MiB;
constexpr size_t WS_BUFB = 116 * MiB;
constexpr size_t WS_BIG = 180 * MiB;
constexpr size_t WS_OB1 = 404 * MiB;
constexpr size_t WS_HGE = 468 * MiB;
constexpr size_t WS_HGD = 500 * MiB;
constexpr size_t WS_END = 501 * MiB;
static_assert(WS_WGU1 + (size_t)2 * DFF * DMODEL * 2 <= WS_WD1 && WS_WD1 + (size_t)DMODEL * DFF * 2 <= WS_WIN && WS_WIN + (size_t)DIN * DMODEL * 2 <= WS_WOUT && WS_WOUT + (size_t)DMODEL * DMODEL * 2 <= WS_WGU2
              && WS_WGU2 + (size_t)2 * DFF * DMODEL * 2 <= WS_WD2 && WS_WD2 + (size_t)DMODEL * DFF * 2 <= WS_BUFA && WS_BUFA + (size_t)TOK * DMODEL * 2 <= WS_BUFB && WS_BUFB + (size_t)TOK * DMODEL * 2 <= WS_BIG
              && WS_BIG + (size_t)TOK * DIN * 2 <= WS_OB1 && WS_OB1 + (size_t)TOK * 512 * 4 <= WS_HGE && WS_HGE + (size_t)512 * 65536 <= WS_HGD && WS_P16 + 3 * 2 * MiB <= WS_WGU1, "d_ws map");
constexpr int CW_BAR = 4096;
constexpr int RING_OFF = 0, RING_BYTES = 131072;
constexpr int LDSCTL_OFF = RING_BYTES, MISC_OFF = LDSCTL_OFF + 320;
constexpr int LDS_BYTES = 147456;
static_assert(MISC_OFF + 128 <= LDS_BYTES, "LDS map");

#define GAS __attribute__((address_space(1)))
#define LAS __attribute__((address_space(3)))
typedef unsigned short bf16;
typedef unsigned v4u __attribute__((ext_vector_type(4)));
typedef float f32x4 __attribute__((ext_vector_type(4)));
typedef short bf16x8 __attribute__((ext_vector_type(8)));
typedef GAS unsigned gu32;
typedef GAS unsigned long long gu64;
#define RLX_AGENT __ATOMIC_RELAXED, __HIP_MEMORY_SCOPE_AGENT
#define LDS_WAIT() asm volatile("s_waitcnt lgkmcnt(0)" ::: "memory")
#define VM_WAIT() asm volatile("s_waitcnt vmcnt(0)" ::: "memory")
__device__ __forceinline__ unsigned long long rt() { return __builtin_amdgcn_s_memrealtime(); }
__device__ __forceinline__ unsigned f2bf(float f) { unsigned u = __builtin_bit_cast(unsigned, f); return (u + 0x7fffu + ((u >> 16) & 1u)) >> 16; }
__device__ __forceinline__ unsigned pk2(float lo, float hi) { return f2bf(lo) | (f2bf(hi) << 16); }

#define XB_TMO      128
#define XB_XCNT(j)  (256  + 64 * (j))
#define XB_XSUB(j)  (1280 + 64 * (j))
#define XB_XGEN(j)  (2304 + 64 * (j))
#define XB_TOP      3328
#define XB_TOPGEN   3392
#define XCD_BAR_WORDS 3456
#define XB_SPIN_CAP (1u << 18)

__device__ __forceinline__ unsigned xb_ld(unsigned* p)              { return __hip_atomic_load(p, __ATOMIC_RELAXED, __HIP_MEMORY_SCOPE_AGENT); }
__device__ __forceinline__ unsigned xb_add(unsigned* p, unsigned v) { return __hip_atomic_fetch_add(p, v, __ATOMIC_RELAXED, __HIP_MEMORY_SCOPE_AGENT); }
__device__ __forceinline__ unsigned xb_xcc_id() { return (unsigned)__builtin_amdgcn_s_getreg((3 << 11) | 20) & 0xFu; }
#define XB_SPIN(cond, bar) do { unsigned _sp = 0; while (cond) { __builtin_amdgcn_s_sleep(1); \
    if ((++_sp & 255u) == 0u) { if (xb_ld(&(bar)[XB_TMO])) break; if (_sp > XB_SPIN_CAP) { atomicAdd(&(bar)[XB_TMO], 1u); break; } } } } while (0)

struct XcdBarrier {
    unsigned* bar; unsigned x;
    volatile LAS unsigned* st;
};

__device__ __forceinline__ XcdBarrier xcd_barrier_post(unsigned* bar, volatile LAS unsigned* st) {
    XcdBarrier b; b.bar = bar; b.x = xb_xcc_id(); b.st = st;
    if (threadIdx.x == 0) st[3] = xb_add(&bar[XB_XCNT(b.x)], 1u);
    return b;
}
__device__ __forceinline__ void xcd_barrier_complete(unsigned* bar, unsigned x, unsigned& nloc, unsigned& nx) {
    const unsigned G = gridDim.x * gridDim.y * gridDim.z;
    unsigned sum, cnt, mine, sp = 0u;
    for (;;) {
        sum = 0u; cnt = 0u; mine = 0u;
#pragma unroll
        for (unsigned j = 0; j < 16; ++j) { const unsigned c = xb_ld(&bar[XB_XCNT(j)]); sum += c; cnt += (c > 0u) ? 1u : 0u; mine = (j == x) ? c : mine; }
        if (sum == G) break;
        __builtin_amdgcn_s_sleep(1);
        if ((++sp & 255u) == 0u) { if (xb_ld(&bar[XB_TMO])) break; if (sp > XB_SPIN_CAP) { atomicAdd(&bar[XB_TMO], 1u); break; } }
    }
    nloc = mine > 0u ? mine : 1u; nx = cnt > 0u ? cnt : 1u;
}
__device__ __forceinline__ unsigned xcd_census_uniform(unsigned* bar) {
    const unsigned G = gridDim.x * gridDim.y * gridDim.z; unsigned ok = (G % 8u == 0u) ? 1u : 0u;
#pragma unroll
    for (unsigned j = 0; j < 16; ++j) { const unsigned c = xb_ld(&bar[XB_XCNT(j)]); if (j < 8u ? (c != G / 8u) : (c != 0u)) ok = 0u; }
    return (xb_ld(&bar[XB_TMO]) == 0u) ? ok : 0u;
}

__device__ __forceinline__ void xcd_barrier(const XcdBarrier& b) {
    asm volatile("s_waitcnt vmcnt(0)" ::: "memory");
    __syncthreads();
    if (threadIdx.x == 0) {
        unsigned* bar = b.bar;
        __builtin_amdgcn_s_waitcnt(0);
        unsigned nloc = b.st[0], nx = b.st[1];
        if (nloc == 0u) { xcd_barrier_complete(bar, b.x, nloc, nx); b.st[0] = nloc; b.st[1] = nx; b.st[2] = xcd_census_uniform(bar); }
        const unsigned old = xb_add(&bar[XB_XSUB(b.x)], 1u);
        const unsigned gen = old / nloc;
        if (old + 1u == (gen + 1u) * nloc) {
            __builtin_amdgcn_fence(__ATOMIC_RELEASE, "agent");
            asm volatile("s_waitcnt vmcnt(0)" ::: "memory");
            const unsigned og = xb_add(&bar[XB_TOP], 1u);
            const unsigned tg = og / nx;
            if (og + 1u == (tg + 1u) * nx) xb_add(&bar[XB_TOPGEN], 1u);
            else XB_SPIN(xb_ld(&bar[XB_TOPGEN]) == tg, bar);
            __builtin_amdgcn_fence(__ATOMIC_ACQUIRE, "agent");
            xb_add(&bar[XB_XGEN(b.x)], 1u);
            asm volatile("s_waitcnt vmcnt(0)" ::: "memory");
        } else {
            XB_SPIN(xb_ld(&bar[XB_XGEN(b.x)]) == gen, bar);
            __builtin_amdgcn_fence(__ATOMIC_ACQUIRE, "agent");
            asm volatile("s_waitcnt vmcnt(0)" ::: "memory");
        }
    }
    __syncthreads();
}
#define XB_LSUB(j)  (3456 + 64 * (j))
#define XB_LGEN(j)  (4480 + 64 * (j))
__device__ __forceinline__ void xcd_local_barrier(const XcdBarrier& b, unsigned seq) {
    asm volatile("s_waitcnt vmcnt(0)" ::: "memory");
    __syncthreads();
    if (threadIdx.x == 0) {
        unsigned* bar = b.bar;
        const unsigned target = seq * b.st[0];
        __hip_atomic_fetch_add(&bar[XB_LSUB(b.x)], 1u, __ATOMIC_RELAXED, __HIP_MEMORY_SCOPE_AGENT);
        asm volatile("buffer_inv sc1" ::: "memory");
        XB_SPIN(xb_ld(&bar[XB_LSUB(b.x)]) < target, bar);
        asm volatile("s_waitcnt vmcnt(0)" ::: "memory");
    }
    __syncthreads();
}

typedef unsigned v2u __attribute__((ext_vector_type(2)));
__device__ __forceinline__ float wave_sum(float v) {
#pragma unroll
    for (int o = 1; o < 64; o <<= 1) v += __shfl_xor(v, o);
    return v;
}
__device__ __forceinline__ float bflo(unsigned w) { return __builtin_bit_cast(float, w << 16); }
__device__ __forceinline__ float bfhi(unsigned w) { return __builtin_bit_cast(float, w & 0xffff0000u); }
__device__ __forceinline__ float bf1(unsigned short h) { return __builtin_bit_cast(float, (unsigned)h << 16); }
__device__ __forceinline__ float ex2(float x) { return __builtin_amdgcn_exp2f(x); }
__device__ __forceinline__ float rsq(float x) { return __builtin_amdgcn_rsqf(x); }

__device__ __forceinline__ void p0_item(const float* W, int Nsrc, int k0, int scol0, const float* gain, bf16* WT, int K, int drow0, LAS float* scr, int lane) {
    const int r8 = lane >> 3, c4 = 4 * (lane & 7);
    f32x4 v[8];
#pragma unroll
    for (int i = 0; i < 8; ++i) v[i] = *(const GAS f32x4*)(W + (size_t)(k0 + 8 * i + r8) * Nsrc + scol0 + c4);
#pragma unroll
    for (int i = 0; i < 8; ++i) { const int kk = 8 * i + r8; f32x4 t = v[i]; if (gain) t = t * gain[k0 + kk];
        scr[kk * 33 + c4] = t[0]; scr[kk * 33 + c4 + 1] = t[1]; scr[kk * 33 + c4 + 2] = t[2]; scr[kk * 33 + c4 + 3] = t[3]; }
    LDS_WAIT(); asm volatile("" ::: "memory");
    const int c = lane & 7;
#pragma unroll
    for (int j = 0; j < 4; ++j) { const int n = (lane >> 3) + 8 * j; const LAS float* s = scr + (8 * c) * 33 + n;
        v4u o; o.x = pk2(s[0 * 33], s[1 * 33]); o.y = pk2(s[2 * 33], s[3 * 33]); o.z = pk2(s[4 * 33], s[5 * 33]); o.w = pk2(s[6 * 33], s[7 * 33]);
        *(GAS v4u*)(WT + (size_t)(drow0 + n) * K + k0 + 8 * c) = o; }
    LDS_WAIT(); asm volatile("" ::: "memory");
}
__device__ __forceinline__ void p0_gu(const float* Wg, const float* Wu, const float* gain, bf16* WT, int r, LAS float* scr, int lane) {
    const int nblk = 2 * DFF / 32, kb = r / nblk, nb = r % nblk, n0 = 32 * nb, pn = n0 >> 8, bj = (n0 >> 7) & 1, j0 = n0 & 127;
    p0_item(bj ? Wu : Wg, DFF, 64 * kb, 128 * pn + j0, gain, WT, DMODEL, n0, scr, lane);
}
__device__ __forceinline__ void p0_plain(const float* W, int K, int N, const float* gain, bf16* WT, int r, LAS float* scr, int lane) {
    const int nblk = N / 32, kb = r / nblk, nb = r % nblk;
    p0_item(W, N, 64 * kb, 32 * nb, gain, WT, K, 32 * nb, scr, lane);
}
__device__ __forceinline__ void p0_prologue(LAS unsigned char* lds, const float* const* in, unsigned char* ws, int gw, int NGW, int wave, int lane) {
    LAS float* scr = (LAS float*)(lds + RING_OFF + wave * 16384);
    constexpr int I_GU = (DMODEL / 64) * (2 * DFF / 32), I_D = (DFF / 64) * (DMODEL / 32), I_IN = (DMODEL / 64) * (DIN / 32), I_OUT = (DMODEL / 64) * (DMODEL / 32);
    constexpr int NITEMS = 2 * I_GU + 2 * I_D + I_IN + I_OUT;
    for (int it = gw; it < NITEMS; it += NGW) {
        int r = it;
        if (r < I_GU) { p0_gu(in[3], in[4], in[2], (bf16*)(ws + WS_WGU1), r, scr, lane); continue; } r -= I_GU;
        if (r < I_GU) { p0_gu(in[18], in[19], in[17], (bf16*)(ws + WS_WGU2), r, scr, lane); continue; } r -= I_GU;
        if (r < I_D) { p0_plain(in[5], DFF, DMODEL, nullptr, (bf16*)(ws + WS_WD1), r, scr, lane); continue; } r -= I_D;
        if (r < I_D) { p0_plain(in[20], DFF, DMODEL, nullptr, (bf16*)(ws + WS_WD2), r, scr, lane); continue; } r -= I_D;
        if (r < I_IN) { p0_plain(in[7], DMODEL, DIN, in[6], (bf16*)(ws + WS_WIN), r, scr, lane); continue; } r -= I_IN;
        p0_plain(in[16], DMODEL, DMODEL, nullptr, (bf16*)(ws + WS_WOUT), r, scr, lane);
    }
    bf16* XB = (bf16*)(ws + WS_BUFA); float* p16 = (float*)(ws + WS_P16);
    for (int m0 = gw; m0 < TOK; m0 += 4 * NGW) {
        f32x4 v[4][4]; float s[4];
#pragma unroll
        for (int q = 0; q < 4; ++q) { const int m = m0 + q * NGW;
            if (m < TOK) { const float* xrow = m < NPROMPT ? in[0] + (size_t)m * DMODEL : in[1] + (size_t)(m - NPROMPT) * DMODEL; const GAS f32x4* xr = (const GAS f32x4*)xrow + lane;
#pragma unroll
                for (int j = 0; j < 4; ++j) v[q][j] = xr[64 * j]; } }
#pragma unroll
        for (int q = 0; q < 4; ++q) { s[q] = 0.f;
#pragma unroll
            for (int j = 0; j < 4; ++j) s[q] += (v[q][j].x * v[q][j].x + v[q][j].y * v[q][j].y) + (v[q][j].z * v[q][j].z + v[q][j].w * v[q][j].w); }
#pragma unroll
        for (int o = 1; o < 64; o <<= 1) {
#pragma unroll
            for (int q = 0; q < 4; ++q) s[q] += __shfl_xor(s[q], o); }
#pragma unroll
        for (int q = 0; q < 4; ++q) { const int m = m0 + q * NGW;
            if (m < TOK) { GAS v2u* o8 = (GAS v2u*)(XB + (size_t)m * DMODEL) + lane;
#pragma unroll
                for (int j = 0; j < 4; ++j) { v2u w; w.x = pk2(v[q][j].x, v[q][j].y); w.y = pk2(v[q][j].z, v[q][j].w); o8[64 * j] = w; }
                if (lane < 16) p16[(size_t)m * 16 + lane] = lane == 0 ? s[q] : 0.f; } }
    }
}

__device__ __forceinline__ void final_norm(const bf16* XBr, float* out, const float* gfin, int rbeg, int rend, int gw, int NGW, int lane) {
    for (int m = rbeg + gw; m < rend; m += NGW) {
        const v4u w0 = *(const GAS v4u*)(XBr + (size_t)m * DMODEL + 8 * lane), w1 = *(const GAS v4u*)(XBr + (size_t)m * DMODEL + 512 + 8 * lane);
        float x[16] = {bflo(w0.x), bfhi(w0.x), bflo(w0.y), bfhi(w0.y), bflo(w0.z), bfhi(w0.z), bflo(w0.w), bfhi(w0.w), bflo(w1.x), bfhi(w1.x), bflo(w1.y), bfhi(w1.y), bflo(w1.z), bfhi(w1.z), bflo(w1.w), bfhi(w1.w)};
        float s = 0.f;
#pragma unroll
        for (int e = 0; e < 16; ++e) s += x[e] * x[e];
        const float r = rsq(wave_sum(s) * (1.0f / DMODEL) + EPS);
#pragma unroll
        for (int j = 0; j < 2; ++j) { const int c = 512 * j + 8 * lane;
            const f32x4 g0 = *(const GAS f32x4*)(gfin + c), g1 = *(const GAS f32x4*)(gfin + c + 4);
            *(GAS f32x4*)(out + (size_t)m * DMODEL + c) = (f32x4){x[8 * j] * r * g0[0], x[8 * j + 1] * r * g0[1], x[8 * j + 2] * r * g0[2], x[8 * j + 3] * r * g0[3]};
            *(GAS f32x4*)(out + (size_t)m * DMODEL + c + 4) = (f32x4){x[8 * j + 4] * r * g1[0], x[8 * j + 5] * r * g1[1], x[8 * j + 6] * r * g1[2], x[8 * j + 7] * r * g1[3]}; }
    }
}

constexpr int HG_RAWLF = 0, HG_RAWQ = 17408, HG_QN = 34816, HG_KN = 52224, HG_KT = 69632, HG_VT = 88064, HG_SCL = 97280, HG_ST = 106496, HG_SEG = 115200, HG_SA = 119296, HG_SB = 119808, HG_END = 120320;
static_assert(HG_END <= RING_BYTES, "hgrn LDS");
__device__ __forceinline__ void hgrn_item(LAS unsigned char* lds, const bf16* P, float* ob, int row0, int L, int h, int dir, int dq, int tid, int lane, int wave) {
    const int fr = lane & 15, fq = lane >> 4, nch = L >> 6;
    const bf16* gq = P + COL_Q + h * 128;
    const bf16* gl = P + (dir ? COL_FB : COL_FF) + h * 128;
    const bf16* gv = P + COL_I + h * 128 + dq * 32;
    float* go = ob + h * 128 + dq * 32;
    const int lr = tid >> 4, lc = tid & 15, lp = (tid >> 2) & 31, vc = tid & 3, cp = lane, s8 = wave;
#define TOKROW(n, l) (row0 + (dir ? (L - 1 - (64 * (n) + (l))) : (64 * (n) + (l))))
#define HG_LOAD(n) do { _Pragma("unroll") for (int i_ = 0; i_ < 2; ++i_) { const size_t ro_ = (size_t)TOKROW(n, lr + 32 * i_) * DIN + 8 * lc; rl[i_] = *(const GAS v4u*)(gl + ro_); rq[i_] = *(const GAS v4u*)(gq + ro_); \
        rv[i_] = *(const GAS v4u*)(gv + (size_t)TOKROW(n, 2 * lp + i_) * DIN + 8 * vc); } } while (0)
    v4u rl[2], rq[2], rv[2];
    HG_LOAD(0);
    f32x4 S0 = {0.f, 0.f, 0.f, 0.f}, S1 = {0.f, 0.f, 0.f, 0.f};
    for (int n = 0; n < nch; ++n) {
        const int vbuf = HG_VT + (n & 1) * 4608;
#pragma unroll
        for (int i = 0; i < 2; ++i) { *(LAS v4u*)(lds + HG_RAWLF + (lr + 32 * i) * 272 + lc * 16) = rl[i]; *(LAS v4u*)(lds + HG_RAWQ + (lr + 32 * i) * 272 + lc * 16) = rq[i]; }
        if (tid < 128) {
#pragma unroll
            for (int e = 0; e < 4; ++e) { const unsigned w0 = rv[0][e], w1 = rv[1][e];
                *(LAS unsigned*)(lds + vbuf + (8 * vc + 2 * e) * 144 + lp * 4) = (w0 & 0xffffu) | (w1 << 16);
                *(LAS unsigned*)(lds + vbuf + (8 * vc + 2 * e + 1) * 144 + lp * 4) = (w0 >> 16) | (w1 & 0xffff0000u); }
        }
        if (n + 1 < nch) HG_LOAD(n + 1);
        __syncthreads();
        float lfa[8], lfb[8], ava[8], avb[8]; float runa = 0.f, runb = 0.f;
#pragma unroll
        for (int j = 0; j < 8; ++j) { const unsigned w = *(const LAS unsigned*)(lds + HG_RAWLF + (8 * s8 + j) * 272 + cp * 4);
            lfa[j] = bflo(w); lfb[j] = bfhi(w); runa += lfa[j]; runb += lfb[j]; ava[j] = runa; avb[j] = runb; }
        *(LAS v2u*)(lds + HG_SEG + (s8 * 128 + 2 * cp) * 4) = (v2u){__builtin_bit_cast(unsigned, runa), __builtin_bit_cast(unsigned, runb)};
        __syncthreads();
        {
            typedef float f32x2v __attribute__((ext_vector_type(2)));
            f32x2v sg_[8];
#pragma unroll
            for (int q = 0; q < 8; ++q) sg_[q] = *(const LAS f32x2v*)(lds + HG_SEG + (q * 128 + 2 * cp) * 4);
            const f32x2v amid2 = (sg_[0] + sg_[1]) + (sg_[2] + sg_[3]);
            const f32x2v atot2 = amid2 + ((sg_[4] + sg_[5]) + (sg_[6] + sg_[7]));
            f32x2v off2 = -amid2;
#pragma unroll
            for (int q = 0; q < 7; ++q) { const float mq = (q < s8) ? 1.0f : 0.0f; off2 = off2 + sg_[q] * mq; }
            const float amida = amid2.x, amidb = amid2.y, atota = atot2.x, atotb = atot2.y;
            const float offa = off2.x, offb = off2.y;
            unsigned kta[4], ktb[4];
#pragma unroll
            for (int j = 0; j < 8; ++j) {
                const float aa = offa + ava[j], ab = offb + avb[j];
                const unsigned qw = *(const LAS unsigned*)(lds + HG_RAWQ + (8 * s8 + j) * 272 + cp * 4);
                const float qta = bflo(qw) * ex2(aa), qtb = bfhi(qw) * ex2(ab);
                const float k_a = (1.0f - ex2(lfa[j])) * ex2(-aa), k_b = (1.0f - ex2(lfb[j])) * ex2(-ab);
                const unsigned kba = f2bf(k_a), kbb = f2bf(k_b);
                *(LAS unsigned*)(lds + HG_QN + (8 * s8 + j) * 272 + cp * 4) = pk2(qta, qtb);
                *(LAS unsigned*)(lds + HG_KN + (8 * s8 + j) * 272 + cp * 4) = kba | (kbb << 16);
                if (j & 1) { kta[j >> 1] |= kba << 16; ktb[j >> 1] |= kbb << 16; } else { kta[j >> 1] = kba; ktb[j >> 1] = kbb; }
            }
            *(LAS v4u*)(lds + HG_KT + (2 * cp) * 144 + s8 * 16) = (v4u){kta[0], kta[1], kta[2], kta[3]};
            *(LAS v4u*)(lds + HG_KT + (2 * cp + 1) * 144 + s8 * 16) = (v4u){ktb[0], ktb[1], ktb[2], ktb[3]};
            if (s8 == 0) { *(LAS v2u*)(lds + HG_SA + (2 * cp) * 4) = (v2u){__builtin_bit_cast(unsigned, ex2(amida)), __builtin_bit_cast(unsigned, ex2(amidb))};
                           *(LAS v2u*)(lds + HG_SB + (2 * cp) * 4) = (v2u){__builtin_bit_cast(unsigned, ex2(atota - amida)), __builtin_bit_cast(unsigned, ex2(atotb - amidb))}; }
        }
        __syncthreads();
        {
            const f32x4 sa = *(const LAS f32x4*)(lds + HG_SA + (16 * wave + 4 * fq) * 4);
            S0 = S0 * sa; S1 = S1 * sa;
#ifdef DBG_NOSTATE
            S0 = (f32x4){0.f,0.f,0.f,0.f}; S1 = S0;
#endif
            v2u w0, w1; w0.x = pk2(S0[0], S0[1]); w0.y = pk2(S0[2], S0[3]); w1.x = pk2(S1[0], S1[1]); w1.y = pk2(S1[2], S1[3]);
            *(LAS v2u*)(lds + HG_ST + fr * 272 + (16 * wave + 4 * fq) * 2) = w0;
            *(LAS v2u*)(lds + HG_ST + (16 + fr) * 272 + (16 * wave + 4 * fq) * 2) = w1;
        }
        {
            const int ib = wave & 3, jp = wave >> 2;
#pragma unroll
            for (int t = 0; t < 2; ++t) {
                const int jb = 2 * jp + t;
                f32x4 sc = {0.f, 0.f, 0.f, 0.f};
                if (jb <= ib) {
#pragma unroll
                    for (int ks = 0; ks < 4; ++ks) {
                        const bf16x8 x = *(const LAS bf16x8*)(lds + HG_KN + (16 * jb + fr) * 272 + ks * 64 + fq * 16);
                        const bf16x8 y = *(const LAS bf16x8*)(lds + HG_QN + (16 * ib + fr) * 272 + ks * 64 + fq * 16);
                        sc = __builtin_amdgcn_mfma_f32_16x16x32_bf16(x, y, sc, 0, 0, 0);
                    }
                    if (jb == ib) {
#pragma unroll
                        for (int r = 0; r < 4; ++r) if (4 * fq + r > fr) sc[r] = 0.f;
                    }
                }
                v2u w; w.x = pk2(sc[0], sc[1]); w.y = pk2(sc[2], sc[3]);
                *(LAS v2u*)(lds + HG_SCL + (16 * ib + fr) * 144 + (16 * jb + 4 * fq) * 2) = w;
            }
        }
        __syncthreads();
        {
            const int ib2 = wave >> 1, db = wave & 1;
            f32x4 O = {0.f, 0.f, 0.f, 0.f};
#pragma unroll
            for (int ks = 0; ks < 2; ++ks) {
                const bf16x8 x = *(const LAS bf16x8*)(lds + vbuf + (16 * db + fr) * 144 + ks * 64 + fq * 16);
                const bf16x8 y = *(const LAS bf16x8*)(lds + HG_SCL + (16 * ib2 + fr) * 144 + ks * 64 + fq * 16);
                O = __builtin_amdgcn_mfma_f32_16x16x32_bf16(x, y, O, 0, 0, 0);
            }
#pragma unroll
            for (int ks = 0; ks < 4; ++ks) {
                const bf16x8 x = *(const LAS bf16x8*)(lds + HG_ST + (16 * db + fr) * 272 + ks * 64 + fq * 16);
                const bf16x8 y = *(const LAS bf16x8*)(lds + HG_QN + (16 * ib2 + fr) * 272 + ks * 64 + fq * 16);
                O = __builtin_amdgcn_mfma_f32_16x16x32_bf16(x, y, O, 0, 0, 0);
            }
#if defined(DBG_HG) && DBG_HG == 1
            { const v2u w = *(const LAS v2u*)(lds + HG_QN + (16 * ib2 + fr) * 272 + (16 * db + 4 * fq) * 2); O = (f32x4){bflo(w.x), bfhi(w.x), bflo(w.y), bfhi(w.y)}; }
#elif defined(DBG_HG) && DBG_HG == 2
            { const v2u w = *(const LAS v2u*)(lds + HG_SCL + (16 * ib2 + fr) * 144 + (16 * db + 4 * fq) * 2); O = (f32x4){bflo(w.x), bfhi(w.x), bflo(w.y), bfhi(w.y)}; }
#elif defined(DBG_HG) && DBG_HG == 3
            { const v2u w = *(const LAS v2u*)(lds + vbuf + (16 * db + fr) * 144 + (16 * (ib2 & 3) + 4 * fq) * 2); O = (f32x4){bflo(w.x), bfhi(w.x), bflo(w.y), bfhi(w.y)}; }
#elif defined(DBG_HG) && DBG_HG == 5
            { const v2u w = *(const GAS v2u*)(gq + (size_t)TOKROW(n, 16 * ib2 + fr) * DIN + 16 * db + 4 * fq); O = (f32x4){bflo(w.x), bfhi(w.x), bflo(w.y), bfhi(w.y)}; }
#elif defined(DBG_HG) && DBG_HG == 9
            { const v2u w = *(const GAS v2u*)(gl + (size_t)TOKROW(n, 16 * ib2 + fr) * DIN + 16 * db + 4 * fq); O = (f32x4){bflo(w.x), bfhi(w.x), bflo(w.y), bfhi(w.y)}; }
#elif defined(DBG_HG) && DBG_HG == 10
            { const v2u w = *(const LAS v2u*)(lds + HG_RAWLF + (16 * ib2 + fr) * 272 + (16 * db + 4 * fq) * 2); O = (f32x4){bflo(w.x), bfhi(w.x), bflo(w.y), bfhi(w.y)}; }
#elif defined(DBG_HG) && DBG_HG == 7
            { const v2u w = *(const GAS v2u*)(P + COL_U + h * 128 + (size_t)TOKROW(n, 16 * ib2 + fr) * DIN + 16 * db + 4 * fq); O = (f32x4){bflo(w.x), bfhi(w.x), bflo(w.y), bfhi(w.y)}; }
#elif defined(DBG_HG) && DBG_HG == 8
            { O = (f32x4){(float)TOKROW(n, 16 * ib2 + fr), (float)(16 * db + 4 * fq), (float)h, (float)dq}; }
#elif defined(DBG_HG) && DBG_HG == 6
            { const v2u w = *(const LAS v2u*)(lds + HG_RAWQ + (16 * ib2 + fr) * 272 + (16 * db + 4 * fq) * 2); O = (f32x4){bflo(w.x), bfhi(w.x), bflo(w.y), bfhi(w.y)}; }
#elif defined(DBG_HG) && DBG_HG == 4
            { const v2u w = *(const LAS v2u*)(lds + HG_KN + (16 * ib2 + fr) * 272 + (16 * db + 4 * fq) * 2); O = (f32x4){bflo(w.x), bfhi(w.x), bflo(w.y), bfhi(w.y)}; }
#endif
            *(GAS f32x4*)(go + (size_t)TOKROW(n, 16 * ib2 + fr) * 512 + 16 * db + 4 * fq) = O;
        }
        {
#pragma unroll
            for (int ks = 0; ks < 2; ++ks) {
                const bf16x8 x = *(const LAS bf16x8*)(lds + HG_KT + (16 * wave + fr) * 144 + ks * 64 + fq * 16);
                const bf16x8 y0 = *(const LAS bf16x8*)(lds + vbuf + fr * 144 + ks * 64 + fq * 16);
                const bf16x8 y1 = *(const LAS bf16x8*)(lds + vbuf + (16 + fr) * 144 + ks * 64 + fq * 16);
                S0 = __builtin_amdgcn_mfma_f32_16x16x32_bf16(x, y0, S0, 0, 0, 0);
                S1 = __builtin_amdgcn_mfma_f32_16x16x32_bf16(x, y1, S1, 0, 0, 0);
            }
            const f32x4 sb = *(const LAS f32x4*)(lds + HG_SB + (16 * wave + 4 * fq) * 4);
            S0 = S0 * sb; S1 = S1 * sb;
        }
        __syncthreads();
    }
#undef HG_LOAD
#undef TOKROW
}

constexpr int H2_RAWLF = 0, H2_RAWQ = 17408, H2_ST = 0, H2_QN = 34816, H2_KN = 52224, H2_KT = 69632, H2_VT = 88064, H2_SCL = 106496, H2_SEG = 115712, H2_SA = 119808, H2_SB = 120320, H2_END = 120832;
static_assert(H2_END <= RING_BYTES, "hgrn v2 LDS");
struct Hg2Inst { int row0, L, h, dir, sc, seqid; };
__device__ __forceinline__ Hg2Inst hg2_decode(int i) {
    Hg2Inst I; const int hd = i & 7, sp = i >> 3; I.h = hd >> 1; I.dir = hd & 1;
    if (sp < 32) { const int b = sp >> 2; I.sc = sp & 3; I.row0 = 2048 * b; I.L = 2048; I.seqid = b; }
    else { const int b = (sp - 32) >> 3; I.sc = (sp - 32) & 7; I.row0 = NPROMPT + 4096 * b; I.L = 4096; I.seqid = 8 + b; }
    return I;
}
__device__ __forceinline__ int hg2_index(int seqid, int h, int dir, int sc) { const int sp = seqid < 8 ? seqid * 4 + sc : 32 + (seqid - 8) * 8 + sc; return sp * 8 + h * 2 + dir; }
__device__ __forceinline__ int hg2_xcc_inst(int x, int k) { const int hd = k & 7, sq = k >> 3; const int seqid = x < 4 ? 2 * x + (sq >> 2) : 8 + (x - 4), sc = x < 4 ? (sq & 3) : sq; return hg2_index(seqid, hd >> 1, hd & 1, sc); }
#define H2_TOKROW(p) (row0 + (dir ? (L - 1 - (p)) : (p)))
typedef float f32x2v __attribute__((ext_vector_type(2)));

__device__ __forceinline__ void hg2_state_pass(LAS unsigned char* lds, const bf16* P, float* Ebuf, float* Dbuf, int inst, int tid, int lane, int wave) {
    const Hg2Inst I = hg2_decode(inst); const int row0 = I.row0, L = I.L, h = I.h, dir = I.dir;
    const int fr = lane & 15, fq = lane >> 4, cp = lane, s8 = wave;
    const bf16* gl = P + (dir ? COL_FB : COL_FF) + h * 128;
    const bf16* gv = P + COL_I + h * 128;
    const int lr = tid >> 4, lc = tid & 15, vc = 4 * (wave & 3) + (lane & 3), lp = 16 * (wave >> 2) + (lane >> 2);
    const int p0 = 512 * I.sc;
#define H2_LOAD1(n) do { _Pragma("unroll") for (int i_ = 0; i_ < 2; ++i_) { rl[i_] = *(const GAS v4u*)(gl + (size_t)H2_TOKROW(p0 + 64 * (n) + lr + 32 * i_) * DIN + 8 * lc); \
        rv[i_] = *(const GAS v4u*)(gv + (size_t)H2_TOKROW(p0 + 64 * (n) + 2 * lp + i_) * DIN + 8 * vc); } } while (0)
    v4u rl[2], rv[2];
    H2_LOAD1(0);
    f32x4 S[8];
#pragma unroll
    for (int t = 0; t < 8; ++t) S[t] = (f32x4){0.f, 0.f, 0.f, 0.f};
    f32x2v dlog = {0.f, 0.f};
    for (int n = 0; n < 8; ++n) {
#pragma unroll
        for (int i = 0; i < 2; ++i) *(LAS v4u*)(lds + H2_RAWLF + (lr + 32 * i) * 272 + lc * 16) = rl[i];
#pragma unroll
        for (int e = 0; e < 4; ++e) { const unsigned w0 = rv[0][e], w1 = rv[1][e];
            *(LAS unsigned*)(lds + H2_VT + (8 * vc + 2 * e) * 144 + lp * 4) = (w0 & 0xffffu) | (w1 << 16);
            *(LAS unsigned*)(lds + H2_VT + (8 * vc + 2 * e + 1) * 144 + lp * 4) = (w0 >> 16) | (w1 & 0xffff0000u); }
        if (n + 1 < 8) H2_LOAD1(n + 1);
        __syncthreads();
        float lfa[8], lfb[8]; f32x2v av[8]; f32x2v run = {0.f, 0.f};
#pragma unroll
        for (int j = 0; j < 8; ++j) { const unsigned w = *(const LAS unsigned*)(lds + H2_RAWLF + (8 * s8 + j) * 272 + cp * 4);
            lfa[j] = bflo(w); lfb[j] = bfhi(w); run = run + (f32x2v){lfa[j], lfb[j]}; av[j] = run; }
        *(LAS f32x2v*)(lds + H2_SEG + (s8 * 128 + 2 * cp) * 4) = run;
        __syncthreads();
        {
            f32x2v sg_[8];
#pragma unroll
            for (int q = 0; q < 8; ++q) sg_[q] = *(const LAS f32x2v*)(lds + H2_SEG + (q * 128 + 2 * cp) * 4);
            const f32x2v amid2 = (sg_[0] + sg_[1]) + (sg_[2] + sg_[3]);
            const f32x2v atot2 = amid2 + ((sg_[4] + sg_[5]) + (sg_[6] + sg_[7]));
            f32x2v off2 = -amid2;
#pragma unroll
            for (int q = 0; q < 7; ++q) { const float mq = (q < s8) ? 1.0f : 0.0f; off2 = off2 + sg_[q] * mq; }
            unsigned kta[4], ktb[4];
#pragma unroll
            for (int j = 0; j < 8; ++j) {
                const f32x2v aa = off2 + av[j];
                const unsigned kba = f2bf((1.0f - ex2(lfa[j])) * ex2(-aa.x)), kbb = f2bf((1.0f - ex2(lfb[j])) * ex2(-aa.y));
                if (j & 1) { kta[j >> 1] |= kba << 16; ktb[j >> 1] |= kbb << 16; } else { kta[j >> 1] = kba; ktb[j >> 1] = kbb; }
            }
            *(LAS v4u*)(lds + H2_KT + (2 * cp) * 144 + s8 * 16) = (v4u){kta[0], kta[1], kta[2], kta[3]};
            *(LAS v4u*)(lds + H2_KT + (2 * cp + 1) * 144 + s8 * 16) = (v4u){ktb[0], ktb[1], ktb[2], ktb[3]};
            if (s8 == 0) { *(LAS f32x2v*)(lds + H2_SA + (2 * cp) * 4) = (f32x2v){ex2(amid2.x), ex2(amid2.y)};
                           *(LAS f32x2v*)(lds + H2_SB + (2 * cp) * 4) = (f32x2v){ex2(atot2.x - amid2.x), ex2(atot2.y - amid2.y)}; dlog = dlog + atot2; }
        }
        __syncthreads();
        {
            const f32x4 sa = *(const LAS f32x4*)(lds + H2_SA + (16 * wave + 4 * fq) * 4), sb = *(const LAS f32x4*)(lds + H2_SB + (16 * wave + 4 * fq) * 4);
            bf16x8 x[2];
#pragma unroll
            for (int ks = 0; ks < 2; ++ks) x[ks] = *(const LAS bf16x8*)(lds + H2_KT + (16 * wave + fr) * 144 + ks * 64 + fq * 16);
#pragma unroll
            for (int t = 0; t < 8; ++t) S[t] = S[t] * sa;
#pragma unroll
            for (int ks = 0; ks < 2; ++ks) { bf16x8 y[8];
#pragma unroll
                for (int t = 0; t < 8; ++t) y[t] = *(const LAS bf16x8*)(lds + H2_VT + (16 * t + fr) * 144 + ks * 64 + fq * 16);
#pragma unroll
                for (int t = 0; t < 8; ++t) S[t] = __builtin_amdgcn_mfma_f32_16x16x32_bf16(x[ks], y[t], S[t], 0, 0, 0); }
#pragma unroll
            for (int t = 0; t < 8; ++t) S[t] = S[t] * sb;
        }
        __syncthreads();
    }
    float* E = Ebuf + (size_t)inst * 16384;
#pragma unroll
    for (int t = 0; t < 8; ++t) *(GAS f32x4*)(E + ((wave * 8 + t) * 64 + lane) * 4) = S[t];
    if (s8 == 0) *(GAS f32x2v*)(Dbuf + (size_t)inst * 128 + 2 * cp) = dlog;
#undef H2_LOAD1
}

__device__ __forceinline__ void hg2_out_pass(LAS unsigned char* lds, const bf16* P, bf16* ob, const float* Ebuf, const float* Dbuf, int inst, int tid, int lane, int wave) {
    const Hg2Inst I = hg2_decode(inst); const int row0 = I.row0, L = I.L, h = I.h, dir = I.dir;
    const int fr = lane & 15, fq = lane >> 4, cp = lane, s8 = wave;
    const bf16* gq = P + COL_Q + h * 128;
    const bf16* gl = P + (dir ? COL_FB : COL_FF) + h * 128;
    const bf16* gv = P + COL_I + h * 128;
    bf16* go = ob + h * 128;
    const int lr = tid >> 4, lc = tid & 15, vc = 4 * (wave & 3) + (lane & 3), lp = 16 * (wave >> 2) + (lane >> 2);
    const int p0 = 512 * I.sc;
#define H2_LOAD2(n) do { _Pragma("unroll") for (int i_ = 0; i_ < 2; ++i_) { const size_t ro_ = (size_t)H2_TOKROW(p0 + 64 * (n) + lr + 32 * i_) * DIN + 8 * lc; rl[i_] = *(const GAS v4u*)(gl + ro_); rq[i_] = *(const GAS v4u*)(gq + ro_); \
        rv[i_] = *(const GAS v4u*)(gv + (size_t)H2_TOKROW(p0 + 64 * (n) + 2 * lp + i_) * DIN + 8 * vc); } } while (0)
    v4u rl[2], rq[2], rv[2];
    H2_LOAD2(0);
    f32x4 S[8];
#pragma unroll
    for (int t = 0; t < 8; ++t) S[t] = (f32x4){0.f, 0.f, 0.f, 0.f};
    if (I.sc > 0) {
        f32x4 ec[8], en[8], dc, dn;
        { const int ij = hg2_index(I.seqid, h, dir, 0); dc = *(const GAS f32x4*)(Dbuf + (size_t)ij * 128 + 16 * wave + 4 * fq); const float* E = Ebuf + (size_t)ij * 16384;
#pragma unroll
          for (int t = 0; t < 8; ++t) ec[t] = *(const GAS f32x4*)(E + ((wave * 8 + t) * 64 + lane) * 4); }
        for (int j = 0; j < I.sc; ++j) {
            if (j + 1 < I.sc) { const int ij = hg2_index(I.seqid, h, dir, j + 1); dn = *(const GAS f32x4*)(Dbuf + (size_t)ij * 128 + 16 * wave + 4 * fq); const float* E = Ebuf + (size_t)ij * 16384;
#pragma unroll
                for (int t = 0; t < 8; ++t) en[t] = *(const GAS f32x4*)(E + ((wave * 8 + t) * 64 + lane) * 4); }
            const f32x4 dec = {ex2(dc[0]), ex2(dc[1]), ex2(dc[2]), ex2(dc[3])};
#pragma unroll
            for (int t = 0; t < 8; ++t) { S[t] = S[t] * dec + ec[t]; ec[t] = en[t]; }
            dc = dn;
        }
    }
    for (int n = 0; n < 8; ++n) {
#pragma unroll
        for (int i = 0; i < 2; ++i) { *(LAS v4u*)(lds + H2_RAWLF + (lr + 32 * i) * 272 + lc * 16) = rl[i]; *(LAS v4u*)(lds + H2_RAWQ + (lr + 32 * i) * 272 + lc * 16) = rq[i]; }
#pragma unroll
        for (int e = 0; e < 4; ++e) { const unsigned w0 = rv[0][e], w1 = rv[1][e];
            *(LAS unsigned*)(lds + H2_VT + (8 * vc + 2 * e) * 144 + lp * 4) = (w0 & 0xffffu) | (w1 << 16);
            *(LAS unsigned*)(lds + H2_VT + (8 * vc + 2 * e + 1) * 144 + lp * 4) = (w0 >> 16) | (w1 & 0xffff0000u); }
        if (n + 1 < 8) H2_LOAD2(n + 1);
        __syncthreads();
        float lfa[8], lfb[8]; f32x2v av[8]; f32x2v run = {0.f, 0.f};
#pragma unroll
        for (int j = 0; j < 8; ++j) { const unsigned w = *(const LAS unsigned*)(lds + H2_RAWLF + (8 * s8 + j) * 272 + cp * 4);
            lfa[j] = bflo(w); lfb[j] = bfhi(w); run = run + (f32x2v){lfa[j], lfb[j]}; av[j] = run; }
        *(LAS f32x2v*)(lds + H2_SEG + (s8 * 128 + 2 * cp) * 4) = run;
        __syncthreads();
        {
            f32x2v sg_[8];
#pragma unroll
            for (int q = 0; q < 8; ++q) sg_[q] = *(const LAS f32x2v*)(lds + H2_SEG + (q * 128 + 2 * cp) * 4);
            const f32x2v amid2 = (sg_[0] + sg_[1]) + (sg_[2] + sg_[3]);
            const f32x2v atot2 = amid2 + ((sg_[4] + sg_[5]) + (sg_[6] + sg_[7]));
            f32x2v off2 = -amid2;
#pragma unroll
            for (int q = 0; q < 7; ++q) { const float mq = (q < s8) ? 1.0f : 0.0f; off2 = off2 + sg_[q] * mq; }
            unsigned kta[4], ktb[4];
#pragma unroll
            for (int j = 0; j < 8; ++j) {
                const f32x2v aa = off2 + av[j];
                const unsigned qw = *(const LAS unsigned*)(lds + H2_RAWQ + (8 * s8 + j) * 272 + cp * 4);
                const float qta = bflo(qw) * ex2(aa.x), qtb = bfhi(qw) * ex2(aa.y);
                const unsigned kba = f2bf((1.0f - ex2(lfa[j])) * ex2(-aa.x)), kbb = f2bf((1.0f - ex2(lfb[j])) * ex2(-aa.y));
                *(LAS unsigned*)(lds + H2_QN + (8 * s8 + j) * 272 + cp * 4) = pk2(qta, qtb);
                *(LAS unsigned*)(lds + H2_KN + (8 * s8 + j) * 272 + cp * 4) = kba | (kbb << 16);
                if (j & 1) { kta[j >> 1] |= kba << 16; ktb[j >> 1] |= kbb << 16; } else { kta[j >> 1] = kba; ktb[j >> 1] = kbb; }
            }
            *(LAS v4u*)(lds + H2_KT + (2 * cp) * 144 + s8 * 16) = (v4u){kta[0], kta[1], kta[2], kta[3]};
            *(LAS v4u*)(lds + H2_KT + (2 * cp + 1) * 144 + s8 * 16) = (v4u){ktb[0], ktb[1], ktb[2], ktb[3]};
            if (s8 == 0) { *(LAS f32x2v*)(lds + H2_SA + (2 * cp) * 4) = (f32x2v){ex2(amid2.x), ex2(amid2.y)};
                           *(LAS f32x2v*)(lds + H2_SB + (2 * cp) * 4) = (f32x2v){ex2(atot2.x - amid2.x), ex2(atot2.y - amid2.y)}; }
        }
        __syncthreads();
        {
            const f32x4 sa = *(const LAS f32x4*)(lds + H2_SA + (16 * wave + 4 * fq) * 4);
#pragma unroll
            for (int t = 0; t < 8; ++t) { S[t] = S[t] * sa; v2u w; w.x = pk2(S[t][0], S[t][1]); w.y = pk2(S[t][2], S[t][3]);
                *(LAS v2u*)(lds + H2_ST + (16 * t + fr) * 272 + (16 * wave + 4 * fq) * 2) = w; }
        }
        {
            const int ib = wave & 3, jp = wave >> 2;
#pragma unroll
            for (int t = 0; t < 2; ++t) {
                const int jb = 2 * jp + t;
                f32x4 sc = {0.f, 0.f, 0.f, 0.f};
                if (jb <= ib) {
#pragma unroll
                    for (int ks = 0; ks < 4; ++ks) {
                        const bf16x8 x = *(const LAS bf16x8*)(lds + H2_KN + (16 * jb + fr) * 272 + ks * 64 + fq * 16);
                        const bf16x8 y = *(const LAS bf16x8*)(lds + H2_QN + (16 * ib + fr) * 272 + ks * 64 + fq * 16);
                        sc = __builtin_amdgcn_mfma_f32_16x16x32_bf16(x, y, sc, 0, 0, 0);
                    }
                    if (jb == ib) {
#pragma unroll
                        for (int r = 0; r < 4; ++r) if (4 * fq + r > fr) sc[r] = 0.f;
                    }
                }
                v2u w; w.x = pk2(sc[0], sc[1]); w.y = pk2(sc[2], sc[3]);
                *(LAS v2u*)(lds + H2_SCL + (16 * ib + fr) * 144 + (16 * jb + 4 * fq) * 2) = w;
            }
        }
        __syncthreads();
        {
            const int ib2 = wave >> 1, dh = wave & 1;
            bf16x8 ys[2], yq[4];
#pragma unroll
            for (int ks = 0; ks < 2; ++ks) ys[ks] = *(const LAS bf16x8*)(lds + H2_SCL + (16 * ib2 + fr) * 144 + ks * 64 + fq * 16);
#pragma unroll
            for (int ks = 0; ks < 4; ++ks) yq[ks] = *(const LAS bf16x8*)(lds + H2_QN + (16 * ib2 + fr) * 272 + ks * 64 + fq * 16);
            const size_t orow = (size_t)H2_TOKROW(p0 + 64 * n + 16 * ib2 + fr) * 512;
            f32x4 O[4];
#pragma unroll
            for (int t = 0; t < 4; ++t) O[t] = (f32x4){0.f, 0.f, 0.f, 0.f};
#pragma unroll
            for (int ks = 0; ks < 2; ++ks) { bf16x8 x[4];
#pragma unroll
                for (int t = 0; t < 4; ++t) x[t] = *(const LAS bf16x8*)(lds + H2_VT + (16 * (4 * dh + t) + fr) * 144 + ks * 64 + fq * 16);
#pragma unroll
                for (int t = 0; t < 4; ++t) O[t] = __builtin_amdgcn_mfma_f32_16x16x32_bf16(x[t], ys[ks], O[t], 0, 0, 0); }
#pragma unroll
            for (int ks = 0; ks < 4; ++ks) { bf16x8 x[4];
#pragma unroll
                for (int t = 0; t < 4; ++t) x[t] = *(const LAS bf16x8*)(lds + H2_ST + (16 * (4 * dh + t) + fr) * 272 + ks * 64 + fq * 16);
#pragma unroll
                for (int t = 0; t < 4; ++t) O[t] = __builtin_amdgcn_mfma_f32_16x16x32_bf16(x[t], yq[ks], O[t], 0, 0, 0); }
#pragma unroll
            for (int t = 0; t < 4; ++t) { v2u w; w.x = pk2(O[t][0], O[t][1]); w.y = pk2(O[t][2], O[t][3]); *(GAS v2u*)(go + orow + 16 * (4 * dh + t) + 4 * fq) = w; }
        }
        {
            const f32x4 sb = *(const LAS f32x4*)(lds + H2_SB + (16 * wave + 4 * fq) * 4);
            bf16x8 x[2];
#pragma unroll
            for (int ks = 0; ks < 2; ++ks) x[ks] = *(const LAS bf16x8*)(lds + H2_KT + (16 * wave + fr) * 144 + ks * 64 + fq * 16);
#pragma unroll
            for (int ks = 0; ks < 2; ++ks) { bf16x8 y[8];
#pragma unroll
                for (int t = 0; t < 8; ++t) y[t] = *(const LAS bf16x8*)(lds + H2_VT + (16 * t + fr) * 144 + ks * 64 + fq * 16);
#pragma unroll
                for (int t = 0; t < 8; ++t) S[t] = __builtin_amdgcn_mfma_f32_16x16x32_bf16(x[ks], y[t], S[t], 0, 0, 0); }
#pragma unroll
            for (int t = 0; t < 8; ++t) S[t] = S[t] * sb;
        }
        __syncthreads();
    }
#undef H2_LOAD2
}

#ifdef DBG_NAIVE_HGRN
__device__ __forceinline__ void naive_hgrn_item(LAS unsigned char* lds, const bf16* P, float* ob, int row0, int L, int h, int dir, int tid) {
    LAS float* LQ = (LAS float*)lds; LAS float* LF = LQ + 2048; LAS float* LK = LF + 2048;
    const unsigned short* Pu = (const unsigned short*)P;
    float S[128];
#pragma unroll
    for (int k = 0; k < 128; ++k) S[k] = 0.f;
    for (int t0 = 0; t0 < L; t0 += 16) {
        __syncthreads();
#pragma unroll
        for (int i = 0; i < 4; ++i) { const int idx = tid + 512 * i, st = idx >> 7, k = idx & 127; const size_t row = (size_t)(row0 + (dir ? (L - 1 - (t0 + st)) : (t0 + st)));
            const float qv = bf1(Pu[row * DIN + COL_Q + h * 128 + k]), l2 = bf1(Pu[row * DIN + (dir ? COL_FB : COL_FF) + h * 128 + k]), f = exp2f(l2);
            LQ[st * 128 + k] = qv; LF[st * 128 + k] = f; LK[st * 128 + k] = 1.0f - f; }
        __syncthreads();
        if (tid < 128) {
#pragma unroll 1
            for (int st = 0; st < 16; ++st) { const size_t row = (size_t)(row0 + (dir ? (L - 1 - (t0 + st)) : (t0 + st)));
                const float v = bf1(Pu[row * DIN + COL_I + h * 128 + tid]); float o = 0.f;
#pragma unroll
                for (int k4 = 0; k4 < 32; ++k4) { const f32x4 f4 = *(const LAS f32x4*)(LF + st * 128 + 4 * k4), k4v = *(const LAS f32x4*)(LK + st * 128 + 4 * k4), q4 = *(const LAS f32x4*)(LQ + st * 128 + 4 * k4);
#pragma unroll
                    for (int e = 0; e < 4; ++e) { S[4 * k4 + e] = f4[e] * S[4 * k4 + e] + k4v[e] * v; o += q4[e] * S[4 * k4 + e]; } }
                ob[row * 512 + h * 128 + tid] = o; }
        }
    }
    __syncthreads();
}
#endif
__device__ __forceinline__ void hgrn_combine(const bf16* ob0, const bf16* ob1, const bf16* P, const float* onorm, const float* ssg, const float* gon, bf16* Y, int rbeg, int rend, int gw, int NGW, int lane) {
    const int c = 8 * lane;
    const f32x4 g0 = *(const GAS f32x4*)(onorm + c), g1 = *(const GAS f32x4*)(onorm + c + 4);
    const f32x4 n0 = *(const GAS f32x4*)(gon + c), n1 = *(const GAS f32x4*)(gon + c + 4);
    for (int m = rbeg + gw; m < rend; m += NGW) {
        const v4u aw = *(const GAS v4u*)(ob0 + (size_t)m * 512 + c), bw = *(const GAS v4u*)(ob1 + (size_t)m * 512 + c);
        const f32x4 a0 = {bflo(aw.x), bfhi(aw.x), bflo(aw.y), bfhi(aw.y)}, a1 = {bflo(aw.z), bfhi(aw.z), bflo(aw.w), bfhi(aw.w)};
        const f32x4 b0 = {bflo(bw.x), bfhi(bw.x), bflo(bw.y), bfhi(bw.y)}, b1 = {bflo(bw.z), bfhi(bw.z), bflo(bw.w), bfhi(bw.w)};
        const v4u sgw = *(const GAS v4u*)(P + (size_t)m * DIN + COL_G + c);
#ifdef DBG_PCOPY
        f32x4 o0 = {0.f,0.f,0.f,0.f}, o1 = o0;
        { const int segs[4] = {COL_Q, COL_I, COL_FF, COL_FB};
#pragma unroll
          for (int q_ = 0; q_ < 4; ++q_) { const v4u pw = *(const GAS v4u*)(P + (size_t)m * DIN + segs[q_] + c);
            o0 += (f32x4){bflo(pw.x), bfhi(pw.x), bflo(pw.y), bfhi(pw.y)}; o1 += (f32x4){bflo(pw.z), bfhi(pw.z), bflo(pw.w), bfhi(pw.w)}; } }
#else
        const f32x4 o0 = a0 + b0, o1 = a1 + b1;
#endif
        float s = ((o0[0] * o0[0] + o0[1] * o0[1]) + (o0[2] * o0[2] + o0[3] * o0[3])) + ((o1[0] * o1[0] + o1[1] * o1[1]) + (o1[2] * o1[2] + o1[3] * o1[3]));
        s += __shfl_xor(s, 1); s += __shfl_xor(s, 2); s += __shfl_xor(s, 4); s += __shfl_xor(s, 8);
        const float r = rsq(s * (1.0f / 128.0f) + EPS);
        const f32x4 y0 = o0 * r * g0 * (f32x4){bflo(sgw.x), bfhi(sgw.x), bflo(sgw.y), bfhi(sgw.y)};
        const f32x4 y1 = o1 * r * g1 * (f32x4){bflo(sgw.z), bfhi(sgw.z), bflo(sgw.w), bfhi(sgw.w)};
        v4u w; w.x = pk2(y0[0], y0[1]); w.y = pk2(y0[2], y0[3]); w.z = pk2(y1[0], y1[1]); w.w = pk2(y1[2], y1[3]);
        *(GAS v4u*)(Y + (size_t)m * DMODEL + 512 + c) = w;
#ifndef NO_GMLP
        const f32x4 sv = *(const GAS f32x4*)(ssg + (size_t)m * 4);
        const float rg = rsq(((sv[0] + sv[1]) + (sv[2] + sv[3])) * (1.0f / 512.0f) + EPS);
        const v4u yw = *(const GAS v4u*)(Y + (size_t)m * DMODEL + c);
        const f32x4 z0 = (f32x4){bflo(yw.x), bfhi(yw.x), bflo(yw.y), bfhi(yw.y)} * rg * n0, z1 = (f32x4){bflo(yw.z), bfhi(yw.z), bflo(yw.w), bfhi(yw.w)} * rg * n1;
        v4u zw; zw.x = pk2(z0[0], z0[1]); zw.y = pk2(z0[2], z0[3]); zw.z = pk2(z1[0], z1[1]); zw.w = pk2(z1[2], z1[3]);
        *(GAS v4u*)(Y + (size_t)m * DMODEL + c) = zw;
#endif
    }
}

__device__ __forceinline__ void hgrn_combine_local(const bf16* ob0, const bf16* ob1, const bf16* P, const float* onorm, bf16* Y, int rbase, int h, int tid) {
    const int l16 = tid & 15, tg = tid >> 4;
    const int c = h * 128 + 8 * l16;
    const f32x4 g0 = *(const GAS f32x4*)(onorm + c), g1 = *(const GAS f32x4*)(onorm + c + 4);
#pragma unroll 1
    for (int t0 = 0; t0 < 512; t0 += 128) {
        v4u aw[4], bw[4], sw[4];
#pragma unroll
        for (int q = 0; q < 4; ++q) { const size_t m = (size_t)(rbase + t0 + 32 * q + tg);
            aw[q] = *(const GAS v4u*)(ob0 + m * 512 + c); bw[q] = *(const GAS v4u*)(ob1 + m * 512 + c); sw[q] = *(const GAS v4u*)(P + m * DIN + COL_G + c); }
#pragma unroll
        for (int q = 0; q < 4; ++q) { const size_t m = (size_t)(rbase + t0 + 32 * q + tg);
            const f32x4 o0 = (f32x4){bflo(aw[q].x), bfhi(aw[q].x), bflo(aw[q].y), bfhi(aw[q].y)} + (f32x4){bflo(bw[q].x), bfhi(bw[q].x), bflo(bw[q].y), bfhi(bw[q].y)};
            const f32x4 o1 = (f32x4){bflo(aw[q].z), bfhi(aw[q].z), bflo(aw[q].w), bfhi(aw[q].w)} + (f32x4){bflo(bw[q].z), bfhi(bw[q].z), bflo(bw[q].w), bfhi(bw[q].w)};
            float sq = ((o0[0] * o0[0] + o0[1] * o0[1]) + (o0[2] * o0[2] + o0[3] * o0[3])) + ((o1[0] * o1[0] + o1[1] * o1[1]) + (o1[2] * o1[2] + o1[3] * o1[3]));
            sq += __shfl_xor(sq, 1); sq += __shfl_xor(sq, 2); sq += __shfl_xor(sq, 4); sq += __shfl_xor(sq, 8);
            const float r = rsq(sq * (1.0f / 128.0f) + EPS);
            const f32x4 y0 = o0 * r * g0 * (f32x4){bflo(sw[q].x), bfhi(sw[q].x), bflo(sw[q].y), bfhi(sw[q].y)};
            const f32x4 y1 = o1 * r * g1 * (f32x4){bflo(sw[q].z), bfhi(sw[q].z), bflo(sw[q].w), bfhi(sw[q].w)};
            v4u w; w.x = pk2(y0[0], y0[1]); w.y = pk2(y0[2], y0[3]); w.z = pk2(y1[0], y1[1]); w.w = pk2(y1[2], y1[3]);
            *(GAS v4u*)(Y + m * DMODEL + 512 + c) = w; }
    }
}
__device__ __forceinline__ void yg_fixup(const float* ssg, const float* gon, bf16* Y, int rbeg, int rend, int gw, int NGW, int lane) {
    const int c = 8 * lane;
    const f32x4 n0 = *(const GAS f32x4*)(gon + c), n1 = *(const GAS f32x4*)(gon + c + 4);
    for (int m0 = rbeg + gw; m0 < rend; m0 += 4 * NGW) {
        f32x4 sv[4]; v4u yw[4];
#pragma unroll
        for (int q = 0; q < 4; ++q) { const int m = m0 + q * NGW; if (m < rend) { sv[q] = *(const GAS f32x4*)(ssg + (size_t)m * 4); yw[q] = *(const GAS v4u*)(Y + (size_t)m * DMODEL + c); } }
#pragma unroll
        for (int q = 0; q < 4; ++q) { const int m = m0 + q * NGW; if (m < rend) {
            const float rg = rsq(((sv[q][0] + sv[q][1]) + (sv[q][2] + sv[q][3])) * (1.0f / 512.0f) + EPS);
            const f32x4 z0 = (f32x4){bflo(yw[q].x), bfhi(yw[q].x), bflo(yw[q].y), bfhi(yw[q].y)} * rg * n0, z1 = (f32x4){bflo(yw[q].z), bfhi(yw[q].z), bflo(yw[q].w), bfhi(yw[q].w)} * rg * n1;
            v4u zw; zw.x = pk2(z0[0], z0[1]); zw.y = pk2(z0[2], z0[3]); zw.z = pk2(z1[0], z1[1]); zw.w = pk2(z1[2], z1[3]);
            *(GAS v4u*)(Y + (size_t)m * DMODEL + c) = zw; } }
    }
}
constexpr int GM_RAWV = 0, GM_VLT = 34816, GM_WL = 69632, GM_MEAN = 104448, GM_RSTD = 104960, GM_END = 105472;
static_assert(GM_END <= RING_BYTES, "gmlp LDS");
__device__ __forceinline__ void gmlp_item(LAS unsigned char* lds, const bf16* P, bf16* Y, float* ssg, const float* ln_g, const float* ln_b, const float* w_s, const float* b_s, int c, int h, int tid, int lane, int wave) {
    const int fr = lane & 15, fq = lane >> 4, R0 = 128 * c;
#pragma unroll 1
    for (int jj = 0; jj < 4; ++jj) {
        float sm[4], sq[4];
#pragma unroll
        for (int j = 0; j < 4; ++j) {
            const int s = 16 * wave + 4 * jj + j;
            const v4u raw = *(const GAS v4u*)(P + (size_t)(R0 + s) * DIN + COL_V + 8 * lane);
            const float x0 = bflo(raw.x), x1 = bfhi(raw.x), x2 = bflo(raw.y), x3 = bfhi(raw.y), x4 = bflo(raw.z), x5 = bfhi(raw.z), x6 = bflo(raw.w), x7 = bfhi(raw.w);
            sm[j] = ((x0 + x1) + (x2 + x3)) + ((x4 + x5) + (x6 + x7));
            sq[j] = ((x0 * x0 + x1 * x1) + (x2 * x2 + x3 * x3)) + ((x4 * x4 + x5 * x5) + (x6 * x6 + x7 * x7));
        }
#pragma unroll
        for (int o = 1; o < 64; o <<= 1) {
#pragma unroll
            for (int j = 0; j < 4; ++j) { sm[j] += __shfl_xor(sm[j], o); sq[j] += __shfl_xor(sq[j], o); }
        }
        if (lane == 0) {
#pragma unroll
            for (int j = 0; j < 4; ++j) { const int s = 16 * wave + 4 * jj + j; const float mean = sm[j] * (1.0f / 512.0f), var = fmaxf(sq[j] * (1.0f / 512.0f) - mean * mean, 0.f);
                *(LAS float*)(lds + GM_MEAN + s * 4) = mean; *(LAS float*)(lds + GM_RSTD + s * 4) = rsq(var + EPS); }
        }
    }
#pragma unroll
    for (int i = 0; i < 4; ++i) { const int idx = tid + 512 * i, row = idx >> 4, c16 = idx & 15;
        *(LAS v4u*)(lds + GM_RAWV + row * 272 + c16 * 16) = *(const GAS v4u*)(P + (size_t)(R0 + row) * DIN + COL_V + 128 * h + 8 * c16); }
#pragma unroll
    for (int i = 0; i < 8; ++i) { const int idx = tid + 512 * i, tt = idx >> 5, s4 = idx & 31;
        const f32x4 w = *(const GAS f32x4*)(w_s + (size_t)h * 16384 + tt * 128 + 4 * s4);
        v2u o; o.x = pk2(w[0], w[1]); o.y = pk2(w[2], w[3]);
        *(LAS v2u*)(lds + GM_WL + tt * 272 + s4 * 8) = o; }
    __syncthreads();
    {
        const int ch = tid & 127, sq4 = tid >> 7;
        const float g = ln_g[128 * h + ch], b = ln_b[128 * h + ch];
#pragma unroll
        for (int i = 0; i < 4; ++i) {
            unsigned wv[4];
#pragma unroll
            for (int e = 0; e < 8; ++e) { const int s = 32 * sq4 + 8 * i + e;
                const float x = bf1(*(const LAS unsigned short*)(lds + GM_RAWV + s * 272 + ch * 2));
                const float y = (x - *(const LAS float*)(lds + GM_MEAN + s * 4)) * *(const LAS float*)(lds + GM_RSTD + s * 4) * g + b;
                const unsigned yb = f2bf(y);
                if (e & 1) wv[e >> 1] |= yb << 16; else wv[e >> 1] = yb; }
            *(LAS v4u*)(lds + GM_VLT + ch * 272 + (32 * sq4 + 8 * i) * 2) = (v4u){wv[0], wv[1], wv[2], wv[3]};
        }
    }
    __syncthreads();
    const int t = 16 * wave + fr;
    bf16x8 yf[4];
#pragma unroll
    for (int ks = 0; ks < 4; ++ks) yf[ks] = *(const LAS bf16x8*)(lds + GM_WL + (16 * wave + fr) * 272 + ks * 64 + fq * 16);
    const float bs = b_s[h * 128 + t];
    float ss = 0.f;
#pragma unroll
    for (int cb = 0; cb < 8; ++cb) {
        f32x4 a = {0.f, 0.f, 0.f, 0.f};
#pragma unroll
        for (int ks = 0; ks < 4; ++ks) {
            const bf16x8 x = *(const LAS bf16x8*)(lds + GM_VLT + (16 * cb + fr) * 272 + ks * 64 + fq * 16);
            a = __builtin_amdgcn_mfma_f32_16x16x32_bf16(x, yf[ks], a, 0, 0, 0);
        }
        const int ch = 128 * h + 16 * cb + 4 * fq;
        const v2u uw = *(const GAS v2u*)(P + (size_t)(R0 + t) * DIN + COL_U + ch);
        const f32x4 uu = {bflo(uw.x), bfhi(uw.x), bflo(uw.y), bfhi(uw.y)};
        a = (a + bs) * uu;
        ss += (a[0] * a[0] + a[1] * a[1]) + (a[2] * a[2] + a[3] * a[3]);
        v2u w; w.x = pk2(a[0], a[1]); w.y = pk2(a[2], a[3]);
        *(GAS v2u*)(Y + (size_t)(R0 + t) * DMODEL + ch) = w;
    }
    ss += __shfl_xor(ss, 16); ss += __shfl_xor(ss, 32);
    if (fq == 0) ssg[(size_t)(R0 + t) * 4 + h] = ss;
    __syncthreads();
}

struct Args { const float* in[22]; float* out; unsigned char* ws; int ph_lo, ph_hi, li, pad; };
constexpr int N_PHASES = 11;
#ifndef MK_N_LAUNCHES
#define MK_N_LAUNCHES 1
#endif
#ifndef DUP_PHASE
#define DUP_PHASE (-1)
#endif
__global__ void __launch_bounds__(NWAVES * 64, 2) fwd_kernel(Args args) {
    extern __shared__ __attribute__((aligned(16))) unsigned char lds_raw[];
    LAS unsigned char* lds = (LAS unsigned char*)lds_raw;
    volatile LAS unsigned* MISC = (volatile LAS unsigned*)(lds + MISC_OFF);
    const int tid = threadIdx.x, lane = tid & 63, wave = __builtin_amdgcn_readfirstlane(tid >> 6);
    const int G = gridDim.x, bx = blockIdx.x;
    const int vcu = (G % 8 == 0) ? (bx % 8) * (G / 8) + bx / 8 : bx;
    const int gw = vcu * NWAVES + wave, NGW = G * NWAVES;
    unsigned char* ws = args.ws;
    gu32* ctl = (gu32*)(ws + WS_CTL);
    for (int u = tid; u < (LDS_BYTES - LDSCTL_OFF) / 4; u += NWAVES * 64) ((LAS unsigned*)(lds + LDSCTL_OFF))[u] = 0u;
    __syncthreads();
    XcdBarrier bar = xcd_barrier_post((unsigned*)(ctl + CW_BAR) + args.li * XCD_BAR_WORDS, MISC + 8);
    const int lo = args.ph_lo, hi = args.ph_hi;
#define IN(k) (lo <= (k) && (k) < hi)
    int uni = 0, cid = bx, xr = 0, xx = 0; unsigned lseq = 0;
#define SEAM(k) do { if (IN(k) && IN((k) + 1)) { if (uni) xcd_local_barrier(bar, ++lseq); else xcd_barrier(bar); } } while (0)
    bf16* XB = (bf16*)(ws + WS_BUFA); bf16* Y = (bf16*)(ws + WS_BUFB); bf16* BIG = (bf16*)(ws + WS_BIG);
    bf16* OB0 = (bf16*)args.out; bf16* OB1 = (bf16*)args.out + (size_t)TOK * 512;
    float* SSG = (float*)(ws + WS_SSG); float* HGE = (float*)(ws + WS_HGE); float* HGD = (float*)(ws + WS_HGD);
    float* P16_0 = (float*)(ws + WS_P16); float* P16_1 = (float*)(ws + WS_P16 + 2 * MiB); float* P16_2 = (float*)(ws + WS_P16 + 4 * MiB);

    for (int rep_ = 0; rep_ < ((DUP_PHASE == 0) ? 2 : 1); ++rep_) if (IN(0)) { p0_prologue(lds, args.in, ws, gw, NGW, wave, lane); }
    if (IN(0) && IN(1)) { xcd_barrier(bar);
        if (MISC[10] != 0u && G == 256) { uni = 1; xr = (int)MISC[11]; xx = (int)bar.x; cid = 8 * xr + xx; } }
#define PHASE1 if (IN(1)) { pg8::Gemm g{XB, (const bf16*)(ws + WS_WGU1), TOK, 2 * DFF, DMODEL}; pg8::StaticOrder S; S.init(TOK, 2 * DFF, G, cid); \
        pg8::EpiSwiGLU E{BIG, DFF, P16_0}; pg8::gemm_phase<pg8::EpiSwiGLU, pg8::StaticOrder, PG8_ALIGN, PG8_SP2>(lds + RING_OFF, g, S, E); }
    PHASE1
#if DUP_PHASE == 1
    PHASE1
#endif
    SEAM(1);
#if DUP_PHASE == 90
    for (int r_ = 0; r_ < 10; ++r_) { if (uni) xcd_local_barrier(bar, ++lseq); else xcd_barrier(bar); }
#endif
#define PHASE2 if (IN(2)) { pg8::Gemm g{BIG, (const bf16*)(ws + WS_WD1), TOK, DMODEL, DFF}; pg8::StaticOrder S; S.init(TOK, DMODEL, G, cid); \
        pg8::EpiResidBf<true> E{XB, P16_1, 0.5f}; pg8::gemm_phase<pg8::EpiResidBf<true>, pg8::StaticOrder, PG8_ALIGN, PG8_SP2>(lds + RING_OFF, g, S, E); }
    PHASE2
#if DUP_PHASE == 2
    PHASE2
#endif
#if DUP_PHASE == 20
    if (IN(2)) { pg8::Gemm g{BIG, (const bf16*)(ws + WS_WD1), TOK, DMODEL, DFF}; pg8::StaticOrder S; S.init(TOK, DMODEL, G, cid);
        pg8::EpiNull E{SSG}; pg8::gemm_phase<pg8::EpiNull, pg8::StaticOrder, PG8_ALIGN, PG8_SP2>(lds + RING_OFF, g, S, E); }
#endif
#if DUP_PHASE == 10
    if (IN(2)) { pg8::Gemm g{XB, (const bf16*)(ws + WS_WGU1), TOK, 2 * DFF, DMODEL}; pg8::StaticOrder S; S.init(TOK, 2 * DFF, G, cid);
        pg8::EpiNull E{SSG}; pg8::gemm_phase<pg8::EpiNull, pg8::StaticOrder, PG8_ALIGN, PG8_SP2>(lds + RING_OFF, g, S, E); }
#endif
    SEAM(2);
#define PHASE3 if (IN(3)) { pg8::Gemm g{XB, (const bf16*)(ws + WS_WIN), TOK, DIN, DMODEL}; pg8::StaticOrder S; S.init(TOK, DIN, G, cid); \
        pg8::EpiMix E{BIG, DIN, P16_1, args.in[13], args.in[14]}; pg8::gemm_phase<pg8::EpiMix, pg8::StaticOrder, PG8_ALIGN, PG8_SP2>(lds + RING_OFF, g, S, E); }
    PHASE3
#if DUP_PHASE == 3
    PHASE3
#endif
    SEAM(3);
    for (int rep_ = 0; rep_ < ((DUP_PHASE == 4 || DUP_PHASE == 40 || DUP_PHASE == 41) ? 2 : 1); ++rep_) if (IN(4)) {
        if (uni) {
            for (int k = xr; k < 64; k += 32) hg2_state_pass(lds, BIG, HGE, HGD, hg2_xcc_inst(xx, k), tid, lane, wave);
            for (int k = xr; k < 128; k += 32) gmlp_item(lds, BIG, Y, SSG, args.in[8], args.in[9], args.in[10], args.in[11], 32 * xx + (k >> 2), k & 3, tid, lane, wave);
        } else {
        if (rep_ == 0 || DUP_PHASE != 41) for (int i = bx; i < 512; i += G) hg2_state_pass(lds, BIG, HGE, HGD, i, tid, lane, wave);
        if (rep_ == 0 || DUP_PHASE != 40) for (int it = bx; it < 1024; it += G) gmlp_item(lds, BIG, Y, SSG, args.in[8], args.in[9], args.in[10], args.in[11], it >> 2, it & 3, tid, lane, wave);
        }
    }
    SEAM(4);
    for (int rep_ = 0; rep_ < ((DUP_PHASE == 5) ? 2 : 1); ++rep_) if (IN(5)) {
        if (uni) {
            const int h = xr & 3, sq = xr >> 2;
            const int seqid = xx < 4 ? 2 * xx + (sq >> 2) : 8 + (xx - 4), scf = xx < 4 ? (sq & 3) : sq, nsc = xx < 4 ? 4 : 8;
            hg2_out_pass(lds, BIG, OB1, HGE, HGD, hg2_index(seqid, h, 1, nsc - 1 - scf), tid, lane, wave);
            hg2_out_pass(lds, BIG, OB0, HGE, HGD, hg2_index(seqid, h, 0, scf), tid, lane, wave);
            asm volatile("s_waitcnt vmcnt(0)" ::: "memory"); __syncthreads();
            if (tid == 0) { asm volatile("buffer_inv sc1" ::: "memory"); asm volatile("s_waitcnt vmcnt(0)" ::: "memory"); }
            __syncthreads();
            hgrn_combine_local(OB0, OB1, BIG, args.in[15], Y, 4096 * xx + 512 * sq, h, tid);
            yg_fixup(SSG, args.in[12], Y, 4096 * xx, 4096 * xx + 4096, 8 * xr + wave, 256, lane);
        }
        else { for (int i = bx; i < 512; i += G) { const Hg2Inst I = hg2_decode(i); hg2_out_pass(lds, BIG, I.dir ? OB1 : OB0, HGE, HGD, i, tid, lane, wave); } }
    }
    if (!uni) SEAM(5);
    if (IN(6) && !uni) { if (uni) hgrn_combine(OB0, OB1, BIG, args.in[15], SSG, args.in[12], Y, 4096 * xx, 4096 * xx + 4096, 8 * xr + wave, 256, lane);
                 else hgrn_combine(OB0, OB1, BIG, args.in[15], SSG, args.in[12], Y, 0, TOK, gw, NGW, lane); }
    SEAM(6);
    if (IN(7)) { pg8::Gemm g{Y, (const bf16*)(ws + WS_WOUT), TOK, DMODEL, DMODEL}; pg8::StaticOrder S; S.init(TOK, DMODEL, G, cid);
        pg8::EpiResidBf<true> E{XB, P16_2, 1.0f};
        pg8::gemm_phase<pg8::EpiResidBf<true>, pg8::StaticOrder, PG8_ALIGN, PG8_SP2>(lds + RING_OFF, g, S, E); }
    SEAM(7);
    if (IN(8)) { pg8::Gemm g{XB, (const bf16*)(ws + WS_WGU2), TOK, 2 * DFF, DMODEL}; pg8::StaticOrder S; S.init(TOK, 2 * DFF, G, cid);
        pg8::EpiSwiGLU E{BIG, DFF, P16_2};
        pg8::gemm_phase<pg8::EpiSwiGLU, pg8::StaticOrder, PG8_ALIGN, PG8_SP2>(lds + RING_OFF, g, S, E); }
    SEAM(8);
    if (IN(9)) { pg8::Gemm g{BIG, (const bf16*)(ws + WS_WD2), TOK, DMODEL, DFF}; pg8::StaticOrder S; S.init(TOK, DMODEL, G, cid);
        pg8::EpiResidBf<false> E{XB, nullptr, 0.5f};
        pg8::gemm_phase<pg8::EpiResidBf<false>, pg8::StaticOrder, PG8_ALIGN, PG8_SP2>(lds + RING_OFF, g, S, E); }
    SEAM(9);
    if (IN(10)) { if (uni) final_norm(XB, args.out, args.in[21], 4096 * xx, 4096 * xx + 4096, 8 * xr + wave, 256, lane); else final_norm(XB, args.out, args.in[21], 0, TOK, gw, NGW, lane); }
#undef IN
#undef SEAM
}

extern "C" void kernel_launch(void* const* d_in, const int* in_sizes, int n_in, void* d_out, int out_size, void* d_ws, size_t ws_size, hipStream_t stream) {
    static int grid = 0;
    if (grid == 0) {
        if (n_in != 22 || out_size != TOK * DMODEL || ws_size < WS_END) { fprintf(stderr, "kernel_launch: unexpected problem (n_in %d, out %d, ws %zu); nothing launched\n", n_in, out_size, ws_size); grid = -1; return; }
        int dev = 0, cus = 0, per_cu = 0;
        if (hipGetDevice(&dev) != hipSuccess || hipDeviceGetAttribute(&cus, hipDeviceAttributeMultiprocessorCount, dev) != hipSuccess) { grid = -1; return; }
        if (hipFuncSetAttribute((const void*)fwd_kernel, hipFuncAttributeMaxDynamicSharedMemorySize, LDS_BYTES) != hipSuccess) { fprintf(stderr, "kernel_launch: hipFuncSetAttribute failed\n"); grid = -1; return; }
        if (hipOccupancyMaxActiveBlocksPerMultiprocessor(&per_cu, (const void*)fwd_kernel, NWAVES * 64, LDS_BYTES) != hipSuccess || per_cu < 1) { fprintf(stderr, "kernel_launch: occupancy query says %d blocks per CU; nothing launched\n", per_cu); (void)hipGetLastError(); grid = -1; return; }
        grid = cus;
    }
    if (grid < 0) return;
    if (hipMemsetAsync((char*)d_ws + WS_CTL, 0, CTL_ZERO_BYTES, stream) != hipSuccess) return;
    Args a{};
    for (int i = 0; i < 22; ++i) a.in[i] = (const float*)d_in[i];
    a.out = (float*)d_out; a.ws = (unsigned char*)d_ws;
    constexpr int NL = MK_N_LAUNCHES;
    for (int li = 0; li < NL; ++li) {
        a.ph_lo = (NL == 1) ? 0 : li; a.ph_hi = (NL == 1) ? N_PHASES : li + 1; a.li = 0;
        hipLaunchKernelGGL(fwd_kernel, dim3(grid), dim3(NWAVES * 64), LDS_BYTES, stream, a);
        if (hipPeekAtLastError() != hipSuccess) { fprintf(stderr, "kernel_launch: launch %d failed\n", li); break; }
    }
}
```

```cpp
#include <hip/hip_runtime.h>
#include <cstdio>
#include <cstdint>
namespace pg8 {
#define PG8_LAS __attribute__((address_space(3)))
typedef unsigned short bf16_t;
typedef short bf16x8 __attribute__((ext_vector_type(8)));
typedef float f32x4 __attribute__((ext_vector_type(4)));
typedef unsigned u32x4 __attribute__((ext_vector_type(4)));
constexpr int BM = 256, BK = 64, HALF = 128, HTB = HALF * BK * 2  , STAGE_BYTES = 8 * HTB, NXCD = 8, WGM = 8;

__host__ __device__ __forceinline__ int lds_byte(int r, int c) { const int st = (r >> 4) * 2 + (c >> 5), rr = r & 15, cc = c & 31, ob = rr * 64 + cc * 2; return st * 1024 + (ob ^ (((ob >> 9) & 1) << 5)); }
__host__ __device__ __forceinline__ void stage_rc(int b, int& R, int& C) { const int st = b / 1024, sb = b % 1024, swz = sb ^ (((sb >> 9) & 1) << 5); R = (st >> 1) * 16 + swz / 64; C = (st & 1) * 32 + (swz % 64) / 2; }
__host__ __device__ __forceinline__ int perm32(int rho) { const int n = rho >> 4, i = rho & 15; return 8 * (i >> 2) + 4 * n + (i & 3); }

struct Unit { int pm, pn; };
struct Gemm { const bf16_t* A; const bf16_t* Bt; int M, N, K; };

struct StaticOrder {
    int nM, nN, nwg, G, c;
    __host__ __device__ void init(int M, int N, int G_, int c_) { nM = M / BM; nN = N / BM; nwg = nM * nN; G = G_; c = c_; }
    __host__ __device__ bool next(int i, Unit& u) const {
        const long L = (long)i * G + c; if (L >= nwg) return false;
        int wgid = (int)L; { const int q = nwg / NXCD, r = nwg % NXCD, xcd = wgid % NXCD, off = wgid / NXCD; wgid = (xcd < r ? xcd * (q + 1) : r * (q + 1) + (xcd - r) * q) + off; }
        const int nig = WGM * nN, gid = wgid / nig, fm = gid * WGM, gsz = (nM - fm) < WGM ? (nM - fm) : WGM;
        u.pm = fm + ((wgid % nig) % gsz); u.pn = (wgid % nig) / gsz; return true;
    }
    __device__ __forceinline__ void a_ready(const Unit&) const {}
    __device__ __forceinline__ void done(const Unit&) const {}
};

typedef __bf16 bf16x2_hw __attribute__((ext_vector_type(2)));
typedef float f32x2_hw __attribute__((ext_vector_type(2)));
__device__ __forceinline__ unsigned cvt_pk_bf16(float lo, float hi) { const f32x2_hw v = {lo, hi}; const bf16x2_hw b = __builtin_convertvector(v, bf16x2_hw); return __builtin_bit_cast(unsigned, b); }
typedef float f32x2 __attribute__((ext_vector_type(2)));
__device__ __forceinline__ f32x2 gelu_pk(f32x2 v) {
    const f32x2 av = __builtin_elementwise_abs(v), d = av * 0.2316418882f + 1.0f;
    f32x2 t; t.x = __builtin_amdgcn_rcpf(d.x); t.y = __builtin_amdgcn_rcpf(d.y);
    f32x2 q = t * 0.5307027145f + (-0.7265760135f); q = q * t + 0.7107068705f; q = q * t + (-0.142248368f); q = q * t + 0.127414796f; q = q * t;
    const f32x2 s = (v * v) * (-0.72134752044f);
    f32x2 e; e.x = __builtin_amdgcn_exp2f(s.x); e.y = __builtin_amdgcn_exp2f(s.y);
    const f32x2 m = v * (q * e), r = v - m;
    f32x2 o; o.x = v.x < 0.f ? m.x : r.x; o.y = v.y < 0.f ? m.y : r.y; return o;
}

constexpr float RMS_EPS = 1e-6f;
constexpr int DM = 1024;
__device__ __forceinline__ float row_rstd(const float* p16, int row, int fq) {
    const f32x4 v = *(const f32x4*)(p16 + (size_t)row * 16 + 4 * fq);
    float s = (v[0] + v[1]) + (v[2] + v[3]);
    s += __shfl_xor(s, 16); s += __shfl_xor(s, 32);
    return __builtin_amdgcn_rsqf(s * (1.0f / DM) + RMS_EPS);
}
__device__ __forceinline__ void row_rstd8(const float* p16, int row0, int fq, float (&rr)[8]) {
    f32x4 pv[8];
#pragma unroll
    for (int i = 0; i < 8; ++i) pv[i] = *(const f32x4*)(p16 + (size_t)(row0 + (i >> 2) * HALF + (i & 3) * 16) * 16 + 4 * fq);
#pragma unroll
    for (int i = 0; i < 8; ++i) { float s = (pv[i][0] + pv[i][1]) + (pv[i][2] + pv[i][3]); s += __shfl_xor(s, 16); s += __shfl_xor(s, 32); rr[i] = __builtin_amdgcn_rsqf(s * (1.0f / DM) + RMS_EPS); }
}
__device__ __forceinline__ float fast_sigmoid(float z) { return __builtin_amdgcn_rcpf(1.0f + __builtin_amdgcn_exp2f(-1.44269504089f * z)); }

struct EpiSwiGLU {
    static constexpr bool PERM = true, AFTER_DRAIN = false;
    bf16_t* O; int ldo; const float* p16;
    __device__ __forceinline__ void operator()(const f32x4 (&acc)[2][2][4][2], const Unit& u, int wr, int wc, int fr, int fq) const {
        const int row0 = u.pm * BM + wr * 64 + fr, col0 = u.pn * HALF + wc * 32 + 8 * fq;
        float rr[8];
        row_rstd8(p16, row0, fq, rr);
#pragma unroll
        for (int ai = 0; ai < 2; ++ai)
#pragma unroll
            for (int m = 0; m < 4; ++m) {
                const int row = row0 + ai * HALF + m * 16;
                const float r = rr[ai * 4 + m];
                float h[8];
#pragma unroll
                for (int n = 0; n < 2; ++n)
#pragma unroll
                    for (int e = 0; e < 4; ++e) { const float g = acc[ai][0][m][n][e] * r, up = acc[ai][1][m][n][e] * r; h[4 * n + e] = g * up * fast_sigmoid(g); }
                u32x4 w; w.x = cvt_pk_bf16(h[0], h[1]); w.y = cvt_pk_bf16(h[2], h[3]); w.z = cvt_pk_bf16(h[4], h[5]); w.w = cvt_pk_bf16(h[6], h[7]);
                *(u32x4*)(O + (size_t)row * ldo + col0) = w;
            }
    }
};

template <bool WANT_BF16, bool WANT_SS> struct EpiResid {
    static constexpr bool PERM = true, AFTER_DRAIN = false;
    const float* base0; const float* base1;
    float* out; bf16_t* xb; float* p16; float alpha;
    __device__ __forceinline__ void operator()(const f32x4 (&acc)[2][2][4][2], const Unit& u, int wr, int wc, int fr, int fq) const {
        const int row0 = u.pm * BM + wr * 64 + fr, col0 = u.pn * BM + wc * 32 + 8 * fq;
        const float* bp = (u.pm < 64) ? base0 : base1; const int brow = (u.pm < 64) ? 0 : 16384;
        f32x4 bcur[4], bnxt[4];
#define RESID_LOAD(dst, it) do { const size_t bo_ = (size_t)(row0 + ((it) >> 2) * HALF + ((it) & 3) * 16 - brow) * DM + col0; \
            dst[0] = *(const f32x4*)(bp + bo_); dst[1] = *(const f32x4*)(bp + bo_ + 4); dst[2] = *(const f32x4*)(bp + bo_ + HALF); dst[3] = *(const f32x4*)(bp + bo_ + HALF + 4); } while (0)
        RESID_LOAD(bcur, 0);
#pragma unroll
        for (int it = 0; it < 8; ++it) {
            const int ai = it >> 2, m = it & 3;
            if (it + 1 < 8) RESID_LOAD(bnxt, it + 1);
            const int row = row0 + ai * HALF + m * 16; const size_t off = (size_t)row * DM + col0;
            float ss = 0.f;
#pragma unroll
            for (int bj = 0; bj < 2; ++bj) {
                const f32x4 v0 = bcur[2 * bj] + acc[ai][bj][m][0] * alpha, v1 = bcur[2 * bj + 1] + acc[ai][bj][m][1] * alpha;
                *(f32x4*)(out + off + bj * HALF) = v0; *(f32x4*)(out + off + bj * HALF + 4) = v1;
                if (WANT_BF16) { u32x4 w; w.x = cvt_pk_bf16(v0[0], v0[1]); w.y = cvt_pk_bf16(v0[2], v0[3]); w.z = cvt_pk_bf16(v1[0], v1[1]); w.w = cvt_pk_bf16(v1[2], v1[3]);
                    *(u32x4*)(xb + off + bj * HALF) = w; }
                if (WANT_SS) ss += ((v0[0] * v0[0] + v0[1] * v0[1]) + (v0[2] * v0[2] + v0[3] * v0[3])) + ((v1[0] * v1[0] + v1[1] * v1[1]) + (v1[2] * v1[2] + v1[3] * v1[3]));
            }
            if (WANT_SS) { ss += __shfl_xor(ss, 16); ss += __shfl_xor(ss, 32); if (fq == 0) p16[(size_t)row * 16 + 4 * u.pn + wc] = ss; }
#pragma unroll
            for (int q = 0; q < 4; ++q) bcur[q] = bnxt[q];
            asm volatile("" ::: "memory");
        }
#undef RESID_LOAD
    }
};

template <bool WANT_SS> struct EpiResidBf {
    static constexpr bool PERM = true, AFTER_DRAIN = false;
    bf16_t* xb; float* p16; float alpha;
    __device__ __forceinline__ void operator()(const f32x4 (&acc)[2][2][4][2], const Unit& u, int wr, int wc, int fr, int fq) const {
        const int row0 = u.pm * BM + wr * 64 + fr, col0 = u.pn * BM + wc * 32 + 8 * fq;
        u32x4 bcur[2], bnxt[2];
#define RESB_LOAD(dst, it) do { const size_t bo_ = (size_t)(row0 + ((it) >> 2) * HALF + ((it) & 3) * 16) * DM + col0; dst[0] = *(const u32x4*)(xb + bo_); dst[1] = *(const u32x4*)(xb + bo_ + HALF); } while (0)
        RESB_LOAD(bcur, 0);
#pragma unroll
        for (int it = 0; it < 8; ++it) {
            const int ai = it >> 2, m = it & 3;
            if (it + 1 < 8) RESB_LOAD(bnxt, it + 1);
            const int row = row0 + ai * HALF + m * 16; const size_t off = (size_t)row * DM + col0;
            float ss = 0.f;
#pragma unroll
            for (int bj = 0; bj < 2; ++bj) {
                const u32x4 b = bcur[bj];
                const f32x4 b0 = {__builtin_bit_cast(float, b.x << 16), __builtin_bit_cast(float, b.x & 0xffff0000u), __builtin_bit_cast(float, b.y << 16), __builtin_bit_cast(float, b.y & 0xffff0000u)};
                const f32x4 b1 = {__builtin_bit_cast(float, b.z << 16), __builtin_bit_cast(float, b.z & 0xffff0000u), __builtin_bit_cast(float, b.w << 16), __builtin_bit_cast(float, b.w & 0xffff0000u)};
                const f32x4 v0 = b0 + acc[ai][bj][m][0] * alpha, v1 = b1 + acc[ai][bj][m][1] * alpha;
                u32x4 w; w.x = cvt_pk_bf16(v0[0], v0[1]); w.y = cvt_pk_bf16(v0[2], v0[3]); w.z = cvt_pk_bf16(v1[0], v1[1]); w.w = cvt_pk_bf16(v1[2], v1[3]);
                *(u32x4*)(xb + off + bj * HALF) = w;
                if (WANT_SS) ss += ((v0[0] * v0[0] + v0[1] * v0[1]) + (v0[2] * v0[2] + v0[3] * v0[3])) + ((v1[0] * v1[0] + v1[1] * v1[1]) + (v1[2] * v1[2] + v1[3] * v1[3]));
            }
            if (WANT_SS) { ss += __shfl_xor(ss, 16); ss += __shfl_xor(ss, 32); if (fq == 0) p16[(size_t)row * 16 + 4 * u.pn + wc] = ss; }
            bcur[0] = bnxt[0]; bcur[1] = bnxt[1];
            asm volatile("" ::: "memory");
        }
#undef RESB_LOAD
    }
};
struct EpiNull { static constexpr bool PERM = true, AFTER_DRAIN = false; float* sink;
    __device__ __forceinline__ void operator()(const f32x4 (&acc)[2][2][4][2], const Unit& u, int wr, int wc, int fr, int fq) const {
        float s = 0.f;
#pragma unroll
        for (int ai = 0; ai < 2; ++ai)
#pragma unroll
            for (int bj = 0; bj < 2; ++bj)
#pragma unroll
                for (int m = 0; m < 4; ++m)
#pragma unroll
                    for (int n = 0; n < 2; ++n) s += acc[ai][bj][m][n][0] + acc[ai][bj][m][n][1] + acc[ai][bj][m][n][2] + acc[ai][bj][m][n][3];
        if (s == 12345.678f) sink[0] = s;
    } };
struct EpiMix {
    static constexpr bool PERM = true, AFTER_DRAIN = false;
    bf16_t* P; int ldp; const float* p16; const float* lbf; const float* lbb;
    float* vstat;
    template <int ACT> __device__ __forceinline__ void run(const f32x4 (&acc)[2][2][4][2], const Unit& u, int wr, int wc, int fr, int fq) const {
        const int row0 = u.pm * BM + wr * 64 + fr, col0 = u.pn * BM + wc * 32 + 8 * fq;
        float oml[2][8];
        if (ACT == 3) { const float* lb = ((u.pn >> 1) == 4) ? lbf : lbb; const int c0 = (u.pn & 1) * BM + wc * 32 + 8 * fq;
#pragma unroll
            for (int bj = 0; bj < 2; ++bj)
#pragma unroll
                for (int e = 0; e < 8; ++e) { const float a0 = lb[c0 + bj * HALF + e], a1 = lb[512 + c0 + bj * HALF + e]; oml[bj][e] = fast_sigmoid(a1 - a0);
#ifdef DBG_OML
                    oml[bj][e] = 0.5f;
#endif
                } }
        float rr[8];
        row_rstd8(p16, row0, fq, rr);
#pragma unroll
        for (int ai = 0; ai < 2; ++ai)
#pragma unroll
            for (int m = 0; m < 4; ++m) {
                const int row = row0 + ai * HALF + m * 16;
                const float r = rr[ai * 4 + m];
                float vs = 0.f, vq = 0.f;
#pragma unroll
                for (int bj = 0; bj < 2; ++bj) {
                    float h[8];
#pragma unroll
                    for (int n = 0; n < 2; ++n) {
                        const f32x4 z = acc[ai][bj][m][n] * r;
                        if (ACT == 0) { const f32x2 a = gelu_pk((f32x2){z[0], z[1]}), b = gelu_pk((f32x2){z[2], z[3]}); h[4 * n] = a.x; h[4 * n + 1] = a.y; h[4 * n + 2] = b.x; h[4 * n + 3] = b.y; }
                        else if (ACT == 1) {
#pragma unroll
                            for (int e = 0; e < 4; ++e) h[4 * n + e] = z[e] * fast_sigmoid(z[e]); }
                        else if (ACT == 2) {
#pragma unroll
                            for (int e = 0; e < 4; ++e) h[4 * n + e] = z[e]; }
                        else {
#pragma unroll
                            for (int e = 0; e < 4; ++e) { const float kk = oml[bj][4 * n + e] * __builtin_amdgcn_rcpf(1.0f + __builtin_amdgcn_exp2f(1.44269504089f * z[e]));
                                h[4 * n + e] = __builtin_amdgcn_logf(1.0f - kk); }
                        }
                    }
                    u32x4 w; w.x = cvt_pk_bf16(h[0], h[1]); w.y = cvt_pk_bf16(h[2], h[3]); w.z = cvt_pk_bf16(h[4], h[5]); w.w = cvt_pk_bf16(h[6], h[7]);
                    *(u32x4*)(P + (size_t)row * ldp + col0 + bj * HALF) = w;
                    if (ACT == 0) { vs += ((h[0] + h[1]) + (h[2] + h[3])) + ((h[4] + h[5]) + (h[6] + h[7]));
                        vq += ((h[0] * h[0] + h[1] * h[1]) + (h[2] * h[2] + h[3] * h[3])) + ((h[4] * h[4] + h[5] * h[5]) + (h[6] * h[6] + h[7] * h[7])); }
                }
                if (ACT == 0 && (u.pn >> 1) == 1) {
                    vs += __shfl_xor(vs, 16); vs += __shfl_xor(vs, 32); vq += __shfl_xor(vq, 16); vq += __shfl_xor(vq, 32);
                    if (fq == 0) *(f32x2*)(vstat + ((size_t)row * 8 + 4 * (u.pn & 1) + wc) * 2) = (f32x2){vs, vq}; }
            }
    }
    __device__ __forceinline__ void operator()(const f32x4 (&acc)[2][2][4][2], const Unit& u, int wr, int wc, int fr, int fq) const {
        const int seg = u.pn >> 1;
        if (seg <= 1) run<0>(acc, u, wr, wc, fr, fq);
        else if (seg == 2 || seg == 6) run<1>(acc, u, wr, wc, fr, fq);
        else if (seg == 3) run<2>(acc, u, wr, wc, fr, fq);
        else run<3>(acc, u, wr, wc, fr, fq);
    }
};

template <class Epi, class Sched, bool ALIGN_EPI = false, bool SP2 = false>
__device__ __forceinline__ void gemm_phase(PG8_LAS unsigned char* lds, const Gemm g, const Sched& S, const Epi& E) {
    const int tid = threadIdx.x, wid = __builtin_amdgcn_readfirstlane(tid >> 6), lane = tid & 63, wr = wid >> 2, wc = wid & 3, fr = lane & 15, fq = lane >> 4;
    const int K = g.K, nt = K / BK;
    unsigned voffA[2], voffB[2];
#pragma unroll
    for (int i = 0; i < 2; ++i) { int R, C; stage_rc(tid * 16 + i * 8192, R, C); const int Rb = Epi::PERM ? ((R & ~31) + perm32(R & 31)) : R;
        voffA[i] = (unsigned)(R * K + C) * 2u; voffB[i] = (unsigned)(Rb * K + C) * 2u; }
    const size_t kstep = (size_t)(BK * 2);
    const size_t hstep = (size_t)HALF * K * 2;
    const size_t tstep = 2 * hstep;
    const unsigned ldsw = (unsigned)wid * 1024u;
    const int aoff = lds_byte(wr * 64 + fr, fq * 8), boff = lds_byte(wc * 32 + fr, fq * 8);
#define PG8_SA(b, h) (((b) * 2 + (h)) * HTB)
#define PG8_SB(b, h) ((4 + (b) * 2 + (h)) * HTB)
#define PG8_STAGE(bufoff, gbase, voff) do { _Pragma("unroll") for (int _i = 0; _i < 2; ++_i) \
        __builtin_amdgcn_global_load_lds((const unsigned*)((const char*)(gbase) + (voff)[_i]), (PG8_LAS unsigned*)(lds + (bufoff) + ldsw + _i * 8192), 16, 0, 0); } while (0)
#define PG8_LDA(dst, b, h) do { _Pragma("unroll") for (int m = 0; m < 4; ++m) _Pragma("unroll") for (int k = 0; k < 2; ++k) dst[m][k] = *(const PG8_LAS bf16x8*)(lds + PG8_SA(b, h) + aoff + m * 2048 + k * 1024); } while (0)
#define PG8_LDB(dst, b, h) do { _Pragma("unroll") for (int n = 0; n < 2; ++n) _Pragma("unroll") for (int k = 0; k < 2; ++k) dst[n][k] = *(const PG8_LAS bf16x8*)(lds + PG8_SB(b, h) + boff + n * 2048 + k * 1024); } while (0)
#define PG8_MMA(ai, bj, At, Bt) do { __builtin_amdgcn_s_setprio(1); _Pragma("unroll") for (int m = 0; m < 4; ++m) _Pragma("unroll") for (int n = 0; n < 2; ++n) _Pragma("unroll") for (int k = 0; k < 2; ++k) \
        acc[ai][bj][m][n] = __builtin_amdgcn_mfma_f32_16x16x32_bf16(Bt[n][k], At[m][k], acc[ai][bj][m][n], 0, 0, 0); __builtin_amdgcn_s_setprio(0); } while (0)
#define PG8_WAIT_V(n) asm volatile("s_waitcnt vmcnt(" #n ")" ::: "memory")
#define PG8_WAIT_L(n) asm volatile("s_waitcnt lgkmcnt(" #n ")" ::: "memory")
#define PG8_BAR __builtin_amdgcn_s_barrier()
#define PG8_SCHED __builtin_amdgcn_sched_barrier(0)
    Unit cur, nxt; int ui = 0;
    if (!S.next(0, cur)) return;
    f32x4 acc[2][2][4][2];
#pragma unroll
    for (int a = 0; a < 2; ++a)
#pragma unroll
        for (int b = 0; b < 2; ++b)
#pragma unroll
            for (int m = 0; m < 4; ++m)
#pragma unroll
                for (int n = 0; n < 2; ++n) acc[a][b][m][n] = (f32x4){0.f, 0.f, 0.f, 0.f};
    bf16x8 At[4][2], B0[2][2], B1[2][2];
    const char* cA = (const char*)g.A + (size_t)cur.pm * tstep; const char* cB = (const char*)g.Bt + (size_t)cur.pn * tstep;
    S.a_ready(cur);
    if constexpr (SP2) {
        PG8_STAGE(PG8_SB(0, 0), cB, voffB); PG8_STAGE(PG8_SB(0, 1), cB + hstep, voffB); PG8_STAGE(PG8_SA(0, 0), cA, voffA); PG8_STAGE(PG8_SA(0, 1), cA + hstep, voffA);
        if (wr == 1) PG8_BAR;
        PG8_WAIT_V(2); PG8_BAR;
        PG8_STAGE(PG8_SB(1, 0), cB + kstep, voffB); PG8_STAGE(PG8_SA(1, 0), cA + kstep, voffA); PG8_STAGE(PG8_SB(1, 1), cB + hstep + kstep, voffB);
        PG8_WAIT_V(6); PG8_BAR;
    } else {
        PG8_STAGE(PG8_SB(0, 0), cB, voffB); PG8_STAGE(PG8_SA(0, 0), cA, voffA); PG8_STAGE(PG8_SB(0, 1), cB + hstep, voffB); PG8_STAGE(PG8_SA(0, 1), cA + hstep, voffA);
        if (wr == 1) PG8_BAR;
        PG8_WAIT_V(4); PG8_BAR;
        PG8_STAGE(PG8_SB(1, 0), cB + kstep, voffB); PG8_STAGE(PG8_SA(1, 0), cA + kstep, voffA); PG8_STAGE(PG8_SB(1, 1), cB + hstep + kstep, voffB);
        PG8_WAIT_V(6); PG8_BAR;
    }
    for (;;) {
        const bool has_next = S.next(ui + 1, nxt);
        const char* nA = has_next ? (const char*)g.A + (size_t)nxt.pm * tstep : cA; const char* nB = has_next ? (const char*)g.Bt + (size_t)nxt.pn * tstep : cB;
        for (int t = 0; t < nt; t += 2) {
            const bool last = (t == nt - 2);
            const char* a1 = cA + (size_t)(t + 1) * kstep;
            const char* a2 = last ? nA : cA + (size_t)(t + 2) * kstep; const char* b2 = last ? nB : cB + (size_t)(t + 2) * kstep;
            const char* a3 = a2 + kstep; const char* b3 = b2 + kstep;
            if (last && has_next) S.a_ready(nxt);
            if constexpr (SP2) {
            PG8_LDB(B0, 0, 0); PG8_LDB(B1, 0, 1); PG8_SCHED; PG8_LDA(At, 0, 0); PG8_STAGE(PG8_SA(1, 1), a1 + hstep, voffA);
            PG8_WAIT_V(8); PG8_WAIT_L(0); PG8_BAR; PG8_MMA(0, 0, At, B0); PG8_MMA(0, 1, At, B1); PG8_BAR; PG8_SCHED;
            PG8_LDA(At, 0, 1); PG8_STAGE(PG8_SB(0, 0), b2, voffB); PG8_STAGE(PG8_SB(0, 1), b2 + hstep, voffB); PG8_STAGE(PG8_SA(0, 0), a2, voffA);
            PG8_WAIT_V(8); PG8_WAIT_L(0); PG8_BAR; PG8_MMA(1, 0, At, B0); PG8_MMA(1, 1, At, B1); PG8_BAR; PG8_SCHED;
            PG8_LDB(B0, 1, 0); PG8_LDB(B1, 1, 1); PG8_SCHED; PG8_LDA(At, 1, 0); PG8_STAGE(PG8_SA(0, 1), a2 + hstep, voffA);
            PG8_WAIT_V(8); PG8_WAIT_L(0); PG8_BAR; PG8_MMA(0, 0, At, B0); PG8_MMA(0, 1, At, B1); PG8_BAR; PG8_SCHED;
            PG8_LDA(At, 1, 1); PG8_STAGE(PG8_SB(1, 0), b3, voffB); PG8_STAGE(PG8_SB(1, 1), b3 + hstep, voffB); PG8_STAGE(PG8_SA(1, 0), a3, voffA);
            PG8_WAIT_V(8); PG8_WAIT_L(0); PG8_BAR; PG8_MMA(1, 0, At, B0); PG8_MMA(1, 1, At, B1); PG8_BAR; PG8_SCHED;
            } else {
            PG8_LDB(B0, 0, 0); PG8_SCHED; PG8_LDA(At, 0, 0); PG8_STAGE(PG8_SA(1, 1), a1 + hstep, voffA);
            PG8_WAIT_L(8); PG8_BAR; PG8_WAIT_L(0); PG8_MMA(0, 0, At, B0); PG8_BAR; PG8_SCHED;
            PG8_LDB(B1, 0, 1); PG8_STAGE(PG8_SB(0, 0), b2, voffB);
            PG8_BAR; PG8_WAIT_L(0); PG8_MMA(0, 1, At, B1); PG8_BAR;
            PG8_LDA(At, 0, 1); PG8_STAGE(PG8_SA(0, 0), a2, voffA);
            PG8_BAR; PG8_WAIT_L(0); PG8_MMA(1, 0, At, B0); PG8_BAR; PG8_SCHED;
            PG8_STAGE(PG8_SB(0, 1), b2 + hstep, voffB);
            PG8_WAIT_V(6); PG8_BAR; PG8_MMA(1, 1, At, B1); PG8_BAR;
            PG8_LDB(B0, 1, 0); PG8_SCHED; PG8_LDA(At, 1, 0); PG8_STAGE(PG8_SA(0, 1), a2 + hstep, voffA);
            PG8_WAIT_L(8); PG8_BAR; PG8_WAIT_L(0); PG8_MMA(0, 0, At, B0); PG8_BAR; PG8_SCHED;
            PG8_LDB(B1, 1, 1); PG8_STAGE(PG8_SB(1, 0), b3, voffB);
            PG8_BAR; PG8_WAIT_L(0); PG8_MMA(0, 1, At, B1); PG8_BAR;
            PG8_LDA(At, 1, 1); PG8_STAGE(PG8_SA(1, 0), a3, voffA);
            PG8_BAR; PG8_WAIT_L(0); PG8_MMA(1, 0, At, B0); PG8_BAR; PG8_SCHED;
            PG8_STAGE(PG8_SB(1, 1), b3 + hstep, voffB);
            PG8_WAIT_V(6); PG8_BAR; PG8_MMA(1, 1, At, B1); PG8_BAR;
            }
        }
        if constexpr (ALIGN_EPI) { if (wr == 0) PG8_BAR; }
        if constexpr (!Epi::AFTER_DRAIN) { E(acc, cur, wr, wc, fr, fq); S.done(cur); }
        if (!has_next) break;
#pragma unroll
        for (int a = 0; a < 2; ++a)
#pragma unroll
            for (int b = 0; b < 2; ++b)
#pragma unroll
                for (int m = 0; m < 4; ++m)
#pragma unroll
                    for (int n = 0; n < 2; ++n) acc[a][b][m][n] = (f32x4){0.f, 0.f, 0.f, 0.f};
        cur = nxt; cA = nA; cB = nB; ++ui;
        if constexpr (ALIGN_EPI) { if (wr == 1) PG8_BAR; }
    }
    PG8_WAIT_V(0);
    if constexpr (!ALIGN_EPI) { if (wr == 0) PG8_BAR; }
    PG8_BAR;
    if constexpr (Epi::AFTER_DRAIN) { E.fused(acc, cur, wr, wc, fr, fq, lds, wid, lane); S.done(cur); }
#undef PG8_SA
#undef PG8_SB
#undef PG8_STAGE
#undef PG8_LDA
#undef PG8_LDB
#undef PG8_MMA
#undef PG8_WAIT_V
#undef PG8_WAIT_L
#undef PG8_BAR
#undef PG8_SCHED
}
}

#ifndef PG8_SP2
#define PG8_SP2 true
#endif
#ifndef PG8_ALIGN
#define PG8_ALIGN true
#endif
constexpr int NWAVES = 8;
constexpr int TOK = 32768, NPROMPT = 16384;
constexpr int DMODEL = 1024, DFF = 2816, DIN = 3584;
constexpr int COL_U = 0, COL_V = 512, COL_Q = 1024, COL_I = 1536, COL_FF = 2048, COL_FB = 2560, COL_G = 3072;
constexpr float EPS = 1e-6f;
constexpr size_t MiB = 1u << 20;
constexpr size_t WS_CTL = 0, CTL_ZERO_BYTES = 1 * MiB;
constexpr size_t WS_SSG = 1 * MiB;
constexpr size_t WS_P16 = 2 * MiB;
constexpr size_t WS_WGU1 = 8 * MiB, WS_WD1 = 19 * MiB, WS_WIN = 25 * MiB, WS_WOUT = 32 * MiB, WS_WGU2 = 34 * MiB, WS_WD2 = 45 * MiB;
constexpr size_t WS_BUFA = 52 * MiB;
constexpr size_t WS_BUFB = 116 * MiB;
constexpr size_t WS_BIG = 180 * MiB;
constexpr size_t WS_OB1 = 404 * MiB;
constexpr size_t WS_HGE = 468 * MiB;
constexpr size_t WS_HGD = 500 * MiB;
constexpr size_t WS_END = 501 * MiB;
static_assert(WS_WGU1 + (size_t)2 * DFF * DMODEL * 2 <= WS_WD1 && WS_WD1 + (size_t)DMODEL * DFF * 2 <= WS_WIN && WS_WIN + (size_t)DIN * DMODEL * 2 <= WS_WOUT && WS_WOUT + (size_t)DMODEL * DMODEL * 2 <= WS_WGU2
              && WS_WGU2 + (size_t)2 * DFF * DMODEL * 2 <= WS_WD2 && WS_WD2 + (size_t)DMODEL * DFF * 2 <= WS_BUFA && WS_BUFA + (size_t)TOK * DMODEL * 2 <= WS_BUFB && WS_BUFB + (size_t)TOK * DMODEL * 2 <= WS_BIG
              && WS_BIG + (size_t)TOK * DIN * 2 <= WS_OB1 && WS_OB1 + (size_t)TOK * 512 * 4 <= WS_HGE && WS_HGE + (size_t)512 * 65536 <= WS_HGD && WS_P16 + 3 * 2 * MiB <= WS_WGU1, "d_ws map");
constexpr int CW_BAR = 4096;
constexpr int RING_OFF = 0, RING_BYTES = 131072;
constexpr int LDSCTL_OFF = RING_BYTES, MISC_OFF = LDSCTL_OFF + 320;
constexpr int LDS_BYTES = 147456;
static_assert(MISC_OFF + 128 <= LDS_BYTES, "LDS map");

#define GAS __attribute__((address_space(1)))
#define LAS __attribute__((address_space(3)))
typedef unsigned short bf16;
typedef unsigned v4u __attribute__((ext_vector_type(4)));
typedef float f32x4 __attribute__((ext_vector_type(4)));
typedef short bf16x8 __attribute__((ext_vector_type(8)));
typedef GAS unsigned gu32;
typedef GAS unsigned long long gu64;
#define RLX_AGENT __ATOMIC_RELAXED, __HIP_MEMORY_SCOPE_AGENT
#define LDS_WAIT() asm volatile("s_waitcnt lgkmcnt(0)" ::: "memory")
#define VM_WAIT() asm volatile("s_waitcnt vmcnt(0)" ::: "memory")
__device__ __forceinline__ unsigned long long rt() { return __builtin_amdgcn_s_memrealtime(); }
__device__ __forceinline__ unsigned f2bf(float f) { unsigned u = __builtin_bit_cast(unsigned, f); return (u + 0x7fffu + ((u >> 16) & 1u)) >> 16; }
__device__ __forceinline__ unsigned pk2(float lo, float hi) { return f2bf(lo) | (f2bf(hi) << 16); }

#define XB_TMO      128
#define XB_XCNT(j)  (256  + 64 * (j))
#define XB_XSUB(j)  (1280 + 64 * (j))
#define XB_XGEN(j)  (2304 + 64 * (j))
#define XB_TOP      3328
#define XB_TOPGEN   3392
#define XCD_BAR_WORDS 3456
#define XB_SPIN_CAP (1u << 18)

__device__ __forceinline__ unsigned xb_ld(unsigned* p)              { return __hip_atomic_load(p, __ATOMIC_RELAXED, __HIP_MEMORY_SCOPE_AGENT); }
__device__ __forceinline__ unsigned xb_add(unsigned* p, unsigned v) { return __hip_atomic_fetch_add(p, v, __ATOMIC_RELAXED, __HIP_MEMORY_SCOPE_AGENT); }
__device__ __forceinline__ unsigned xb_xcc_id() { return (unsigned)__builtin_amdgcn_s_getreg((3 << 11) | 20) & 0xFu; }
#define XB_SPIN(cond, bar) do { unsigned _sp = 0; while (cond) { __builtin_amdgcn_s_sleep(1); \
    if ((++_sp & 255u) == 0u) { if (xb_ld(&(bar)[XB_TMO])) break; if (_sp > XB_SPIN_CAP) { atomicAdd(&(bar)[XB_TMO], 1u); break; } } } } while (0)

struct XcdBarrier {
    unsigned* bar; unsigned x;
    volatile LAS unsigned* st;
};

__device__ __forceinline__ XcdBarrier xcd_barrier_post(unsigned* bar, volatile LAS unsigned* st) {
    XcdBarrier b; b.bar = bar; b.x = xb_xcc_id(); b.st = st;
    if (threadIdx.x == 0) st[3] = xb_add(&bar[XB_XCNT(b.x)], 1u);
    return b;
}
__device__ __forceinline__ void xcd_barrier_complete(unsigned* bar, unsigned x, unsigned& nloc, unsigned& nx) {
    const unsigned G = gridDim.x * gridDim.y * gridDim.z;
    unsigned sum, cnt, mine, sp = 0u;
    for (;;) {
        sum = 0u; cnt = 0u; mine = 0u;
#pragma unroll
        for (unsigned j = 0; j < 16; ++j) { const unsigned c = xb_ld(&bar[XB_XCNT(j)]); sum += c; cnt += (c > 0u) ? 1u : 0u; mine = (j == x) ? c : mine; }
        if (sum == G) break;
        __builtin_amdgcn_s_sleep(1);
        if ((++sp & 255u) == 0u) { if (xb_ld(&bar[XB_TMO])) break; if (sp > XB_SPIN_CAP) { atomicAdd(&bar[XB_TMO], 1u); break; } }
    }
    nloc = mine > 0u ? mine : 1u; nx = cnt > 0u ? cnt : 1u;
}
__device__ __forceinline__ unsigned xcd_census_uniform(unsigned* bar) {
    const unsigned G = gridDim.x * gridDim.y * gridDim.z; unsigned ok = (G % 8u == 0u) ? 1u : 0u;
#pragma unroll
    for (unsigned j = 0; j < 16; ++j) { const unsigned c = xb_ld(&bar[XB_XCNT(j)]); if (j < 8u ? (c != G / 8u) : (c != 0u)) ok = 0u; }
    return (xb_ld(&bar[XB_TMO]) == 0u) ? ok : 0u;
}

__device__ __forceinline__ void xcd_barrier(const XcdBarrier& b) {
    asm volatile("s_waitcnt vmcnt(0)" ::: "memory");
    __syncthreads();
    if (threadIdx.x == 0) {
        unsigned* bar = b.bar;
        __builtin_amdgcn_s_waitcnt(0);
        unsigned nloc = b.st[0], nx = b.st[1];
        if (nloc == 0u) { xcd_barrier_complete(bar, b.x, nloc, nx); b.st[0] = nloc; b.st[1] = nx; b.st[2] = xcd_census_uniform(bar); }
        const unsigned old = xb_add(&bar[XB_XSUB(b.x)], 1u);
        const unsigned gen = old / nloc;
        if (old + 1u == (gen + 1u) * nloc) {
            __builtin_amdgcn_fence(__ATOMIC_RELEASE, "agent");
            asm volatile("s_waitcnt vmcnt(0)" ::: "memory");
            const unsigned og = xb_add(&bar[XB_TOP], 1u);
            const unsigned tg = og / nx;
            if (og + 1u == (tg + 1u) * nx) xb_add(&bar[XB_TOPGEN], 1u);
            else XB_SPIN(xb_ld(&bar[XB_TOPGEN]) == tg, bar);
            __builtin_amdgcn_fence(__ATOMIC_ACQUIRE, "agent");
            xb_add(&bar[XB_XGEN(b.x)], 1u);
            asm volatile("s_waitcnt vmcnt(0)" ::: "memory");
        } else {
            XB_SPIN(xb_ld(&bar[XB_XGEN(b.x)]) == gen, bar);
            __builtin_amdgcn_fence(__ATOMIC_ACQUIRE, "agent");
            asm volatile("s_waitcnt vmcnt(0)" ::: "memory");
        }
    }
    __syncthreads();
}
#define XB_LSUB(j)  (3456 + 64 * (j))
#define XB_LGEN(j)  (4480 + 64 * (j))
__device__ __forceinline__ void xcd_local_barrier(const XcdBarrier& b, unsigned seq) {
    asm volatile("s_waitcnt vmcnt(0)" ::: "memory");
    __syncthreads();
    if (threadIdx.x == 0) {
        unsigned* bar = b.bar;
        const unsigned target = seq * b.st[0];
        __hip_atomic_fetch_add(&bar[XB_LSUB(b.x)], 1u, __ATOMIC_RELAXED, __HIP_MEMORY_SCOPE_AGENT);
        asm volatile("buffer_inv sc1" ::: "memory");
        XB_SPIN(xb_ld(&bar[XB_LSUB(b.x)]) < target, bar);
        asm volatile("s_waitcnt vmcnt(0)" ::: "memory");
    }
    __syncthreads();
}

typedef unsigned v2u __attribute__((ext_vector_type(2)));
__device__ __forceinline__ float wave_sum(float v) {
#pragma unroll
    for (int o = 1; o < 64; o <<= 1) v += __shfl_xor(v, o);
    return v;
}
__device__ __forceinline__ float bflo(unsigned w) { return __builtin_bit_cast(float, w << 16); }
__device__ __forceinline__ float bfhi(unsigned w) { return __builtin_bit_cast(float, w & 0xffff0000u); }
__device__ __forceinline__ float bf1(unsigned short h) { return __builtin_bit_cast(float, (unsigned)h << 16); }
__device__ __forceinline__ float ex2(float x) { return __builtin_amdgcn_exp2f(x); }
__device__ __forceinline__ float rsq(float x) { return __builtin_amdgcn_rsqf(x); }

__device__ __forceinline__ void p0_item(const float* W, int Nsrc, int k0, int scol0, const float* gain, bf16* WT, int K, int drow0, LAS float* scr, int lane) {
    const int r8 = lane >> 3, c4 = 4 * (lane & 7);
    f32x4 v[8];
#pragma unroll
    for (int i = 0; i < 8; ++i) v[i] = *(const GAS f32x4*)(W + (size_t)(k0 + 8 * i + r8) * Nsrc + scol0 + c4);
#pragma unroll
    for (int i = 0; i < 8; ++i) { const int kk = 8 * i + r8; f32x4 t = v[i]; if (gain) t = t * gain[k0 + kk];
        scr[kk * 33 + c4] = t[0]; scr[kk * 33 + c4 + 1] = t[1]; scr[kk * 33 + c4 + 2] = t[2]; scr[kk * 33 + c4 + 3] = t[3]; }
    LDS_WAIT(); asm volatile("" ::: "memory");
    const int c = lane & 7;
#pragma unroll
    for (int j = 0; j < 4; ++j) { const int n = (lane >> 3) + 8 * j; const LAS float* s = scr + (8 * c) * 33 + n;
        v4u o; o.x = pk2(s[0 * 33], s[1 * 33]); o.y = pk2(s[2 * 33], s[3 * 33]); o.z = pk2(s[4 * 33], s[5 * 33]); o.w = pk2(s[6 * 33], s[7 * 33]);
        *(GAS v4u*)(WT + (size_t)(drow0 + n) * K + k0 + 8 * c) = o; }
    LDS_WAIT(); asm volatile("" ::: "memory");
}
__device__ __forceinline__ void p0_gu(const float* Wg, const float* Wu, const float* gain, bf16* WT, int r, LAS float* scr, int lane) {
    const int nblk = 2 * DFF / 32, kb = r / nblk, nb = r % nblk, n0 = 32 * nb, pn = n0 >> 8, bj = (n0 >> 7) & 1, j0 = n0 & 127;
    p0_item(bj ? Wu : Wg, DFF, 64 * kb, 128 * pn + j0, gain, WT, DMODEL, n0, scr, lane);
}
__device__ __forceinline__ void p0_plain(const float* W, int K, int N, const float* gain, bf16* WT, int r, LAS float* scr, int lane) {
    const int nblk = N / 32, kb = r / nblk, nb = r % nblk;
    p0_item(W, N, 64 * kb, 32 * nb, gain, WT, K, 32 * nb, scr, lane);
}
__device__ __forceinline__ void p0_prologue(LAS unsigned char* lds, const float* const* in, unsigned char* ws, int gw, int NGW, int wave, int lane) {
    LAS float* scr = (LAS float*)(lds + RING_OFF + wave * 16384);
    constexpr int I_GU = (DMODEL / 64) * (2 * DFF / 32), I_D = (DFF / 64) * (DMODEL / 32), I_IN = (DMODEL / 64) * (DIN / 32), I_OUT = (DMODEL / 64) * (DMODEL / 32);
    constexpr int NITEMS = 2 * I_GU + 2 * I_D + I_IN + I_OUT;
    for (int it = gw; it < NITEMS; it += NGW) {
        int r = it;
        if (r < I_GU) { p0_gu(in[3], in[4], in[2], (bf16*)(ws + WS_WGU1), r, scr, lane); continue; } r -= I_GU;
        if (r < I_GU) { p0_gu(in[18], in[19], in[17], (bf16*)(ws + WS_WGU2), r, scr, lane); continue; } r -= I_GU;
        if (r < I_D) { p0_plain(in[5], DFF, DMODEL, nullptr, (bf16*)(ws + WS_WD1), r, scr, lane); continue; } r -= I_D;
        if (r < I_D) { p0_plain(in[20], DFF, DMODEL, nullptr, (bf16*)(ws + WS_WD2), r, scr, lane); continue; } r -= I_D;
        if (r < I_IN) { p0_plain(in[7], DMODEL, DIN, in[6], (bf16*)(ws + WS_WIN), r, scr, lane); continue; } r -= I_IN;
        p0_plain(in[16], DMODEL, DMODEL, nullptr, (bf16*)(ws + WS_WOUT), r, scr, lane);
    }
    bf16* XB = (bf16*)(ws + WS_BUFA); float* p16 = (float*)(ws + WS_P16);
    for (int m0 = gw; m0 < TOK; m0 += 4 * NGW) {
        f32x4 v[4][4]; float s[4];
#pragma unroll
        for (int q = 0; q < 4; ++q) { const int m = m0 + q * NGW;
            if (m < TOK) { const float* xrow = m < NPROMPT ? in[0] + (size_t)m * DMODEL : in[1] + (size_t)(m - NPROMPT) * DMODEL; const GAS f32x4* xr = (const GAS f32x4*)xrow + lane;
#pragma unroll
                for (int j = 0; j < 4; ++j) v[q][j] = xr[64 * j]; } }
#pragma unroll
        for (int q = 0; q < 4; ++q) { s[q] = 0.f;
#pragma unroll
            for (int j = 0; j < 4; ++j) s[q] += (v[q][j].x * v[q][j].x + v[q][j].y * v[q][j].y) + (v[q][j].z * v[q][j].z + v[q][j].w * v[q][j].w); }
#pragma unroll
        for (int o = 1; o < 64; o <<= 1) {
#pragma unroll
            for (int q = 0; q < 4; ++q) s[q] += __shfl_xor(s[q], o); }
#pragma unroll
        for (int q = 0; q < 4; ++q) { const int m = m0 + q * NGW;
            if (m < TOK) { GAS v2u* o8 = (GAS v2u*)(XB + (size_t)m * DMODEL) + lane;
#pragma unroll
                for (int j = 0; j < 4; ++j) { v2u w; w.x = pk2(v[q][j].x, v[q][j].y); w.y = pk2(v[q][j].z, v[q][j].w); o8[64 * j] = w; }
                if (lane < 16) p16[(size_t)m * 16 + lane] = lane == 0 ? s[q] : 0.f; } }
    }
}

__device__ __forceinline__ void final_norm(const bf16* XBr, float* out, const float* gfin, int rbeg, int rend, int gw, int NGW, int lane) {
    for (int m = rbeg + gw; m < rend; m += NGW) {
        const v4u w0 = *(const GAS v4u*)(XBr + (size_t)m * DMODEL + 8 * lane), w1 = *(const GAS v4u*)(XBr + (size_t)m * DMODEL + 512 + 8 * lane);
        float x[16] = {bflo(w0.x), bfhi(w0.x), bflo(w0.y), bfhi(w0.y), bflo(w0.z), bfhi(w0.z), bflo(w0.w), bfhi(w0.w), bflo(w1.x), bfhi(w1.x), bflo(w1.y), bfhi(w1.y), bflo(w1.z), bfhi(w1.z), bflo(w1.w), bfhi(w1.w)};
        float s = 0.f;
#pragma unroll
        for (int e = 0; e < 16; ++e) s += x[e] * x[e];
        const float r = rsq(wave_sum(s) * (1.0f / DMODEL) + EPS);
#pragma unroll
        for (int j = 0; j < 2; ++j) { const int c = 512 * j + 8 * lane;
            const f32x4 g0 = *(const GAS f32x4*)(gfin + c), g1 = *(const GAS f32x4*)(gfin + c + 4);
            *(GAS f32x4*)(out + (size_t)m * DMODEL + c) = (f32x4){x[8 * j] * r * g0[0], x[8 * j + 1] * r * g0[1], x[8 * j + 2] * r * g0[2], x[8 * j + 3] * r * g0[3]};
            *(GAS f32x4*)(out + (size_t)m * DMODEL + c + 4) = (f32x4){x[8 * j + 4] * r * g1[0], x[8 * j + 5] * r * g1[1], x[8 * j + 6] * r * g1[2], x[8 * j + 7] * r * g1[3]}; }
    }
}

constexpr int HG_RAWLF = 0, HG_RAWQ = 17408, HG_QN = 34816, HG_KN = 52224, HG_KT = 69632, HG_VT = 88064, HG_SCL = 97280, HG_ST = 106496, HG_SEG = 115200, HG_SA = 119296, HG_SB = 119808, HG_END = 120320;
static_assert(HG_END <= RING_BYTES, "hgrn LDS");
__device__ __forceinline__ void hgrn_item(LAS unsigned char* lds, const bf16* P, float* ob, int row0, int L, int h, int dir, int dq, int tid, int lane, int wave) {
    const int fr = lane & 15, fq = lane >> 4, nch = L >> 6;
    const bf16* gq = P + COL_Q + h * 128;
    const bf16* gl = P + (dir ? COL_FB : COL_FF) + h * 128;
    const bf16* gv = P + COL_I + h * 128 + dq * 32;
    float* go = ob + h * 128 + dq * 32;
    const int lr = tid >> 4, lc = tid & 15, lp = (tid >> 2) & 31, vc = tid & 3, cp = lane, s8 = wave;
#define TOKROW(n, l) (row0 + (dir ? (L - 1 - (64 * (n) + (l))) : (64 * (n) + (l))))
#define HG_LOAD(n) do { _Pragma("unroll") for (int i_ = 0; i_ < 2; ++i_) { const size_t ro_ = (size_t)TOKROW(n, lr + 32 * i_) * DIN + 8 * lc; rl[i_] = *(const GAS v4u*)(gl + ro_); rq[i_] = *(const GAS v4u*)(gq + ro_); \
        rv[i_] = *(const GAS v4u*)(gv + (size_t)TOKROW(n, 2 * lp + i_) * DIN + 8 * vc); } } while (0)
    v4u rl[2], rq[2], rv[2];
    HG_LOAD(0);
    f32x4 S0 = {0.f, 0.f, 0.f, 0.f}, S1 = {0.f, 0.f, 0.f, 0.f};
    for (int n = 0; n < nch; ++n) {
        const int vbuf = HG_VT + (n & 1) * 4608;
#pragma unroll
        for (int i = 0; i < 2; ++i) { *(LAS v4u*)(lds + HG_RAWLF + (lr + 32 * i) * 272 + lc * 16) = rl[i]; *(LAS v4u*)(lds + HG_RAWQ + (lr + 32 * i) * 272 + lc * 16) = rq[i]; }
        if (tid < 128) {
#pragma unroll
            for (int e = 0; e < 4; ++e) { const unsigned w0 = rv[0][e], w1 = rv[1][e];
                *(LAS unsigned*)(lds + vbuf + (8 * vc + 2 * e) * 144 + lp * 4) = (w0 & 0xffffu) | (w1 << 16);
                *(LAS unsigned*)(lds + vbuf + (8 * vc + 2 * e + 1) * 144 + lp * 4) = (w0 >> 16) | (w1 & 0xffff0000u); }
        }
        if (n + 1 < nch) HG_LOAD(n + 1);
        __syncthreads();
        float lfa[8], lfb[8], ava[8], avb[8]; float runa = 0.f, runb = 0.f;
#pragma unroll
        for (int j = 0; j < 8; ++j) { const unsigned w = *(const LAS unsigned*)(lds + HG_RAWLF + (8 * s8 + j) * 272 + cp * 4);
            lfa[j] = bflo(w); lfb[j] = bfhi(w); runa += lfa[j]; runb += lfb[j]; ava[j] = runa; avb[j] = runb; }
        *(LAS v2u*)(lds + HG_SEG + (s8 * 128 + 2 * cp) * 4) = (v2u){__builtin_bit_cast(unsigned, runa), __builtin_bit_cast(unsigned, runb)};
        __syncthreads();
        {
            typedef float f32x2v __attribute__((ext_vector_type(2)));
            f32x2v sg_[8];
#pragma unroll
            for (int q = 0; q < 8; ++q) sg_[q] = *(const LAS f32x2v*)(lds + HG_SEG + (q * 128 + 2 * cp) * 4);
            const f32x2v amid2 = (sg_[0] + sg_[1]) + (sg_[2] + sg_[3]);
            const f32x2v atot2 = amid2 + ((sg_[4] + sg_[5]) + (sg_[6] + sg_[7]));
            f32x2v off2 = -amid2;
#pragma unroll
            for (int q = 0; q < 7; ++q) { const float mq = (q < s8) ? 1.0f : 0.0f; off2 = off2 + sg_[q] * mq; }
            const float amida = amid2.x, amidb = amid2.y, atota = atot2.x, atotb = atot2.y;
            const float offa = off2.x, offb = off2.y;
            unsigned kta[4], ktb[4];
#pragma unroll
            for (int j = 0; j < 8; ++j) {
                const float aa = offa + ava[j], ab = offb + avb[j];
                const unsigned qw = *(const LAS unsigned*)(lds + HG_RAWQ + (8 * s8 + j) * 272 + cp * 4);
                const float qta = bflo(qw) * ex2(aa), qtb = bfhi(qw) * ex2(ab);
                const float k_a = (1.0f - ex2(lfa[j])) * ex2(-aa), k_b = (1.0f - ex2(lfb[j])) * ex2(-ab);
                const unsigned kba = f2bf(k_a), kbb = f2bf(k_b);
                *(LAS unsigned*)(lds + HG_QN + (8 * s8 + j) * 272 + cp * 4) = pk2(qta, qtb);
                *(LAS unsigned*)(lds + HG_KN + (8 * s8 + j) * 272 + cp * 4) = kba | (kbb << 16);
                if (j & 1) { kta[j >> 1] |= kba << 16; ktb[j >> 1] |= kbb << 16; } else { kta[j >> 1] = kba; ktb[j >> 1] = kbb; }
            }
            *(LAS v4u*)(lds + HG_KT + (2 * cp) * 144 + s8 * 16) = (v4u){kta[0], kta[1], kta[2], kta[3]};
            *(LAS v4u*)(lds + HG_KT + (2 * cp + 1) * 144 + s8 * 16) = (v4u){ktb[0], ktb[1], ktb[2], ktb[3]};
            if (s8 == 0) { *(LAS v2u*)(lds + HG_SA + (2 * cp) * 4) = (v2u){__builtin_bit_cast(unsigned, ex2(amida)), __builtin_bit_cast(unsigned, ex2(amidb))};
                           *(LAS v2u*)(lds + HG_SB + (2 * cp) * 4) = (v2u){__builtin_bit_cast(unsigned, ex2(atota - amida)), __builtin_bit_cast(unsigned, ex2(atotb - amidb))}; }
        }
        __syncthreads();
        {
            const f32x4 sa = *(const LAS f32x4*)(lds + HG_SA + (16 * wave + 4 * fq) * 4);
            S0 = S0 * sa; S1 = S1 * sa;
#ifdef DBG_NOSTATE
            S0 = (f32x4){0.f,0.f,0.f,0.f}; S1 = S0;
#endif
            v2u w0, w1; w0.x = pk2(S0[0], S0[1]); w0.y = pk2(S0[2], S0[3]); w1.x = pk2(S1[0], S1[1]); w1.y = pk2(S1[2], S1[3]);
            *(LAS v2u*)(lds + HG_ST + fr * 272 + (16 * wave + 4 * fq) * 2) = w0;
            *(LAS v2u*)(lds + HG_ST + (16 + fr) * 272 + (16 * wave + 4 * fq) * 2) = w1;
        }
        {
            const int ib = wave & 3, jp = wave >> 2;
#pragma unroll
            for (int t = 0; t < 2; ++t) {
                const int jb = 2 * jp + t;
                f32x4 sc = {0.f, 0.f, 0.f, 0.f};
                if (jb <= ib) {
#pragma unroll
                    for (int ks = 0; ks < 4; ++ks) {
                        const bf16x8 x = *(const LAS bf16x8*)(lds + HG_KN + (16 * jb + fr) * 272 + ks * 64 + fq * 16);
                        const bf16x8 y = *(const LAS bf16x8*)(lds + HG_QN + (16 * ib + fr) * 272 + ks * 64 + fq * 16);
                        sc = __builtin_amdgcn_mfma_f32_16x16x32_bf16(x, y, sc, 0, 0, 0);
                    }
                    if (jb == ib) {
#pragma unroll
                        for (int r = 0; r < 4; ++r) if (4 * fq + r > fr) sc[r] = 0.f;
                    }
                }
                v2u w; w.x = pk2(sc[0], sc[1]); w.y = pk2(sc[2], sc[3]);
                *(LAS v2u*)(lds + HG_SCL + (16 * ib + fr) * 144 + (16 * jb + 4 * fq) * 2) = w;
            }
        }
        __syncthreads();
        {
            const int ib2 = wave >> 1, db = wave & 1;
            f32x4 O = {0.f, 0.f, 0.f, 0.f};
#pragma unroll
            for (int ks = 0; ks < 2; ++ks) {
                const bf16x8 x = *(const LAS bf16x8*)(lds + vbuf + (16 * db + fr) * 144 + ks * 64 + fq * 16);
                const bf16x8 y = *(const LAS bf16x8*)(lds + HG_SCL + (16 * ib2 + fr) * 144 + ks * 64 + fq * 16);
                O = __builtin_amdgcn_mfma_f32_16x16x32_bf16(x, y, O, 0, 0, 0);
            }
#pragma unroll
            for (int ks = 0; ks < 4; ++ks) {
                const bf16x8 x = *(const LAS bf16x8*)(lds + HG_ST + (16 * db + fr) * 272 + ks * 64 + fq * 16);
                const bf16x8 y = *(const LAS bf16x8*)(lds + HG_QN + (16 * ib2 + fr) * 272 + ks * 64 + fq * 16);
                O = __builtin_amdgcn_mfma_f32_16x16x32_bf16(x, y, O, 0, 0, 0);
            }
#if defined(DBG_HG) && DBG_HG == 1
            { const v2u w = *(const LAS v2u*)(lds + HG_QN + (16 * ib2 + fr) * 272 + (16 * db + 4 * fq) * 2); O = (f32x4){bflo(w.x), bfhi(w.x), bflo(w.y), bfhi(w.y)}; }
#elif defined(DBG_HG) && DBG_HG == 2
            { const v2u w = *(const LAS v2u*)(lds + HG_SCL + (16 * ib2 + fr) * 144 + (16 * db + 4 * fq) * 2); O = (f32x4){bflo(w.x), bfhi(w.x), bflo(w.y), bfhi(w.y)}; }
#elif defined(DBG_HG) && DBG_HG == 3
            { const v2u w = *(const LAS v2u*)(lds + vbuf + (16 * db + fr) * 144 + (16 * (ib2 & 3) + 4 * fq) * 2); O = (f32x4){bflo(w.x), bfhi(w.x), bflo(w.y), bfhi(w.y)}; }
#elif defined(DBG_HG) && DBG_HG == 5
            { const v2u w = *(const GAS v2u*)(gq + (size_t)TOKROW(n, 16 * ib2 + fr) * DIN + 16 * db + 4 * fq); O = (f32x4){bflo(w.x), bfhi(w.x), bflo(w.y), bfhi(w.y)}; }
#elif defined(DBG_HG) && DBG_HG == 9
            { const v2u w = *(const GAS v2u*)(gl + (size_t)TOKROW(n, 16 * ib2 + fr) * DIN + 16 * db + 4 * fq); O = (f32x4){bflo(w.x), bfhi(w.x), bflo(w.y), bfhi(w.y)}; }
#elif defined(DBG_HG) && DBG_HG == 10
            { const v2u w = *(const LAS v2u*)(lds + HG_RAWLF + (16 * ib2 + fr) * 272 + (16 * db + 4 * fq) * 2); O = (f32x4){bflo(w.x), bfhi(w.x), bflo(w.y), bfhi(w.y)}; }
#elif defined(DBG_HG) && DBG_HG == 7
            { const v2u w = *(const GAS v2u*)(P + COL_U + h * 128 + (size_t)TOKROW(n, 16 * ib2 + fr) * DIN + 16 * db + 4 * fq); O = (f32x4){bflo(w.x), bfhi(w.x), bflo(w.y), bfhi(w.y)}; }
#elif defined(DBG_HG) && DBG_HG == 8
            { O = (f32x4){(float)TOKROW(n, 16 * ib2 + fr), (float)(16 * db + 4 * fq), (float)h, (float)dq}; }
#elif defined(DBG_HG) && DBG_HG == 6
            { const v2u w = *(const LAS v2u*)(lds + HG_RAWQ + (16 * ib2 + fr) * 272 + (16 * db + 4 * fq) * 2); O = (f32x4){bflo(w.x), bfhi(w.x), bflo(w.y), bfhi(w.y)}; }
#elif defined(DBG_HG) && DBG_HG == 4
            { const v2u w = *(const LAS v2u*)(lds + HG_KN + (16 * ib2 + fr) * 272 + (16 * db + 4 * fq) * 2); O = (f32x4){bflo(w.x), bfhi(w.x), bflo(w.y), bfhi(w.y)}; }
#endif
            *(GAS f32x4*)(go + (size_t)TOKROW(n, 16 * ib2 + fr) * 512 + 16 * db + 4 * fq) = O;
        }
        {
#pragma unroll
            for (int ks = 0; ks < 2; ++ks) {
                const bf16x8 x = *(const LAS bf16x8*)(lds + HG_KT + (16 * wave + fr) * 144 + ks * 64 + fq * 16);
                const bf16x8 y0 = *(const LAS bf16x8*)(lds + vbuf + fr * 144 + ks * 64 + fq * 16);
                const bf16x8 y1 = *(const LAS bf16x8*)(lds + vbuf + (16 + fr) * 144 + ks * 64 + fq * 16);
                S0 = __builtin_amdgcn_mfma_f32_16x16x32_bf16(x, y0, S0, 0, 0, 0);
                S1 = __builtin_amdgcn_mfma_f32_16x16x32_bf16(x, y1, S1, 0, 0, 0);
            }
            const f32x4 sb = *(const LAS f32x4*)(lds + HG_SB + (16 * wave + 4 * fq) * 4);
            S0 = S0 * sb; S1 = S1 * sb;
        }
        __syncthreads();
    }
#undef HG_LOAD
#undef TOKROW
}

constexpr int H2_RAWLF = 0, H2_RAWQ = 17408, H2_ST = 0, H2_QN = 34816, H2_KN = 52224, H2_KT = 69632, H2_VT = 88064, H2_SCL = 106496, H2_SEG = 115712, H2_SA = 119808, H2_SB = 120320, H2_END = 120832;
static_assert(H2_END <= RING_BYTES, "hgrn v2 LDS");
struct Hg2Inst { int row0, L, h, dir, sc, seqid; };
__device__ __forceinline__ Hg2Inst hg2_decode(int i) {
    Hg2Inst I; const int hd = i & 7, sp = i >> 3; I.h = hd >> 1; I.dir = hd & 1;
    if (sp < 32) { const int b = sp >> 2; I.sc = sp & 3; I.row0 = 2048 * b; I.L = 2048; I.seqid = b; }
    else { const int b = (sp - 32) >> 3; I.sc = (sp - 32) & 7; I.row0 = NPROMPT + 4096 * b; I.L = 4096; I.seqid = 8 + b; }
    return I;
}
__device__ __forceinline__ int hg2_index(int seqid, int h, int dir, int sc) { const int sp = seqid < 8 ? seqid * 4 + sc : 32 + (seqid - 8) * 8 + sc; return sp * 8 + h * 2 + dir; }
__device__ __forceinline__ int hg2_xcc_inst(int x, int k) { const int hd = k & 7, sq = k >> 3; const int seqid = x < 4 ? 2 * x + (sq >> 2) : 8 + (x - 4), sc = x < 4 ? (sq & 3) : sq; return hg2_index(seqid, hd >> 1, hd & 1, sc); }
#define H2_TOKROW(p) (row0 + (dir ? (L - 1 - (p)) : (p)))
typedef float f32x2v __attribute__((ext_vector_type(2)));

__device__ __forceinline__ void hg2_state_pass(LAS unsigned char* lds, const bf16* P, float* Ebuf, float* Dbuf, int inst, int tid, int lane, int wave) {
    const Hg2Inst I = hg2_decode(inst); const int row0 = I.row0, L = I.L, h = I.h, dir = I.dir;
    const int fr = lane & 15, fq = lane >> 4, cp = lane, s8 = wave;
    const bf16* gl = P + (dir ? COL_FB : COL_FF) + h * 128;
    const bf16* gv = P + COL_I + h * 128;
    const int lr = tid >> 4, lc = tid & 15, vc = 4 * (wave & 3) + (lane & 3), lp = 16 * (wave >> 2) + (lane >> 2);
    const int p0 = 512 * I.sc;
#define H2_LOAD1(n) do { _Pragma("unroll") for (int i_ = 0; i_ < 2; ++i_) { rl[i_] = *(const GAS v4u*)(gl + (size_t)H2_TOKROW(p0 + 64 * (n) + lr + 32 * i_) * DIN + 8 * lc); \
        rv[i_] = *(const GAS v4u*)(gv + (size_t)H2_TOKROW(p0 + 64 * (n) + 2 * lp + i_) * DIN + 8 * vc); } } while (0)
    v4u rl[2], rv[2];
    H2_LOAD1(0);
    f32x4 S[8];
#pragma unroll
    for (int t = 0; t < 8; ++t) S[t] = (f32x4){0.f, 0.f, 0.f, 0.f};
    f32x2v dlog = {0.f, 0.f};
    for (int n = 0; n < 8; ++n) {
#pragma unroll
        for (int i = 0; i < 2; ++i) *(LAS v4u*)(lds + H2_RAWLF + (lr + 32 * i) * 272 + lc * 16) = rl[i];
#pragma unroll
        for (int e = 0; e < 4; ++e) { const unsigned w0 = rv[0][e], w1 = rv[1][e];
            *(LAS unsigned*)(lds + H2_VT + (8 * vc + 2 * e) * 144 + lp * 4) = (w0 & 0xffffu) | (w1 << 16);
            *(LAS unsigned*)(lds + H2_VT + (8 * vc + 2 * e + 1) * 144 + lp * 4) = (w0 >> 16) | (w1 & 0xffff0000u); }
        if (n + 1 < 8) H2_LOAD1(n + 1);
        __syncthreads();
        float lfa[8], lfb[8]; f32x2v av[8]; f32x2v run = {0.f, 0.f};
#pragma unroll
        for (int j = 0; j < 8; ++j) { const unsigned w = *(const LAS unsigned*)(lds + H2_RAWLF + (8 * s8 + j) * 272 + cp * 4);
            lfa[j] = bflo(w); lfb[j] = bfhi(w); run = run + (f32x2v){lfa[j], lfb[j]}; av[j] = run; }
        *(LAS f32x2v*)(lds + H2_SEG + (s8 * 128 + 2 * cp) * 4) = run;
        __syncthreads();
        {
            f32x2v sg_[8];
#pragma unroll
            for (int q = 0; q < 8; ++q) sg_[q] = *(const LAS f32x2v*)(lds + H2_SEG + (q * 128 + 2 * cp) * 4);
            const f32x2v amid2 = (sg_[0] + sg_[1]) + (sg_[2] + sg_[3]);
            const f32x2v atot2 = amid2 + ((sg_[4] + sg_[5]) + (sg_[6] + sg_[7]));
            f32x2v off2 = -amid2;
#pragma unroll
            for (int q = 0; q < 7; ++q) { const float mq = (q < s8) ? 1.0f : 0.0f; off2 = off2 + sg_[q] * mq; }
            unsigned kta[4], ktb[4];
#pragma unroll
            for (int j = 0; j < 8; ++j) {
                const f32x2v aa = off2 + av[j];
                const unsigned kba = f2bf((1.0f - ex2(lfa[j])) * ex2(-aa.x)), kbb = f2bf((1.0f - ex2(lfb[j])) * ex2(-aa.y));
                if (j & 1) { kta[j >> 1] |= kba << 16; ktb[j >> 1] |= kbb << 16; } else { kta[j >> 1] = kba; ktb[j >> 1] = kbb; }
            }
            *(LAS v4u*)(lds + H2_KT + (2 * cp) * 144 + s8 * 16) = (v4u){kta[0], kta[1], kta[2], kta[3]};
            *(LAS v4u*)(lds + H2_KT + (2 * cp + 1) * 144 + s8 * 16) = (v4u){ktb[0], ktb[1], ktb[2], ktb[3]};
            if (s8 == 0) { *(LAS f32x2v*)(lds + H2_SA + (2 * cp) * 4) = (f32x2v){ex2(amid2.x), ex2(amid2.y)};
                           *(LAS f32x2v*)(lds + H2_SB + (2 * cp) * 4) = (f32x2v){ex2(atot2.x - amid2.x), ex2(atot2.y - amid2.y)}; dlog = dlog + atot2; }
        }
        __syncthreads();
        {
            const f32x4 sa = *(const LAS f32x4*)(lds + H2_SA + (16 * wave + 4 * fq) * 4), sb = *(const LAS f32x4*)(lds + H2_SB + (16 * wave + 4 * fq) * 4);
            bf16x8 x[2];
#pragma unroll
            for (int ks = 0; ks < 2; ++ks) x[ks] = *(const LAS bf16x8*)(lds + H2_KT + (16 * wave + fr) * 144 + ks * 64 + fq * 16);
#pragma unroll
            for (int t = 0; t < 8; ++t) S[t] = S[t] * sa;
#pragma unroll
            for (int ks = 0; ks < 2; ++ks) { bf16x8 y[8];
#pragma unroll
                for (int t = 0; t < 8; ++t) y[t] = *(const LAS bf16x8*)(lds + H2_VT + (16 * t + fr) * 144 + ks * 64 + fq * 16);
#pragma unroll
                for (int t = 0; t < 8; ++t) S[t] = __builtin_amdgcn_mfma_f32_16x16x32_bf16(x[ks], y[t], S[t], 0, 0, 0); }
#pragma unroll
            for (int t = 0; t < 8; ++t) S[t] = S[t] * sb;
        }
        __syncthreads();
    }
    float* E = Ebuf + (size_t)inst * 16384;
#pragma unroll
    for (int t = 0; t < 8; ++t) *(GAS f32x4*)(E + ((wave * 8 + t) * 64 + lane) * 4) = S[t];
    if (s8 == 0) *(GAS f32x2v*)(Dbuf + (size_t)inst * 128 + 2 * cp) = dlog;
#undef H2_LOAD1
}

__device__ __forceinline__ void hg2_out_pass(LAS unsigned char* lds, const bf16* P, bf16* ob, const float* Ebuf, const float* Dbuf, int inst, int tid, int lane, int wave) {
    const Hg2Inst I = hg2_decode(inst); const int row0 = I.row0, L = I.L, h = I.h, dir = I.dir;
    const int fr = lane & 15, fq = lane >> 4, cp = lane, s8 = wave;
    const bf16* gq = P + COL_Q + h * 128;
    const bf16* gl = P + (dir ? COL_FB : COL_FF) + h * 128;
    const bf16* gv = P + COL_I + h * 128;
    bf16* go = ob + h * 128;
    const int lr = tid >> 4, lc = tid & 15, vc = 4 * (wave & 3) + (lane & 3), lp = 16 * (wave >> 2) + (lane >> 2);
    const int p0 = 512 * I.sc;
#define H2_LOAD2(n) do { _Pragma("unroll") for (int i_ = 0; i_ < 2; ++i_) { const size_t ro_ = (size_t)H2_TOKROW(p0 + 64 * (n) + lr + 32 * i_) * DIN + 8 * lc; rl[i_] = *(const GAS v4u*)(gl + ro_); rq[i_] = *(const GAS v4u*)(gq + ro_); \
        rv[i_] = *(const GAS v4u*)(gv + (size_t)H2_TOKROW(p0 + 64 * (n) + 2 * lp + i_) * DIN + 8 * vc); } } while (0)
    v4u rl[2], rq[2], rv[2];
    H2_LOAD2(0);
    f32x4 S[8];
#pragma unroll
    for (int t = 0; t < 8; ++t) S[t] = (f32x4){0.f, 0.f, 0.f, 0.f};
    if (I.sc > 0) {
        f32x4 ec[8], en[8], dc, dn;
        { const int ij = hg2_index(I.seqid, h, dir, 0); dc = *(const GAS f32x4*)(Dbuf + (size_t)ij * 128 + 16 * wave + 4 * fq); const float* E = Ebuf + (size_t)ij * 16384;
#pragma unroll
          for (int t = 0; t < 8; ++t) ec[t] = *(const GAS f32x4*)(E + ((wave * 8 + t) * 64 + lane) * 4); }
        for (int j = 0; j < I.sc; ++j) {
            if (j + 1 < I.sc) { const int ij = hg2_index(I.seqid, h, dir, j + 1); dn = *(const GAS f32x4*)(Dbuf + (size_t)ij * 128 + 16 * wave + 4 * fq); const float* E = Ebuf + (size_t)ij * 16384;
#pragma unroll
                for (int t = 0; t < 8; ++t) en[t] = *(const GAS f32x4*)(E + ((wave * 8 + t) * 64 + lane) * 4); }
            const f32x4 dec = {ex2(dc[0]), ex2(dc[1]), ex2(dc[2]), ex2(dc[3])};
#pragma unroll
            for (int t = 0; t < 8; ++t) { S[t] = S[t] * dec + ec[t]; ec[t] = en[t]; }
            dc = dn;
        }
    }
    for (int n = 0; n < 8; ++n) {
#pragma unroll
        for (int i = 0; i < 2; ++i) { *(LAS v4u*)(lds + H2_RAWLF + (lr + 32 * i) * 272 + lc * 16) = rl[i]; *(LAS v4u*)(lds + H2_RAWQ + (lr + 32 * i) * 272 + lc * 16) = rq[i]; }
#pragma unroll
        for (int e = 0; e < 4; ++e) { const unsigned w0 = rv[0][e], w1 = rv[1][e];
            *(LAS unsigned*)(lds + H2_VT + (8 * vc + 2 * e) * 144 + lp * 4) = (w0 & 0xffffu) | (w1 << 16);
            *(LAS unsigned*)(lds + H2_VT + (8 * vc + 2 * e + 1) * 144 + lp * 4) = (w0 >> 16) | (w1 & 0xffff0000u); }
        if (n + 1 < 8) H2_LOAD2(n + 1);
        __syncthreads();
        float lfa[8], lfb[8]; f32x2v av[8]; f32x2v run = {0.f, 0.f};
#pragma unroll
        for (int j = 0; j < 8; ++j) { const unsigned w = *(const LAS unsigned*)(lds + H2_RAWLF + (8 * s8 + j) * 272 + cp * 4);
            lfa[j] = bflo(w); lfb[j] = bfhi(w); run = run + (f32x2v){lfa[j], lfb[j]}; av[j] = run; }
        *(LAS f32x2v*)(lds + H2_SEG + (s8 * 128 + 2 * cp) * 4) = run;
        __syncthreads();
        {
            f32x2v sg_[8];
#pragma unroll
            for (int q = 0; q < 8; ++q) sg_[q] = *(const LAS f32x2v*)(lds + H2_SEG + (q * 128 + 2 * cp) * 4);
            const f32x2v amid2 = (sg_[0] + sg_[1]) + (sg_[2] + sg_[3]);
            const f32x2v atot2 = amid2 + ((sg_[4] + sg_[5]) + (sg_[6] + sg_[7]));
            f32x2v off2 = -amid2;
#pragma unroll
            for (int q = 0; q < 7; ++q) { const float mq = (q < s8) ? 1.0f : 0.0f; off2 = off2 + sg_[q] * mq; }
            unsigned kta[4], ktb[4];
#pragma unroll
            for (int j = 0; j < 8; ++j) {
                const f32x2v aa = off2 + av[j];
                const unsigned qw = *(const LAS unsigned*)(lds + H2_RAWQ + (8 * s8 + j) * 272 + cp * 4);
                const float qta = bflo(qw) * ex2(aa.x), qtb = bfhi(qw) * ex2(aa.y);
                const unsigned kba = f2bf((1.0f - ex2(lfa[j])) * ex2(-aa.x)), kbb = f2bf((1.0f - ex2(lfb[j])) * ex2(-aa.y));
                *(LAS unsigned*)(lds + H2_QN + (8 * s8 + j) * 272 + cp * 4) = pk2(qta, qtb);
                *(LAS unsigned*)(lds + H2_KN + (8 * s8 + j) * 272 + cp * 4) = kba | (kbb << 16);
                if (j & 1) { kta[j >> 1] |= kba << 16; ktb[j >> 1] |= kbb << 16; } else { kta[j >> 1] = kba; ktb[j >> 1] = kbb; }
            }
            *(LAS v4u*)(lds + H2_KT + (2 * cp) * 144 + s8 * 16) = (v4u){kta[0], kta[1], kta[2], kta[3]};
            *(LAS v4u*)(lds + H2_KT + (2 * cp + 1) * 144 + s8 * 16) = (v4u){ktb[0], ktb[1], ktb[2], ktb[3]};
            if (s8 == 0) { *(LAS f32x2v*)(lds + H2_SA + (2 * cp) * 4) = (f32x2v){ex2(amid2.x), ex2(amid2.y)};
                           *(LAS f32x2v*)(lds + H2_SB + (2 * cp) * 4) = (f32x2v){ex2(atot2.x - amid2.x), ex2(atot2.y - amid2.y)}; }
        }
        __syncthreads();
        {
            const f32x4 sa = *(const LAS f32x4*)(lds + H2_SA + (16 * wave + 4 * fq) * 4);
#pragma unroll
            for (int t = 0; t < 8; ++t) { S[t] = S[t] * sa; v2u w; w.x = pk2(S[t][0], S[t][1]); w.y = pk2(S[t][2], S[t][3]);
                *(LAS v2u*)(lds + H2_ST + (16 * t + fr) * 272 + (16 * wave + 4 * fq) * 2) = w; }
        }
        {
            const int ib = wave & 3, jp = wave >> 2;
#pragma unroll
            for (int t = 0; t < 2; ++t) {
                const int jb = 2 * jp + t;
                f32x4 sc = {0.f, 0.f, 0.f, 0.f};
                if (jb <= ib) {
#pragma unroll
                    for (int ks = 0; ks < 4; ++ks) {
                        const bf16x8 x = *(const LAS bf16x8*)(lds + H2_KN + (16 * jb + fr) * 272 + ks * 64 + fq * 16);
                        const bf16x8 y = *(const LAS bf16x8*)(lds + H2_QN + (16 * ib + fr) * 272 + ks * 64 + fq * 16);
                        sc = __builtin_amdgcn_mfma_f32_16x16x32_bf16(x, y, sc, 0, 0, 0);
                    }
                    if (jb == ib) {
#pragma unroll
                        for (int r = 0; r < 4; ++r) if (4 * fq + r > fr) sc[r] = 0.f;
                    }
                }
                v2u w; w.x = pk2(sc[0], sc[1]); w.y = pk2(sc[2], sc[3]);
                *(LAS v2u*)(lds + H2_SCL + (16 * ib + fr) * 144 + (16 * jb + 4 * fq) * 2) = w;
            }
        }
        __syncthreads();
        {
            const int ib2 = wave >> 1, dh = wave & 1;
            bf16x8 ys[2], yq[4];
#pragma unroll
            for (int ks = 0; ks < 2; ++ks) ys[ks] = *(const LAS bf16x8*)(lds + H2_SCL + (16 * ib2 + fr) * 144 + ks * 64 + fq * 16);
#pragma unroll
            for (int ks = 0; ks < 4; ++ks) yq[ks] = *(const LAS bf16x8*)(lds + H2_QN + (16 * ib2 + fr) * 272 + ks * 64 + fq * 16);
            const size_t orow = (size_t)H2_TOKROW(p0 + 64 * n + 16 * ib2 + fr) * 512;
            f32x4 O[4];
#pragma unroll
            for (int t = 0; t < 4; ++t) O[t] = (f32x4){0.f, 0.f, 0.f, 0.f};
#pragma unroll
            for (int ks = 0; ks < 2; ++ks) { bf16x8 x[4];
#pragma unroll
                for (int t = 0; t < 4; ++t) x[t] = *(const LAS bf16x8*)(lds + H2_VT + (16 * (4 * dh + t) + fr) * 144 + ks * 64 + fq * 16);
#pragma unroll
                for (int t = 0; t < 4; ++t) O[t] = __builtin_amdgcn_mfma_f32_16x16x32_bf16(x[t], ys[ks], O[t], 0, 0, 0); }
#pragma unroll
            for (int ks = 0; ks < 4; ++ks) { bf16x8 x[4];
#pragma unroll
                for (int t = 0; t < 4; ++t) x[t] = *(const LAS bf16x8*)(lds + H2_ST + (16 * (4 * dh + t) + fr) * 272 + ks * 64 + fq * 16);
#pragma unroll
                for (int t = 0; t < 4; ++t) O[t] = __builtin_amdgcn_mfma_f32_16x16x32_bf16(x[t], yq[ks], O[t], 0, 0, 0); }
#pragma unroll
            for (int t = 0; t < 4; ++t) { v2u w; w.x = pk2(O[t][0], O[t][1]); w.y = pk2(O[t][2], O[t][3]); *(GAS v2u*)(go + orow + 16 * (4 * dh + t) + 4 * fq) = w; }
        }
        {
            const f32x4 sb = *(const LAS f32x4*)(lds + H2_SB + (16 * wave + 4 * fq) * 4);
            bf16x8 x[2];
#pragma unroll
            for (int ks = 0; ks < 2; ++ks) x[ks] = *(const LAS bf16x8*)(lds + H2_KT + (16 * wave + fr) * 144 + ks * 64 + fq * 16);
#pragma unroll
            for (int ks = 0; ks < 2; ++ks) { bf16x8 y[8];
#pragma unroll
                for (int t = 0; t < 8; ++t) y[t] = *(const LAS bf16x8*)(lds + H2_VT + (16 * t + fr) * 144 + ks * 64 + fq * 16);
#pragma unroll
                for (int t = 0; t < 8; ++t) S[t] = __builtin_amdgcn_mfma_f32_16x16x32_bf16(x[ks], y[t], S[t], 0, 0, 0); }
#pragma unroll
            for (int t = 0; t < 8; ++t) S[t] = S[t] * sb;
        }
        __syncthreads();
    }
#undef H2_LOAD2
}

#ifdef DBG_NAIVE_HGRN
__device__ __forceinline__ void naive_hgrn_item(LAS unsigned char* lds, const bf16* P, float* ob, int row0, int L, int h, int dir, int tid) {
    LAS float* LQ = (LAS float*)lds; LAS float* LF = LQ + 2048; LAS float* LK = LF + 2048;
    const unsigned short* Pu = (const unsigned short*)P;
    float S[128];
#pragma unroll
    for (int k = 0; k < 128; ++k) S[k] = 0.f;
    for (int t0 = 0; t0 < L; t0 += 16) {
        __syncthreads();
#pragma unroll
        for (int i = 0; i < 4; ++i) { const int idx = tid + 512 * i, st = idx >> 7, k = idx & 127; const size_t row = (size_t)(row0 + (dir ? (L - 1 - (t0 + st)) : (t0 + st)));
            const float qv = bf1(Pu[row * DIN + COL_Q + h * 128 + k]), l2 = bf1(Pu[row * DIN + (dir ? COL_FB : COL_FF) + h * 128 + k]), f = exp2f(l2);
            LQ[st * 128 + k] = qv; LF[st * 128 + k] = f; LK[st * 128 + k] = 1.0f - f; }
        __syncthreads();
        if (tid < 128) {
#pragma unroll 1
            for (int st = 0; st < 16; ++st) { const size_t row = (size_t)(row0 + (dir ? (L - 1 - (t0 + st)) : (t0 + st)));
                const float v = bf1(Pu[row * DIN + COL_I + h * 128 + tid]); float o = 0.f;
#pragma unroll
                for (int k4 = 0; k4 < 32; ++k4) { const f32x4 f4 = *(const LAS f32x4*)(LF + st * 128 + 4 * k4), k4v = *(const LAS f32x4*)(LK + st * 128 + 4 * k4), q4 = *(const LAS f32x4*)(LQ + st * 128 + 4 * k4);
#pragma unroll
                    for (int e = 0; e < 4; ++e) { S[4 * k4 + e] = f4[e] * S[4 * k4 + e] + k4v[e] * v; o += q4[e] * S[4 * k4 + e]; } }
                ob[row * 512 + h * 128 + tid] = o; }
        }
    }
    __syncthreads();
}
#endif
__device__ __forceinline__ void hgrn_combine(const bf16* ob0, const bf16* ob1, const bf16* P, const float* onorm, const float* ssg, const float* gon, bf16* Y, int rbeg, int rend, int gw, int NGW, int lane) {
    const int c = 8 * lane;
    const f32x4 g0 = *(const GAS f32x4*)(onorm + c), g1 = *(const GAS f32x4*)(onorm + c + 4);
    const f32x4 n0 = *(const GAS f32x4*)(gon + c), n1 = *(const GAS f32x4*)(gon + c + 4);
    for (int m = rbeg + gw; m < rend; m += NGW) {
        const v4u aw = *(const GAS v4u*)(ob0 + (size_t)m * 512 + c), bw = *(const GAS v4u*)(ob1 + (size_t)m * 512 + c);
        const f32x4 a0 = {bflo(aw.x), bfhi(aw.x), bflo(aw.y), bfhi(aw.y)}, a1 = {bflo(aw.z), bfhi(aw.z), bflo(aw.w), bfhi(aw.w)};
        const f32x4 b0 = {bflo(bw.x), bfhi(bw.x), bflo(bw.y), bfhi(bw.y)}, b1 = {bflo(bw.z), bfhi(bw.z), bflo(bw.w), bfhi(bw.w)};
        const v4u sgw = *(const GAS v4u*)(P + (size_t)m * DIN + COL_G + c);
#ifdef DBG_PCOPY
        f32x4 o0 = {0.f,0.f,0.f,0.f}, o1 = o0;
        { const int segs[4] = {COL_Q, COL_I, COL_FF, COL_FB};
#pragma unroll
          for (int q_ = 0; q_ < 4; ++q_) { const v4u pw = *(const GAS v4u*)(P + (size_t)m * DIN + segs[q_] + c);
            o0 += (f32x4){bflo(pw.x), bfhi(pw.x), bflo(pw.y), bfhi(pw.y)}; o1 += (f32x4){bflo(pw.z), bfhi(pw.z), bflo(pw.w), bfhi(pw.w)}; } }
#else
        const f32x4 o0 = a0 + b0, o1 = a1 + b1;
#endif
        float s = ((o0[0] * o0[0] + o0[1] * o0[1]) + (o0[2] * o0[2] + o0[3] * o0[3])) + ((o1[0] * o1[0] + o1[1] * o1[1]) + (o1[2] * o1[2] + o1[3] * o1[3]));
        s += __shfl_xor(s, 1); s += __shfl_xor(s, 2); s += __shfl_xor(s, 4); s += __shfl_xor(s, 8);
        const float r = rsq(s * (1.0f / 128.0f) + EPS);
        const f32x4 y0 = o0 * r * g0 * (f32x4){bflo(sgw.x), bfhi(sgw.x), bflo(sgw.y), bfhi(sgw.y)};
        const f32x4 y1 = o1 * r * g1 * (f32x4){bflo(sgw.z), bfhi(sgw.z), bflo(sgw.w), bfhi(sgw.w)};
        v4u w; w.x = pk2(y0[0], y0[1]); w.y = pk2(y0[2], y0[3]); w.z = pk2(y1[0], y1[1]); w.w = pk2(y1[2], y1[3]);
        *(GAS v4u*)(Y + (size_t)m * DMODEL + 512 + c) = w;
#ifndef NO_GMLP
        const f32x4 sv = *(const GAS f32x4*)(ssg + (size_t)m * 4);
        const float rg = rsq(((sv[0] + sv[1]) + (sv[2] + sv[3])) * (1.0f / 512.0f) + EPS);
        const v4u yw = *(const GAS v4u*)(Y + (size_t)m * DMODEL + c);
        const f32x4 z0 = (f32x4){bflo(yw.x), bfhi(yw.x), bflo(yw.y), bfhi(yw.y)} * rg * n0, z1 = (f32x4){bflo(yw.z), bfhi(yw.z), bflo(yw.w), bfhi(yw.w)} * rg * n1;
        v4u zw; zw.x = pk2(z0[0], z0[1]); zw.y = pk2(z0[2], z0[3]); zw.z = pk2(z1[0], z1[1]); zw.w = pk2(z1[2], z1[3]);
        *(GAS v4u*)(Y + (size_t)m * DMODEL + c) = zw;
#endif
    }
}

__device__ __forceinline__ void hgrn_combine_local(const bf16* ob0, const bf16* ob1, const bf16* P, const float* onorm, bf16* Y, int rbase, int h, int tid) {
    const int l16 = tid & 15, tg = tid >> 4;
    const int c = h * 128 + 8 * l16;
    const f32x4 g0 = *(const GAS f32x4*)(onorm + c), g1 = *(const GAS f32x4*)(onorm + c + 4);
#pragma unroll 1
    for (int t0 = 0; t0 < 512; t0 += 128) {
        v4u aw[4], bw[4], sw[4];
#pragma unroll
        for (int q = 0; q < 4; ++q) { const size_t m = (size_t)(rbase + t0 + 32 * q + tg);
            aw[q] = *(const GAS v4u*)(ob0 + m * 512 + c); bw[q] = *(const GAS v4u*)(ob1 + m * 512 + c); sw[q] = *(const GAS v4u*)(P + m * DIN + COL_G + c); }
#pragma unroll
        for (int q = 0; q < 4; ++q) { const size_t m = (size_t)(rbase + t0 + 32 * q + tg);
            const f32x4 o0 = (f32x4){bflo(aw[q].x), bfhi(aw[q].x), bflo(aw[q].y), bfhi(aw[q].y)} + (f32x4){bflo(bw[q].x), bfhi(bw[q].x), bflo(bw[q].y), bfhi(bw[q].y)};
            const f32x4 o1 = (f32x4){bflo(aw[q].z), bfhi(aw[q].z), bflo(aw[q].w), bfhi(aw[q].w)} + (f32x4){bflo(bw[q].z), bfhi(bw[q].z), bflo(bw[q].w), bfhi(bw[q].w)};
            float sq = ((o0[0] * o0[0] + o0[1] * o0[1]) + (o0[2] * o0[2] + o0[3] * o0[3])) + ((o1[0] * o1[0] + o1[1] * o1[1]) + (o1[2] * o1[2] + o1[3] * o1[3]));
            sq += __shfl_xor(sq, 1); sq += __shfl_xor(sq, 2); sq += __shfl_xor(sq, 4); sq += __shfl_xor(sq, 8);
            const float r = rsq(sq * (1.0f / 128.0f) + EPS);
            const f32x4 y0 = o0 * r * g0 * (f32x4){bflo(sw[q].x), bfhi(sw[q].x), bflo(sw[q].y), bfhi(sw[q].y)};
            const f32x4 y1 = o1 * r * g1 * (f32x4){bflo(sw[q].z), bfhi(sw[q].z), bflo(sw[q].w), bfhi(sw[q].w)};
            v4u w; w.x = pk2(y0[0], y0[1]); w.y = pk2(y0[2], y0[3]); w.z = pk2(y1[0], y1[1]); w.w = pk2(y1[2], y1[3]);
            *(GAS v4u*)(Y + m * DMODEL + 512 + c) = w; }
    }
}
__device__ __forceinline__ void yg_fixup(const float* ssg, const float* gon, bf16* Y, int rbeg, int rend, int gw, int NGW, int lane) {
    const int c = 8 * lane;
    const f32x4 n0 = *(const GAS f32x4*)(gon + c), n1 = *(const GAS f32x4*)(gon + c + 4);
    for (int m0 = rbeg + gw; m0 < rend; m0 += 4 * NGW) {
        f32x4 sv[4]; v4u yw[4];
#pragma unroll
        for (int q = 0; q < 4; ++q) { const int m = m0 + q * NGW; if (m < rend) { sv[q] = *(const GAS f32x4*)(ssg + (size_t)m * 4); yw[q] = *(const GAS v4u*)(Y + (size_t)m * DMODEL + c); } }
#pragma unroll
        for (int q = 0; q < 4; ++q) { const int m = m0 + q * NGW; if (m < rend) {
            const float rg = rsq(((sv[q][0] + sv[q][1]) + (sv[q][2] + sv[q][3])) * (1.0f / 512.0f) + EPS);
            const f32x4 z0 = (f32x4){bflo(yw[q].x), bfhi(yw[q].x), bflo(yw[q].y), bfhi(yw[q].y)} * rg * n0, z1 = (f32x4){bflo(yw[q].z), bfhi(yw[q].z), bflo(yw[q].w), bfhi(yw[q].w)} * rg * n1;
            v4u zw; zw.x = pk2(z0[0], z0[1]); zw.y = pk2(z0[2], z0[3]); zw.z = pk2(z1[0], z1[1]); zw.w = pk2(z1[2], z1[3]);
            *(GAS v4u*)(Y + (size_t)m * DMODEL + c) = zw; } }
    }
}
constexpr int GM_RAWV = 0, GM_VLT = 34816, GM_WL = 69632, GM_MEAN = 104448, GM_RSTD = 104960, GM_END = 105472;
static_assert(GM_END <= RING_BYTES, "gmlp LDS");
__device__ __forceinline__ void gmlp_item(LAS unsigned char* lds, const bf16* P, const float* vstat, bf16* Y, float* ssg, const float* ln_g, const float* ln_b, const float* w_s, const float* b_s, int c, int h, int tid, int lane, int wave) {
    const int fr = lane & 15, fq = lane >> 4, R0 = 128 * c;
    if (tid < 128) { const float* vp = vstat + (size_t)(R0 + tid) * 16;
        const f32x4 a = *(const GAS f32x4*)vp, b = *(const GAS f32x4*)(vp + 4), c4 = *(const GAS f32x4*)(vp + 8), d = *(const GAS f32x4*)(vp + 12);
        const float sm = ((a[0] + a[2]) + (b[0] + b[2])) + ((c4[0] + c4[2]) + (d[0] + d[2])), sq = ((a[1] + a[3]) + (b[1] + b[3])) + ((c4[1] + c4[3]) + (d[1] + d[3]));
        const float mean = sm * (1.0f / 512.0f), var = fmaxf(sq * (1.0f / 512.0f) - mean * mean, 0.f);
        *(LAS float*)(lds + GM_MEAN + tid * 4) = mean; *(LAS float*)(lds + GM_RSTD + tid * 4) = rsq(var + EPS); }
#pragma unroll
    for (int i = 0; i < 4; ++i) { const int idx = tid + 512 * i, row = idx >> 4, c16 = idx & 15;
        *(LAS v4u*)(lds + GM_RAWV + row * 272 + c16 * 16) = *(const GAS v4u*)(P + (size_t)(R0 + row) * DIN + COL_V + 128 * h + 8 * c16); }
#pragma unroll
    for (int i = 0; i < 8; ++i) { const int idx = tid + 512 * i, tt = idx >> 5, s4 = idx & 31;
        const f32x4 w = *(const GAS f32x4*)(w_s + (size_t)h * 16384 + tt * 128 + 4 * s4);
        v2u o; o.x = pk2(w[0], w[1]); o.y = pk2(w[2], w[3]);
        *(LAS v2u*)(lds + GM_WL + tt * 272 + s4 * 8) = o; }
    __syncthreads();
    {
        const int ch = tid & 127, sq4 = tid >> 7;
        const float g = ln_g[128 * h + ch], b = ln_b[128 * h + ch];
#pragma unroll
        for (int i = 0; i < 4; ++i) {
            unsigned wv[4];
#pragma unroll
            for (int e = 0; e < 8; ++e) { const int s = 32 * sq4 + 8 * i + e;
                const float x = bf1(*(const LAS unsigned short*)(lds + GM_RAWV + s * 272 + ch * 2));
                const float y = (x - *(const LAS float*)(lds + GM_MEAN + s * 4)) * *(const LAS float*)(lds + GM_RSTD + s * 4) * g + b;
                const unsigned yb = f2bf(y);
                if (e & 1) wv[e >> 1] |= yb << 16; else wv[e >> 1] = yb; }
            *(LAS v4u*)(lds + GM_VLT + ch * 272 + (32 * sq4 + 8 * i) * 2) = (v4u){wv[0], wv[1], wv[2], wv[3]};
        }
    }
    __syncthreads();
    const int t = 16 * wave + fr;
    bf16x8 yf[4];
#pragma unroll
    for (int ks = 0; ks < 4; ++ks) yf[ks] = *(const LAS bf16x8*)(lds + GM_WL + (16 * wave + fr) * 272 + ks * 64 + fq * 16);
    const float bs = b_s[h * 128 + t];
    float ss = 0.f;
#pragma unroll
    for (int cb = 0; cb < 8; ++cb) {
        f32x4 a = {0.f, 0.f, 0.f, 0.f};
#pragma unroll
        for (int ks = 0; ks < 4; ++ks) {
            const bf16x8 x = *(const LAS bf16x8*)(lds + GM_VLT + (16 * cb + fr) * 272 + ks * 64 + fq * 16);
            a = __builtin_amdgcn_mfma_f32_16x16x32_bf16(x, yf[ks], a, 0, 0, 0);
        }
        const int ch = 128 * h + 16 * cb + 4 * fq;
        const v2u uw = *(const GAS v2u*)(P + (size_t)(R0 + t) * DIN + COL_U + ch);
        const f32x4 uu = {bflo(uw.x), bfhi(uw.x), bflo(uw.y), bfhi(uw.y)};
        a = (a + bs) * uu;
        ss += (a[0] * a[0] + a[1] * a[1]) + (a[2] * a[2] + a[3] * a[3]);
        v2u w; w.x = pk2(a[0], a[1]); w.y = pk2(a[2], a[3]);
        *(GAS v2u*)(Y + (size_t)(R0 + t) * DMODEL + ch) = w;
    }
    ss += __shfl_xor(ss, 16); ss += __shfl_xor(ss, 32);
    if (fq == 0) ssg[(size_t)(R0 + t) * 4 + h] = ss;
    __syncthreads();
}

struct Args { const float* in[22]; float* out; unsigned char* ws; int ph_lo, ph_hi, li, pad; };
constexpr int N_PHASES = 11;
#ifndef MK_N_LAUNCHES
#define MK_N_LAUNCHES 1
#endif
#ifndef DUP_PHASE
#define DUP_PHASE (-1)
#endif
__global__ void __launch_bounds__(NWAVES * 64, 2) fwd_kernel(Args args) {
    extern __shared__ __attribute__((aligned(16))) unsigned char lds_raw[];
    LAS unsigned char* lds = (LAS unsigned char*)lds_raw;
    volatile LAS unsigned* MISC = (volatile LAS unsigned*)(lds + MISC_OFF);
    const int tid = threadIdx.x, lane = tid & 63, wave = __builtin_amdgcn_readfirstlane(tid >> 6);
    const int G = gridDim.x, bx = blockIdx.x;
    const int vcu = (G % 8 == 0) ? (bx % 8) * (G / 8) + bx / 8 : bx;
    const int gw = vcu * NWAVES + wave, NGW = G * NWAVES;
    unsigned char* ws = args.ws;
    gu32* ctl = (gu32*)(ws + WS_CTL);
    for (int u = tid; u < (LDS_BYTES - LDSCTL_OFF) / 4; u += NWAVES * 64) ((LAS unsigned*)(lds + LDSCTL_OFF))[u] = 0u;
    __syncthreads();
    XcdBarrier bar = xcd_barrier_post((unsigned*)(ctl + CW_BAR) + args.li * XCD_BAR_WORDS, MISC + 8);
    const int lo = args.ph_lo, hi = args.ph_hi;
#define IN(k) (lo <= (k) && (k) < hi)
    int uni = 0, cid = bx, xr = 0, xx = 0; unsigned lseq = 0;
#define SEAM(k) do { if (IN(k) && IN((k) + 1)) { if (uni) xcd_local_barrier(bar, ++lseq); else xcd_barrier(bar); } } while (0)
    bf16* XB = (bf16*)(ws + WS_BUFA); bf16* Y = (bf16*)(ws + WS_BUFB); bf16* BIG = (bf16*)(ws + WS_BIG);
    bf16* OB0 = (bf16*)args.out; bf16* OB1 = (bf16*)args.out + (size_t)TOK * 512;
    float* VST = (float*)(ws + WS_P16);
    float* SSG = (float*)(ws + WS_SSG); float* HGE = (float*)(ws + WS_HGE); float* HGD = (float*)(ws + WS_HGD);
    float* P16_0 = (float*)(ws + WS_P16); float* P16_1 = (float*)(ws + WS_P16 + 2 * MiB); float* P16_2 = (float*)(ws + WS_P16 + 4 * MiB);

    for (int rep_ = 0; rep_ < ((DUP_PHASE == 0) ? 2 : 1); ++rep_) if (IN(0)) { p0_prologue(lds, args.in, ws, gw, NGW, wave, lane); }
    if (IN(0) && IN(1)) { xcd_barrier(bar);
        if (MISC[10] != 0u && G == 256) { uni = 1; xr = (int)MISC[11]; xx = (int)bar.x; cid = 8 * xr + xx; } }
#define PHASE1 if (IN(1)) { pg8::Gemm g{XB, (const bf16*)(ws + WS_WGU1), TOK, 2 * DFF, DMODEL}; pg8::StaticOrder S; S.init(TOK, 2 * DFF, G, cid); \
        pg8::EpiSwiGLU E{BIG, DFF, P16_0}; pg8::gemm_phase<pg8::EpiSwiGLU, pg8::StaticOrder, PG8_ALIGN, PG8_SP2>(lds + RING_OFF, g, S, E); }
    PHASE1
#if DUP_PHASE == 1
    PHASE1
#endif
    SEAM(1);
#if DUP_PHASE == 90
    for (int r_ = 0; r_ < 10; ++r_) { if (uni) xcd_local_barrier(bar, ++lseq); else xcd_barrier(bar); }
#endif
#define PHASE2 if (IN(2)) { pg8::Gemm g{BIG, (const bf16*)(ws + WS_WD1), TOK, DMODEL, DFF}; pg8::StaticOrder S; S.init(TOK, DMODEL, G, cid); \
        pg8::EpiResidBf<true> E{XB, P16_1, 0.5f}; pg8::gemm_phase<pg8::EpiResidBf<true>, pg8::StaticOrder, PG8_ALIGN, PG8_SP2>(lds + RING_OFF, g, S, E); }
    PHASE2
#if DUP_PHASE == 2
    PHASE2
#endif
#if DUP_PHASE == 20
    if (IN(2)) { pg8::Gemm g{BIG, (const bf16*)(ws + WS_WD1), TOK, DMODEL, DFF}; pg8::StaticOrder S; S.init(TOK, DMODEL, G, cid);
        pg8::EpiNull E{SSG}; pg8::gemm_phase<pg8::EpiNull, pg8::StaticOrder, PG8_ALIGN, PG8_SP2>(lds + RING_OFF, g, S, E); }
#endif
#if DUP_PHASE == 10
    if (IN(2)) { pg8::Gemm g{XB, (const bf16*)(ws + WS_WGU1), TOK, 2 * DFF, DMODEL}; pg8::StaticOrder S; S.init(TOK, 2 * DFF, G, cid);
        pg8::EpiNull E{SSG}; pg8::gemm_phase<pg8::EpiNull, pg8::StaticOrder, PG8_ALIGN, PG8_SP2>(lds + RING_OFF, g, S, E); }
#endif
    SEAM(2);
#define PHASE3 if (IN(3)) { pg8::Gemm g{XB, (const bf16*)(ws + WS_WIN), TOK, DIN, DMODEL}; pg8::StaticOrder S; S.init(TOK, DIN, G, cid); \
        pg8::EpiMix E{BIG, DIN, P16_1, args.in[13], args.in[14], VST}; pg8::gemm_phase<pg8::EpiMix, pg8::StaticOrder, PG8_ALIGN, PG8_SP2>(lds + RING_OFF, g, S, E); }
    PHASE3
#if DUP_PHASE == 3
    PHASE3
#endif
    SEAM(3);
    for (int rep_ = 0; rep_ < ((DUP_PHASE == 4 || DUP_PHASE == 40 || DUP_PHASE == 41) ? 2 : 1); ++rep_) if (IN(4)) {
        if (uni) {
            for (int k = xr; k < 64; k += 32) hg2_state_pass(lds, BIG, HGE, HGD, hg2_xcc_inst(xx, k), tid, lane, wave);
            for (int k = xr; k < 128; k += 32) gmlp_item(lds, BIG, VST, Y, SSG, args.in[8], args.in[9], args.in[10], args.in[11], 32 * xx + (k >> 2), k & 3, tid, lane, wave);
        } else {
        if (rep_ == 0 || DUP_PHASE != 41) for (int i = bx; i < 512; i += G) hg2_state_pass(lds, BIG, HGE, HGD, i, tid, lane, wave);
        if (rep_ == 0 || DUP_PHASE != 40) for (int it = bx; it < 1024; it += G) gmlp_item(lds, BIG, VST, Y, SSG, args.in[8], args.in[9], args.in[10], args.in[11], it >> 2, it & 3, tid, lane, wave);
        }
    }
    SEAM(4);
    for (int rep_ = 0; rep_ < ((DUP_PHASE == 5) ? 2 : 1); ++rep_) if (IN(5)) {
        if (uni) {
            const int h = xr & 3, sq = xr >> 2;
            const int seqid = xx < 4 ? 2 * xx + (sq >> 2) : 8 + (xx - 4), scf = xx < 4 ? (sq & 3) : sq, nsc = xx < 4 ? 4 : 8;
            hg2_out_pass(lds, BIG, OB1, HGE, HGD, hg2_index(seqid, h, 1, nsc - 1 - scf), tid, lane, wave);
            hg2_out_pass(lds, BIG, OB0, HGE, HGD, hg2_index(seqid, h, 0, scf), tid, lane, wave);
            asm volatile("s_waitcnt vmcnt(0)" ::: "memory"); __syncthreads();
            if (tid == 0) { asm volatile("buffer_inv sc1" ::: "memory"); asm volatile("s_waitcnt vmcnt(0)" ::: "memory"); }
            __syncthreads();
            hgrn_combine_local(OB0, OB1, BIG, args.in[15], Y, 4096 * xx + 512 * sq, h, tid);
            yg_fixup(SSG, args.in[12], Y, 4096 * xx, 4096 * xx + 4096, 8 * xr + wave, 256, lane);
        }
        else { for (int i = bx; i < 512; i += G) { const Hg2Inst I = hg2_decode(i); hg2_out_pass(lds, BIG, I.dir ? OB1 : OB0, HGE, HGD, i, tid, lane, wave); } }
    }
    if (!uni) SEAM(5);
    if (IN(6) && !uni) { if (uni) hgrn_combine(OB0, OB1, BIG, args.in[15], SSG, args.in[12], Y, 4096 * xx, 4096 * xx + 4096, 8 * xr + wave, 256, lane);
                 else hgrn_combine(OB0, OB1, BIG, args.in[15], SSG, args.in[12], Y, 0, TOK, gw, NGW, lane); }
    SEAM(6);
    if (IN(7)) { pg8::Gemm g{Y, (const bf16*)(ws + WS_WOUT), TOK, DMODEL, DMODEL}; pg8::StaticOrder S; S.init(TOK, DMODEL, G, cid);
        pg8::EpiResidBf<true> E{XB, P16_2, 1.0f};
        pg8::gemm_phase<pg8::EpiResidBf<true>, pg8::StaticOrder, PG8_ALIGN, PG8_SP2>(lds + RING_OFF, g, S, E); }
    SEAM(7);
    if (IN(8)) { pg8::Gemm g{XB, (const bf16*)(ws + WS_WGU2), TOK, 2 * DFF, DMODEL}; pg8::StaticOrder S; S.init(TOK, 2 * DFF, G, cid);
        pg8::EpiSwiGLU E{BIG, DFF, P16_2};
        pg8::gemm_phase<pg8::EpiSwiGLU, pg8::StaticOrder, PG8_ALIGN, PG8_SP2>(lds + RING_OFF, g, S, E); }
    SEAM(8);
    if (IN(9)) { pg8::Gemm g{BIG, (const bf16*)(ws + WS_WD2), TOK, DMODEL, DFF}; pg8::StaticOrder S; S.init(TOK, DMODEL, G, cid);
        pg8::EpiResidBf<false> E{XB, nullptr, 0.5f};
        pg8::gemm_phase<pg8::EpiResidBf<false>, pg8::StaticOrder, PG8_ALIGN, PG8_SP2>(lds + RING_OFF, g, S, E); }
    SEAM(9);
    if (IN(10)) { if (uni) final_norm(XB, args.out, args.in[21], 4096 * xx, 4096 * xx + 4096, 8 * xr + wave, 256, lane); else final_norm(XB, args.out, args.in[21], 0, TOK, gw, NGW, lane); }
#undef IN
#undef SEAM
}

extern "C" void kernel_launch(void* const* d_in, const int* in_sizes, int n_in, void* d_out, int out_size, void* d_ws, size_t ws_size, hipStream_t stream) {
    static int grid = 0;
    if (grid == 0) {
        if (n_in != 22 || out_size != TOK * DMODEL || ws_size < WS_END) { fprintf(stderr, "kernel_launch: unexpected problem (n_in %d, out %d, ws %zu); nothing launched\n", n_in, out_size, ws_size); grid = -1; return; }
        int dev = 0, cus = 0, per_cu = 0;
        if (hipGetDevice(&dev) != hipSuccess || hipDeviceGetAttribute(&cus, hipDeviceAttributeMultiprocessorCount, dev) != hipSuccess) { grid = -1; return; }
        if (hipFuncSetAttribute((const void*)fwd_kernel, hipFuncAttributeMaxDynamicSharedMemorySize, LDS_BYTES) != hipSuccess) { fprintf(stderr, "kernel_launch: hipFuncSetAttribute failed\n"); grid = -1; return; }
        if (hipOccupancyMaxActiveBlocksPerMultiprocessor(&per_cu, (const void*)fwd_kernel, NWAVES * 64, LDS_BYTES) != hipSuccess || per_cu < 1) { fprintf(stderr, "kernel_launch: occupancy query says %d blocks per CU; nothing launched\n", per_cu); (void)hipGetLastError(); grid = -1; return; }
        grid = cus;
    }
    if (grid < 0) return;
    if (hipMemsetAsync((char*)d_ws + WS_CTL, 0, CTL_ZERO_BYTES, stream) != hipSuccess) return;
    Args a{};
    for (int i = 0; i < 22; ++i) a.in[i] = (const float*)d_in[i];
    a.out = (float*)d_out; a.ws = (unsigned char*)d_ws;
    constexpr int NL = MK_N_LAUNCHES;
    for (int li = 0; li < NL; ++li) {
        a.ph_lo = (NL == 1) ? 0 : li; a.ph_hi = (NL == 1) ? N_PHASES : li + 1; a.li = 0;
        hipLaunchKernelGGL(fwd_kernel, dim3(grid), dim3(NWAVES * 64), LDS_BYTES, stream, a);
        if (hipPeekAtLastError() != hipSuccess) { fprintf(stderr, "kernel_launch: launch %d failed\n", li); break; }
    }
}
```

```cpp
#include <hip/hip_runtime.h>
#include <cstdio>
#include <cstdint>
namespace pg8 {
#define PG8_LAS __attribute__((address_space(3)))
typedef unsigned short bf16_t;
typedef short bf16x8 __attribute__((ext_vector_type(8)));
typedef float f32x4 __attribute__((ext_vector_type(4)));
typedef unsigned u32x4 __attribute__((ext_vector_type(4)));
constexpr int BM = 256, BK = 64, HALF = 128, HTB = HALF * BK * 2  , STAGE_BYTES = 8 * HTB, NXCD = 8, WGM = 8;

__host__ __device__ __forceinline__ int lds_byte(int r, int c) { const int st = (r >> 4) * 2 + (c >> 5), rr = r & 15, cc = c & 31, ob = rr * 64 + cc * 2; return st * 1024 + (ob ^ (((ob >> 9) & 1) << 5)); }
__host__ __device__ __forceinline__ void stage_rc(int b, int& R, int& C) { const int st = b / 1024, sb = b % 1024, swz = sb ^ (((sb >> 9) & 1) << 5); R = (st >> 1) * 16 + swz / 64; C = (st & 1) * 32 + (swz % 64) / 2; }
__host__ __device__ __forceinline__ int perm32(int rho) { const int n = rho >> 4, i = rho & 15; return 8 * (i >> 2) + 4 * n + (i & 3); }

struct Unit { int pm, pn; };
struct Gemm { const bf16_t* A; const bf16_t* Bt; int M, N, K; };

struct StaticOrder {
    int nM, nN, nwg, G, c;
    __host__ __device__ void init(int M, int N, int G_, int c_) { nM = M / BM; nN = N / BM; nwg = nM * nN; G = G_; c = c_; }
    __host__ __device__ bool next(int i, Unit& u) const {
        const long L = (long)i * G + c; if (L >= nwg) return false;
        int wgid = (int)L; { const int q = nwg / NXCD, r = nwg % NXCD, xcd = wgid % NXCD, off = wgid / NXCD; wgid = (xcd < r ? xcd * (q + 1) : r * (q + 1) + (xcd - r) * q) + off; }
        const int nig = WGM * nN, gid = wgid / nig, fm = gid * WGM, gsz = (nM - fm) < WGM ? (nM - fm) : WGM;
        u.pm = fm + ((wgid % nig) % gsz); u.pn = (wgid % nig) / gsz; return true;
    }
    __device__ __forceinline__ void a_ready(const Unit&) const {}
    __device__ __forceinline__ void done(const Unit&) const {}
};

typedef __bf16 bf16x2_hw __attribute__((ext_vector_type(2)));
typedef float f32x2_hw __attribute__((ext_vector_type(2)));
__device__ __forceinline__ unsigned cvt_pk_bf16(float lo, float hi) { const f32x2_hw v = {lo, hi}; const bf16x2_hw b = __builtin_convertvector(v, bf16x2_hw); return __builtin_bit_cast(unsigned, b); }
typedef float f32x2 __attribute__((ext_vector_type(2)));
__device__ __forceinline__ f32x2 gelu_pk(f32x2 v) {
    const f32x2 av = __builtin_elementwise_abs(v), d = av * 0.2316418882f + 1.0f;
    f32x2 t; t.x = __builtin_amdgcn_rcpf(d.x); t.y = __builtin_amdgcn_rcpf(d.y);
    f32x2 q = t * 0.5307027145f + (-0.7265760135f); q = q * t + 0.7107068705f; q = q * t + (-0.142248368f); q = q * t + 0.127414796f; q = q * t;
    const f32x2 s = (v * v) * (-0.72134752044f);
    f32x2 e; e.x = __builtin_amdgcn_exp2f(s.x); e.y = __builtin_amdgcn_exp2f(s.y);
    const f32x2 m = v * (q * e), r = v - m;
    f32x2 o; o.x = v.x < 0.f ? m.x : r.x; o.y = v.y < 0.f ? m.y : r.y; return o;
}

constexpr float RMS_EPS = 1e-6f;
constexpr int DM = 1024;
__device__ __forceinline__ float row_rstd(const float* p16, int row, int fq) {
    const f32x4 v = *(const f32x4*)(p16 + (size_t)row * 16 + 4 * fq);
    float s = (v[0] + v[1]) + (v[2] + v[3]);
    s += __shfl_xor(s, 16); s += __shfl_xor(s, 32);
    return __builtin_amdgcn_rsqf(s * (1.0f / DM) + RMS_EPS);
}
__device__ __forceinline__ void row_rstd8(const float* p16, int row0, int fq, float (&rr)[8]) {
    f32x4 pv[8];
#pragma unroll
    for (int i = 0; i < 8; ++i) pv[i] = *(const f32x4*)(p16 + (size_t)(row0 + (i >> 2) * HALF + (i & 3) * 16) * 16 + 4 * fq);
#pragma unroll
    for (int i = 0; i < 8; ++i) { float s = (pv[i][0] + pv[i][1]) + (pv[i][2] + pv[i][3]); s += __shfl_xor(s, 16); s += __shfl_xor(s, 32); rr[i] = __builtin_amdgcn_rsqf(s * (1.0f / DM) + RMS_EPS); }
}
__device__ __forceinline__ void row_rstd8_cached(const float* p16, int pm, int wr, int fr, int fq, int stage, PG8_LAS unsigned char* rc, float (&rr)[8]) {
    const unsigned want = (unsigned)(stage * 256 + pm + 1);
    const unsigned tag = *(volatile PG8_LAS unsigned*)(rc + 512);
    if (__builtin_amdgcn_readfirstlane(tag) != want) {
        const int lane = fq * 16 + fr;
#pragma unroll
        for (int q = 0; q < 2; ++q) { const int li = lane + 64 * q; const int row = pm * BM + (li >> 6) * HALF + wr * 64 + (li & 63);
            const f32x4 a = *(const f32x4*)(p16 + (size_t)row * 16), b = *(const f32x4*)(p16 + (size_t)row * 16 + 4), c = *(const f32x4*)(p16 + (size_t)row * 16 + 8), d = *(const f32x4*)(p16 + (size_t)row * 16 + 12);
            const float s = (((a[0] + a[1]) + (a[2] + a[3])) + ((b[0] + b[1]) + (b[2] + b[3]))) + (((c[0] + c[1]) + (c[2] + c[3])) + ((d[0] + d[1]) + (d[2] + d[3])));
            *(PG8_LAS float*)(rc + li * 4) = __builtin_amdgcn_rsqf(s * (1.0f / DM) + RMS_EPS); }
        if (lane == 0) *(volatile PG8_LAS unsigned*)(rc + 512) = want;
        asm volatile("s_waitcnt lgkmcnt(0)" ::: "memory");
    }
#pragma unroll
    for (int i = 0; i < 8; ++i) rr[i] = *(const PG8_LAS float*)(rc + ((i >> 2) * 64 + (i & 3) * 16 + fr) * 4);
}
__device__ __forceinline__ float fast_sigmoid(float z) { return __builtin_amdgcn_rcpf(1.0f + __builtin_amdgcn_exp2f(-1.44269504089f * z)); }

struct EpiSwiGLU {
    static constexpr bool PERM = true, AFTER_DRAIN = false;
    bf16_t* O; int ldo; const float* p16; PG8_LAS unsigned char* rcb; int stage;
    __device__ __forceinline__ void operator()(const f32x4 (&acc)[2][2][4][2], const Unit& u, int wr, int wc, int fr, int fq) const {
        const int row0 = u.pm * BM + wr * 64 + fr, col0 = u.pn * HALF + wc * 32 + 8 * fq;
        float rr[8];
        row_rstd8_cached(p16, u.pm, wr, fr, fq, stage, rcb + (wr * 4 + wc) * 528, rr);
#pragma unroll
        for (int ai = 0; ai < 2; ++ai)
#pragma unroll
            for (int m = 0; m < 4; ++m) {
                const int row = row0 + ai * HALF + m * 16;
                const float r = rr[ai * 4 + m];
                float h[8];
#pragma unroll
                for (int n = 0; n < 2; ++n)
#pragma unroll
                    for (int e = 0; e < 4; ++e) { const float g = acc[ai][0][m][n][e] * r, up = acc[ai][1][m][n][e] * r; h[4 * n + e] = g * up * fast_sigmoid(g); }
                u32x4 w; w.x = cvt_pk_bf16(h[0], h[1]); w.y = cvt_pk_bf16(h[2], h[3]); w.z = cvt_pk_bf16(h[4], h[5]); w.w = cvt_pk_bf16(h[6], h[7]);
                *(u32x4*)(O + (size_t)row * ldo + col0) = w;
            }
    }
};

template <bool WANT_BF16, bool WANT_SS> struct EpiResid {
    static constexpr bool PERM = true, AFTER_DRAIN = false;
    const float* base0; const float* base1;
    float* out; bf16_t* xb; float* p16; float alpha;
    __device__ __forceinline__ void operator()(const f32x4 (&acc)[2][2][4][2], const Unit& u, int wr, int wc, int fr, int fq) const {
        const int row0 = u.pm * BM + wr * 64 + fr, col0 = u.pn * BM + wc * 32 + 8 * fq;
        const float* bp = (u.pm < 64) ? base0 : base1; const int brow = (u.pm < 64) ? 0 : 16384;
        f32x4 bcur[4], bnxt[4];
#define RESID_LOAD(dst, it) do { const size_t bo_ = (size_t)(row0 + ((it) >> 2) * HALF + ((it) & 3) * 16 - brow) * DM + col0; \
            dst[0] = *(const f32x4*)(bp + bo_); dst[1] = *(const f32x4*)(bp + bo_ + 4); dst[2] = *(const f32x4*)(bp + bo_ + HALF); dst[3] = *(const f32x4*)(bp + bo_ + HALF + 4); } while (0)
        RESID_LOAD(bcur, 0);
#pragma unroll
        for (int it = 0; it < 8; ++it) {
            const int ai = it >> 2, m = it & 3;
            if (it + 1 < 8) RESID_LOAD(bnxt, it + 1);
            const int row = row0 + ai * HALF + m * 16; const size_t off = (size_t)row * DM + col0;
            float ss = 0.f;
#pragma unroll
            for (int bj = 0; bj < 2; ++bj) {
                const f32x4 v0 = bcur[2 * bj] + acc[ai][bj][m][0] * alpha, v1 = bcur[2 * bj + 1] + acc[ai][bj][m][1] * alpha;
                *(f32x4*)(out + off + bj * HALF) = v0; *(f32x4*)(out + off + bj * HALF + 4) = v1;
                if (WANT_BF16) { u32x4 w; w.x = cvt_pk_bf16(v0[0], v0[1]); w.y = cvt_pk_bf16(v0[2], v0[3]); w.z = cvt_pk_bf16(v1[0], v1[1]); w.w = cvt_pk_bf16(v1[2], v1[3]);
                    *(u32x4*)(xb + off + bj * HALF) = w; }
                if (WANT_SS) ss += ((v0[0] * v0[0] + v0[1] * v0[1]) + (v0[2] * v0[2] + v0[3] * v0[3])) + ((v1[0] * v1[0] + v1[1] * v1[1]) + (v1[2] * v1[2] + v1[3] * v1[3]));
            }
            if (WANT_SS) { ss += __shfl_xor(ss, 16); ss += __shfl_xor(ss, 32); if (fq == 0) p16[(size_t)row * 16 + 4 * u.pn + wc] = ss; }
#pragma unroll
            for (int q = 0; q < 4; ++q) bcur[q] = bnxt[q];
            asm volatile("" ::: "memory");
        }
#undef RESID_LOAD
    }
};

template <bool WANT_SS> struct EpiResidBf {
    static constexpr bool PERM = true, AFTER_DRAIN = false;
    bf16_t* xb; float* p16; float alpha;
    __device__ __forceinline__ void operator()(const f32x4 (&acc)[2][2][4][2], const Unit& u, int wr, int wc, int fr, int fq) const {
        const int row0 = u.pm * BM + wr * 64 + fr, col0 = u.pn * BM + wc * 32 + 8 * fq;
        u32x4 bcur[2], bnxt[2];
#define RESB_LOAD(dst, it) do { const size_t bo_ = (size_t)(row0 + ((it) >> 2) * HALF + ((it) & 3) * 16) * DM + col0; dst[0] = *(const u32x4*)(xb + bo_); dst[1] = *(const u32x4*)(xb + bo_ + HALF); } while (0)
        RESB_LOAD(bcur, 0);
#pragma unroll
        for (int it = 0; it < 8; ++it) {
            const int ai = it >> 2, m = it & 3;
            if (it + 1 < 8) RESB_LOAD(bnxt, it + 1);
            const int row = row0 + ai * HALF + m * 16; const size_t off = (size_t)row * DM + col0;
            float ss = 0.f;
#pragma unroll
            for (int bj = 0; bj < 2; ++bj) {
                const u32x4 b = bcur[bj];
                const f32x4 b0 = {__builtin_bit_cast(float, b.x << 16), __builtin_bit_cast(float, b.x & 0xffff0000u), __builtin_bit_cast(float, b.y << 16), __builtin_bit_cast(float, b.y & 0xffff0000u)};
                const f32x4 b1 = {__builtin_bit_cast(float, b.z << 16), __builtin_bit_cast(float, b.z & 0xffff0000u), __builtin_bit_cast(float, b.w << 16), __builtin_bit_cast(float, b.w & 0xffff0000u)};
                const f32x4 v0 = b0 + acc[ai][bj][m][0] * alpha, v1 = b1 + acc[ai][bj][m][1] * alpha;
                u32x4 w; w.x = cvt_pk_bf16(v0[0], v0[1]); w.y = cvt_pk_bf16(v0[2], v0[3]); w.z = cvt_pk_bf16(v1[0], v1[1]); w.w = cvt_pk_bf16(v1[2], v1[3]);
                *(u32x4*)(xb + off + bj * HALF) = w;
                if (WANT_SS) ss += ((v0[0] * v0[0] + v0[1] * v0[1]) + (v0[2] * v0[2] + v0[3] * v0[3])) + ((v1[0] * v1[0] + v1[1] * v1[1]) + (v1[2] * v1[2] + v1[3] * v1[3]));
            }
            if (WANT_SS) { ss += __shfl_xor(ss, 16); ss += __shfl_xor(ss, 32); if (fq == 0) p16[(size_t)row * 16 + 4 * u.pn + wc] = ss; }
            bcur[0] = bnxt[0]; bcur[1] = bnxt[1];
            asm volatile("" ::: "memory");
        }
#undef RESB_LOAD
    }
};
struct EpiNull { static constexpr bool PERM = true, AFTER_DRAIN = false; float* sink;
    __device__ __forceinline__ void operator()(const f32x4 (&acc)[2][2][4][2], const Unit& u, int wr, int wc, int fr, int fq) const {
        float s = 0.f;
#pragma unroll
        for (int ai = 0; ai < 2; ++ai)
#pragma unroll
            for (int bj = 0; bj < 2; ++bj)
#pragma unroll
                for (int m = 0; m < 4; ++m)
#pragma unroll
                    for (int n = 0; n < 2; ++n) s += acc[ai][bj][m][n][0] + acc[ai][bj][m][n][1] + acc[ai][bj][m][n][2] + acc[ai][bj][m][n][3];
        if (s == 12345.678f) sink[0] = s;
    } };
struct EpiMix {
    static constexpr bool PERM = true, AFTER_DRAIN = false;
    bf16_t* P; int ldp; const float* p16; const float* lbf; const float* lbb;
    PG8_LAS unsigned char* rcb; int stage;
    float* vstat;
    template <int ACT> __device__ __forceinline__ void run(const f32x4 (&acc)[2][2][4][2], const Unit& u, int wr, int wc, int fr, int fq) const {
        const int row0 = u.pm * BM + wr * 64 + fr, col0 = u.pn * BM + wc * 32 + 8 * fq;
        float oml[2][8];
        if (ACT == 3) { const float* lb = ((u.pn >> 1) == 4) ? lbf : lbb; const int c0 = (u.pn & 1) * BM + wc * 32 + 8 * fq;
#pragma unroll
            for (int bj = 0; bj < 2; ++bj)
#pragma unroll
                for (int e = 0; e < 8; ++e) { const float a0 = lb[c0 + bj * HALF + e], a1 = lb[512 + c0 + bj * HALF + e]; oml[bj][e] = fast_sigmoid(a1 - a0);
#ifdef DBG_OML
                    oml[bj][e] = 0.5f;
#endif
                } }
        float rr[8];
        row_rstd8_cached(p16, u.pm, wr, fr, fq, stage, rcb + (wr * 4 + wc) * 528, rr);
#pragma unroll
        for (int ai = 0; ai < 2; ++ai)
#pragma unroll
            for (int m = 0; m < 4; ++m) {
                const int row = row0 + ai * HALF + m * 16;
                const float r = rr[ai * 4 + m];
                float vs = 0.f, vq = 0.f;
#pragma unroll
                for (int bj = 0; bj < 2; ++bj) {
                    float h[8];
#pragma unroll
                    for (int n = 0; n < 2; ++n) {
                        const f32x4 z = acc[ai][bj][m][n] * r;
                        if (ACT == 0) { const f32x2 a = gelu_pk((f32x2){z[0], z[1]}), b = gelu_pk((f32x2){z[2], z[3]}); h[4 * n] = a.x; h[4 * n + 1] = a.y; h[4 * n + 2] = b.x; h[4 * n + 3] = b.y; }
                        else if (ACT == 1) {
#pragma unroll
                            for (int e = 0; e < 4; ++e) h[4 * n + e] = z[e] * fast_sigmoid(z[e]); }
                        else if (ACT == 2) {
#pragma unroll
                            for (int e = 0; e < 4; ++e) h[4 * n + e] = z[e]; }
                        else {
#pragma unroll
                            for (int e = 0; e < 4; ++e) { const float kk = oml[bj][4 * n + e] * __builtin_amdgcn_rcpf(1.0f + __builtin_amdgcn_exp2f(1.44269504089f * z[e]));
                                h[4 * n + e] = __builtin_amdgcn_logf(1.0f - kk); }
                        }
                    }
                    u32x4 w; w.x = cvt_pk_bf16(h[0], h[1]); w.y = cvt_pk_bf16(h[2], h[3]); w.z = cvt_pk_bf16(h[4], h[5]); w.w = cvt_pk_bf16(h[6], h[7]);
                    *(u32x4*)(P + (size_t)row * ldp + col0 + bj * HALF) = w;
                    if (ACT == 0) { vs += ((h[0] + h[1]) + (h[2] + h[3])) + ((h[4] + h[5]) + (h[6] + h[7]));
                        vq += ((h[0] * h[0] + h[1] * h[1]) + (h[2] * h[2] + h[3] * h[3])) + ((h[4] * h[4] + h[5] * h[5]) + (h[6] * h[6] + h[7] * h[7])); }
                }
                if (ACT == 0 && (u.pn >> 1) == 1) {
                    vs += __shfl_xor(vs, 16); vs += __shfl_xor(vs, 32); vq += __shfl_xor(vq, 16); vq += __shfl_xor(vq, 32);
                    if (fq == 0) *(f32x2*)(vstat + ((size_t)row * 8 + 4 * (u.pn & 1) + wc) * 2) = (f32x2){vs, vq}; }
            }
    }
    __device__ __forceinline__ void operator()(const f32x4 (&acc)[2][2][4][2], const Unit& u, int wr, int wc, int fr, int fq) const {
        const int seg = u.pn >> 1;
        if (seg <= 1) run<0>(acc, u, wr, wc, fr, fq);
        else if (seg == 2 || seg == 6) run<1>(acc, u, wr, wc, fr, fq);
        else if (seg == 3) run<2>(acc, u, wr, wc, fr, fq);
        else run<3>(acc, u, wr, wc, fr, fq);
    }
};

template <class Epi, class Sched, bool ALIGN_EPI = false, bool SP2 = false>
__device__ __forceinline__ void gemm_phase(PG8_LAS unsigned char* lds, const Gemm g, const Sched& S, const Epi& E) {
    const int tid = threadIdx.x, wid = __builtin_amdgcn_readfirstlane(tid >> 6), lane = tid & 63, wr = wid >> 2, wc = wid & 3, fr = lane & 15, fq = lane >> 4;
    const int K = g.K, nt = K / BK;
    unsigned voffA[2], voffB[2];
#pragma unroll
    for (int i = 0; i < 2; ++i) { int R, C; stage_rc(tid * 16 + i * 8192, R, C); const int Rb = Epi::PERM ? ((R & ~31) + perm32(R & 31)) : R;
        voffA[i] = (unsigned)(R * K + C) * 2u; voffB[i] = (unsigned)(Rb * K + C) * 2u; }
    const size_t kstep = (size_t)(BK * 2);
    const size_t hstep = (size_t)HALF * K * 2;
    const size_t tstep = 2 * hstep;
    const unsigned ldsw = (unsigned)wid * 1024u;
    const int aoff = lds_byte(wr * 64 + fr, fq * 8), boff = lds_byte(wc * 32 + fr, fq * 8);
#define PG8_SA(b, h) (((b) * 2 + (h)) * HTB)
#define PG8_SB(b, h) ((4 + (b) * 2 + (h)) * HTB)
#define PG8_STAGE(bufoff, gbase, voff) do { _Pragma("unroll") for (int _i = 0; _i < 2; ++_i) \
        __builtin_amdgcn_global_load_lds((const unsigned*)((const char*)(gbase) + (voff)[_i]), (PG8_LAS unsigned*)(lds + (bufoff) + ldsw + _i * 8192), 16, 0, 0); } while (0)
#define PG8_LDA(dst, b, h) do { _Pragma("unroll") for (int m = 0; m < 4; ++m) _Pragma("unroll") for (int k = 0; k < 2; ++k) dst[m][k] = *(const PG8_LAS bf16x8*)(lds + PG8_SA(b, h) + aoff + m * 2048 + k * 1024); } while (0)
#define PG8_LDB(dst, b, h) do { _Pragma("unroll") for (int n = 0; n < 2; ++n) _Pragma("unroll") for (int k = 0; k < 2; ++k) dst[n][k] = *(const PG8_LAS bf16x8*)(lds + PG8_SB(b, h) + boff + n * 2048 + k * 1024); } while (0)
#define PG8_MMA(ai, bj, At, Bt) do { __builtin_amdgcn_s_setprio(1); _Pragma("unroll") for (int m = 0; m < 4; ++m) _Pragma("unroll") for (int n = 0; n < 2; ++n) _Pragma("unroll") for (int k = 0; k < 2; ++k) \
        acc[ai][bj][m][n] = __builtin_amdgcn_mfma_f32_16x16x32_bf16(Bt[n][k], At[m][k], acc[ai][bj][m][n], 0, 0, 0); __builtin_amdgcn_s_setprio(0); } while (0)
#define PG8_WAIT_V(n) asm volatile("s_waitcnt vmcnt(" #n ")" ::: "memory")
#define PG8_WAIT_L(n) asm volatile("s_waitcnt lgkmcnt(" #n ")" ::: "memory")
#define PG8_BAR __builtin_amdgcn_s_barrier()
#define PG8_SCHED __builtin_amdgcn_sched_barrier(0)
    Unit cur, nxt; int ui = 0;
    if (!S.next(0, cur)) return;
    f32x4 acc[2][2][4][2];
#pragma unroll
    for (int a = 0; a < 2; ++a)
#pragma unroll
        for (int b = 0; b < 2; ++b)
#pragma unroll
            for (int m = 0; m < 4; ++m)
#pragma unroll
                for (int n = 0; n < 2; ++n) acc[a][b][m][n] = (f32x4){0.f, 0.f, 0.f, 0.f};
    bf16x8 At[4][2], B0[2][2], B1[2][2];
    const char* cA = (const char*)g.A + (size_t)cur.pm * tstep; const char* cB = (const char*)g.Bt + (size_t)cur.pn * tstep;
    S.a_ready(cur);
    if constexpr (SP2) {
        PG8_STAGE(PG8_SB(0, 0), cB, voffB); PG8_STAGE(PG8_SB(0, 1), cB + hstep, voffB); PG8_STAGE(PG8_SA(0, 0), cA, voffA); PG8_STAGE(PG8_SA(0, 1), cA + hstep, voffA);
        if (wr == 1) PG8_BAR;
        PG8_WAIT_V(2); PG8_BAR;
        PG8_STAGE(PG8_SB(1, 0), cB + kstep, voffB); PG8_STAGE(PG8_SA(1, 0), cA + kstep, voffA); PG8_STAGE(PG8_SB(1, 1), cB + hstep + kstep, voffB);
        PG8_WAIT_V(6); PG8_BAR;
    } else {
        PG8_STAGE(PG8_SB(0, 0), cB, voffB); PG8_STAGE(PG8_SA(0, 0), cA, voffA); PG8_STAGE(PG8_SB(0, 1), cB + hstep, voffB); PG8_STAGE(PG8_SA(0, 1), cA + hstep, voffA);
        if (wr == 1) PG8_BAR;
        PG8_WAIT_V(4); PG8_BAR;
        PG8_STAGE(PG8_SB(1, 0), cB + kstep, voffB); PG8_STAGE(PG8_SA(1, 0), cA + kstep, voffA); PG8_STAGE(PG8_SB(1, 1), cB + hstep + kstep, voffB);
        PG8_WAIT_V(6); PG8_BAR;
    }
    for (;;) {
        const bool has_next = S.next(ui + 1, nxt);
        const char* nA = has_next ? (const char*)g.A + (size_t)nxt.pm * tstep : cA; const char* nB = has_next ? (const char*)g.Bt + (size_t)nxt.pn * tstep : cB;
        for (int t = 0; t < nt; t += 2) {
            const bool last = (t == nt - 2);
            const char* a1 = cA + (size_t)(t + 1) * kstep;
            const char* a2 = last ? nA : cA + (size_t)(t + 2) * kstep; const char* b2 = last ? nB : cB + (size_t)(t + 2) * kstep;
            const char* a3 = a2 + kstep; const char* b3 = b2 + kstep;
            if (last && has_next) S.a_ready(nxt);
            if constexpr (SP2) {
            PG8_LDB(B0, 0, 0); PG8_LDB(B1, 0, 1); PG8_SCHED; PG8_LDA(At, 0, 0); PG8_STAGE(PG8_SA(1, 1), a1 + hstep, voffA);
            PG8_WAIT_V(8); PG8_WAIT_L(0); PG8_BAR; PG8_MMA(0, 0, At, B0); PG8_MMA(0, 1, At, B1); PG8_BAR; PG8_SCHED;
            PG8_LDA(At, 0, 1); PG8_STAGE(PG8_SB(0, 0), b2, voffB); PG8_STAGE(PG8_SB(0, 1), b2 + hstep, voffB); PG8_STAGE(PG8_SA(0, 0), a2, voffA);
            PG8_WAIT_V(8); PG8_WAIT_L(0); PG8_BAR; PG8_MMA(1, 0, At, B0); PG8_MMA(1, 1, At, B1); PG8_BAR; PG8_SCHED;
            PG8_LDB(B0, 1, 0); PG8_LDB(B1, 1, 1); PG8_SCHED; PG8_LDA(At, 1, 0); PG8_STAGE(PG8_SA(0, 1), a2 + hstep, voffA);
            PG8_WAIT_V(8); PG8_WAIT_L(0); PG8_BAR; PG8_MMA(0, 0, At, B0); PG8_MMA(0, 1, At, B1); PG8_BAR; PG8_SCHED;
            PG8_LDA(At, 1, 1); PG8_STAGE(PG8_SB(1, 0), b3, voffB); PG8_STAGE(PG8_SB(1, 1), b3 + hstep, voffB); PG8_STAGE(PG8_SA(1, 0), a3, voffA);
            PG8_WAIT_V(8); PG8_WAIT_L(0); PG8_BAR; PG8_MMA(1, 0, At, B0); PG8_MMA(1, 1, At, B1); PG8_BAR; PG8_SCHED;
            } else {
            PG8_LDB(B0, 0, 0); PG8_SCHED; PG8_LDA(At, 0, 0); PG8_STAGE(PG8_SA(1, 1), a1 + hstep, voffA);
            PG8_WAIT_L(8); PG8_BAR; PG8_WAIT_L(0); PG8_MMA(0, 0, At, B0); PG8_BAR; PG8_SCHED;
            PG8_LDB(B1, 0, 1); PG8_STAGE(PG8_SB(0, 0), b2, voffB);
            PG8_BAR; PG8_WAIT_L(0); PG8_MMA(0, 1, At, B1); PG8_BAR;
            PG8_LDA(At, 0, 1); PG8_STAGE(PG8_SA(0, 0), a2, voffA);
            PG8_BAR; PG8_WAIT_L(0); PG8_MMA(1, 0, At, B0); PG8_BAR; PG8_SCHED;
            PG8_STAGE(PG8_SB(0, 1), b2 + hstep, voffB);
            PG8_WAIT_V(6); PG8_BAR; PG8_MMA(1, 1, At, B1); PG8_BAR;
            PG8_LDB(B0, 1, 0); PG8_SCHED; PG8_LDA(At, 1, 0); PG8_STAGE(PG8_SA(0, 1), a2 + hstep, voffA);
            PG8_WAIT_L(8); PG8_BAR; PG8_WAIT_L(0); PG8_MMA(0, 0, At, B0); PG8_BAR; PG8_SCHED;
            PG8_LDB(B1, 1, 1); PG8_STAGE(PG8_SB(1, 0), b3, voffB);
            PG8_BAR; PG8_WAIT_L(0); PG8_MMA(0, 1, At, B1); PG8_BAR;
            PG8_LDA(At, 1, 1); PG8_STAGE(PG8_SA(1, 0), a3, voffA);
            PG8_BAR; PG8_WAIT_L(0); PG8_MMA(1, 0, At, B0); PG8_BAR; PG8_SCHED;
            PG8_STAGE(PG8_SB(1, 1), b3 + hstep, voffB);
            PG8_WAIT_V(6); PG8_BAR; PG8_MMA(1, 1, At, B1); PG8_BAR;
            }
        }
        if constexpr (ALIGN_EPI) { if (wr == 0) PG8_BAR; }
        if constexpr (!Epi::AFTER_DRAIN) { E(acc, cur, wr, wc, fr, fq); S.done(cur); }
        if (!has_next) break;
#pragma unroll
        for (int a = 0; a < 2; ++a)
#pragma unroll
            for (int b = 0; b < 2; ++b)
#pragma unroll
                for (int m = 0; m < 4; ++m)
#pragma unroll
                    for (int n = 0; n < 2; ++n) acc[a][b][m][n] = (f32x4){0.f, 0.f, 0.f, 0.f};
        cur = nxt; cA = nA; cB = nB; ++ui;
        if constexpr (ALIGN_EPI) { if (wr == 1) PG8_BAR; }
    }
    PG8_WAIT_V(0);
    if constexpr (!ALIGN_EPI) { if (wr == 0) PG8_BAR; }
    PG8_BAR;
    if constexpr (Epi::AFTER_DRAIN) { E.fused(acc, cur, wr, wc, fr, fq, lds, wid, lane); S.done(cur); }
#undef PG8_SA
#undef PG8_SB
#undef PG8_STAGE
#undef PG8_LDA
#undef PG8_LDB
#undef PG8_MMA
#undef PG8_WAIT_V
#undef PG8_WAIT_L
#undef PG8_BAR
#undef PG8_SCHED
}
}

#ifndef PG8_SP2
#define PG8_SP2 true
#endif
#ifndef PG8_ALIGN
#define PG8_ALIGN true
#endif
constexpr int NWAVES = 8;
constexpr int TOK = 32768, NPROMPT = 16384;
constexpr int DMODEL = 1024, DFF = 2816, DIN = 3584;
constexpr int COL_U = 0, COL_V = 512, COL_Q = 1024, COL_I = 1536, COL_FF = 2048, COL_FB = 2560, COL_G = 3072;
constexpr float EPS = 1e-6f;
constexpr size_t MiB = 1u << 20;
constexpr size_t WS_CTL = 0, CTL_ZERO_BYTES = 1 * MiB;
constexpr size_t WS_SSG = 1 * MiB;
constexpr size_t WS_P16 = 2 * MiB;
constexpr size_t WS_WGU1 = 8 * MiB, WS_WD1 = 19 * MiB, WS_WIN = 25 * MiB, WS_WOUT = 32 * MiB, WS_WGU2 = 34 * MiB, WS_WD2 = 45 * MiB;
constexpr size_t WS_BUFA = 52 * MiB;
constexpr size_t WS_BUFB = 116 * MiB;
constexpr size_t WS_BIG = 180 * MiB;
constexpr size_t WS_OB1 = 404 * MiB;
constexpr size_t WS_HGE = 468 * MiB;
constexpr size_t WS_HGD = 500 * MiB;
constexpr size_t WS_END = 501 * MiB;
static_assert(WS_WGU1 + (size_t)2 * DFF * DMODEL * 2 <= WS_WD1 && WS_WD1 + (size_t)DMODEL * DFF * 2 <= WS_WIN && WS_WIN + (size_t)DIN * DMODEL * 2 <= WS_WOUT && WS_WOUT + (size_t)DMODEL * DMODEL * 2 <= WS_WGU2
              && WS_WGU2 + (size_t)2 * DFF * DMODEL * 2 <= WS_WD2 && WS_WD2 + (size_t)DMODEL * DFF * 2 <= WS_BUFA && WS_BUFA + (size_t)TOK * DMODEL * 2 <= WS_BUFB && WS_BUFB + (size_t)TOK * DMODEL * 2 <= WS_BIG
              && WS_BIG + (size_t)TOK * DIN * 2 <= WS_OB1 && WS_OB1 + (size_t)TOK * 512 * 4 <= WS_HGE && WS_HGE + (size_t)512 * 65536 <= WS_HGD && WS_P16 + 3 * 2 * MiB <= WS_WGU1, "d_ws map");
constexpr int CW_BAR = 4096;
constexpr int RING_OFF = 0, RING_BYTES = 131072;
constexpr int LDSCTL_OFF = RING_BYTES, MISC_OFF = LDSCTL_OFF + 320;
constexpr int LDS_BYTES = 147456;
constexpr int RC_OFF = LDSCTL_OFF + 1024;
static_assert(MISC_OFF + 128 <= LDS_BYTES, "LDS map");

#define GAS __attribute__((address_space(1)))
#define LAS __attribute__((address_space(3)))
typedef unsigned short bf16;
typedef unsigned v4u __attribute__((ext_vector_type(4)));
typedef float f32x4 __attribute__((ext_vector_type(4)));
typedef short bf16x8 __attribute__((ext_vector_type(8)));
typedef GAS unsigned gu32;
typedef GAS unsigned long long gu64;
#define RLX_AGENT __ATOMIC_RELAXED, __HIP_MEMORY_SCOPE_AGENT
#define LDS_WAIT() asm volatile("s_waitcnt lgkmcnt(0)" ::: "memory")
#define VM_WAIT() asm volatile("s_waitcnt vmcnt(0)" ::: "memory")
__device__ __forceinline__ unsigned long long rt() { return __builtin_amdgcn_s_memrealtime(); }
__device__ __forceinline__ unsigned f2bf(float f) { unsigned u = __builtin_bit_cast(unsigned, f); return (u + 0x7fffu + ((u >> 16) & 1u)) >> 16; }
__device__ __forceinline__ unsigned pk2(float lo, float hi) { return f2bf(lo) | (f2bf(hi) << 16); }

#define XB_TMO      128
#define XB_XCNT(j)  (256  + 64 * (j))
#define XB_XSUB(j)  (1280 + 64 * (j))
#define XB_XGEN(j)  (2304 + 64 * (j))
#define XB_TOP      3328
#define XB_TOPGEN   3392
#define XCD_BAR_WORDS 3456
#define XB_SPIN_CAP (1u << 18)

__device__ __forceinline__ unsigned xb_ld(unsigned* p)              { return __hip_atomic_load(p, __ATOMIC_RELAXED, __HIP_MEMORY_SCOPE_AGENT); }
__device__ __forceinline__ unsigned xb_add(unsigned* p, unsigned v) { return __hip_atomic_fetch_add(p, v, __ATOMIC_RELAXED, __HIP_MEMORY_SCOPE_AGENT); }
__device__ __forceinline__ unsigned xb_xcc_id() { return (unsigned)__builtin_amdgcn_s_getreg((3 << 11) | 20) & 0xFu; }
#define XB_SPIN(cond, bar) do { unsigned _sp = 0; while (cond) { __builtin_amdgcn_s_sleep(1); \
    if ((++_sp & 255u) == 0u) { if (xb_ld(&(bar)[XB_TMO])) break; if (_sp > XB_SPIN_CAP) { atomicAdd(&(bar)[XB_TMO], 1u); break; } } } } while (0)

struct XcdBarrier {
    unsigned* bar; unsigned x;
    volatile LAS unsigned* st;
};

__device__ __forceinline__ XcdBarrier xcd_barrier_post(unsigned* bar, volatile LAS unsigned* st) {
    XcdBarrier b; b.bar = bar; b.x = xb_xcc_id(); b.st = st;
    if (threadIdx.x == 0) st[3] = xb_add(&bar[XB_XCNT(b.x)], 1u);
    return b;
}
__device__ __forceinline__ void xcd_barrier_complete(unsigned* bar, unsigned x, unsigned& nloc, unsigned& nx) {
    const unsigned G = gridDim.x * gridDim.y * gridDim.z;
    unsigned sum, cnt, mine, sp = 0u;
    for (;;) {
        sum = 0u; cnt = 0u; mine = 0u;
#pragma unroll
        for (unsigned j = 0; j < 16; ++j) { const unsigned c = xb_ld(&bar[XB_XCNT(j)]); sum += c; cnt += (c > 0u) ? 1u : 0u; mine = (j == x) ? c : mine; }
        if (sum == G) break;
        __builtin_amdgcn_s_sleep(1);
        if ((++sp & 255u) == 0u) { if (xb_ld(&bar[XB_TMO])) break; if (sp > XB_SPIN_CAP) { atomicAdd(&bar[XB_TMO], 1u); break; } }
    }
    nloc = mine > 0u ? mine : 1u; nx = cnt > 0u ? cnt : 1u;
}
__device__ __forceinline__ unsigned xcd_census_uniform(unsigned* bar) {
    const unsigned G = gridDim.x * gridDim.y * gridDim.z; unsigned ok = (G % 8u == 0u) ? 1u : 0u;
#pragma unroll
    for (unsigned j = 0; j < 16; ++j) { const unsigned c = xb_ld(&bar[XB_XCNT(j)]); if (j < 8u ? (c != G / 8u) : (c != 0u)) ok = 0u; }
    return (xb_ld(&bar[XB_TMO]) == 0u) ? ok : 0u;
}

__device__ __forceinline__ void xcd_barrier(const XcdBarrier& b) {
    asm volatile("s_waitcnt vmcnt(0)" ::: "memory");
    __syncthreads();
    if (threadIdx.x == 0) {
        unsigned* bar = b.bar;
        __builtin_amdgcn_s_waitcnt(0);
        unsigned nloc = b.st[0], nx = b.st[1];
        if (nloc == 0u) { xcd_barrier_complete(bar, b.x, nloc, nx); b.st[0] = nloc; b.st[1] = nx; b.st[2] = xcd_census_uniform(bar); }
        const unsigned old = xb_add(&bar[XB_XSUB(b.x)], 1u);
        const unsigned gen = old / nloc;
        if (old + 1u == (gen + 1u) * nloc) {
            __builtin_amdgcn_fence(__ATOMIC_RELEASE, "agent");
            asm volatile("s_waitcnt vmcnt(0)" ::: "memory");
            const unsigned og = xb_add(&bar[XB_TOP], 1u);
            const unsigned tg = og / nx;
            if (og + 1u == (tg + 1u) * nx) xb_add(&bar[XB_TOPGEN], 1u);
            else XB_SPIN(xb_ld(&bar[XB_TOPGEN]) == tg, bar);
            __builtin_amdgcn_fence(__ATOMIC_ACQUIRE, "agent");
            xb_add(&bar[XB_XGEN(b.x)], 1u);
            asm volatile("s_waitcnt vmcnt(0)" ::: "memory");
        } else {
            XB_SPIN(xb_ld(&bar[XB_XGEN(b.x)]) == gen, bar);
            __builtin_amdgcn_fence(__ATOMIC_ACQUIRE, "agent");
            asm volatile("s_waitcnt vmcnt(0)" ::: "memory");
        }
    }
    __syncthreads();
}
#define XB_LSUB(j)  (3456 + 64 * (j))
#define XB_LGEN(j)  (4480 + 64 * (j))
__device__ __forceinline__ void xcd_local_barrier(const XcdBarrier& b, unsigned seq) {
    asm volatile("s_waitcnt vmcnt(0)" ::: "memory");
    __syncthreads();
    if (threadIdx.x == 0) {
        unsigned* bar = b.bar;
        const unsigned target = seq * b.st[0];
        __hip_atomic_fetch_add(&bar[XB_LSUB(b.x)], 1u, __ATOMIC_RELAXED, __HIP_MEMORY_SCOPE_AGENT);
        asm volatile("buffer_inv sc1" ::: "memory");
        XB_SPIN(xb_ld(&bar[XB_LSUB(b.x)]) < target, bar);
        asm volatile("s_waitcnt vmcnt(0)" ::: "memory");
    }
    __syncthreads();
}

typedef unsigned v2u __attribute__((ext_vector_type(2)));
__device__ __forceinline__ float wave_sum(float v) {
#pragma unroll
    for (int o = 1; o < 64; o <<= 1) v += __shfl_xor(v, o);
    return v;
}
__device__ __forceinline__ float bflo(unsigned w) { return __builtin_bit_cast(float, w << 16); }
__device__ __forceinline__ float bfhi(unsigned w) { return __builtin_bit_cast(float, w & 0xffff0000u); }
__device__ __forceinline__ float bf1(unsigned short h) { return __builtin_bit_cast(float, (unsigned)h << 16); }
__device__ __forceinline__ float ex2(float x) { return __builtin_amdgcn_exp2f(x); }
__device__ __forceinline__ float rsq(float x) { return __builtin_amdgcn_rsqf(x); }

__device__ __forceinline__ void p0_item(const float* W, int Nsrc, int k0, int scol0, const float* gain, bf16* WT, int K, int drow0, LAS float* scr, int lane) {
    const int r8 = lane >> 3, c4 = 4 * (lane & 7);
    f32x4 v[8];
#pragma unroll
    for (int i = 0; i < 8; ++i) v[i] = *(const GAS f32x4*)(W + (size_t)(k0 + 8 * i + r8) * Nsrc + scol0 + c4);
#pragma unroll
    for (int i = 0; i < 8; ++i) { const int kk = 8 * i + r8; f32x4 t = v[i]; if (gain) t = t * gain[k0 + kk];
        scr[kk * 33 + c4] = t[0]; scr[kk * 33 + c4 + 1] = t[1]; scr[kk * 33 + c4 + 2] = t[2]; scr[kk * 33 + c4 + 3] = t[3]; }
    LDS_WAIT(); asm volatile("" ::: "memory");
    const int c = lane & 7;
#pragma unroll
    for (int j = 0; j < 4; ++j) { const int n = (lane >> 3) + 8 * j; const LAS float* s = scr + (8 * c) * 33 + n;
        v4u o; o.x = pk2(s[0 * 33], s[1 * 33]); o.y = pk2(s[2 * 33], s[3 * 33]); o.z = pk2(s[4 * 33], s[5 * 33]); o.w = pk2(s[6 * 33], s[7 * 33]);
        *(GAS v4u*)(WT + (size_t)(drow0 + n) * K + k0 + 8 * c) = o; }
    LDS_WAIT(); asm volatile("" ::: "memory");
}
__device__ __forceinline__ void p0_gu(const float* Wg, const float* Wu, const float* gain, bf16* WT, int r, LAS float* scr, int lane) {
    const int nblk = 2 * DFF / 32, kb = r / nblk, nb = r % nblk, n0 = 32 * nb, pn = n0 >> 8, bj = (n0 >> 7) & 1, j0 = n0 & 127;
    p0_item(bj ? Wu : Wg, DFF, 64 * kb, 128 * pn + j0, gain, WT, DMODEL, n0, scr, lane);
}
__device__ __forceinline__ void p0_plain(const float* W, int K, int N, const float* gain, bf16* WT, int r, LAS float* scr, int lane) {
    const int nblk = N / 32, kb = r / nblk, nb = r % nblk;
    p0_item(W, N, 64 * kb, 32 * nb, gain, WT, K, 32 * nb, scr, lane);
}
__device__ __forceinline__ void p0_prologue(LAS unsigned char* lds, const float* const* in, unsigned char* ws, int gw, int NGW, int wave, int lane) {
    LAS float* scr = (LAS float*)(lds + RING_OFF + wave * 16384);
    constexpr int I_GU = (DMODEL / 64) * (2 * DFF / 32), I_D = (DFF / 64) * (DMODEL / 32), I_IN = (DMODEL / 64) * (DIN / 32), I_OUT = (DMODEL / 64) * (DMODEL / 32);
    constexpr int NITEMS = 2 * I_GU + 2 * I_D + I_IN + I_OUT;
    for (int it = gw; it < NITEMS; it += NGW) {
        int r = it;
        if (r < I_GU) { p0_gu(in[3], in[4], in[2], (bf16*)(ws + WS_WGU1), r, scr, lane); continue; } r -= I_GU;
        if (r < I_GU) { p0_gu(in[18], in[19], in[17], (bf16*)(ws + WS_WGU2), r, scr, lane); continue; } r -= I_GU;
        if (r < I_D) { p0_plain(in[5], DFF, DMODEL, nullptr, (bf16*)(ws + WS_WD1), r, scr, lane); continue; } r -= I_D;
        if (r < I_D) { p0_plain(in[20], DFF, DMODEL, nullptr, (bf16*)(ws + WS_WD2), r, scr, lane); continue; } r -= I_D;
        if (r < I_IN) { p0_plain(in[7], DMODEL, DIN, in[6], (bf16*)(ws + WS_WIN), r, scr, lane); continue; } r -= I_IN;
        p0_plain(in[16], DMODEL, DMODEL, nullptr, (bf16*)(ws + WS_WOUT), r, scr, lane);
    }
    bf16* XB = (bf16*)(ws + WS_BUFA); float* p16 = (float*)(ws + WS_P16);
    for (int m0 = gw; m0 < TOK; m0 += 4 * NGW) {
        f32x4 v[4][4]; float s[4];
#pragma unroll
        for (int q = 0; q < 4; ++q) { const int m = m0 + q * NGW;
            if (m < TOK) { const float* xrow = m < NPROMPT ? in[0] + (size_t)m * DMODEL : in[1] + (size_t)(m - NPROMPT) * DMODEL; const GAS f32x4* xr = (const GAS f32x4*)xrow + lane;
#pragma unroll
                for (int j = 0; j < 4; ++j) v[q][j] = xr[64 * j]; } }
#pragma unroll
        for (int q = 0; q < 4; ++q) { s[q] = 0.f;
#pragma unroll
            for (int j = 0; j < 4; ++j) s[q] += (v[q][j].x * v[q][j].x + v[q][j].y * v[q][j].y) + (v[q][j].z * v[q][j].z + v[q][j].w * v[q][j].w); }
#pragma unroll
        for (int o = 1; o < 64; o <<= 1) {
#pragma unroll
            for (int q = 0; q < 4; ++q) s[q] += __shfl_xor(s[q], o); }
#pragma unroll
        for (int q = 0; q < 4; ++q) { const int m = m0 + q * NGW;
            if (m < TOK) { GAS v2u* o8 = (GAS v2u*)(XB + (size_t)m * DMODEL) + lane;
#pragma unroll
                for (int j = 0; j < 4; ++j) { v2u w; w.x = pk2(v[q][j].x, v[q][j].y); w.y = pk2(v[q][j].z, v[q][j].w); o8[64 * j] = w; }
                if (lane < 16) p16[(size_t)m * 16 + lane] = lane == 0 ? s[q] : 0.f; } }
    }
}

__device__ __forceinline__ void final_norm(const bf16* XBr, float* out, const float* gfin, int rbeg, int rend, int gw, int NGW, int lane) {
    for (int m = rbeg + gw; m < rend; m += NGW) {
        const v4u w0 = *(const GAS v4u*)(XBr + (size_t)m * DMODEL + 8 * lane), w1 = *(const GAS v4u*)(XBr + (size_t)m * DMODEL + 512 + 8 * lane);
        float x[16] = {bflo(w0.x), bfhi(w0.x), bflo(w0.y), bfhi(w0.y), bflo(w0.z), bfhi(w0.z), bflo(w0.w), bfhi(w0.w), bflo(w1.x), bfhi(w1.x), bflo(w1.y), bfhi(w1.y), bflo(w1.z), bfhi(w1.z), bflo(w1.w), bfhi(w1.w)};
        float s = 0.f;
#pragma unroll
        for (int e = 0; e < 16; ++e) s += x[e] * x[e];
        const float r = rsq(wave_sum(s) * (1.0f / DMODEL) + EPS);
#pragma unroll
        for (int j = 0; j < 2; ++j) { const int c = 512 * j + 8 * lane;
            const f32x4 g0 = *(const GAS f32x4*)(gfin + c), g1 = *(const GAS f32x4*)(gfin + c + 4);
            *(GAS f32x4*)(out + (size_t)m * DMODEL + c) = (f32x4){x[8 * j] * r * g0[0], x[8 * j + 1] * r * g0[1], x[8 * j + 2] * r * g0[2], x[8 * j + 3] * r * g0[3]};
            *(GAS f32x4*)(out + (size_t)m * DMODEL + c + 4) = (f32x4){x[8 * j + 4] * r * g1[0], x[8 * j + 5] * r * g1[1], x[8 * j + 6] * r * g1[2], x[8 * j + 7] * r * g1[3]}; }
    }
}

constexpr int HG_RAWLF = 0, HG_RAWQ = 17408, HG_QN = 34816, HG_KN = 52224, HG_KT = 69632, HG_VT = 88064, HG_SCL = 97280, HG_ST = 106496, HG_SEG = 115200, HG_SA = 119296, HG_SB = 119808, HG_END = 120320;
static_assert(HG_END <= RING_BYTES, "hgrn LDS");
__device__ __forceinline__ void hgrn_item(LAS unsigned char* lds, const bf16* P, float* ob, int row0, int L, int h, int dir, int dq, int tid, int lane, int wave) {
    const int fr = lane & 15, fq = lane >> 4, nch = L >> 6;
    const bf16* gq = P + COL_Q + h * 128;
    const bf16* gl = P + (dir ? COL_FB : COL_FF) + h * 128;
    const bf16* gv = P + COL_I + h * 128 + dq * 32;
    float* go = ob + h * 128 + dq * 32;
    const int lr = tid >> 4, lc = tid & 15, lp = (tid >> 2) & 31, vc = tid & 3, cp = lane, s8 = wave;
#define TOKROW(n, l) (row0 + (dir ? (L - 1 - (64 * (n) + (l))) : (64 * (n) + (l))))
#define HG_LOAD(n) do { _Pragma("unroll") for (int i_ = 0; i_ < 2; ++i_) { const size_t ro_ = (size_t)TOKROW(n, lr + 32 * i_) * DIN + 8 * lc; rl[i_] = *(const GAS v4u*)(gl + ro_); rq[i_] = *(const GAS v4u*)(gq + ro_); \
        rv[i_] = *(const GAS v4u*)(gv + (size_t)TOKROW(n, 2 * lp + i_) * DIN + 8 * vc); } } while (0)
    v4u rl[2], rq[2], rv[2];
    HG_LOAD(0);
    f32x4 S0 = {0.f, 0.f, 0.f, 0.f}, S1 = {0.f, 0.f, 0.f, 0.f};
    for (int n = 0; n < nch; ++n) {
        const int vbuf = HG_VT + (n & 1) * 4608;
#pragma unroll
        for (int i = 0; i < 2; ++i) { *(LAS v4u*)(lds + HG_RAWLF + (lr + 32 * i) * 272 + lc * 16) = rl[i]; *(LAS v4u*)(lds + HG_RAWQ + (lr + 32 * i) * 272 + lc * 16) = rq[i]; }
        if (tid < 128) {
#pragma unroll
            for (int e = 0; e < 4; ++e) { const unsigned w0 = rv[0][e], w1 = rv[1][e];
                *(LAS unsigned*)(lds + vbuf + (8 * vc + 2 * e) * 144 + lp * 4) = (w0 & 0xffffu) | (w1 << 16);
                *(LAS unsigned*)(lds + vbuf + (8 * vc + 2 * e + 1) * 144 + lp * 4) = (w0 >> 16) | (w1 & 0xffff0000u); }
        }
        if (n + 1 < nch) HG_LOAD(n + 1);
        __syncthreads();
        float lfa[8], lfb[8], ava[8], avb[8]; float runa = 0.f, runb = 0.f;
#pragma unroll
        for (int j = 0; j < 8; ++j) { const unsigned w = *(const LAS unsigned*)(lds + HG_RAWLF + (8 * s8 + j) * 272 + cp * 4);
            lfa[j] = bflo(w); lfb[j] = bfhi(w); runa += lfa[j]; runb += lfb[j]; ava[j] = runa; avb[j] = runb; }
        *(LAS v2u*)(lds + HG_SEG + (s8 * 128 + 2 * cp) * 4) = (v2u){__builtin_bit_cast(unsigned, runa), __builtin_bit_cast(unsigned, runb)};
        __syncthreads();
        {
            typedef float f32x2v __attribute__((ext_vector_type(2)));
            f32x2v sg_[8];
#pragma unroll
            for (int q = 0; q < 8; ++q) sg_[q] = *(const LAS f32x2v*)(lds + HG_SEG + (q * 128 + 2 * cp) * 4);
            const f32x2v amid2 = (sg_[0] + sg_[1]) + (sg_[2] + sg_[3]);
            const f32x2v atot2 = amid2 + ((sg_[4] + sg_[5]) + (sg_[6] + sg_[7]));
            f32x2v off2 = -amid2;
#pragma unroll
            for (int q = 0; q < 7; ++q) { const float mq = (q < s8) ? 1.0f : 0.0f; off2 = off2 + sg_[q] * mq; }
            const float amida = amid2.x, amidb = amid2.y, atota = atot2.x, atotb = atot2.y;
            const float offa = off2.x, offb = off2.y;
            unsigned kta[4], ktb[4];
#pragma unroll
            for (int j = 0; j < 8; ++j) {
                const float aa = offa + ava[j], ab = offb + avb[j];
                const unsigned qw = *(const LAS unsigned*)(lds + HG_RAWQ + (8 * s8 + j) * 272 + cp * 4);
                const float qta = bflo(qw) * ex2(aa), qtb = bfhi(qw) * ex2(ab);
                const float k_a = (1.0f - ex2(lfa[j])) * ex2(-aa), k_b = (1.0f - ex2(lfb[j])) * ex2(-ab);
                const unsigned kba = f2bf(k_a), kbb = f2bf(k_b);
                *(LAS unsigned*)(lds + HG_QN + (8 * s8 + j) * 272 + cp * 4) = pk2(qta, qtb);
                *(LAS unsigned*)(lds + HG_KN + (8 * s8 + j) * 272 + cp * 4) = kba | (kbb << 16);
                if (j & 1) { kta[j >> 1] |= kba << 16; ktb[j >> 1] |= kbb << 16; } else { kta[j >> 1] = kba; ktb[j >> 1] = kbb; }
            }
            *(LAS v4u*)(lds + HG_KT + (2 * cp) * 144 + s8 * 16) = (v4u){kta[0], kta[1], kta[2], kta[3]};
            *(LAS v4u*)(lds + HG_KT + (2 * cp + 1) * 144 + s8 * 16) = (v4u){ktb[0], ktb[1], ktb[2], ktb[3]};
            if (s8 == 0) { *(LAS v2u*)(lds + HG_SA + (2 * cp) * 4) = (v2u){__builtin_bit_cast(unsigned, ex2(amida)), __builtin_bit_cast(unsigned, ex2(amidb))};
                           *(LAS v2u*)(lds + HG_SB + (2 * cp) * 4) = (v2u){__builtin_bit_cast(unsigned, ex2(atota - amida)), __builtin_bit_cast(unsigned, ex2(atotb - amidb))}; }
        }
        __syncthreads();
        {
            const f32x4 sa = *(const LAS f32x4*)(lds + HG_SA + (16 * wave + 4 * fq) * 4);
            S0 = S0 * sa; S1 = S1 * sa;
#ifdef DBG_NOSTATE
            S0 = (f32x4){0.f,0.f,0.f,0.f}; S1 = S0;
#endif
            v2u w0, w1; w0.x = pk2(S0[0], S0[1]); w0.y = pk2(S0[2], S0[3]); w1.x = pk2(S1[0], S1[1]); w1.y = pk2(S1[2], S1[3]);
            *(LAS v2u*)(lds + HG_ST + fr * 272 + (16 * wave + 4 * fq) * 2) = w0;
            *(LAS v2u*)(lds + HG_ST + (16 + fr) * 272 + (16 * wave + 4 * fq) * 2) = w1;
        }
        {
            const int ib = wave & 3, jp = wave >> 2;
#pragma unroll
            for (int t = 0; t < 2; ++t) {
                const int jb = 2 * jp + t;
                f32x4 sc = {0.f, 0.f, 0.f, 0.f};
                if (jb <= ib) {
#pragma unroll
                    for (int ks = 0; ks < 4; ++ks) {
                        const bf16x8 x = *(const LAS bf16x8*)(lds + HG_KN + (16 * jb + fr) * 272 + ks * 64 + fq * 16);
                        const bf16x8 y = *(const LAS bf16x8*)(lds + HG_QN + (16 * ib + fr) * 272 + ks * 64 + fq * 16);
                        sc = __builtin_amdgcn_mfma_f32_16x16x32_bf16(x, y, sc, 0, 0, 0);
                    }
                    if (jb == ib) {
#pragma unroll
                        for (int r = 0; r < 4; ++r) if (4 * fq + r > fr) sc[r] = 0.f;
                    }
                }
                v2u w; w.x = pk2(sc[0], sc[1]); w.y = pk2(sc[2], sc[3]);
                *(LAS v2u*)(lds + HG_SCL + (16 * ib + fr) * 144 + (16 * jb + 4 * fq) * 2) = w;
            }
        }
        __syncthreads();
        {
            const int ib2 = wave >> 1, db = wave & 1;
            f32x4 O = {0.f, 0.f, 0.f, 0.f};
#pragma unroll
            for (int ks = 0; ks < 2; ++ks) {
                const bf16x8 x = *(const LAS bf16x8*)(lds + vbuf + (16 * db + fr) * 144 + ks * 64 + fq * 16);
                const bf16x8 y = *(const LAS bf16x8*)(lds + HG_SCL + (16 * ib2 + fr) * 144 + ks * 64 + fq * 16);
                O = __builtin_amdgcn_mfma_f32_16x16x32_bf16(x, y, O, 0, 0, 0);
            }
#pragma unroll
            for (int ks = 0; ks < 4; ++ks) {
                const bf16x8 x = *(const LAS bf16x8*)(lds + HG_ST + (16 * db + fr) * 272 + ks * 64 + fq * 16);
                const bf16x8 y = *(const LAS bf16x8*)(lds + HG_QN + (16 * ib2 + fr) * 272 + ks * 64 + fq * 16);
                O = __builtin_amdgcn_mfma_f32_16x16x32_bf16(x, y, O, 0, 0, 0);
            }
#if defined(DBG_HG) && DBG_HG == 1
            { const v2u w = *(const LAS v2u*)(lds + HG_QN + (16 * ib2 + fr) * 272 + (16 * db + 4 * fq) * 2); O = (f32x4){bflo(w.x), bfhi(w.x), bflo(w.y), bfhi(w.y)}; }
#elif defined(DBG_HG) && DBG_HG == 2
            { const v2u w = *(const LAS v2u*)(lds + HG_SCL + (16 * ib2 + fr) * 144 + (16 * db + 4 * fq) * 2); O = (f32x4){bflo(w.x), bfhi(w.x), bflo(w.y), bfhi(w.y)}; }
#elif defined(DBG_HG) && DBG_HG == 3
            { const v2u w = *(const LAS v2u*)(lds + vbuf + (16 * db + fr) * 144 + (16 * (ib2 & 3) + 4 * fq) * 2); O = (f32x4){bflo(w.x), bfhi(w.x), bflo(w.y), bfhi(w.y)}; }
#elif defined(DBG_HG) && DBG_HG == 5
            { const v2u w = *(const GAS v2u*)(gq + (size_t)TOKROW(n, 16 * ib2 + fr) * DIN + 16 * db + 4 * fq); O = (f32x4){bflo(w.x), bfhi(w.x), bflo(w.y), bfhi(w.y)}; }
#elif defined(DBG_HG) && DBG_HG == 9
            { const v2u w = *(const GAS v2u*)(gl + (size_t)TOKROW(n, 16 * ib2 + fr) * DIN + 16 * db + 4 * fq); O = (f32x4){bflo(w.x), bfhi(w.x), bflo(w.y), bfhi(w.y)}; }
#elif defined(DBG_HG) && DBG_HG == 10
            { const v2u w = *(const LAS v2u*)(lds + HG_RAWLF + (16 * ib2 + fr) * 272 + (16 * db + 4 * fq) * 2); O = (f32x4){bflo(w.x), bfhi(w.x), bflo(w.y), bfhi(w.y)}; }
#elif defined(DBG_HG) && DBG_HG == 7
            { const v2u w = *(const GAS v2u*)(P + COL_U + h * 128 + (size_t)TOKROW(n, 16 * ib2 + fr) * DIN + 16 * db + 4 * fq); O = (f32x4){bflo(w.x), bfhi(w.x), bflo(w.y), bfhi(w.y)}; }
#elif defined(DBG_HG) && DBG_HG == 8
            { O = (f32x4){(float)TOKROW(n, 16 * ib2 + fr), (float)(16 * db + 4 * fq), (float)h, (float)dq}; }
#elif defined(DBG_HG) && DBG_HG == 6
            { const v2u w = *(const LAS v2u*)(lds + HG_RAWQ + (16 * ib2 + fr) * 272 + (16 * db + 4 * fq) * 2); O = (f32x4){bflo(w.x), bfhi(w.x), bflo(w.y), bfhi(w.y)}; }
#elif defined(DBG_HG) && DBG_HG == 4
            { const v2u w = *(const LAS v2u*)(lds + HG_KN + (16 * ib2 + fr) * 272 + (16 * db + 4 * fq) * 2); O = (f32x4){bflo(w.x), bfhi(w.x), bflo(w.y), bfhi(w.y)}; }
#endif
            *(GAS f32x4*)(go + (size_t)TOKROW(n, 16 * ib2 + fr) * 512 + 16 * db + 4 * fq) = O;
        }
        {
#pragma unroll
            for (int ks = 0; ks < 2; ++ks) {
                const bf16x8 x = *(const LAS bf16x8*)(lds + HG_KT + (16 * wave + fr) * 144 + ks * 64 + fq * 16);
                const bf16x8 y0 = *(const LAS bf16x8*)(lds + vbuf + fr * 144 + ks * 64 + fq * 16);
                const bf16x8 y1 = *(const LAS bf16x8*)(lds + vbuf + (16 + fr) * 144 + ks * 64 + fq * 16);
                S0 = __builtin_amdgcn_mfma_f32_16x16x32_bf16(x, y0, S0, 0, 0, 0);
                S1 = __builtin_amdgcn_mfma_f32_16x16x32_bf16(x, y1, S1, 0, 0, 0);
            }
            const f32x4 sb = *(const LAS f32x4*)(lds + HG_SB + (16 * wave + 4 * fq) * 4);
            S0 = S0 * sb; S1 = S1 * sb;
        }
        __syncthreads();
    }
#undef HG_LOAD
#undef TOKROW
}

constexpr int H2_RAWLF = 0, H2_RAWQ = 17408, H2_ST = 0, H2_QN = 34816, H2_KN = 52224, H2_KT = 69632, H2_VT = 88064, H2_SCL = 106496, H2_SEG = 115712, H2_SA = 119808, H2_SB = 120320, H2_END = 120832;
static_assert(H2_END <= RING_BYTES, "hgrn v2 LDS");
struct Hg2Inst { int row0, L, h, dir, sc, seqid; };
__device__ __forceinline__ Hg2Inst hg2_decode(int i) {
    Hg2Inst I; const int hd = i & 7, sp = i >> 3; I.h = hd >> 1; I.dir = hd & 1;
    if (sp < 32) { const int b = sp >> 2; I.sc = sp & 3; I.row0 = 2048 * b; I.L = 2048; I.seqid = b; }
    else { const int b = (sp - 32) >> 3; I.sc = (sp - 32) & 7; I.row0 = NPROMPT + 4096 * b; I.L = 4096; I.seqid = 8 + b; }
    return I;
}
__device__ __forceinline__ int hg2_index(int seqid, int h, int dir, int sc) { const int sp = seqid < 8 ? seqid * 4 + sc : 32 + (seqid - 8) * 8 + sc; return sp * 8 + h * 2 + dir; }
__device__ __forceinline__ int hg2_xcc_inst(int x, int k) { const int hd = k & 7, sq = k >> 3; const int seqid = x < 4 ? 2 * x + (sq >> 2) : 8 + (x - 4), sc = x < 4 ? (sq & 3) : sq; return hg2_index(seqid, hd >> 1, hd & 1, sc); }
#define H2_TOKROW(p) (row0 + (dir ? (L - 1 - (p)) : (p)))
typedef float f32x2v __attribute__((ext_vector_type(2)));

__device__ __forceinline__ void hg2_state_pass(LAS unsigned char* lds, const bf16* P, float* Ebuf, float* Dbuf, int inst, int tid, int lane, int wave) {
    const Hg2Inst I = hg2_decode(inst); const int row0 = I.row0, L = I.L, h = I.h, dir = I.dir;
    const int fr = lane & 15, fq = lane >> 4, cp = lane, s8 = wave;
    const bf16* gl = P + (dir ? COL_FB : COL_FF) + h * 128;
    const bf16* gv = P + COL_I + h * 128;
    const int lr = tid >> 4, lc = tid & 15, vc = 4 * (wave & 3) + (lane & 3), lp = 16 * (wave >> 2) + (lane >> 2);
    const int p0 = 512 * I.sc;
#define H2_LOAD1(n) do { _Pragma("unroll") for (int i_ = 0; i_ < 2; ++i_) { rl[i_] = *(const GAS v4u*)(gl + (size_t)H2_TOKROW(p0 + 64 * (n) + lr + 32 * i_) * DIN + 8 * lc); \
        rv[i_] = *(const GAS v4u*)(gv + (size_t)H2_TOKROW(p0 + 64 * (n) + 2 * lp + i_) * DIN + 8 * vc); } } while (0)
    v4u rl[2], rv[2];
    H2_LOAD1(0);
    f32x4 S[8];
#pragma unroll
    for (int t = 0; t < 8; ++t) S[t] = (f32x4){0.f, 0.f, 0.f, 0.f};
    f32x2v dlog = {0.f, 0.f};
    for (int n = 0; n < 8; ++n) {
#pragma unroll
        for (int i = 0; i < 2; ++i) *(LAS v4u*)(lds + H2_RAWLF + (lr + 32 * i) * 272 + lc * 16) = rl[i];
#pragma unroll
        for (int e = 0; e < 4; ++e) { const unsigned w0 = rv[0][e], w1 = rv[1][e];
            *(LAS unsigned*)(lds + H2_VT + (8 * vc + 2 * e) * 144 + lp * 4) = (w0 & 0xffffu) | (w1 << 16);
            *(LAS unsigned*)(lds + H2_VT + (8 * vc + 2 * e + 1) * 144 + lp * 4) = (w0 >> 16) | (w1 & 0xffff0000u); }
        if (n + 1 < 8) H2_LOAD1(n + 1);
        __syncthreads();
        float lfa[8], lfb[8]; f32x2v av[8]; f32x2v run = {0.f, 0.f};
#pragma unroll
        for (int j = 0; j < 8; ++j) { const unsigned w = *(const LAS unsigned*)(lds + H2_RAWLF + (8 * s8 + j) * 272 + cp * 4);
            lfa[j] = bflo(w); lfb[j] = bfhi(w); run = run + (f32x2v){lfa[j], lfb[j]}; av[j] = run; }
        *(LAS f32x2v*)(lds + H2_SEG + (s8 * 128 + 2 * cp) * 4) = run;
        __syncthreads();
        {
            f32x2v sg_[8];
#pragma unroll
            for (int q = 0; q < 8; ++q) sg_[q] = *(const LAS f32x2v*)(lds + H2_SEG + (q * 128 + 2 * cp) * 4);
            const f32x2v amid2 = (sg_[0] + sg_[1]) + (sg_[2] + sg_[3]);
            const f32x2v atot2 = amid2 + ((sg_[4] + sg_[5]) + (sg_[6] + sg_[7]));
            f32x2v off2 = -amid2;
#pragma unroll
            for (int q = 0; q < 7; ++q) { const float mq = (q < s8) ? 1.0f : 0.0f; off2 = off2 + sg_[q] * mq; }
            unsigned kta[4], ktb[4];
#pragma unroll
            for (int j = 0; j < 8; ++j) {
                const f32x2v aa = off2 + av[j];
                const unsigned kba = f2bf((1.0f - ex2(lfa[j])) * ex2(-aa.x)), kbb = f2bf((1.0f - ex2(lfb[j])) * ex2(-aa.y));
                if (j & 1) { kta[j >> 1] |= kba << 16; ktb[j >> 1] |= kbb << 16; } else { kta[j >> 1] = kba; ktb[j >> 1] = kbb; }
            }
            *(LAS v4u*)(lds + H2_KT + (2 * cp) * 144 + s8 * 16) = (v4u){kta[0], kta[1], kta[2], kta[3]};
            *(LAS v4u*)(lds + H2_KT + (2 * cp + 1) * 144 + s8 * 16) = (v4u){ktb[0], ktb[1], ktb[2], ktb[3]};
            if (s8 == 0) { *(LAS f32x2v*)(lds + H2_SA + (2 * cp) * 4) = (f32x2v){ex2(amid2.x), ex2(amid2.y)};
                           *(LAS f32x2v*)(lds + H2_SB + (2 * cp) * 4) = (f32x2v){ex2(atot2.x - amid2.x), ex2(atot2.y - amid2.y)}; dlog = dlog + atot2; }
        }
        __syncthreads();
        {
            const f32x4 sa = *(const LAS f32x4*)(lds + H2_SA + (16 * wave + 4 * fq) * 4), sb = *(const LAS f32x4*)(lds + H2_SB + (16 * wave + 4 * fq) * 4);
            bf16x8 x[2];
#pragma unroll
            for (int ks = 0; ks < 2; ++ks) x[ks] = *(const LAS bf16x8*)(lds + H2_KT + (16 * wave + fr) * 144 + ks * 64 + fq * 16);
#pragma unroll
            for (int t = 0; t < 8; ++t) S[t] = S[t] * sa;
#pragma unroll
            for (int ks = 0; ks < 2; ++ks) { bf16x8 y[8];
#pragma unroll
                for (int t = 0; t < 8; ++t) y[t] = *(const LAS bf16x8*)(lds + H2_VT + (16 * t + fr) * 144 + ks * 64 + fq * 16);
#pragma unroll
                for (int t = 0; t < 8; ++t) S[t] = __builtin_amdgcn_mfma_f32_16x16x32_bf16(x[ks], y[t], S[t], 0, 0, 0); }
#pragma unroll
            for (int t = 0; t < 8; ++t) S[t] = S[t] * sb;
        }
        __syncthreads();
    }
    float* E = Ebuf + (size_t)inst * 16384;
#pragma unroll
    for (int t = 0; t < 8; ++t) *(GAS f32x4*)(E + ((wave * 8 + t) * 64 + lane) * 4) = S[t];
    if (s8 == 0) *(GAS f32x2v*)(Dbuf + (size_t)inst * 128 + 2 * cp) = dlog;
#undef H2_LOAD1
}

__device__ __forceinline__ void hg2_out_pass(LAS unsigned char* lds, const bf16* P, bf16* ob, const float* Ebuf, const float* Dbuf, int inst, int tid, int lane, int wave) {
    const Hg2Inst I = hg2_decode(inst); const int row0 = I.row0, L = I.L, h = I.h, dir = I.dir;
    const int fr = lane & 15, fq = lane >> 4, cp = lane, s8 = wave;
    const bf16* gq = P + COL_Q + h * 128;
    const bf16* gl = P + (dir ? COL_FB : COL_FF) + h * 128;
    const bf16* gv = P + COL_I + h * 128;
    bf16* go = ob + h * 128;
    const int lr = tid >> 4, lc = tid & 15, vc = 4 * (wave & 3) + (lane & 3), lp = 16 * (wave >> 2) + (lane >> 2);
    const int p0 = 512 * I.sc;
#define H2_LOAD2(n) do { _Pragma("unroll") for (int i_ = 0; i_ < 2; ++i_) { const size_t ro_ = (size_t)H2_TOKROW(p0 + 64 * (n) + lr + 32 * i_) * DIN + 8 * lc; rl[i_] = *(const GAS v4u*)(gl + ro_); rq[i_] = *(const GAS v4u*)(gq + ro_); \
        rv[i_] = *(const GAS v4u*)(gv + (size_t)H2_TOKROW(p0 + 64 * (n) + 2 * lp + i_) * DIN + 8 * vc); } } while (0)
    v4u rl[2], rq[2], rv[2];
    H2_LOAD2(0);
    f32x4 S[8];
#pragma unroll
    for (int t = 0; t < 8; ++t) S[t] = (f32x4){0.f, 0.f, 0.f, 0.f};
    if (I.sc > 0) {
        f32x4 ec[8], en[8], dc, dn;
        { const int ij = hg2_index(I.seqid, h, dir, 0); dc = *(const GAS f32x4*)(Dbuf + (size_t)ij * 128 + 16 * wave + 4 * fq); const float* E = Ebuf + (size_t)ij * 16384;
#pragma unroll
          for (int t = 0; t < 8; ++t) ec[t] = *(const GAS f32x4*)(E + ((wave * 8 + t) * 64 + lane) * 4); }
        for (int j = 0; j < I.sc; ++j) {
            if (j + 1 < I.sc) { const int ij = hg2_index(I.seqid, h, dir, j + 1); dn = *(const GAS f32x4*)(Dbuf + (size_t)ij * 128 + 16 * wave + 4 * fq); const float* E = Ebuf + (size_t)ij * 16384;
#pragma unroll
                for (int t = 0; t < 8; ++t) en[t] = *(const GAS f32x4*)(E + ((wave * 8 + t) * 64 + lane) * 4); }
            const f32x4 dec = {ex2(dc[0]), ex2(dc[1]), ex2(dc[2]), ex2(dc[3])};
#pragma unroll
            for (int t = 0; t < 8; ++t) { S[t] = S[t] * dec + ec[t]; ec[t] = en[t]; }
            dc = dn;
        }
    }
    for (int n = 0; n < 8; ++n) {
#pragma unroll
        for (int i = 0; i < 2; ++i) { *(LAS v4u*)(lds + H2_RAWLF + (lr + 32 * i) * 272 + lc * 16) = rl[i]; *(LAS v4u*)(lds + H2_RAWQ + (lr + 32 * i) * 272 + lc * 16) = rq[i]; }
#pragma unroll
        for (int e = 0; e < 4; ++e) { const unsigned w0 = rv[0][e], w1 = rv[1][e];
            *(LAS unsigned*)(lds + H2_VT + (8 * vc + 2 * e) * 144 + lp * 4) = (w0 & 0xffffu) | (w1 << 16);
            *(LAS unsigned*)(lds + H2_VT + (8 * vc + 2 * e + 1) * 144 + lp * 4) = (w0 >> 16) | (w1 & 0xffff0000u); }
        if (n + 1 < 8) H2_LOAD2(n + 1);
        __syncthreads();
        float lfa[8], lfb[8]; f32x2v av[8]; f32x2v run = {0.f, 0.f};
#pragma unroll
        for (int j = 0; j < 8; ++j) { const unsigned w = *(const LAS unsigned*)(lds + H2_RAWLF + (8 * s8 + j) * 272 + cp * 4);
            lfa[j] = bflo(w); lfb[j] = bfhi(w); run = run + (f32x2v){lfa[j], lfb[j]}; av[j] = run; }
        *(LAS f32x2v*)(lds + H2_SEG + (s8 * 128 + 2 * cp) * 4) = run;
        __syncthreads();
        {
            f32x2v sg_[8];
#pragma unroll
            for (int q = 0; q < 8; ++q) sg_[q] = *(const LAS f32x2v*)(lds + H2_SEG + (q * 128 + 2 * cp) * 4);
            const f32x2v amid2 = (sg_[0] + sg_[1]) + (sg_[2] + sg_[3]);
            const f32x2v atot2 = amid2 + ((sg_[4] + sg_[5]) + (sg_[6] + sg_[7]));
            f32x2v off2 = -amid2;
#pragma unroll
            for (int q = 0; q < 7; ++q) { const float mq = (q < s8) ? 1.0f : 0.0f; off2 = off2 + sg_[q] * mq; }
            unsigned kta[4], ktb[4];
#pragma unroll
            for (int j = 0; j < 8; ++j) {
                const f32x2v aa = off2 + av[j];
                const unsigned qw = *(const LAS unsigned*)(lds + H2_RAWQ + (8 * s8 + j) * 272 + cp * 4);
                const float qta = bflo(qw) * ex2(aa.x), qtb = bfhi(qw) * ex2(aa.y);
                const unsigned kba = f2bf((1.0f - ex2(lfa[j])) * ex2(-aa.x)), kbb = f2bf((1.0f - ex2(lfb[j])) * ex2(-aa.y));
                *(LAS unsigned*)(lds + H2_QN + (8 * s8 + j) * 272 + cp * 4) = pk2(qta, qtb);
                *(LAS unsigned*)(lds + H2_KN + (8 * s8 + j) * 272 + cp * 4) = kba | (kbb << 16);
                if (j & 1) { kta[j >> 1] |= kba << 16; ktb[j >> 1] |= kbb << 16; } else { kta[j >> 1] = kba; ktb[j >> 1] = kbb; }
            }
            *(LAS v4u*)(lds + H2_KT + (2 * cp) * 144 + s8 * 16) = (v4u){kta[0], kta[1], kta[2], kta[3]};
            *(LAS v4u*)(lds + H2_KT + (2 * cp + 1) * 144 + s8 * 16) = (v4u){ktb[0], ktb[1], ktb[2], ktb[3]};
            if (s8 == 0) { *(LAS f32x2v*)(lds + H2_SA + (2 * cp) * 4) = (f32x2v){ex2(amid2.x), ex2(amid2.y)};
                           *(LAS f32x2v*)(lds + H2_SB + (2 * cp) * 4) = (f32x2v){ex2(atot2.x - amid2.x), ex2(atot2.y - amid2.y)}; }
        }
        __syncthreads();
        {
            const f32x4 sa = *(const LAS f32x4*)(lds + H2_SA + (16 * wave + 4 * fq) * 4);
#pragma unroll
            for (int t = 0; t < 8; ++t) { S[t] = S[t] * sa; v2u w; w.x = pk2(S[t][0], S[t][1]); w.y = pk2(S[t][2], S[t][3]);
                *(LAS v2u*)(lds + H2_ST + (16 * t + fr) * 272 + (16 * wave + 4 * fq) * 2) = w; }
        }
        {
            const int ib = wave & 3, jp = wave >> 2;
#pragma unroll
            for (int t = 0; t < 2; ++t) {
                const int jb = 2 * jp + t;
                f32x4 sc = {0.f, 0.f, 0.f, 0.f};
                if (jb <= ib) {
#pragma unroll
                    for (int ks = 0; ks < 4; ++ks) {
                        const bf16x8 x = *(const LAS bf16x8*)(lds + H2_KN + (16 * jb + fr) * 272 + ks * 64 + fq * 16);
                        const bf16x8 y = *(const LAS bf16x8*)(lds + H2_QN + (16 * ib + fr) * 272 + ks * 64 + fq * 16);
                        sc = __builtin_amdgcn_mfma_f32_16x16x32_bf16(x, y, sc, 0, 0, 0);
                    }
                    if (jb == ib) {
#pragma unroll
                        for (int r = 0; r < 4; ++r) if (4 * fq + r > fr) sc[r] = 0.f;
                    }
                }
                v2u w; w.x = pk2(sc[0], sc[1]); w.y = pk2(sc[2], sc[3]);
                *(LAS v2u*)(lds + H2_SCL + (16 * ib + fr) * 144 + (16 * jb + 4 * fq) * 2) = w;
            }
        }
        __syncthreads();
        {
            const int ib2 = wave >> 1, dh = wave & 1;
            bf16x8 ys[2], yq[4];
#pragma unroll
            for (int ks = 0; ks < 2; ++ks) ys[ks] = *(const LAS bf16x8*)(lds + H2_SCL + (16 * ib2 + fr) * 144 + ks * 64 + fq * 16);
#pragma unroll
            for (int ks = 0; ks < 4; ++ks) yq[ks] = *(const LAS bf16x8*)(lds + H2_QN + (16 * ib2 + fr) * 272 + ks * 64 + fq * 16);
            const size_t orow = (size_t)H2_TOKROW(p0 + 64 * n + 16 * ib2 + fr) * 512;
            f32x4 O[4];
#pragma unroll
            for (int t = 0; t < 4; ++t) O[t] = (f32x4){0.f, 0.f, 0.f, 0.f};
#pragma unroll
            for (int ks = 0; ks < 2; ++ks) { bf16x8 x[4];
#pragma unroll
                for (int t = 0; t < 4; ++t) x[t] = *(const LAS bf16x8*)(lds + H2_VT + (16 * (4 * dh + t) + fr) * 144 + ks * 64 + fq * 16);
#pragma unroll
                for (int t = 0; t < 4; ++t) O[t] = __builtin_amdgcn_mfma_f32_16x16x32_bf16(x[t], ys[ks], O[t], 0, 0, 0); }
#pragma unroll
            for (int ks = 0; ks < 4; ++ks) { bf16x8 x[4];
#pragma unroll
                for (int t = 0; t < 4; ++t) x[t] = *(const LAS bf16x8*)(lds + H2_ST + (16 * (4 * dh + t) + fr) * 272 + ks * 64 + fq * 16);
#pragma unroll
                for (int t = 0; t < 4; ++t) O[t] = __builtin_amdgcn_mfma_f32_16x16x32_bf16(x[t], yq[ks], O[t], 0, 0, 0); }
#pragma unroll
            for (int t = 0; t < 4; ++t) { v2u w; w.x = pk2(O[t][0], O[t][1]); w.y = pk2(O[t][2], O[t][3]); *(GAS v2u*)(go + orow + 16 * (4 * dh + t) + 4 * fq) = w; }
        }
        {
            const f32x4 sb = *(const LAS f32x4*)(lds + H2_SB + (16 * wave + 4 * fq) * 4);
            bf16x8 x[2];
#pragma unroll
            for (int ks = 0; ks < 2; ++ks) x[ks] = *(const LAS bf16x8*)(lds + H2_KT + (16 * wave + fr) * 144 + ks * 64 + fq * 16);
#pragma unroll
            for (int ks = 0; ks < 2; ++ks) { bf16x8 y[8];
#pragma unroll
                for (int t = 0; t < 8; ++t) y[t] = *(const LAS bf16x8*)(lds + H2_VT + (16 * t + fr) * 144 + ks * 64 + fq * 16);
#pragma unroll
                for (int t = 0; t < 8; ++t) S[t] = __builtin_amdgcn_mfma_f32_16x16x32_bf16(x[ks], y[t], S[t], 0, 0, 0); }
#pragma unroll
            for (int t = 0; t < 8; ++t) S[t] = S[t] * sb;
        }
        __syncthreads();
    }
#undef H2_LOAD2
}

#ifdef DBG_NAIVE_HGRN
__device__ __forceinline__ void naive_hgrn_item(LAS unsigned char* lds, const bf16* P, float* ob, int row0, int L, int h, int dir, int tid) {
    LAS float* LQ = (LAS float*)lds; LAS float* LF = LQ + 2048; LAS float* LK = LF + 2048;
    const unsigned short* Pu = (const unsigned short*)P;
    float S[128];
#pragma unroll
    for (int k = 0; k < 128; ++k) S[k] = 0.f;
    for (int t0 = 0; t0 < L; t0 += 16) {
        __syncthreads();
#pragma unroll
        for (int i = 0; i < 4; ++i) { const int idx = tid + 512 * i, st = idx >> 7, k = idx & 127; const size_t row = (size_t)(row0 + (dir ? (L - 1 - (t0 + st)) : (t0 + st)));
            const float qv = bf1(Pu[row * DIN + COL_Q + h * 128 + k]), l2 = bf1(Pu[row * DIN + (dir ? COL_FB : COL_FF) + h * 128 + k]), f = exp2f(l2);
            LQ[st * 128 + k] = qv; LF[st * 128 + k] = f; LK[st * 128 + k] = 1.0f - f; }
        __syncthreads();
        if (tid < 128) {
#pragma unroll 1
            for (int st = 0; st < 16; ++st) { const size_t row = (size_t)(row0 + (dir ? (L - 1 - (t0 + st)) : (t0 + st)));
                const float v = bf1(Pu[row * DIN + COL_I + h * 128 + tid]); float o = 0.f;
#pragma unroll
                for (int k4 = 0; k4 < 32; ++k4) { const f32x4 f4 = *(const LAS f32x4*)(LF + st * 128 + 4 * k4), k4v = *(const LAS f32x4*)(LK + st * 128 + 4 * k4), q4 = *(const LAS f32x4*)(LQ + st * 128 + 4 * k4);
#pragma unroll
                    for (int e = 0; e < 4; ++e) { S[4 * k4 + e] = f4[e] * S[4 * k4 + e] + k4v[e] * v; o += q4[e] * S[4 * k4 + e]; } }
                ob[row * 512 + h * 128 + tid] = o; }
        }
    }
    __syncthreads();
}
#endif
__device__ __forceinline__ void hgrn_combine(const bf16* ob0, const bf16* ob1, const bf16* P, const float* onorm, const float* ssg, const float* gon, bf16* Y, int rbeg, int rend, int gw, int NGW, int lane) {
    const int c = 8 * lane;
    const f32x4 g0 = *(const GAS f32x4*)(onorm + c), g1 = *(const GAS f32x4*)(onorm + c + 4);
    const f32x4 n0 = *(const GAS f32x4*)(gon + c), n1 = *(const GAS f32x4*)(gon + c + 4);
    for (int m = rbeg + gw; m < rend; m += NGW) {
        const v4u aw = *(const GAS v4u*)(ob0 + (size_t)m * 512 + c), bw = *(const GAS v4u*)(ob1 + (size_t)m * 512 + c);
        const f32x4 a0 = {bflo(aw.x), bfhi(aw.x), bflo(aw.y), bfhi(aw.y)}, a1 = {bflo(aw.z), bfhi(aw.z), bflo(aw.w), bfhi(aw.w)};
        const f32x4 b0 = {bflo(bw.x), bfhi(bw.x), bflo(bw.y), bfhi(bw.y)}, b1 = {bflo(bw.z), bfhi(bw.z), bflo(bw.w), bfhi(bw.w)};
        const v4u sgw = *(const GAS v4u*)(P + (size_t)m * DIN + COL_G + c);
#ifdef DBG_PCOPY
        f32x4 o0 = {0.f,0.f,0.f,0.f}, o1 = o0;
        { const int segs[4] = {COL_Q, COL_I, COL_FF, COL_FB};
#pragma unroll
          for (int q_ = 0; q_ < 4; ++q_) { const v4u pw = *(const GAS v4u*)(P + (size_t)m * DIN + segs[q_] + c);
            o0 += (f32x4){bflo(pw.x), bfhi(pw.x), bflo(pw.y), bfhi(pw.y)}; o1 += (f32x4){bflo(pw.z), bfhi(pw.z), bflo(pw.w), bfhi(pw.w)}; } }
#else
        const f32x4 o0 = a0 + b0, o1 = a1 + b1;
#endif
        float s = ((o0[0] * o0[0] + o0[1] * o0[1]) + (o0[2] * o0[2] + o0[3] * o0[3])) + ((o1[0] * o1[0] + o1[1] * o1[1]) + (o1[2] * o1[2] + o1[3] * o1[3]));
        s += __shfl_xor(s, 1); s += __shfl_xor(s, 2); s += __shfl_xor(s, 4); s += __shfl_xor(s, 8);
        const float r = rsq(s * (1.0f / 128.0f) + EPS);
        const f32x4 y0 = o0 * r * g0 * (f32x4){bflo(sgw.x), bfhi(sgw.x), bflo(sgw.y), bfhi(sgw.y)};
        const f32x4 y1 = o1 * r * g1 * (f32x4){bflo(sgw.z), bfhi(sgw.z), bflo(sgw.w), bfhi(sgw.w)};
        v4u w; w.x = pk2(y0[0], y0[1]); w.y = pk2(y0[2], y0[3]); w.z = pk2(y1[0], y1[1]); w.w = pk2(y1[2], y1[3]);
        *(GAS v4u*)(Y + (size_t)m * DMODEL + 512 + c) = w;
#ifndef NO_GMLP
        const f32x4 sv = *(const GAS f32x4*)(ssg + (size_t)m * 4);
        const float rg = rsq(((sv[0] + sv[1]) + (sv[2] + sv[3])) * (1.0f / 512.0f) + EPS);
        const v4u yw = *(const GAS v4u*)(Y + (size_t)m * DMODEL + c);
        const f32x4 z0 = (f32x4){bflo(yw.x), bfhi(yw.x), bflo(yw.y), bfhi(yw.y)} * rg * n0, z1 = (f32x4){bflo(yw.z), bfhi(yw.z), bflo(yw.w), bfhi(yw.w)} * rg * n1;
        v4u zw; zw.x = pk2(z0[0], z0[1]); zw.y = pk2(z0[2], z0[3]); zw.z = pk2(z1[0], z1[1]); zw.w = pk2(z1[2], z1[3]);
        *(GAS v4u*)(Y + (size_t)m * DMODEL + c) = zw;
#endif
    }
}

__device__ __forceinline__ void hgrn_combine_local(const bf16* ob0, const bf16* ob1, const bf16* P, const float* onorm, bf16* Y, int rbase, int h, int tid) {
    const int l16 = tid & 15, tg = tid >> 4;
    const int c = h * 128 + 8 * l16;
    const f32x4 g0 = *(const GAS f32x4*)(onorm + c), g1 = *(const GAS f32x4*)(onorm + c + 4);
#pragma unroll 1
    for (int t0 = 0; t0 < 512; t0 += 128) {
        v4u aw[4], bw[4], sw[4];
#pragma unroll
        for (int q = 0; q < 4; ++q) { const size_t m = (size_t)(rbase + t0 + 32 * q + tg);
            aw[q] = *(const GAS v4u*)(ob0 + m * 512 + c); bw[q] = *(const GAS v4u*)(ob1 + m * 512 + c); sw[q] = *(const GAS v4u*)(P + m * DIN + COL_G + c); }
#pragma unroll
        for (int q = 0; q < 4; ++q) { const size_t m = (size_t)(rbase + t0 + 32 * q + tg);
            const f32x4 o0 = (f32x4){bflo(aw[q].x), bfhi(aw[q].x), bflo(aw[q].y), bfhi(aw[q].y)} + (f32x4){bflo(bw[q].x), bfhi(bw[q].x), bflo(bw[q].y), bfhi(bw[q].y)};
            const f32x4 o1 = (f32x4){bflo(aw[q].z), bfhi(aw[q].z), bflo(aw[q].w), bfhi(aw[q].w)} + (f32x4){bflo(bw[q].z), bfhi(bw[q].z), bflo(bw[q].w), bfhi(bw[q].w)};
            float sq = ((o0[0] * o0[0] + o0[1] * o0[1]) + (o0[2] * o0[2] + o0[3] * o0[3])) + ((o1[0] * o1[0] + o1[1] * o1[1]) + (o1[2] * o1[2] + o1[3] * o1[3]));
            sq += __shfl_xor(sq, 1); sq += __shfl_xor(sq, 2); sq += __shfl_xor(sq, 4); sq += __shfl_xor(sq, 8);
            const float r = rsq(sq * (1.0f / 128.0f) + EPS);
            const f32x4 y0 = o0 * r * g0 * (f32x4){bflo(sw[q].x), bfhi(sw[q].x), bflo(sw[q].y), bfhi(sw[q].y)};
            const f32x4 y1 = o1 * r * g1 * (f32x4){bflo(sw[q].z), bfhi(sw[q].z), bflo(sw[q].w), bfhi(sw[q].w)};
            v4u w; w.x = pk2(y0[0], y0[1]); w.y = pk2(y0[2], y0[3]); w.z = pk2(y1[0], y1[1]); w.w = pk2(y1[2], y1[3]);
            *(GAS v4u*)(Y + m * DMODEL + 512 + c) = w; }
    }
}
__device__ __forceinline__ void yg_fixup(const float* ssg, const float* gon, bf16* Y, int rbeg, int rend, int gw, int NGW, int lane) {
    const int c = 8 * lane;
    const f32x4 n0 = *(const GAS f32x4*)(gon + c), n1 = *(const GAS f32x4*)(gon + c + 4);
    for (int m0 = rbeg + gw; m0 < rend; m0 += 4 * NGW) {
        f32x4 sv[4]; v4u yw[4];
#pragma unroll
        for (int q = 0; q < 4; ++q) { const int m = m0 + q * NGW; if (m < rend) { sv[q] = *(const GAS f32x4*)(ssg + (size_t)m * 4); yw[q] = *(const GAS v4u*)(Y + (size_t)m * DMODEL + c); } }
#pragma unroll
        for (int q = 0; q < 4; ++q) { const int m = m0 + q * NGW; if (m < rend) {
            const float rg = rsq(((sv[q][0] + sv[q][1]) + (sv[q][2] + sv[q][3])) * (1.0f / 512.0f) + EPS);
            const f32x4 z0 = (f32x4){bflo(yw[q].x), bfhi(yw[q].x), bflo(yw[q].y), bfhi(yw[q].y)} * rg * n0, z1 = (f32x4){bflo(yw[q].z), bfhi(yw[q].z), bflo(yw[q].w), bfhi(yw[q].w)} * rg * n1;
            v4u zw; zw.x = pk2(z0[0], z0[1]); zw.y = pk2(z0[2], z0[3]); zw.z = pk2(z1[0], z1[1]); zw.w = pk2(z1[2], z1[3]);
            *(GAS v4u*)(Y + (size_t)m * DMODEL + c) = zw; } }
    }
}
constexpr int GM_RAWV = 0, GM_VLT = 34816, GM_WL = 69632, GM_MEAN = 104448, GM_RSTD = 104960, GM_END = 105472;
static_assert(GM_END <= RING_BYTES, "gmlp LDS");
__device__ __forceinline__ void gmlp_item(LAS unsigned char* lds, const bf16* P, const float* vstat, bf16* Y, float* ssg, const float* ln_g, const float* ln_b, const float* w_s, const float* b_s, int c, int h, int tid, int lane, int wave) {
    const int fr = lane & 15, fq = lane >> 4, R0 = 128 * c;
    if (tid < 128) { const float* vp = vstat + (size_t)(R0 + tid) * 16;
        const f32x4 a = *(const GAS f32x4*)vp, b = *(const GAS f32x4*)(vp + 4), c4 = *(const GAS f32x4*)(vp + 8), d = *(const GAS f32x4*)(vp + 12);
        const float sm = ((a[0] + a[2]) + (b[0] + b[2])) + ((c4[0] + c4[2]) + (d[0] + d[2])), sq = ((a[1] + a[3]) + (b[1] + b[3])) + ((c4[1] + c4[3]) + (d[1] + d[3]));
        const float mean = sm * (1.0f / 512.0f), var = fmaxf(sq * (1.0f / 512.0f) - mean * mean, 0.f);
        *(LAS float*)(lds + GM_MEAN + tid * 4) = mean; *(LAS float*)(lds + GM_RSTD + tid * 4) = rsq(var + EPS); }
#pragma unroll
    for (int i = 0; i < 4; ++i) { const int idx = tid + 512 * i, row = idx >> 4, c16 = idx & 15;
        *(LAS v4u*)(lds + GM_RAWV + row * 272 + c16 * 16) = *(const GAS v4u*)(P + (size_t)(R0 + row) * DIN + COL_V + 128 * h + 8 * c16); }
#pragma unroll
    for (int i = 0; i < 8; ++i) { const int idx = tid + 512 * i, tt = idx >> 5, s4 = idx & 31;
        const f32x4 w = *(const GAS f32x4*)(w_s + (size_t)h * 16384 + tt * 128 + 4 * s4);
        v2u o; o.x = pk2(w[0], w[1]); o.y = pk2(w[2], w[3]);
        *(LAS v2u*)(lds + GM_WL + tt * 272 + s4 * 8) = o; }
    __syncthreads();
    {
        const int ch = tid & 127, sq4 = tid >> 7;
        const float g = ln_g[128 * h + ch], b = ln_b[128 * h + ch];
#pragma unroll
        for (int i = 0; i < 4; ++i) {
            unsigned wv[4];
#pragma unroll
            for (int e = 0; e < 8; ++e) { const int s = 32 * sq4 + 8 * i + e;
                const float x = bf1(*(const LAS unsigned short*)(lds + GM_RAWV + s * 272 + ch * 2));
                const float y = (x - *(const LAS float*)(lds + GM_MEAN + s * 4)) * *(const LAS float*)(lds + GM_RSTD + s * 4) * g + b;
                const unsigned yb = f2bf(y);
                if (e & 1) wv[e >> 1] |= yb << 16; else wv[e >> 1] = yb; }
            *(LAS v4u*)(lds + GM_VLT + ch * 272 + (32 * sq4 + 8 * i) * 2) = (v4u){wv[0], wv[1], wv[2], wv[3]};
        }
    }
    __syncthreads();
    const int t = 16 * wave + fr;
    bf16x8 yf[4];
#pragma unroll
    for (int ks = 0; ks < 4; ++ks) yf[ks] = *(const LAS bf16x8*)(lds + GM_WL + (16 * wave + fr) * 272 + ks * 64 + fq * 16);
    const float bs = b_s[h * 128 + t];
    float ss = 0.f;
#pragma unroll
    for (int cb = 0; cb < 8; ++cb) {
        f32x4 a = {0.f, 0.f, 0.f, 0.f};
#pragma unroll
        for (int ks = 0; ks < 4; ++ks) {
            const bf16x8 x = *(const LAS bf16x8*)(lds + GM_VLT + (16 * cb + fr) * 272 + ks * 64 + fq * 16);
            a = __builtin_amdgcn_mfma_f32_16x16x32_bf16(x, yf[ks], a, 0, 0, 0);
        }
        const int ch = 128 * h + 16 * cb + 4 * fq;
        const v2u uw = *(const GAS v2u*)(P + (size_t)(R0 + t) * DIN + COL_U + ch);
        const f32x4 uu = {bflo(uw.x), bfhi(uw.x), bflo(uw.y), bfhi(uw.y)};
        a = (a + bs) * uu;
        ss += (a[0] * a[0] + a[1] * a[1]) + (a[2] * a[2] + a[3] * a[3]);
        v2u w; w.x = pk2(a[0], a[1]); w.y = pk2(a[2], a[3]);
        *(GAS v2u*)(Y + (size_t)(R0 + t) * DMODEL + ch) = w;
    }
    ss += __shfl_xor(ss, 16); ss += __shfl_xor(ss, 32);
    if (fq == 0) ssg[(size_t)(R0 + t) * 4 + h] = ss;
    __syncthreads();
}

struct Args { const float* in[22]; float* out; unsigned char* ws; int ph_lo, ph_hi, li, pad; };
constexpr int N_PHASES = 11;
#ifndef MK_N_LAUNCHES
#define MK_N_LAUNCHES 1
#endif
#ifndef DUP_PHASE
#define DUP_PHASE (-1)
#endif
__global__ void __launch_bounds__(NWAVES * 64, 2) fwd_kernel(Args args) {
    extern __shared__ __attribute__((aligned(16))) unsigned char lds_raw[];
    LAS unsigned char* lds = (LAS unsigned char*)lds_raw;
    volatile LAS unsigned* MISC = (volatile LAS unsigned*)(lds + MISC_OFF);
    const int tid = threadIdx.x, lane = tid & 63, wave = __builtin_amdgcn_readfirstlane(tid >> 6);
    const int G = gridDim.x, bx = blockIdx.x;
    const int vcu = (G % 8 == 0) ? (bx % 8) * (G / 8) + bx / 8 : bx;
    const int gw = vcu * NWAVES + wave, NGW = G * NWAVES;
    unsigned char* ws = args.ws;
    gu32* ctl = (gu32*)(ws + WS_CTL);
    for (int u = tid; u < (LDS_BYTES - LDSCTL_OFF) / 4; u += NWAVES * 64) ((LAS unsigned*)(lds + LDSCTL_OFF))[u] = 0u;
    __syncthreads();
    XcdBarrier bar = xcd_barrier_post((unsigned*)(ctl + CW_BAR) + args.li * XCD_BAR_WORDS, MISC + 8);
    const int lo = args.ph_lo, hi = args.ph_hi;
#define IN(k) (lo <= (k) && (k) < hi)
    int uni = 0, cid = bx, xr = 0, xx = 0; unsigned lseq = 0;
#define SEAM(k) do { if (IN(k) && IN((k) + 1)) { if (uni) xcd_local_barrier(bar, ++lseq); else xcd_barrier(bar); } } while (0)
    bf16* XB = (bf16*)(ws + WS_BUFA); bf16* Y = (bf16*)(ws + WS_BUFB); bf16* BIG = (bf16*)(ws + WS_BIG);
    bf16* OB0 = (bf16*)args.out; bf16* OB1 = (bf16*)args.out + (size_t)TOK * 512;
    float* VST = (float*)(ws + WS_P16);
    float* SSG = (float*)(ws + WS_SSG); float* HGE = (float*)(ws + WS_HGE); float* HGD = (float*)(ws + WS_HGD);
    float* P16_0 = (float*)(ws + WS_P16); float* P16_1 = (float*)(ws + WS_P16 + 2 * MiB); float* P16_2 = (float*)(ws + WS_P16 + 4 * MiB);

    for (int rep_ = 0; rep_ < ((DUP_PHASE == 0) ? 2 : 1); ++rep_) if (IN(0)) { p0_prologue(lds, args.in, ws, gw, NGW, wave, lane); }
    if (IN(0) && IN(1)) { xcd_barrier(bar);
        if (MISC[10] != 0u && G == 256) { uni = 1; xr = (int)MISC[11]; xx = (int)bar.x; cid = 8 * xr + xx; } }
#define PHASE1 if (IN(1)) { pg8::Gemm g{XB, (const bf16*)(ws + WS_WGU1), TOK, 2 * DFF, DMODEL}; pg8::StaticOrder S; S.init(TOK, 2 * DFF, G, cid); \
        pg8::EpiSwiGLU E{BIG, DFF, P16_0, lds + RC_OFF, 1}; pg8::gemm_phase<pg8::EpiSwiGLU, pg8::StaticOrder, PG8_ALIGN, PG8_SP2>(lds + RING_OFF, g, S, E); }
    PHASE1
#if DUP_PHASE == 1
    PHASE1
#endif
    SEAM(1);
#if DUP_PHASE == 90
    for (int r_ = 0; r_ < 10; ++r_) { if (uni) xcd_local_barrier(bar, ++lseq); else xcd_barrier(bar); }
#endif
#define PHASE2 if (IN(2)) { pg8::Gemm g{BIG, (const bf16*)(ws + WS_WD1), TOK, DMODEL, DFF}; pg8::StaticOrder S; S.init(TOK, DMODEL, G, cid); \
        pg8::EpiResidBf<true> E{XB, P16_1, 0.5f}; pg8::gemm_phase<pg8::EpiResidBf<true>, pg8::StaticOrder, PG8_ALIGN, PG8_SP2>(lds + RING_OFF, g, S, E); }
    PHASE2
#if DUP_PHASE == 2
    PHASE2
#endif
#if DUP_PHASE == 20
    if (IN(2)) { pg8::Gemm g{BIG, (const bf16*)(ws + WS_WD1), TOK, DMODEL, DFF}; pg8::StaticOrder S; S.init(TOK, DMODEL, G, cid);
        pg8::EpiNull E{SSG}; pg8::gemm_phase<pg8::EpiNull, pg8::StaticOrder, PG8_ALIGN, PG8_SP2>(lds + RING_OFF, g, S, E); }
#endif
#if DUP_PHASE == 10
    if (IN(2)) { pg8::Gemm g{XB, (const bf16*)(ws + WS_WGU1), TOK, 2 * DFF, DMODEL}; pg8::StaticOrder S; S.init(TOK, 2 * DFF, G, cid);
        pg8::EpiNull E{SSG}; pg8::gemm_phase<pg8::EpiNull, pg8::StaticOrder, PG8_ALIGN, PG8_SP2>(lds + RING_OFF, g, S, E); }
#endif
    SEAM(2);
#define PHASE3 if (IN(3)) { pg8::Gemm g{XB, (const bf16*)(ws + WS_WIN), TOK, DIN, DMODEL}; pg8::StaticOrder S; S.init(TOK, DIN, G, cid); \
        pg8::EpiMix E{BIG, DIN, P16_1, args.in[13], args.in[14], lds + RC_OFF, 2, VST}; pg8::gemm_phase<pg8::EpiMix, pg8::StaticOrder, PG8_ALIGN, PG8_SP2>(lds + RING_OFF, g, S, E); }
    PHASE3
#if DUP_PHASE == 3
    PHASE3
#endif
    SEAM(3);
    for (int rep_ = 0; rep_ < ((DUP_PHASE == 4 || DUP_PHASE == 40 || DUP_PHASE == 41) ? 2 : 1); ++rep_) if (IN(4)) {
        if (uni) {
            for (int k = xr; k < 64; k += 32) hg2_state_pass(lds, BIG, HGE, HGD, hg2_xcc_inst(xx, k), tid, lane, wave);
            for (int k = xr; k < 128; k += 32) gmlp_item(lds, BIG, VST, Y, SSG, args.in[8], args.in[9], args.in[10], args.in[11], 32 * xx + (k >> 2), k & 3, tid, lane, wave);
        } else {
        if (rep_ == 0 || DUP_PHASE != 41) for (int i = bx; i < 512; i += G) hg2_state_pass(lds, BIG, HGE, HGD, i, tid, lane, wave);
        if (rep_ == 0 || DUP_PHASE != 40) for (int it = bx; it < 1024; it += G) gmlp_item(lds, BIG, VST, Y, SSG, args.in[8], args.in[9], args.in[10], args.in[11], it >> 2, it & 3, tid, lane, wave);
        }
    }
    SEAM(4);
    for (int rep_ = 0; rep_ < ((DUP_PHASE == 5) ? 2 : 1); ++rep_) if (IN(5)) {
        if (uni) {
            const int h = xr & 3, sq = xr >> 2;
            const int seqid = xx < 4 ? 2 * xx + (sq >> 2) : 8 + (xx - 4), scf = xx < 4 ? (sq & 3) : sq, nsc = xx < 4 ? 4 : 8;
            hg2_out_pass(lds, BIG, OB1, HGE, HGD, hg2_index(seqid, h, 1, nsc - 1 - scf), tid, lane, wave);
            hg2_out_pass(lds, BIG, OB0, HGE, HGD, hg2_index(seqid, h, 0, scf), tid, lane, wave);
            asm volatile("s_waitcnt vmcnt(0)" ::: "memory"); __syncthreads();
            if (tid == 0) { asm volatile("buffer_inv sc1" ::: "memory"); asm volatile("s_waitcnt vmcnt(0)" ::: "memory"); }
            __syncthreads();
            hgrn_combine_local(OB0, OB1, BIG, args.in[15], Y, 4096 * xx + 512 * sq, h, tid);
            yg_fixup(SSG, args.in[12], Y, 4096 * xx, 4096 * xx + 4096, 8 * xr + wave, 256, lane);
        }
        else { for (int i = bx; i < 512; i += G) { const Hg2Inst I = hg2_decode(i); hg2_out_pass(lds, BIG, I.dir ? OB1 : OB0, HGE, HGD, i, tid, lane, wave); } }
    }
    if (!uni) SEAM(5);
    if (IN(6) && !uni) { if (uni) hgrn_combine(OB0, OB1, BIG, args.in[15], SSG, args.in[12], Y, 4096 * xx, 4096 * xx + 4096, 8 * xr + wave, 256, lane);
                 else hgrn_combine(OB0, OB1, BIG, args.in[15], SSG, args.in[12], Y, 0, TOK, gw, NGW, lane); }
    SEAM(6);
    if (IN(7)) { pg8::Gemm g{Y, (const bf16*)(ws + WS_WOUT), TOK, DMODEL, DMODEL}; pg8::StaticOrder S; S.init(TOK, DMODEL, G, cid);
        pg8::EpiResidBf<true> E{XB, P16_2, 1.0f};
        pg8::gemm_phase<pg8::EpiResidBf<true>, pg8::StaticOrder, PG8_ALIGN, PG8_SP2>(lds + RING_OFF, g, S, E); }
    SEAM(7);
    if (IN(8)) { pg8::Gemm g{XB, (const bf16*)(ws + WS_WGU2), TOK, 2 * DFF, DMODEL}; pg8::StaticOrder S; S.init(TOK, 2 * DFF, G, cid);
        pg8::EpiSwiGLU E{BIG, DFF, P16_2, lds + RC_OFF, 3};
        pg8::gemm_phase<pg8::EpiSwiGLU, pg8::StaticOrder, PG8_ALIGN, PG8_SP2>(lds + RING_OFF, g, S, E); }
    SEAM(8);
    if (IN(9)) { pg8::Gemm g{BIG, (const bf16*)(ws + WS_WD2), TOK, DMODEL, DFF}; pg8::StaticOrder S; S.init(TOK, DMODEL, G, cid);
        pg8::EpiResidBf<false> E{XB, nullptr, 0.5f};
        pg8::gemm_phase<pg8::EpiResidBf<false>, pg8::StaticOrder, PG8_ALIGN, PG8_SP2>(lds + RING_OFF, g, S, E); }
    SEAM(9);
    if (IN(10)) { if (uni) final_norm(XB, args.out, args.in[21], 4096 * xx, 4096 * xx + 4096, 8 * xr + wave, 256, lane); else final_norm(XB, args.out, args.in[21], 0, TOK, gw, NGW, lane); }
#undef IN
#undef SEAM
}

extern "C" void kernel_launch(void* const* d_in, const int* in_sizes, int n_in, void* d_out, int out_size, void* d_ws, size_t ws_size, hipStream_t stream) {
    static int grid = 0;
    if (grid == 0) {
        if (n_in != 22 || out_size != TOK * DMODEL || ws_size < WS_END) { fprintf(stderr, "kernel_launch: unexpected problem (n_in %d, out %d, ws %zu); nothing launched\n", n_in, out_size, ws_size); grid = -1; return; }
        int dev = 0, cus = 0, per_cu = 0;
        if (hipGetDevice(&dev) != hipSuccess || hipDeviceGetAttribute(&cus, hipDeviceAttributeMultiprocessorCount, dev) != hipSuccess) { grid = -1; return; }
        if (hipFuncSetAttribute((const void*)fwd_kernel, hipFuncAttributeMaxDynamicSharedMemorySize, LDS_BYTES) != hipSuccess) { fprintf(stderr, "kernel_launch: hipFuncSetAttribute failed\n"); grid = -1; return; }
        if (hipOccupancyMaxActiveBlocksPerMultiprocessor(&per_cu, (const void*)fwd_kernel, NWAVES * 64, LDS_BYTES) != hipSuccess || per_cu < 1) { fprintf(stderr, "kernel_launch: occupancy query says %d blocks per CU; nothing launched\n", per_cu); (void)hipGetLastError(); grid = -1; return; }
        grid = cus;
    }
    if (grid < 0) return;
    if (hipMemsetAsync((char*)d_ws + WS_CTL, 0, CTL_ZERO_BYTES, stream) != hipSuccess) return;
    Args a{};
    for (int i = 0; i < 22; ++i) a.in[i] = (const float*)d_in[i];
    a.out = (float*)d_out; a.ws = (unsigned char*)d_ws;
    constexpr int NL = MK_N_LAUNCHES;
    for (int li = 0; li < NL; ++li) {
        a.ph_lo = (NL == 1) ? 0 : li; a.ph_hi = (NL == 1) ? N_PHASES : li + 1; a.li = 0;
        hipLaunchKernelGGL(fwd_kernel, dim3(grid), dim3(NWAVES * 64), LDS_BYTES, stream, a);
        if (hipPeekAtLastError() != hipSuccess) { fprintf(stderr, "kernel_launch: launch %d failed\n", li); break; }
    }
}
```
